# Optimizing an MI355X kernel written in HIP

```python
import math
import jax
import jax.numpy as jnp
from jax import lax
import numpy as np

D_MODEL = 2048
BATCH = 4
SEQ = 2048
DEPTH = 2

GRID_W = 64
CTX_LEN = 256
EPS = 1e-6
N_MIXERS = 4
MIX_WIDTH = D_MODEL
GROUP_W = MIX_WIDTH // N_MIXERS
DN_HEADS = 4
DN_HEAD_DIM = GROUP_W // DN_HEADS
DN_CHUNK = 64
SHORT_CONV = 5
SG_CHUNK = 128
SG_HEADS = 4
SG_HEAD_DIM = GROUP_W // SG_HEADS
POOL_WINDOWS = (2, 4, 8, 16)
POOL_GROUP_DIM = GROUP_W // len(POOL_WINDOWS)
CONF_CONV = 31
QKV_COLS = 3 * GROUP_W
AB_COLS = 4 * DN_HEADS
DN_STATE_COLS = QKV_COLS + AB_COLS
Z_COLS = GROUP_W
SG_COLS = 2 * GROUP_W
POOL_COLS = GROUP_W
CV_COLS = 2 * GROUP_W
IN_WIDTH = DN_STATE_COLS + Z_COLS + SG_COLS + POOL_COLS + CV_COLS
D_FF = 256 * ((8 * D_MODEL // 3 + 255) // 256)
N_EXPERTS = 8
TOP_K = 2
D_FF_EXPERT = 7 * D_MODEL // 2
N_DENSE = (DEPTH + 1) // 2
N_MOE = DEPTH // 2

kernel_name = 'hybrid_headgroup_diffusion_trunk'

F32 = jnp.float32


def rmsnorm(x, g):
    xf = x.astype(F32)
    y = xf * lax.rsqrt(jnp.mean(xf * xf, axis=-1, keepdims=True) + EPS)
    return (y * g.astype(F32)).astype(x.dtype)


def layernorm(x, g, b):
    xf = x.astype(F32)
    mu = jnp.mean(xf, axis=-1, keepdims=True)
    xc = xf - mu
    var = jnp.mean(xc * xc, axis=-1, keepdims=True)
    return (xc * lax.rsqrt(var + EPS) * g.astype(F32) + b.astype(F32)).astype(x.dtype)


def l2norm(x):
    return x * lax.rsqrt(jnp.sum(x * x, axis=-1, keepdims=True) + EPS)


def modulate(h, shift, scale):
    return h * (1 + scale) + shift


def depthwise_conv(x, w):
    pad = w.shape[0] // 2
    return lax.conv_general_dilated(
        x, w.astype(x.dtype)[:, None, :], window_strides=(1,), padding=[(pad, pad)],
        dimension_numbers=('NWC', 'WIO', 'NWC'), feature_group_count=x.shape[-1])


def grid_pos_embed(rows, dim):
    r = jnp.repeat(jnp.arange(rows, dtype=F32), GRID_W)
    col = jnp.tile(jnp.arange(GRID_W, dtype=F32), rows)
    quarter = dim // 4
    freq = jnp.exp(-math.log(10000.0) * jnp.arange(quarter, dtype=F32) / quarter)
    ar = r[:, None] * freq
    ac = col[:, None] * freq
    return jnp.concatenate([jnp.sin(ar), jnp.cos(ar), jnp.sin(ac), jnp.cos(ac)], axis=-1)


def delta_chunked(q, k, v, log_a, beta, s0):
    B_, T, H, _ = q.shape
    C = DN_CHUNK
    N = T // C

    def chunk(t):
        t = t.reshape((B_, N, C, H) + t.shape[3:])
        return jnp.moveaxis(t, (1, 3), (0, 2))

    qc, kc, vc = chunk(q), chunk(k), chunk(v)
    g = jnp.cumsum(chunk(log_a), axis=-1)
    bc = chunk(beta)[..., None]
    kb = kc * bc
    vb = vc * bc
    idx = jnp.arange(C)
    lower = idx[:, None] >= idx[None, :]
    strict = idx[:, None] > idx[None, :]
    gdiff = g[..., :, None] - g[..., None, :]
    decay = jnp.where(lower, jnp.exp(jnp.where(lower, gdiff, 0.0)), 0.0)
    lmat = jnp.where(strict, jnp.einsum('nbhid,nbhjd->nbhij', kb, kc) * decay, 0.0)
    amat = jnp.eye(C, dtype=F32) + lmat
    rhs = jnp.concatenate([vb, kb * jnp.exp(g)[..., None]], axis=-1)
    sol = lax.linalg.triangular_solve(amat, rhs, left_side=True, lower=True)
    dv = v.shape[-1]
    u = sol[..., :dv]
    w = sol[..., dv:]
    qk = jnp.where(lower, jnp.einsum('nbhid,nbhjd->nbhij', qc, kc) * decay, 0.0)
    g_last = g[..., -1]

    def step(S, inp):
        qi, ki, ui, wi, gi, gl, qki = inp
        v_new = ui - jnp.einsum('bhcd,bhde->bhce', wi, S)
        o = (jnp.einsum('bhcd,bhde->bhce', qi * jnp.exp(gi)[..., None], S)
             + jnp.einsum('bhij,bhje->bhie', qki, v_new))
        S = (S * jnp.exp(gl)[..., None, None]
             + jnp.einsum('bhcd,bhce->bhde', ki * jnp.exp(gl[..., None] - gi)[..., None], v_new))
        return S, o

    S, o = lax.scan(step, s0, (qc, kc, u, w, g, g_last, qk))
    o = jnp.moveaxis(o, (0, 2), (1, 3)).reshape(B_, T, H, dv)
    return o, S


def dn_prepare(p, conv_w, a_log, dt_bias):
    B_, T, _ = p.shape
    qkv = jax.nn.silu(depthwise_conv(p[..., :QKV_COLS], conv_w)).astype(F32)
    qkv = qkv.reshape(B_, T, 3, DN_HEADS, DN_HEAD_DIM)
    q = l2norm(qkv[:, :, 0]) * (DN_HEAD_DIM ** -0.5)
    k = l2norm(qkv[:, :, 1])
    v = qkv[:, :, 2]
    ab = p[..., QKV_COLS:DN_STATE_COLS].astype(F32).reshape(B_, T, 4, DN_HEADS)
    log_a = -jnp.exp(a_log.astype(F32)) * jax.nn.softplus(ab[:, :, 0:2] + dt_bias.astype(F32))
    beta = jax.nn.sigmoid(ab[:, :, 2:4])
    return q, k, v, log_a, beta


def dn_bidir_scan(q, k, v, log_a, beta, s0_f, s0_b):
    o_f, s_f = delta_chunked(q, k, v, log_a[:, :, 0], beta[:, :, 0], s0_f)
    fl = lambda t: jnp.flip(t, axis=1)
    o_b, s_b = delta_chunked(fl(q), fl(k), fl(v), fl(log_a[:, :, 1]), fl(beta[:, :, 1]), s0_b)
    return o_f + fl(o_b), s_f, s_b


def gated_head_norm(o, z, g):
    B_, T = z.shape[:2]
    zf = z.astype(F32).reshape(B_, T, DN_HEADS, DN_HEAD_DIM)
    y = o * lax.rsqrt(jnp.mean(o * o, axis=-1, keepdims=True) + EPS) * g.astype(F32) * jax.nn.silu(zf)
    return y.reshape(B_, T, GROUP_W).astype(z.dtype)


def spatial_gating(p, ln_g, ln_b, w_s, b_s):
    B_, T, _ = p.shape
    n = T // SG_CHUNK
    u, v = jnp.split(jax.nn.gelu(p), 2, axis=-1)
    v = layernorm(v, ln_g, ln_b).reshape(B_, n, SG_CHUNK, SG_HEADS, SG_HEAD_DIM)
    s = jnp.einsum('hij,bnjhd->bnihd', w_s, v) + b_s.T[None, None, :, :, None]
    return u * s.reshape(B_, T, GROUP_W)


def multiscale_pool(p, pool_w, pool_scale):
    B_, T, _ = p.shape
    xg = p.reshape(B_, T, len(POOL_WINDOWS), POOL_GROUP_DIM)
    cs = jnp.pad(jnp.cumsum(xg.astype(F32), axis=1), ((0, 0), (1, 0), (0, 0), (0, 0)))
    t = jnp.arange(T)
    means = []
    for gi, w in enumerate(POOL_WINDOWS):
        lo = jnp.clip(t - w // 2, 0, T)
        hi = jnp.clip(t + w // 2, 0, T)
        csg = cs[:, :, gi]
        means.append((csg[:, hi] - csg[:, lo]) / (hi - lo).astype(F32)[None, :, None])
    y = jnp.stack(means, axis=2).astype(p.dtype) - xg
    y = jnp.einsum('btgd,gde->btge', y, pool_w).reshape(B_, T, GROUP_W)
    return y * pool_scale


def conformer_conv(p, cv_w, cv_b, ln_g, ln_b):
    a, g = jnp.split(p, 2, axis=-1)
    h = depthwise_conv(a * jax.nn.sigmoid(g), cv_w) + cv_b
    return jax.nn.silu(layernorm(h, ln_g, ln_b))


def mixers_out(p, o_dn, dn_norm_g, sg_ln_g, sg_ln_b, sg_w, sg_b, pool_w, pool_scale,
               cv_w, cv_b, cv_ln_g, cv_ln_b, w_out):
    off = DN_STATE_COLS
    z = p[..., off:off + Z_COLS]
    off += Z_COLS
    p_sg = p[..., off:off + SG_COLS]
    off += SG_COLS
    p_pool = p[..., off:off + POOL_COLS]
    off += POOL_COLS
    p_cv = p[..., off:off + CV_COLS]
    y = jnp.concatenate([
        gated_head_norm(o_dn, z, dn_norm_g),
        spatial_gating(p_sg, sg_ln_g, sg_ln_b, sg_w, sg_b),
        multiscale_pool(p_pool, pool_w, pool_scale),
        conformer_conv(p_cv, cv_w, cv_b, cv_ln_g, cv_ln_b),
    ], axis=-1)
    return y @ w_out


def swiglu(h, w1, w3, w2):
    return (jax.nn.silu(h @ w1) * (h @ w3)) @ w2


def moe_swiglu(h, router_w, router_b, w1, w3, w2):
    logits = (h @ router_w).astype(F32) + router_b.astype(F32)
    top_val, top_idx = lax.top_k(logits, TOP_K)
    gates = jax.nn.softmax(top_val, axis=-1)
    comb = jnp.sum(jax.nn.one_hot(top_idx, N_EXPERTS, dtype=F32) * gates[..., None], axis=-2)
    comb = comb.astype(h.dtype)
    out = jnp.zeros_like(h)
    for e in range(N_EXPERTS):
        out = out + comb[..., e:e + 1] * swiglu(h, w1[e], w3[e], w2[e])
    return out


def setup_inputs(seed: int = 0) -> dict:
    key = jax.random.key(seed)
    ks = iter(jax.random.split(key, 40))
    nrm = lambda shape, s: jax.random.normal(next(ks), shape, F32) * s
    gain = lambda shape: 1.0 + nrm(shape, 0.02)
    D, L = D_MODEL, DEPTH
    x = nrm((BATCH, SEQ, D), 1.0)
    c = nrm((BATCH, D), 1.0)
    ctx = nrm((BATCH, CTX_LEN, D), 1.0)
    c_ctx = nrm((D,), 1.0)
    ada_w = nrm((L, D, 6 * D), 0.5 * D ** -0.5)
    ada_b = nrm((L, 6 * D), 0.01)
    norm_mix_g = gain((L, D))
    w_in = nrm((L, D, IN_WIDTH), D ** -0.5)
    dn_conv_w = nrm((L, SHORT_CONV, QKV_COLS), SHORT_CONV ** -0.5)
    dn_a_log = jnp.log(jax.random.uniform(next(ks), (L, 2, DN_HEADS), F32, 1.0, 16.0))
    dt = jnp.exp(jax.random.uniform(next(ks), (L, 2, DN_HEADS), F32, math.log(1e-3), math.log(1e-1)))
    dn_dt_bias = dt + jnp.log(-jnp.expm1(-dt))
    dn_norm_g = gain((L, DN_HEAD_DIM))
    sg_ln_g = gain((L, GROUP_W))
    sg_ln_b = nrm((L, GROUP_W), 0.01)
    sg_w = nrm((L, SG_HEADS, SG_CHUNK, SG_CHUNK), SG_CHUNK ** -0.5)
    sg_b = 1.0 + nrm((L, SG_HEADS, SG_CHUNK), 0.02)
    pool_w = nrm((L, len(POOL_WINDOWS), POOL_GROUP_DIM, POOL_GROUP_DIM), POOL_GROUP_DIM ** -0.5)
    pool_scale = gain((L, GROUP_W))
    cv_w = nrm((L, CONF_CONV, GROUP_W), CONF_CONV ** -0.5)
    cv_b = nrm((L, GROUP_W), 0.01)
    cv_ln_g = gain((L, GROUP_W))
    cv_ln_b = nrm((L, GROUP_W), 0.01)
    w_out = nrm((L, MIX_WIDTH, D), MIX_WIDTH ** -0.5)
    norm_ffn_g = gain((L, D))
    ffn_w1 = nrm((N_DENSE, D, D_FF), D ** -0.5)
    ffn_w3 = nrm((N_DENSE, D, D_FF), D ** -0.5)
    ffn_w2 = nrm((N_DENSE, D_FF, D), D_FF ** -0.5)
    router_w = nrm((N_MOE, D, N_EXPERTS), D ** -0.5)
    router_b = nrm((N_MOE, N_EXPERTS), 0.01)
    moe_w1 = nrm((N_MOE, N_EXPERTS, D, D_FF_EXPERT), D ** -0.5)
    moe_w3 = nrm((N_MOE, N_EXPERTS, D, D_FF_EXPERT), D ** -0.5)
    moe_w2 = nrm((N_MOE, N_EXPERTS, D_FF_EXPERT, D), D_FF_EXPERT ** -0.5)
    final_norm_g = gain((D,))
    return {'x': x, 'c': c, 'ctx': ctx, 'c_ctx': c_ctx, 'ada_w': ada_w, 'ada_b': ada_b,
            'norm_mix_g': norm_mix_g, 'w_in': w_in, 'dn_conv_w': dn_conv_w, 'dn_a_log': dn_a_log,
            'dn_dt_bias': dn_dt_bias, 'dn_norm_g': dn_norm_g, 'sg_ln_g': sg_ln_g, 'sg_ln_b': sg_ln_b,
            'sg_w': sg_w, 'sg_b': sg_b, 'pool_w': pool_w, 'pool_scale': pool_scale, 'cv_w': cv_w,
            'cv_b': cv_b, 'cv_ln_g': cv_ln_g, 'cv_ln_b': cv_ln_b, 'w_out': w_out,
            'norm_ffn_g': norm_ffn_g, 'ffn_w1': ffn_w1, 'ffn_w3': ffn_w3, 'ffn_w2': ffn_w2,
            'router_w': router_w, 'router_b': router_b, 'moe_w1': moe_w1, 'moe_w3': moe_w3,
            'moe_w2': moe_w2, 'final_norm_g': final_norm_g}


def reference(x, c, ctx, c_ctx, ada_w, ada_b, norm_mix_g, w_in, dn_conv_w, dn_a_log, dn_dt_bias,
              dn_norm_g, sg_ln_g, sg_ln_b, sg_w, sg_b, pool_w, pool_scale, cv_w, cv_b, cv_ln_g,
              cv_ln_b, w_out, norm_ffn_g, ffn_w1, ffn_w3, ffn_w2, router_w, router_b, moe_w1,
              moe_w3, moe_w2, final_norm_g):
    B_, T, D = x.shape
    ROWS = T // GRID_W
    x = x + grid_pos_embed(ROWS, D).astype(x.dtype)[None]
    h_ctx = ctx
    s_c = jax.nn.silu(c)
    s_cc = jax.nn.silu(c_ctx)
    zero_state = jnp.zeros((B_, DN_HEADS, DN_HEAD_DIM, DN_HEAD_DIM), F32)
    for l in range(DEPTH):
        last = l == DEPTH - 1
        mod_x = (s_c @ ada_w[l] + ada_b[l])[:, None, :]
        mod_c = (s_cc @ ada_w[l] + ada_b[l])[None, None, :]
        shm, scm, gm, shf, scf, gf = jnp.split(mod_x, 6, axis=-1)
        cshm, cscm, cgm, cshf, cscf, cgf = jnp.split(mod_c, 6, axis=-1)
        dn_args = (dn_conv_w[l], dn_a_log[l], dn_dt_bias[l])
        bcd_args = (dn_norm_g[l], sg_ln_g[l], sg_ln_b[l], sg_w[l], sg_b[l], pool_w[l], pool_scale[l],
                    cv_w[l], cv_b[l], cv_ln_g[l], cv_ln_b[l], w_out[l])

        nc = modulate(rmsnorm(h_ctx, norm_mix_g[l]), cshm, cscm)
        pc = nc @ (w_in[l][:, :DN_STATE_COLS] if last else w_in[l])
        o_c, s_f, s_b = dn_bidir_scan(*dn_prepare(pc, *dn_args), zero_state, zero_state)
        nx = modulate(rmsnorm(x, norm_mix_g[l]), shm, scm)
        px = nx @ w_in[l]
        o_x, _, _ = dn_bidir_scan(*dn_prepare(px, *dn_args), s_f, s_b)
        x = x + gm * mixers_out(px, o_x, *bcd_args)
        if not last:
            h_ctx = h_ctx + cgm * mixers_out(pc, o_c, *bcd_args)

        if l % 2 == 0:
            i = l // 2
            ffn = lambda h: swiglu(h, ffn_w1[i], ffn_w3[i], ffn_w2[i])
        else:
            i = l // 2
            ffn = lambda h: moe_swiglu(h, router_w[i], router_b[i], moe_w1[i], moe_w3[i], moe_w2[i])
        x = x + gf * ffn(modulate(rmsnorm(x, norm_ffn_g[l]), shf, scf))
        if not last:
            h_ctx = h_ctx + cgf * ffn(modulate(rmsnorm(h_ctx, norm_ffn_g[l]), cshf, cscf))
    return rmsnorm(x, final_norm_g)
```

```cpp
#include <hip/hip_runtime.h>
#include <cstdio>
#include <cstdint>
#define MK_DEBUG 0
#define DBG_LAYER 0
#define MK_ONE_LAUNCH 1
#define GAS __attribute__((address_space(1)))
#define LAS __attribute__((address_space(3)))
typedef unsigned short bf16;
typedef short bf16x8 __attribute__((ext_vector_type(8)));
typedef float f32x4 __attribute__((ext_vector_type(4)));
typedef float f32x2 __attribute__((ext_vector_type(2)));
typedef unsigned u32x4 __attribute__((ext_vector_type(4)));
typedef unsigned u32x2 __attribute__((ext_vector_type(2)));

namespace mk {
constexpr int D = 2048, NB = 4, TX = 2048, TC = 256, MX = NB * TX, MC = NB * TC, MT = MX + MC;
constexpr int INW = 4624, NIN = 4608;
constexpr int PQ = 0, PK = 512, PV = 1024, PZ = 1536, PSGU = 2048, PSGV = 2560, PPOOL = 3072, PCVA = 3584, PCVG = 4096;
constexpr int DFF = 5632, NE = 8, DFE = 7168;
constexpr int NCH = MT / 64;
constexpr int MSORT = 2 * MX + NE * 256;
constexpr float EPS = 1e-6f;
constexpr int NTHR = 512, NWAVE = 8;
constexpr int LDS_BYTES = 163840;
constexpr int LDS_BARW = LDS_BYTES - 16;

constexpr size_t al(size_t x) { return (x + 4095) & ~(size_t)4095; }
constexpr size_t WS_CTL = 0, CTL_BYTES = 1u << 20;
constexpr size_t WS_MODV = WS_CTL + CTL_BYTES;
constexpr size_t WS_POS = WS_MODV + al((size_t)2 * 5 * 12288 * 4);
constexpr size_t WS_PWT = WS_POS + al((size_t)TX * D * 4);
constexpr size_t WS_WIN = WS_PWT + al((size_t)2 * 4 * 128 * 128 * 2);
constexpr size_t WS_WOUT = WS_WIN + al((size_t)2 * NIN * D * 2);
constexpr size_t WS_W13 = WS_WOUT + al((size_t)2 * D * D * 2);
constexpr size_t WS_W2 = WS_W13 + al((size_t)2 * DFF * D * 2);
constexpr size_t WS_MW13 = WS_W2 + al((size_t)D * DFF * 2);
constexpr size_t WS_MW2 = WS_MW13 + al((size_t)NE * 2 * DFE * D * 2);
constexpr size_t WS_XS = WS_MW2 + al((size_t)NE * D * DFE * 2);
constexpr size_t WS_AN = WS_XS + al((size_t)MT * D * 4);
constexpr size_t WS_ABF = WS_AN + al((size_t)MT * D * 2);
constexpr size_t WS_ROUTE = WS_ABF + al((size_t)MT * 16 * 4);
constexpr size_t WS_BIG = WS_ROUTE + al((size_t)1 << 20);
constexpr size_t WS_P = WS_BIG;
constexpr size_t DN_FRAG = (size_t)2 * NCH * 4;
constexpr size_t WS_DNW = WS_P + al((size_t)MT * NIN * 2);
constexpr size_t WS_DNQG = WS_DNW + al(DN_FRAG * 16384);
constexpr size_t WS_DNKDT = WS_DNQG + al(DN_FRAG * 16384);
constexpr size_t WS_DNQK = WS_DNKDT + al(DN_FRAG * 16384);
constexpr size_t WS_DNU = WS_DNQK + al(DN_FRAG * 8192);
constexpr size_t WS_EGL = WS_DNU + al(DN_FRAG * 32768);
constexpr size_t WS_O = WS_EGL + al(DN_FRAG * 4);
constexpr size_t WS_Y = WS_O + al((size_t)2 * MT * 512 * 4);
constexpr size_t WS_MIX_END = WS_Y + al((size_t)MT * D * 2);
constexpr size_t WS_HM = WS_BIG;
constexpr size_t WS_AS = WS_HM + al((size_t)MSORT * DFE * 2);
constexpr size_t WS_OUTS = WS_AS + al((size_t)MSORT * D * 2);
constexpr size_t WS_FFN_END = WS_OUTS + al((size_t)MSORT * D * 4);
constexpr size_t WS_END = WS_FFN_END > WS_MIX_END ? WS_FFN_END : WS_MIX_END;
constexpr int R_TE = 0;
constexpr int R_TG = R_TE + MX * 2;
constexpr int R_RANK = R_TG + MX * 2;
constexpr int R_POS = R_RANK + MX * 2;
constexpr int R_TILEE = R_POS + MX * 2;
constexpr int R_NT = R_TILEE + 128;
constexpr int CW_CNT = 64;
constexpr int CW_BAR = 4096;

__device__ __forceinline__ float silu(float x) { return x * __builtin_amdgcn_rcpf(1.f + __expf(-x)); }
__device__ __forceinline__ float sigm(float x) { return __builtin_amdgcn_rcpf(1.f + __expf(-x)); }
__device__ __forceinline__ float gelu_tanh(float x) { const float u = 0.7978845608028654f * (x + 0.044715f * x * x * x); const float e = __expf(2.f * u); return x * (1.f - __builtin_amdgcn_rcpf(1.f + e)); }
__device__ __forceinline__ float softplus(float x) { return x > 20.f ? x : log1pf(__expf(x)); }
__device__ __forceinline__ unsigned f2bf(float f) { unsigned u = __builtin_bit_cast(unsigned, f); return (u + 0x7fffu + ((u >> 16) & 1u)) >> 16; }
__device__ __forceinline__ unsigned pk2(float lo, float hi) { return f2bf(lo) | (f2bf(hi) << 16); }
__device__ __forceinline__ float bf2f(unsigned short b) { return __builtin_bit_cast(float, (unsigned)b << 16); }
__device__ __forceinline__ float bflo(unsigned w) { return __builtin_bit_cast(float, w << 16); }
__device__ __forceinline__ float bfhi(unsigned w) { return __builtin_bit_cast(float, w & 0xffff0000u); }
__device__ __forceinline__ bf16x8 pack8(const float* v) { u32x4 w; w.x = pk2(v[0], v[1]); w.y = pk2(v[2], v[3]); w.z = pk2(v[4], v[5]); w.w = pk2(v[6], v[7]); return __builtin_bit_cast(bf16x8, w); }
__device__ __forceinline__ void unpack8(u32x4 w, float* v) { v[0] = bflo(w.x); v[1] = bfhi(w.x); v[2] = bflo(w.y); v[3] = bfhi(w.y); v[4] = bflo(w.z); v[5] = bfhi(w.z); v[6] = bflo(w.w); v[7] = bfhi(w.w); }
__device__ __forceinline__ float wave_sum(float v) {
#pragma unroll
    for (int o = 1; o < 64; o <<= 1) v += __shfl_xor(v, o);
    return v;
}
__device__ __forceinline__ float sum16(float v) {
#pragma unroll
    for (int o = 1; o < 16; o <<= 1) v += __shfl_xor(v, o);
    return v;
}
__device__ __forceinline__ void rowinfo(int row, int& base, int& T, int& t, int& mv) {
    if (row < MX) { const int b = row >> 11; base = b << 11; T = TX; t = row - base; mv = b; }
    else { const int r = row - MX, b = r >> 8; base = MX + (b << 8); T = TC; t = r - (b << 8); mv = 4; }
}
__device__ __forceinline__ int dirrow(int row, int dir) { int base, T, t, mv; rowinfo(row, base, T, t, mv); return dir ? base + (T - 1 - t) : row; }
#define LDS_WAIT() asm volatile("s_waitcnt lgkmcnt(0)" ::: "memory")
#define VM_WAIT() asm volatile("s_waitcnt vmcnt(0)" ::: "memory")
#define WG_BAR() do { __syncthreads(); } while (0)
}
#define XB_TMO      128
#define XB_XCNT(j)  (256  + 64 * (j))
#define XB_XSUB(j)  (1280 + 64 * (j))
#define XB_XGEN(j)  (2304 + 64 * (j))
#define XB_TOP      3328
#define XB_TOPGEN   3392
#define XCD_BAR_WORDS 3456
#define XB_SPIN_CAP (1u << 18)
#define LAS __attribute__((address_space(3)))

__device__ __forceinline__ unsigned xb_ld(unsigned* p)              { return __hip_atomic_load(p, __ATOMIC_RELAXED, __HIP_MEMORY_SCOPE_AGENT); }
__device__ __forceinline__ unsigned xb_add(unsigned* p, unsigned v) { return __hip_atomic_fetch_add(p, v, __ATOMIC_RELAXED, __HIP_MEMORY_SCOPE_AGENT); }
__device__ __forceinline__ unsigned xb_xcc_id() { return (unsigned)__builtin_amdgcn_s_getreg((3 << 11) | 20) & 0xFu; }
#define XB_SPIN(cond, bar) do { unsigned _sp = 0; while (cond) { __builtin_amdgcn_s_sleep(1); \
    if ((++_sp & 255u) == 0u) { if (xb_ld(&(bar)[XB_TMO])) break; if (_sp > XB_SPIN_CAP) { atomicAdd(&(bar)[XB_TMO], 1u); break; } } } } while (0)

struct XcdBarrier {
    unsigned* bar; unsigned x;
    volatile LAS unsigned* st;
};

__device__ __forceinline__ XcdBarrier xcd_barrier_post(unsigned* bar, volatile LAS unsigned* st) {
    XcdBarrier b; b.bar = bar; b.x = xb_xcc_id(); b.st = st;
    if (threadIdx.x == 0) (void)xb_add(&bar[XB_XCNT(b.x)], 1u);
    return b;
}
__device__ __forceinline__ void xcd_barrier_complete(unsigned* bar, unsigned x, unsigned& nloc, unsigned& nx) {
    const unsigned G = gridDim.x * gridDim.y * gridDim.z;
    unsigned sum, cnt, mine, sp = 0u;
    for (;;) {
        sum = 0u; cnt = 0u; mine = 0u;
#pragma unroll
        for (unsigned j = 0; j < 16; ++j) { const unsigned c = xb_ld(&bar[XB_XCNT(j)]); sum += c; cnt += (c > 0u) ? 1u : 0u; mine = (j == x) ? c : mine; }
        if (sum == G) break;
        __builtin_amdgcn_s_sleep(1);
        if ((++sp & 255u) == 0u) { if (xb_ld(&bar[XB_TMO])) break; if (sp > XB_SPIN_CAP) { atomicAdd(&bar[XB_TMO], 1u); break; } }
    }
    nloc = mine > 0u ? mine : 1u; nx = cnt > 0u ? cnt : 1u;
}

__device__ __forceinline__ void xcd_barrier(const XcdBarrier& b) {
    asm volatile("s_waitcnt vmcnt(0)" ::: "memory");
    __syncthreads();
    if (threadIdx.x == 0) {
        unsigned* bar = b.bar;
        __builtin_amdgcn_s_waitcnt(0);
        unsigned nloc = b.st[0], nx = b.st[1];
        if (nloc == 0u) { xcd_barrier_complete(bar, b.x, nloc, nx); b.st[0] = nloc; b.st[1] = nx; }
        const unsigned old = xb_add(&bar[XB_XSUB(b.x)], 1u);
        const unsigned gen = old / nloc;
        if (old + 1u == (gen + 1u) * nloc) {
            __builtin_amdgcn_fence(__ATOMIC_RELEASE, "agent");
            asm volatile("s_waitcnt vmcnt(0)" ::: "memory");
            const unsigned og = xb_add(&bar[XB_TOP], 1u);
            const unsigned tg = og / nx;
            if (og + 1u == (tg + 1u) * nx) xb_add(&bar[XB_TOPGEN], 1u);
            else XB_SPIN(xb_ld(&bar[XB_TOPGEN]) == tg, bar);
            __builtin_amdgcn_fence(__ATOMIC_ACQUIRE, "agent");
            xb_add(&bar[XB_XGEN(b.x)], 1u);
            asm volatile("s_waitcnt vmcnt(0)" ::: "memory");
        } else {
            XB_SPIN(xb_ld(&bar[XB_XGEN(b.x)]) == gen, bar);
            __builtin_amdgcn_fence(__ATOMIC_ACQUIRE, "agent");
            asm volatile("s_waitcnt vmcnt(0)" ::: "memory");
        }
    }
    __syncthreads();
}
namespace pg8 {
#define PG8_LAS __attribute__((address_space(3)))
typedef unsigned short bf16_t;
typedef short bf16x8 __attribute__((ext_vector_type(8)));
typedef float f32x4 __attribute__((ext_vector_type(4)));
typedef unsigned u32x4 __attribute__((ext_vector_type(4)));
constexpr int BM = 256, BK = 64, HALF = 128, HTB = HALF * BK * 2  , STAGE_BYTES = 8 * HTB, NXCD = 8, WGM = 8;

__host__ __device__ __forceinline__ int lds_byte(int r, int c) { const int st = (r >> 4) * 2 + (c >> 5), rr = r & 15, cc = c & 31, ob = rr * 64 + cc * 2; return st * 1024 + (ob ^ (((ob >> 9) & 1) << 5)); }
__host__ __device__ __forceinline__ void stage_rc(int b, int& R, int& C) { const int st = b / 1024, sb = b % 1024, swz = sb ^ (((sb >> 9) & 1) << 5); R = (st >> 1) * 16 + swz / 64; C = (st & 1) * 32 + (swz % 64) / 2; }
__host__ __device__ __forceinline__ int perm32(int rho) { const int n = rho >> 4, i = rho & 15; return 8 * (i >> 2) + 4 * n + (i & 3); }

struct Unit { int pm, pn; };
struct Gemm { const bf16_t* A; const bf16_t* Bt; int M, N, K; };

struct StaticOrder {
    int nM, nN, nwg, G, c;
    __host__ __device__ void init(int M, int N, int G_, int c_) { nM = M / BM; nN = N / BM; nwg = nM * nN; G = G_; c = c_; }
    __host__ __device__ bool next(int i, Unit& u) const {
        const long L = (long)i * G + c; if (L >= nwg) return false;
        int wgid = (int)L; { const int q = nwg / NXCD, r = nwg % NXCD, xcd = wgid % NXCD, off = wgid / NXCD; wgid = (xcd < r ? xcd * (q + 1) : r * (q + 1) + (xcd - r) * q) + off; }
        const int nig = WGM * nN, gid = wgid / nig, fm = gid * WGM, gsz = (nM - fm) < WGM ? (nM - fm) : WGM;
        u.pm = fm + ((wgid % nig) % gsz); u.pn = (wgid % nig) / gsz; return true;
    }
    __device__ __forceinline__ void a_ready(const Unit&) const {}
    __device__ __forceinline__ void done(const Unit&) const {}
};
__device__ __forceinline__ unsigned cvt_pk_bf16(float lo, float hi) { unsigned r; asm volatile("v_cvt_pk_bf16_f32 %0, %1, %2" : "=v"(r) : "v"(lo), "v"(hi)); return r; }
typedef float f32x2 __attribute__((ext_vector_type(2)));
template <class Epi, class Sched, bool ALIGN_EPI = false, bool SP2 = false>
__device__ __forceinline__ void gemm_phase(PG8_LAS unsigned char* lds, const Gemm g, const Sched& S, const Epi& E) {
    const int tid = threadIdx.x, wid = __builtin_amdgcn_readfirstlane(tid >> 6), lane = tid & 63, wr = wid >> 2, wc = wid & 3, fr = lane & 15, fq = lane >> 4;
    const int K = g.K, nt = K / BK;
    unsigned voffA[2], voffB[2];
#pragma unroll
    for (int i = 0; i < 2; ++i) { int R, C; stage_rc(tid * 16 + i * 8192, R, C); const int Rb = Epi::PERM ? ((R & ~31) + perm32(R & 31)) : R;
        voffA[i] = (unsigned)(R * K + C) * 2u; voffB[i] = (unsigned)(Rb * K + C) * 2u; }
    const size_t kstep = (size_t)(BK * 2);
    const size_t hstep = (size_t)HALF * K * 2;
    const size_t tstep = 2 * hstep;
    const unsigned ldsw = (unsigned)wid * 1024u;
    const int aoff = lds_byte(wr * 64 + fr, fq * 8), boff = lds_byte(wc * 32 + fr, fq * 8);
#define PG8_SA(b, h) (((b) * 2 + (h)) * HTB)
#define PG8_SB(b, h) ((4 + (b) * 2 + (h)) * HTB)
#define PG8_STAGE(bufoff, gbase, voff) do { _Pragma("unroll") for (int _i = 0; _i < 2; ++_i) \
        __builtin_amdgcn_global_load_lds((const unsigned*)((const char*)(gbase) + (voff)[_i]), (PG8_LAS unsigned*)(lds + (bufoff) + ldsw + _i * 8192), 16, 0, 0); } while (0)
#define PG8_LDA(dst, b, h) do { _Pragma("unroll") for (int m = 0; m < 4; ++m) _Pragma("unroll") for (int k = 0; k < 2; ++k) dst[m][k] = *(const PG8_LAS bf16x8*)(lds + PG8_SA(b, h) + aoff + m * 2048 + k * 1024); } while (0)
#define PG8_LDB(dst, b, h) do { _Pragma("unroll") for (int n = 0; n < 2; ++n) _Pragma("unroll") for (int k = 0; k < 2; ++k) dst[n][k] = *(const PG8_LAS bf16x8*)(lds + PG8_SB(b, h) + boff + n * 2048 + k * 1024); } while (0)
#define PG8_MMA(ai, bj, At, Bt) do { __builtin_amdgcn_s_setprio(1); _Pragma("unroll") for (int m = 0; m < 4; ++m) _Pragma("unroll") for (int n = 0; n < 2; ++n) _Pragma("unroll") for (int k = 0; k < 2; ++k) \
        acc[ai][bj][m][n] = __builtin_amdgcn_mfma_f32_16x16x32_bf16(Bt[n][k], At[m][k], acc[ai][bj][m][n], 0, 0, 0); __builtin_amdgcn_s_setprio(0); } while (0)
#define PG8_WAIT_V(n) asm volatile("s_waitcnt vmcnt(" #n ")" ::: "memory")
#define PG8_WAIT_L(n) asm volatile("s_waitcnt lgkmcnt(" #n ")" ::: "memory")
#define PG8_BAR __builtin_amdgcn_s_barrier()
#define PG8_SCHED __builtin_amdgcn_sched_barrier(0)
    Unit cur, nxt; int ui = 0;
    if (!S.next(0, cur)) return;
    f32x4 acc[2][2][4][2];
#pragma unroll
    for (int a = 0; a < 2; ++a)
#pragma unroll
        for (int b = 0; b < 2; ++b)
#pragma unroll
            for (int m = 0; m < 4; ++m)
#pragma unroll
                for (int n = 0; n < 2; ++n) acc[a][b][m][n] = (f32x4){0.f, 0.f, 0.f, 0.f};
    bf16x8 At[4][2], B0[2][2], B1[2][2];
    const char* cA = (const char*)g.A + (size_t)cur.pm * tstep; const char* cB = (const char*)g.Bt + (size_t)cur.pn * tstep;
    S.a_ready(cur);
    if constexpr (SP2) {
        PG8_STAGE(PG8_SB(0, 0), cB, voffB); PG8_STAGE(PG8_SB(0, 1), cB + hstep, voffB); PG8_STAGE(PG8_SA(0, 0), cA, voffA); PG8_STAGE(PG8_SA(0, 1), cA + hstep, voffA);
        if (wr == 1) PG8_BAR;
        PG8_WAIT_V(2); PG8_BAR;
        PG8_STAGE(PG8_SB(1, 0), cB + kstep, voffB); PG8_STAGE(PG8_SA(1, 0), cA + kstep, voffA); PG8_STAGE(PG8_SB(1, 1), cB + hstep + kstep, voffB);
        PG8_WAIT_V(6); PG8_BAR;
    } else {
        PG8_STAGE(PG8_SB(0, 0), cB, voffB); PG8_STAGE(PG8_SA(0, 0), cA, voffA); PG8_STAGE(PG8_SB(0, 1), cB + hstep, voffB); PG8_STAGE(PG8_SA(0, 1), cA + hstep, voffA);
        if (wr == 1) PG8_BAR;
        PG8_WAIT_V(4); PG8_BAR;
        PG8_STAGE(PG8_SB(1, 0), cB + kstep, voffB); PG8_STAGE(PG8_SA(1, 0), cA + kstep, voffA); PG8_STAGE(PG8_SB(1, 1), cB + hstep + kstep, voffB);
        PG8_WAIT_V(6); PG8_BAR;
    }
    for (;;) {
        const bool has_next = S.next(ui + 1, nxt);
        const char* nA = has_next ? (const char*)g.A + (size_t)nxt.pm * tstep : cA; const char* nB = has_next ? (const char*)g.Bt + (size_t)nxt.pn * tstep : cB;
        for (int t = 0; t < nt; t += 2) {
            const bool last = (t == nt - 2);
            const char* a1 = cA + (size_t)(t + 1) * kstep;
            const char* a2 = last ? nA : cA + (size_t)(t + 2) * kstep; const char* b2 = last ? nB : cB + (size_t)(t + 2) * kstep;
            const char* a3 = a2 + kstep; const char* b3 = b2 + kstep;
            if (last && has_next) S.a_ready(nxt);
            if constexpr (SP2) {
            PG8_LDB(B0, 0, 0); PG8_LDB(B1, 0, 1); PG8_SCHED; PG8_LDA(At, 0, 0); PG8_STAGE(PG8_SA(1, 1), a1 + hstep, voffA);
            PG8_WAIT_V(8); PG8_WAIT_L(0); PG8_BAR; PG8_MMA(0, 0, At, B0); PG8_MMA(0, 1, At, B1); PG8_BAR; PG8_SCHED;
            PG8_LDA(At, 0, 1); PG8_STAGE(PG8_SB(0, 0), b2, voffB); PG8_STAGE(PG8_SB(0, 1), b2 + hstep, voffB); PG8_STAGE(PG8_SA(0, 0), a2, voffA);
            PG8_WAIT_V(8); PG8_WAIT_L(0); PG8_BAR; PG8_MMA(1, 0, At, B0); PG8_MMA(1, 1, At, B1); PG8_BAR; PG8_SCHED;
            PG8_LDB(B0, 1, 0); PG8_LDB(B1, 1, 1); PG8_SCHED; PG8_LDA(At, 1, 0); PG8_STAGE(PG8_SA(0, 1), a2 + hstep, voffA);
            PG8_WAIT_V(8); PG8_WAIT_L(0); PG8_BAR; PG8_MMA(0, 0, At, B0); PG8_MMA(0, 1, At, B1); PG8_BAR; PG8_SCHED;
            PG8_LDA(At, 1, 1); PG8_STAGE(PG8_SB(1, 0), b3, voffB); PG8_STAGE(PG8_SB(1, 1), b3 + hstep, voffB); PG8_STAGE(PG8_SA(1, 0), a3, voffA);
            PG8_WAIT_V(8); PG8_WAIT_L(0); PG8_BAR; PG8_MMA(1, 0, At, B0); PG8_MMA(1, 1, At, B1); PG8_BAR; PG8_SCHED;
            } else {
            PG8_LDB(B0, 0, 0); PG8_SCHED; PG8_LDA(At, 0, 0); PG8_STAGE(PG8_SA(1, 1), a1 + hstep, voffA);
            PG8_WAIT_L(8); PG8_BAR; PG8_WAIT_L(0); PG8_MMA(0, 0, At, B0); PG8_BAR; PG8_SCHED;
            PG8_LDB(B1, 0, 1); PG8_STAGE(PG8_SB(0, 0), b2, voffB);
            PG8_BAR; PG8_WAIT_L(0); PG8_MMA(0, 1, At, B1); PG8_BAR;
            PG8_LDA(At, 0, 1); PG8_STAGE(PG8_SA(0, 0), a2, voffA);
            PG8_BAR; PG8_WAIT_L(0); PG8_MMA(1, 0, At, B0); PG8_BAR; PG8_SCHED;
            PG8_STAGE(PG8_SB(0, 1), b2 + hstep, voffB);
            PG8_WAIT_V(6); PG8_BAR; PG8_MMA(1, 1, At, B1); PG8_BAR;
            PG8_LDB(B0, 1, 0); PG8_SCHED; PG8_LDA(At, 1, 0); PG8_STAGE(PG8_SA(0, 1), a2 + hstep, voffA);
            PG8_WAIT_L(8); PG8_BAR; PG8_WAIT_L(0); PG8_MMA(0, 0, At, B0); PG8_BAR; PG8_SCHED;
            PG8_LDB(B1, 1, 1); PG8_STAGE(PG8_SB(1, 0), b3, voffB);
            PG8_BAR; PG8_WAIT_L(0); PG8_MMA(0, 1, At, B1); PG8_BAR;
            PG8_LDA(At, 1, 1); PG8_STAGE(PG8_SA(1, 0), a3, voffA);
            PG8_BAR; PG8_WAIT_L(0); PG8_MMA(1, 0, At, B0); PG8_BAR; PG8_SCHED;
            PG8_STAGE(PG8_SB(1, 1), b3 + hstep, voffB);
            PG8_WAIT_V(6); PG8_BAR; PG8_MMA(1, 1, At, B1); PG8_BAR;
            }
        }
        if constexpr (ALIGN_EPI) { if (wr == 0) PG8_BAR; }
        if constexpr (!Epi::AFTER_DRAIN) { E(acc, cur, wr, wc, fr, fq); S.done(cur); }
        if (!has_next) break;
#pragma unroll
        for (int a = 0; a < 2; ++a)
#pragma unroll
            for (int b = 0; b < 2; ++b)
#pragma unroll
                for (int m = 0; m < 4; ++m)
#pragma unroll
                    for (int n = 0; n < 2; ++n) acc[a][b][m][n] = (f32x4){0.f, 0.f, 0.f, 0.f};
        cur = nxt; cA = nA; cB = nB; ++ui;
        if constexpr (ALIGN_EPI) { if (wr == 1) PG8_BAR; }
    }
    PG8_WAIT_V(0);
    if constexpr (!ALIGN_EPI) { if (wr == 0) PG8_BAR; }
    PG8_BAR;
    if constexpr (Epi::AFTER_DRAIN) { E.fused(acc, cur, wr, wc, fr, fq, lds, wid, lane); S.done(cur); }
#undef PG8_SA
#undef PG8_SB
#undef PG8_STAGE
#undef PG8_LDA
#undef PG8_LDB
#undef PG8_MMA
#undef PG8_WAIT_V
#undef PG8_WAIT_L
#undef PG8_BAR
#undef PG8_SCHED
}
struct EpiStoreBf16 {
    static constexpr bool PERM = true, AFTER_DRAIN = false;
    bf16_t* O; int ldc;
    __device__ __forceinline__ void operator()(const f32x4 (&acc)[2][2][4][2], const Unit& u, int wr, int wc, int fr, int fq) const {
        const int row0 = u.pm * BM + wr * 64 + fr, col0 = u.pn * BM + wc * 32 + 8 * fq;
#pragma unroll
        for (int ai = 0; ai < 2; ++ai)
#pragma unroll
            for (int m = 0; m < 4; ++m) { bf16_t* rowp = O + (size_t)(row0 + ai * HALF + m * 16) * ldc + col0;
#pragma unroll
                for (int bj = 0; bj < 2; ++bj) { const f32x4 v0 = acc[ai][bj][m][0], v1 = acc[ai][bj][m][1];
                    u32x4 w; w.x = cvt_pk_bf16(v0[0], v0[1]); w.y = cvt_pk_bf16(v0[2], v0[3]); w.z = cvt_pk_bf16(v1[0], v1[1]); w.w = cvt_pk_bf16(v1[2], v1[3]);
                    *(u32x4*)(rowp + bj * HALF) = w; } }
    }
};
struct EpiResid {
    static constexpr bool PERM = false, AFTER_DRAIN = false;
    float* X; const float* mod; int goff;
    __device__ __forceinline__ void operator()(const f32x4 (&acc)[2][2][4][2], const Unit& u, int wr, int wc, int fr, int fq) const {
        const int row0 = u.pm * BM + wr * 64 + fr, col0 = u.pn * BM + wc * 32 + 4 * fq;
        const int mv = u.pm < 32 ? (u.pm >> 3) : 4;
        const float* gp = mod + (size_t)mv * 12288 + goff + col0;
        f32x4 gv[2][2];
#pragma unroll
        for (int bj = 0; bj < 2; ++bj)
#pragma unroll
            for (int n = 0; n < 2; ++n) gv[bj][n] = *(const f32x4*)(gp + bj * HALF + n * 16);
#pragma unroll
        for (int ai = 0; ai < 2; ++ai)
#pragma unroll
            for (int m = 0; m < 4; ++m) { float* rowp = X + (size_t)(row0 + ai * HALF + m * 16) * 2048 + col0;
#pragma unroll
                for (int bj = 0; bj < 2; ++bj)
#pragma unroll
                    for (int n = 0; n < 2; ++n) { f32x4* p = (f32x4*)(rowp + bj * HALF + n * 16); *p = *p + gv[bj][n] * acc[ai][bj][m][n]; } }
    }
};
__device__ __forceinline__ float silu_f(float x) { return x * __builtin_amdgcn_rcpf(1.f + __builtin_amdgcn_exp2f(-1.4426950408889634f * x)); }
struct EpiSwiglu {
    static constexpr bool PERM = true, AFTER_DRAIN = false;
    bf16_t* H; int ldh; int ntn;
    __device__ __forceinline__ void operator()(const f32x4 (&acc)[2][2][4][2], const Unit& u, int wr, int wc, int fr, int fq) const {
        const int row0 = u.pm * BM + wr * 64 + fr, hcol0 = (u.pn % ntn) * HALF + wc * 32 + 8 * fq;
#pragma unroll
        for (int ai = 0; ai < 2; ++ai)
#pragma unroll
            for (int m = 0; m < 4; ++m) { bf16_t* rowp = H + (size_t)(row0 + ai * HALF + m * 16) * ldh + hcol0;
                const f32x4 a0 = acc[ai][0][m][0], a1 = acc[ai][0][m][1], b0 = acc[ai][1][m][0], b1 = acc[ai][1][m][1];
                float h[8];
#pragma unroll
                for (int j = 0; j < 4; ++j) { h[j] = silu_f(a0[j]) * b0[j]; h[4 + j] = silu_f(a1[j]) * b1[j]; }
                u32x4 w; w.x = cvt_pk_bf16(h[0], h[1]); w.y = cvt_pk_bf16(h[2], h[3]); w.z = cvt_pk_bf16(h[4], h[5]); w.w = cvt_pk_bf16(h[6], h[7]);
                *(u32x4*)rowp = w; }
    }
};
struct EpiStoreF32 {
    static constexpr bool PERM = false, AFTER_DRAIN = false;
    float* C;
    __device__ __forceinline__ void operator()(const f32x4 (&acc)[2][2][4][2], const Unit& u, int wr, int wc, int fr, int fq) const {
        const int row0 = u.pm * BM + wr * 64 + fr, col0 = (u.pn & 7) * BM + wc * 32 + 4 * fq;
#pragma unroll
        for (int ai = 0; ai < 2; ++ai)
#pragma unroll
            for (int m = 0; m < 4; ++m) { float* rowp = C + (size_t)(row0 + ai * HALF + m * 16) * 2048 + col0;
#pragma unroll
                for (int bj = 0; bj < 2; ++bj)
#pragma unroll
                    for (int n = 0; n < 2; ++n) *(f32x4*)(rowp + bj * HALF + n * 16) = acc[ai][bj][m][n]; }
    }
};
struct InProjL1Order {
    StaticOrder so; int G, c;
    __device__ void init(int G_, int c_) { so.init(8192, 4608, G_, c_); G = G_; c = c_; }
    __device__ bool next(int i, Unit& u) const {
        const int L = i * G + c;
        if (L < so.nwg) return so.next(i, u);
        const int L2 = L - so.nwg; if (L2 >= 24) return false;
        u.pm = 32 + (L2 & 3); u.pn = L2 >> 2; return true;
    }
    __device__ __forceinline__ void a_ready(const Unit&) const {}
    __device__ __forceinline__ void done(const Unit&) const {}
};
struct MoeOrder {
    StaticOrder so; const int* tile_e; int NT;
    __device__ void init(int ntiles, int NT_, const int* te, int G_, int c_) { so.nM = ntiles; so.nN = NT_; so.nwg = ntiles * NT_; so.G = G_; so.c = c_; tile_e = te; NT = NT_; }
    __device__ bool next(int i, Unit& u) const { if (!so.next(i, u)) return false; u.pn += tile_e[u.pm] * NT; return true; }
    __device__ __forceinline__ void a_ready(const Unit&) const {}
    __device__ __forceinline__ void done(const Unit&) const {}
};
}
namespace mk {
typedef const float* KP;
typedef __attribute__((address_space(4))) KP const* CIN;
struct Ctx {
    LAS unsigned char* lds;
    CIN in; float* out; unsigned char* ws;
    int tid, lane, wave, G, bid;
};
#define WSP(T, off) ((T*)(C.ws + (off)))
__device__ __forceinline__ const float* inp_(CIN p, int k) { asm volatile("" : "+s"(p)); return p[k]; }
#define INP(k) inp_(C.in, (k))

__device__ __forceinline__ void tr_item(const float* W, int ldw, int k0, int ncol0, bf16* WT, int ldt, int drow0, LAS float* scr, int lane) {
    f32x4 v[16];
#pragma unroll
    for (int i = 0; i < 16; ++i) { const int idx = lane + 64 * i, kk = idx >> 4, c4 = idx & 15; v[i] = *(const f32x4*)(W + (size_t)(k0 + kk) * ldw + ncol0 + 4 * c4); }
#pragma unroll
    for (int i = 0; i < 16; ++i) { const int idx = lane + 64 * i, kk = idx >> 4, c4 = idx & 15; LAS float* p = scr + kk * 65 + 4 * c4; p[0] = v[i].x; p[1] = v[i].y; p[2] = v[i].z; p[3] = v[i].w; }
    LDS_WAIT(); asm volatile("" ::: "memory");
    const int c = lane & 7;
#pragma unroll
    for (int jj = 0; jj < 8; ++jj) { const int n = (lane >> 3) + 8 * jj; const LAS float* s = scr + (8 * c) * 65 + n;
        u32x4 o; o.x = pk2(s[0], s[65]); o.y = pk2(s[2 * 65], s[3 * 65]); o.z = pk2(s[4 * 65], s[5 * 65]); o.w = pk2(s[6 * 65], s[7 * 65]);
        *(u32x4*)(WT + (size_t)(drow0 + n) * ldt + k0 + 8 * c) = o; }
    LDS_WAIT(); asm volatile("" ::: "memory");
}
constexpr int IT_WIN = 32 * 72, IT_WOUT = 32 * 32, IT_W1 = 32 * 88, IT_W2 = 88 * 32, IT_MW1 = 32 * 112, IT_MW2 = 112 * 32, IT_PW = 2 * 2;
constexpr int IT_TOTAL = 2 * IT_WIN + 2 * IT_WOUT + 2 * IT_W1 + IT_W2 + 16 * IT_MW1 + 8 * IT_MW2 + 8 * IT_PW;
__device__ __forceinline__ void tr_dispatch(Ctx& C, int it, LAS float* scr) {
    int r = it;
    if (r < 2 * IT_WIN) { const int l = r / IT_WIN; r -= l * IT_WIN; const int kb = r / 72, nb = r % 72;
        const int src = nb < 24 ? 64 * nb : 1552 + 64 * (nb - 24), dst = nb < 24 ? 64 * nb : 1536 + 64 * (nb - 24);
        tr_item(INP(7) + (size_t)l * D * INW, INW, 64 * kb, src, WSP(bf16, WS_WIN) + (size_t)l * NIN * D, D, dst, scr, C.lane); return; }
    r -= 2 * IT_WIN;
    if (r < 2 * IT_WOUT) { const int l = r / IT_WOUT; r -= l * IT_WOUT; const int kb = r / 32, nb = r % 32;
        tr_item(INP(22) + (size_t)l * D * D, D, 64 * kb, 64 * nb, WSP(bf16, WS_WOUT) + (size_t)l * D * D, D, 64 * nb, scr, C.lane); return; }
    r -= 2 * IT_WOUT;
    if (r < 2 * IT_W1) { const int s = r / IT_W1; r -= s * IT_W1; const int kb = r / 88, nb = r % 88;
        tr_item(INP(24 + s), DFF, 64 * kb, 64 * nb, WSP(bf16, WS_W13), D, 256 * (nb >> 1) + 128 * s + 64 * (nb & 1), scr, C.lane); return; }
    r -= 2 * IT_W1;
    if (r < IT_W2) { const int kb = r / 32, nb = r % 32;
        tr_item(INP(26), D, 64 * kb, 64 * nb, WSP(bf16, WS_W2), DFF, 64 * nb, scr, C.lane); return; }
    r -= IT_W2;
    if (r < 16 * IT_MW1) { const int j = r / IT_MW1; r -= j * IT_MW1; const int s = j >> 3, e = j & 7, kb = r / 112, nb = r % 112;
        tr_item(INP(29 + s) + (size_t)e * D * DFE, DFE, 64 * kb, 64 * nb, WSP(bf16, WS_MW13) + (size_t)e * 2 * DFE * D, D, 256 * (nb >> 1) + 128 * s + 64 * (nb & 1), scr, C.lane); return; }
    r -= 16 * IT_MW1;
    if (r < 8 * IT_MW2) { const int e = r / IT_MW2; r -= e * IT_MW2; const int kb = r / 32, nb = r % 32;
        tr_item(INP(31) + (size_t)e * DFE * D, D, 64 * kb, 64 * nb, WSP(bf16, WS_MW2) + (size_t)e * D * DFE, DFE, 64 * nb, scr, C.lane); return; }
    r -= 8 * IT_MW2;
    { const int m = r / IT_PW; r -= m * IT_PW; const int kb = r / 2, nb = r % 2;
        tr_item(INP(16) + (size_t)m * 128 * 128, 128, 64 * kb, 64 * nb, WSP(bf16, WS_PWT) + (size_t)m * 128 * 128, 128, 64 * nb, scr, C.lane); }
}
__device__ __forceinline__ void mod_unit(Ctx& C, int unit, LAS float* sv  , LAS float* red  ) {
    const int l = unit / 192, col0 = (unit % 192) * 64, cq = C.tid & 15, ks = C.tid >> 4;
    const float* w = INP(4) + ((size_t)l * D + ks * 64) * 12288 + col0 + 4 * cq;
    f32x4 acc[5];
#pragma unroll
    for (int v = 0; v < 5; ++v) acc[v] = (f32x4){0.f, 0.f, 0.f, 0.f};
#pragma unroll 8
    for (int k = 0; k < 64; ++k) { const f32x4 wv = *(const f32x4*)(w + (size_t)k * 12288);
#pragma unroll
        for (int v = 0; v < 5; ++v) acc[v] += wv * sv[v * 2048 + ks * 64 + k]; }
#pragma unroll
    for (int v = 0; v < 5; ++v) *(LAS f32x4*)(red + (ks * 5 + v) * 64 + 4 * cq) = acc[v];
    WG_BAR();
    if (C.tid < 320) { const int v = C.tid >> 6, c = C.tid & 63; float s = 0.f;
#pragma unroll 8
        for (int k = 0; k < 32; ++k) s += red[(k * 5 + v) * 64 + c];
        WSP(float, WS_MODV)[((size_t)l * 5 + v) * 12288 + col0 + c] = s + INP(5)[l * 12288 + col0 + c]; }
    WG_BAR();
}
__device__ __forceinline__ void p_prologue(Ctx& C) {
    LAS float* sv = (LAS float*)C.lds; LAS float* red = sv + 5 * 2048;
    for (int i = C.tid; i < 5 * 2048; i += NTHR) { const float x = i < 4 * 2048 ? INP(1)[i] : INP(3)[i - 4 * 2048]; sv[i] = x / (1.f + expf(-x)); }
    WG_BAR();
    for (int u = C.bid; u < 384; u += C.G) mod_unit(C, u, sv, red);
    { float* pos = WSP(float, WS_POS);
      for (size_t i = (size_t)C.bid * NTHR + C.tid; i < (size_t)TX * D; i += (size_t)C.G * NTHR) {
          const int t = (int)(i >> 11), d = (int)(i & 2047), r = t >> 6, cc = t & 63, part = d >> 9, fi = d & 511;
          const float freq = expf(-9.210340371976184f * (float)fi / 512.f);
          const float ang = (part < 2 ? (float)r : (float)cc) * freq;
          pos[i] = (part & 1) ? cosf(ang) : sinf(ang); } }
    WG_BAR();
    LAS float* scr = (LAS float*)(C.lds + C.wave * 16896);
    const int gw = C.bid * NWAVE + C.wave, NGW = C.G * NWAVE;
    for (int it = gw; it < IT_TOTAL; it += NGW) tr_dispatch(C, it, scr);
}

template <int MODE>
__device__ __forceinline__ void p_norm(Ctx& C, int l) {
    const float* mod = WSP(float, WS_MODV) + (size_t)l * 5 * 12288;
    float* XS = WSP(float, WS_XS); bf16* AN = WSP(bf16, WS_AN);
    const bool mix = MODE <= 1;
    const float* gain = (mix ? INP(6) : INP(23)) + l * D;
    const int sh_off = mix ? 0 : 6144, sc_off = mix ? 2048 : 8192;
    LAS f32x4* wl = (LAS f32x4*)C.lds;
    if (mix) { const float* wsrc = INP(7) + (size_t)l * D * INW + 1536;
        for (int idx = C.tid; idx < 2048 * 4; idx += NTHR) { const int k = idx >> 2, q = idx & 3, ln = (k & 255) >> 2, i = k & 3, j = k >> 8;
            wl[((j * 4 + i) * 4 + q) * 64 + ln] = *(const f32x4*)(wsrc + (size_t)k * INW + 4 * q); }
    } else if (MODE == 3) { const float* wsrc = INP(27);
        for (int idx = C.tid; idx < 2048 * 2; idx += NTHR) { const int k = idx >> 1, q = idx & 1, ln = (k & 255) >> 2, i = k & 3, j = k >> 8;
            wl[((j * 4 + i) * 2 + q) * 64 + ln] = *(const f32x4*)(wsrc + (size_t)k * 8 + 4 * q); } }
    WG_BAR();
    const int nrows = MODE == 3 ? MX : MT;
    const int gw = C.bid * NWAVE + C.wave, NGW = C.G * NWAVE, lane = C.lane;
    for (int row = gw; row < nrows; row += NGW) {
        int base, T, t, mv; rowinfo(row, base, T, t, mv);
        f32x4 x[8]; float ss = 0.f;
        if (MODE == 0) {
            if (row < MX) { const f32x4* xi = (const f32x4*)(INP(0) + (size_t)row * D) + lane; const f32x4* pp = (const f32x4*)(WSP(float, WS_POS) + (size_t)t * D) + lane;
#pragma unroll
                for (int j = 0; j < 8; ++j) x[j] = xi[64 * j] + pp[64 * j]; }
            else { const f32x4* xi = (const f32x4*)(INP(2) + (size_t)(row - MX) * D) + lane;
#pragma unroll
                for (int j = 0; j < 8; ++j) x[j] = xi[64 * j]; }
            f32x4* xo = (f32x4*)(XS + (size_t)row * D) + lane;
#pragma unroll
            for (int j = 0; j < 8; ++j) xo[64 * j] = x[j];
        } else { const f32x4* xi = (const f32x4*)(XS + (size_t)row * D) + lane;
#pragma unroll
            for (int j = 0; j < 8; ++j) x[j] = xi[64 * j]; }
#pragma unroll
        for (int j = 0; j < 8; ++j) ss += (x[j].x * x[j].x + x[j].y * x[j].y) + (x[j].z * x[j].z + x[j].w * x[j].w);
        const float rs = rsqrtf(wave_sum(ss) * (1.f / D) + EPS);
        const f32x4* gp = (const f32x4*)gain + lane; const f32x4* shp = (const f32x4*)(mod + (size_t)mv * 12288 + sh_off) + lane; const f32x4* scp = (const f32x4*)(mod + (size_t)mv * 12288 + sc_off) + lane;
        u32x2* ao = (u32x2*)(AN + (size_t)row * D) + lane;
#pragma unroll
        for (int j = 0; j < 8; ++j) { const f32x4 g = gp[64 * j], sh = shp[64 * j], sc = scp[64 * j];
            x[j] = x[j] * rs * g * (sc + 1.f) + sh;
            u32x2 w; w.x = pk2(x[j].x, x[j].y); w.y = pk2(x[j].z, x[j].w); ao[64 * j] = w; }
        if (mix) {
            f32x4 acc[4];
#pragma unroll
            for (int q = 0; q < 4; ++q) acc[q] = (f32x4){0.f, 0.f, 0.f, 0.f};
#pragma unroll
            for (int j = 0; j < 8; ++j)
#pragma unroll
                for (int i = 0; i < 4; ++i) { const float a = x[j][i];
#pragma unroll
                    for (int q = 0; q < 4; ++q) acc[q] += wl[((j * 4 + i) * 4 + q) * 64 + lane] * a; asm volatile("" ::: "memory"); }
#pragma unroll
            for (int q = 0; q < 4; ++q)
#pragma unroll
                for (int e = 0; e < 4; ++e) acc[q][e] = wave_sum(acc[q][e]);
            if (lane < 4) { f32x4 o = lane == 0 ? acc[0] : lane == 1 ? acc[1] : lane == 2 ? acc[2] : acc[3]; *(f32x4*)(WSP(float, WS_ABF) + (size_t)row * 16 + 4 * lane) = o; }
        }
        if (MODE == 3) {
            f32x4 acc[2] = {(f32x4){0.f, 0.f, 0.f, 0.f}, (f32x4){0.f, 0.f, 0.f, 0.f}};
#pragma unroll
            for (int j = 0; j < 8; ++j)
#pragma unroll
                for (int i = 0; i < 4; ++i) { const float a = x[j][i];
#pragma unroll
                    for (int q = 0; q < 2; ++q) acc[q] += wl[((j * 4 + i) * 2 + q) * 64 + lane] * a; asm volatile("" ::: "memory"); }
            float lg[8];
#pragma unroll
            for (int e = 0; e < 8; ++e) lg[e] = wave_sum(acc[e >> 2][e & 3]) + INP(28)[e];
            if (lane == 0) { int i1 = 0;
#pragma unroll
                for (int e = 1; e < 8; ++e) if (lg[e] > lg[i1]) i1 = e;
                int i2 = i1 == 0 ? 1 : 0;
#pragma unroll
                for (int e = 0; e < 8; ++e) if (e != i1 && lg[e] > lg[i2]) i2 = e;
                float v1 = lg[0], v2 = lg[0];
#pragma unroll
                for (int e = 0; e < 8; ++e) { v1 = e == i1 ? lg[e] : v1; v2 = e == i2 ? lg[e] : v2; }
                const float g2 = 1.f / (1.f + expf(v1 - v2));
                int* R = WSP(int, WS_ROUTE); float* Rf = WSP(float, WS_ROUTE); unsigned* ctl = WSP(unsigned, WS_CTL);
                R[R_TE + 2 * row] = i1; R[R_TE + 2 * row + 1] = i2; Rf[R_TG + 2 * row] = 1.f - g2; Rf[R_TG + 2 * row + 1] = g2;
                R[R_RANK + 2 * row] = (int)atomicAdd(ctl + CW_CNT + 64 * i1, 1u); R[R_RANK + 2 * row + 1] = (int)atomicAdd(ctl + CW_CNT + 64 * i2, 1u); }
        }
    }
}
}
namespace mk {
__device__ __forceinline__ f32x4 mfma16(bf16x8 a, bf16x8 b, f32x4 c) { return __builtin_amdgcn_mfma_f32_16x16x32_bf16(a, b, c, 0, 0, 0); }

constexpr int DP_PITCH = 132;
constexpr int DP_Q = 0, DP_K = 33792, DP_V = 67584;
constexpr int DP_L = 101376;
constexpr int DP_QK = DP_L + 32768;
constexpr int DP_SM = DP_QK + 16384;
static_assert(DP_SM + 2048 <= LDS_BARW, "DN prep LDS map");
__device__ __forceinline__ size_t dn_rec(int dir, int cid, int h) { return ((size_t)dir * NCH + cid) * 4 + h; }

__device__ __forceinline__ void dnprep_unit(Ctx& C, int l, int cidx, int h) {
    LAS float* Qs = (LAS float*)(C.lds + DP_Q); LAS float* Ks = (LAS float*)(C.lds + DP_K); LAS float* Vs = (LAS float*)(C.lds + DP_V);
    LAS float* Ls = (LAS float*)(C.lds + DP_L); LAS bf16* QKi = (LAS bf16*)(C.lds + DP_QK); LAS float* sm = (LAS float*)(C.lds + DP_SM);
    LAS float* Gs = sm; LAS float* Bs = sm + 128; LAS float* EGs = sm + 256; LAS float* EGRs = sm + 384;
    const bf16* P = WSP(bf16, WS_P);
    const int tid = C.tid, lane = C.lane, wave = C.wave;
    const int r0 = cidx * 64; int sbase, T, t0, mv; rowinfo(r0, sbase, T, t0, mv);
    const int nloc = t0 >> 6, nch = T >> 6, cbase = sbase >> 6;
#ifndef DP_SKIP
#define DP_SKIP 0
#endif
    if (!(DP_SKIP & 1)) { if (tid < 384) {
        const int o = tid % 48, tg = tid / 48, wh = o >> 4, oc = o & 15, ch = wh * 512 + h * 128 + 8 * oc;
        float w[5][8];
        const float* cw = INP(8) + (size_t)l * 5 * 1536 + ch;
#pragma unroll
        for (int k = 0; k < 5; ++k) { const f32x4 a = *(const f32x4*)(cw + k * 1536), b = *(const f32x4*)(cw + k * 1536 + 4);
            w[k][0] = a.x; w[k][1] = a.y; w[k][2] = a.z; w[k][3] = a.w; w[k][4] = b.x; w[k][5] = b.y; w[k][6] = b.z; w[k][7] = b.w; }
#pragma unroll 1
        for (int hf = 0; hf < 2; ++hf) {
        float xin[8][8];
#pragma unroll
        for (int i = 0; i < 8; ++i) { const int t = t0 + 8 * tg + 4 * hf + i - 2;
            if (t >= 0 && t < T) { const u32x4 raw = *(const u32x4*)(P + (size_t)(sbase + t) * NIN + ch); unpack8(raw, xin[i]); }
            else {
#pragma unroll
                for (int c = 0; c < 8; ++c) xin[i][c] = 0.f; } }
#pragma unroll
        for (int i = 0; i < 4; ++i) { float ov[8]; float ss = 0.f;
#pragma unroll
            for (int c = 0; c < 8; ++c) { float s = 0.f;
#pragma unroll
                for (int k = 0; k < 5; ++k) s += w[k][c] * xin[i + k][c];
                ov[c] = silu(s); ss += ov[c] * ov[c]; }
            ss = sum16(ss);
            const float sc = wh == 0 ? rsqrtf(ss + EPS) * 0.08838834764831845f : wh == 1 ? rsqrtf(ss + EPS) : 1.f;
            LAS float* dst = (wh == 0 ? Qs : wh == 1 ? Ks : Vs) + (8 * tg + 4 * hf + i) * DP_PITCH + 8 * oc;
            *(LAS f32x4*)dst = (f32x4){ov[0] * sc, ov[1] * sc, ov[2] * sc, ov[3] * sc}; *(LAS f32x4*)(dst + 4) = (f32x4){ov[4] * sc, ov[5] * sc, ov[6] * sc, ov[7] * sc}; }
        }
    } else {
        const int d = wave - 6, s = lane, i = d ? 63 - s : s; const float* ab = WSP(float, WS_ABF) + (size_t)(r0 + i) * 16;
        const float la = -expf(INP(9)[l * 8 + d * 4 + h]) * softplus(ab[d * 4 + h] + INP(10)[l * 8 + d * 4 + h]);
        const float be = sigm(ab[8 + d * 4 + h]);
        float g = la;
#pragma unroll
        for (int o = 1; o < 64; o <<= 1) { const float up = __shfl_up(g, o); if (lane >= o) g += up; }
        const float gl = __shfl(g, 63);
        Gs[d * 64 + s] = g; Bs[d * 64 + s] = be; EGs[d * 64 + s] = expf(g); EGRs[d * 64 + s] = expf(gl - g);
        if (lane == 63) { const int cid = d ? cbase + (nch - 1 - nloc) : cidx; WSP(float, WS_EGL)[dn_rec(d, cid, h)] = expf(gl); }
    } }
    WG_BAR();
    if (!(DP_SKIP & 2)) {
        const int wh = wave >> 2, mb = wave & 3, c = lane & 15, g4 = lane >> 4;
        const LAS float* Am = wh ? Qs : Ks;
        f32x4 acc[4];
#pragma unroll
        for (int nb = 0; nb < 4; ++nb) acc[nb] = (f32x4){0.f, 0.f, 0.f, 0.f};
#pragma unroll
        for (int ks = 0; ks < 4; ++ks) {
            float av[8]; { const LAS float* p = Am + (16 * mb + c) * DP_PITCH + 32 * ks + 8 * g4; const f32x4 a = *(const LAS f32x4*)p, b = *(const LAS f32x4*)(p + 4);
                av[0] = a.x; av[1] = a.y; av[2] = a.z; av[3] = a.w; av[4] = b.x; av[5] = b.y; av[6] = b.z; av[7] = b.w; }
            const bf16x8 af = pack8(av);
#pragma unroll
            for (int nb = 0; nb < 4; ++nb) { float bv[8]; const LAS float* p = Ks + (16 * nb + c) * DP_PITCH + 32 * ks + 8 * g4; const f32x4 a = *(const LAS f32x4*)p, b = *(const LAS f32x4*)(p + 4);
                bv[0] = a.x; bv[1] = a.y; bv[2] = a.z; bv[3] = a.w; bv[4] = b.x; bv[5] = b.y; bv[6] = b.z; bv[7] = b.w;
                acc[nb] = mfma16(af, pack8(bv), acc[nb]); }
        }
        if (wh == 0) {
#pragma unroll
            for (int d = 0; d < 2; ++d) { const LAS float* Gd = Gs + d * 64; const LAS float* Bd = Bs + d * 64; LAS float* Ld = Ls + d * 4096;
#pragma unroll
                for (int r = 0; r < 4; ++r) { const int i = 16 * mb + 4 * g4 + r, s = d ? 63 - i : i; const float gs = Gd[s], bs = Bd[s];
#pragma unroll
                    for (int nb = 0; nb < 4; ++nb) { const int ip = 16 * nb + c, sp = d ? 63 - ip : ip;
                        Ld[s * 64 + sp] = s > sp ? bs * acc[nb][r] * __expf(gs - Gd[sp]) : 0.f; } } }
        } else {
#pragma unroll
            for (int d = 0; d < 2; ++d) { const LAS float* Gd = Gs + d * 64; LAS bf16* Qd = QKi + d * 4096;
#pragma unroll
                for (int r = 0; r < 4; ++r) { const int i = 16 * mb + 4 * g4 + r, s = d ? 63 - i : i; const float gs = Gd[s];
#pragma unroll
                    for (int nb = 0; nb < 4; ++nb) { const int ip = 16 * nb + c, sp = d ? 63 - ip : ip;
                        const float qk = s >= sp ? acc[nb][r] * __expf(gs - Gd[sp]) : 0.f;
                        const int lp = ((sp & 15) >> 2) * 16 + (s & 15), jp = 4 * ((sp >> 4) & 1) + (sp & 3);
                        Qd[(((s >> 4) * 2 + (sp >> 5)) * 64 + lp) * 8 + jp] = (bf16)f2bf(qk); } } }
        }
    }
    WG_BAR();
    if (!(DP_SKIP & 4)) {
        const int d = tid >> 8, col = tid & 255;
        float X[64];
        const LAS float* src = col < 128 ? Vs + col : Ks + (col - 128);
        const LAS float* Bd = Bs + d * 64; const LAS float* Ed = EGs + d * 64;
        if (d == 0) {
#pragma unroll
            for (int s = 0; s < 64; ++s) { const float sc = col < 128 ? Bd[s] : Bd[s] * Ed[s]; X[s] = sc * src[s * DP_PITCH]; if ((s & 7) == 7) asm volatile("" ::: "memory"); }
        } else {
#pragma unroll
            for (int s = 0; s < 64; ++s) { const float sc = col < 128 ? Bd[s] : Bd[s] * Ed[s]; X[s] = sc * src[(63 - s) * DP_PITCH]; if ((s & 7) == 7) asm volatile("" ::: "memory"); }
        }
        WG_BAR();
        const LAS float* Ld = Ls + d * 4096;
#pragma unroll
        for (int s = 1; s < 64; ++s) { float a0 = X[s], a1 = 0.f, a2 = 0.f, a3 = 0.f;
#pragma unroll
            for (int j4 = 0; j4 < (s + 3) / 4; ++j4) { const f32x4 lv = *(const LAS f32x4*)(Ld + s * 64 + 4 * j4);
                if (4 * j4 + 0 < s) a0 -= lv.x * X[4 * j4 + 0];
                if (4 * j4 + 1 < s) a1 -= lv.y * X[4 * j4 + 1];
                if (4 * j4 + 2 < s) a2 -= lv.z * X[4 * j4 + 2];
                if (4 * j4 + 3 < s) a3 -= lv.w * X[4 * j4 + 3]; }
            X[s] = (a0 + a1) + (a2 + a3); asm volatile("" ::: "memory"); }
        const int cid = d ? cbase + (nch - 1 - nloc) : cidx; const size_t rec = dn_rec(d, cid, h);
        if (col < 128) { f32x4* up = (f32x4*)(WSP(float, WS_DNU) + (rec * 128 + col) * 64);
#pragma unroll
            for (int q = 0; q < 16; ++q) up[q] = (f32x4){X[4 * q], X[4 * q + 1], X[4 * q + 2], X[4 * q + 3]}; }
        else { const int dk = col - 128, ks = dk >> 5, q = dk & 31, j = 4 * (q >> 4) + (q & 3), g4 = (q & 15) >> 2;
            LAS bf16* Wi = (LAS bf16*)(C.lds + DP_V) + d * 8192;
#pragma unroll
            for (int s = 0; s < 64; ++s) Wi[(((s >> 4) * 4 + ks) * 64 + g4 * 16 + (s & 15)) * 8 + j] = (bf16)f2bf(X[s]); }
    }
    WG_BAR();
    if (!(DP_SKIP & 8)) {
        for (int ci = tid; ci < 2048; ci += NTHR) { const int d = ci >> 10, cc = ci & 1023; const int cid = d ? cbase + (nch - 1 - nloc) : cidx;
            ((u32x4*)(WSP(unsigned char, WS_DNW) + dn_rec(d, cid, h) * 16384))[cc] = ((const LAS u32x4*)(C.lds + DP_V + d * 16384))[cc]; }
        for (int ci = tid; ci < 1024; ci += NTHR) { const int d = ci >> 9, cc = ci & 511; const int cid = d ? cbase + (nch - 1 - nloc) : cidx;
            ((u32x4*)(WSP(unsigned char, WS_DNQK) + dn_rec(d, cid, h) * 8192))[cc] = ((const LAS u32x4*)(C.lds + DP_QK + d * 8192))[cc]; }
        for (int ci = tid; ci < 2048; ci += NTHR) { const int d = ci >> 10, cc = ci & 1023, mb = cc >> 8, ks = (cc >> 6) & 3, lp = cc & 63, c = lp & 15, g4 = lp >> 4;
            const int s = 16 * mb + c, i = d ? 63 - s : s; const float e = EGs[d * 64 + s];
            const LAS float* p = Qs + i * DP_PITCH + 32 * ks + 4 * g4; const f32x4 a = *(const LAS f32x4*)p, b = *(const LAS f32x4*)(p + 16);
            float v[8] = {a.x * e, a.y * e, a.z * e, a.w * e, b.x * e, b.y * e, b.z * e, b.w * e};
            const int cid = d ? cbase + (nch - 1 - nloc) : cidx;
            ((bf16x8*)(WSP(unsigned char, WS_DNQG) + dn_rec(d, cid, h) * 16384))[cc] = pack8(v); }
        for (int ci = tid; ci < 2048; ci += NTHR) { const int d = ci >> 10, cc = ci & 1023, tt = cc >> 7, ks2 = (cc >> 6) & 1, lp = cc & 63, c = lp & 15, g4 = lp >> 4;
            float v[8];
#pragma unroll
            for (int j = 0; j < 8; ++j) { const int s = 32 * ks2 + 16 * (j >> 2) + 4 * g4 + (j & 3), i = d ? 63 - s : s; v[j] = Ks[i * DP_PITCH + 16 * tt + c] * EGRs[d * 64 + s]; }
            const int cid = d ? cbase + (nch - 1 - nloc) : cidx;
            ((bf16x8*)(WSP(unsigned char, WS_DNKDT) + dn_rec(d, cid, h) * 16384))[cc] = pack8(v); }
    }
    WG_BAR();
}

constexpr int SG_VT = 0, SG_VPITCH = 136;
__device__ __forceinline__ void sg_unit(Ctx& C, int l, int cb, int h) {
    LAS bf16* vT = (LAS bf16*)(C.lds + SG_VT);
    const bf16* P = WSP(bf16, WS_P); bf16* Y = WSP(bf16, WS_Y);
    const int lane = C.lane, wave = C.wave, r0 = cb * 128;
    const float* lg = INP(12) + l * 512; const float* lb = INP(13) + l * 512;
    for (int q = 0; q < 16; ++q) { const int j = 16 * wave + q; float v[8];
        unpack8(*(const u32x4*)(P + (size_t)(r0 + j) * NIN + PSGV + 8 * lane), v);
        float s = 0.f;
#pragma unroll
        for (int c = 0; c < 8; ++c) { v[c] = gelu_tanh(v[c]); s += v[c]; }
        const float mu = wave_sum(s) * (1.f / 512.f); float s2 = 0.f;
#pragma unroll
        for (int c = 0; c < 8; ++c) { v[c] -= mu; s2 += v[c] * v[c]; }
        const float rs = rsqrtf(wave_sum(s2) * (1.f / 512.f) + EPS);
        if ((lane >> 4) == h) { const int d0 = 8 * (lane & 15);
#pragma unroll
            for (int c = 0; c < 8; ++c) vT[(d0 + c) * SG_VPITCH + j] = (bf16)f2bf(v[c] * rs * lg[128 * h + d0 + c] + lb[128 * h + d0 + c]); } }
    WG_BAR();
    const int c = lane & 15, g4 = lane >> 4;
    const float* W = INP(14) + ((size_t)(l * 4 + h) * 128 + 16 * wave + c) * 128;
    f32x4 acc[8];
#pragma unroll
    for (int nb = 0; nb < 8; ++nb) acc[nb] = (f32x4){0.f, 0.f, 0.f, 0.f};
#pragma unroll
    for (int ks = 0; ks < 4; ++ks) { const f32x4 a = *(const f32x4*)(W + 32 * ks + 8 * g4), b = *(const f32x4*)(W + 32 * ks + 8 * g4 + 4);
        float av[8] = {a.x, a.y, a.z, a.w, b.x, b.y, b.z, b.w}; const bf16x8 af = pack8(av);
#pragma unroll
        for (int nb = 0; nb < 8; ++nb) { const bf16x8 bfr = *(const LAS bf16x8*)(vT + (16 * nb + c) * SG_VPITCH + 32 * ks + 8 * g4); acc[nb] = mfma16(af, bfr, acc[nb]); } }
    const float* bs = INP(15) + (l * 4 + h) * 128;
#pragma unroll
    for (int r = 0; r < 4; ++r) { const int i = 16 * wave + 4 * g4 + r; const float bi = bs[i]; const size_t row = (size_t)(r0 + i);
#pragma unroll
        for (int nb = 0; nb < 8; ++nb) { const int d = 16 * nb + c; const float u = gelu_tanh(bf2f(P[row * NIN + PSGU + 128 * h + d]));
            Y[row * D + 512 + 128 * h + d] = (bf16)f2bf(u * (acc[nb][r] + bi)); } }
    WG_BAR();
}

__device__ __forceinline__ void pool_unit(Ctx& C, int l, int cidx, int g) {
    const bf16* P = WSP(bf16, WS_P); bf16* Y = WSP(bf16, WS_Y); const bf16* PW = WSP(bf16, WS_PWT) + (size_t)(l * 4 + g) * 128 * 128;
    const int lane = C.lane, wave = C.wave, c = lane & 15, g4 = lane >> 4, mb = wave & 3, nh = wave >> 2;
    const int r0 = cidx * 64; int sbase, T, t0, mv; rowinfo(r0, sbase, T, t0, mv);
    const int t = t0 + 16 * mb + c, hw = 1 << g;
    const int lo = t - hw < 0 ? 0 : t - hw, hi = t + hw > T ? T : t + hw; const float inv = 1.f / (float)(hi - lo);
    f32x4 acc[4];
#pragma unroll
    for (int nb = 0; nb < 4; ++nb) acc[nb] = (f32x4){0.f, 0.f, 0.f, 0.f};
#pragma unroll
    for (int ks = 0; ks < 4; ++ks) { const bf16* pc = P + PPOOL + 128 * g + 32 * ks + 8 * g4; float s[8] = {0, 0, 0, 0, 0, 0, 0, 0}, x[8];
        for (int tt = lo; tt < hi; ++tt) { float v[8]; unpack8(*(const u32x4*)(pc + (size_t)(sbase + tt) * NIN), v);
#pragma unroll
            for (int q = 0; q < 8; ++q) s[q] += v[q]; }
        unpack8(*(const u32x4*)(pc + (size_t)(sbase + t) * NIN), x);
#pragma unroll
        for (int q = 0; q < 8; ++q) s[q] = s[q] * inv - x[q];
        const bf16x8 af = pack8(s);
#pragma unroll
        for (int nb = 0; nb < 4; ++nb) { const bf16x8 bfr = *(const bf16x8*)(PW + (size_t)(16 * (4 * nh + nb) + c) * 128 + 32 * ks + 8 * g4); acc[nb] = mfma16(af, bfr, acc[nb]); } }
    const float* psc = INP(17) + l * 512 + 128 * g;
#pragma unroll
    for (int nb = 0; nb < 4; ++nb) { const int e = 16 * (4 * nh + nb) + c; const float sc = psc[e];
#pragma unroll
        for (int r = 0; r < 4; ++r) Y[(size_t)(r0 + 16 * mb + 4 * g4 + r) * D + 1024 + 128 * g + e] = (bf16)f2bf(acc[nb][r] * sc); }
}

__device__ __forceinline__ void conf_unit(Ctx& C, int l, int cidx) {
    const bf16* P = WSP(bf16, WS_P); bf16* Y = WSP(bf16, WS_Y); LAS float* hb = (LAS float*)C.lds;
    const int ch = C.tid, r0 = cidx * 64; int sbase, T, t0, mv; rowinfo(r0, sbase, T, t0, mv);
    float w[31];
#pragma unroll
    for (int k = 0; k < 31; ++k) w[k] = INP(18)[((size_t)l * 31 + k) * 512 + ch];
    const float cb = INP(19)[l * 512 + ch];
#pragma unroll 1
    for (int grp = 0; grp < 4; ++grp) {
        float glu[46];
#pragma unroll
        for (int q = 0; q < 46; ++q) { const int t = t0 + 16 * grp + q - 15; float v = 0.f;
            if (t >= 0 && t < T) { const bf16* pr = P + (size_t)(sbase + t) * NIN; v = bf2f(pr[PCVA + ch]) * sigm(bf2f(pr[PCVG + ch])); }
            glu[q] = v; }
#pragma unroll
        for (int i = 0; i < 16; ++i) { float a = cb;
#pragma unroll
            for (int k = 0; k < 31; ++k) a += w[k] * glu[i + k];
            hb[(16 * grp + i) * 512 + ch] = a; }
    }
    WG_BAR();
    const float* lg = INP(20) + l * 512 + 8 * C.lane; const float* lb = INP(21) + l * 512 + 8 * C.lane;
    for (int q = 0; q < 8; ++q) { const int i = 8 * C.wave + q; const LAS float* p = hb + i * 512 + 8 * C.lane; const f32x4 a = *(const LAS f32x4*)p, b = *(const LAS f32x4*)(p + 4);
        float v[8] = {a.x, a.y, a.z, a.w, b.x, b.y, b.z, b.w}; float s = 0.f;
#pragma unroll
        for (int c = 0; c < 8; ++c) s += v[c];
        const float mu = wave_sum(s) * (1.f / 512.f); float s2 = 0.f;
#pragma unroll
        for (int c = 0; c < 8; ++c) { v[c] -= mu; s2 += v[c] * v[c]; }
        const float rs = rsqrtf(wave_sum(s2) * (1.f / 512.f) + EPS);
#pragma unroll
        for (int c = 0; c < 8; ++c) v[c] = silu(v[c] * rs * lg[c] + lb[c]);
        *(bf16x8*)(Y + (size_t)(r0 + i) * D + 1536 + 8 * C.lane) = pack8(v); }
    WG_BAR();
}

__device__ __forceinline__ void p_mixers(Ctx& C, int l) {
    const int nchk = l == 0 ? NCH : MX / 64;
    for (int u = C.bid; u < NCH * 4; u += C.G) dnprep_unit(C, l, u >> 2, u & 3);
    for (int u = (C.bid + 3 * C.G / 4) % C.G; u < nchk; u += C.G) conf_unit(C, l, u);
    for (int u = (C.bid + 3 * C.G / 16) % C.G; u < (nchk / 2) * 4; u += C.G) sg_unit(C, l, u >> 2, u & 3);
    for (int u = (C.bid + 3 * C.G / 16) % C.G; u < nchk * 4; u += C.G) pool_unit(C, l, u >> 2, u & 3);
}

__device__ __forceinline__ void p_scan(Ctx& C, int l) {
    if (C.bid >= 32) return;
    const int b = C.bid >> 3, h = (C.bid >> 1) & 3, dir = C.bid & 1, lane = C.lane, w = C.wave, c = lane & 15, g4 = lane >> 4;
    float* O = WSP(float, WS_O) + (size_t)dir * MT * 512;
    f32x4 S[8];
#pragma unroll
    for (int t = 0; t < 8; ++t) S[t] = (f32x4){0.f, 0.f, 0.f, 0.f};
    for (int seg = 0; seg < 2; ++seg) {
        const int rbase = seg == 0 ? MX + b * TC : b * TX, nch = seg == 0 ? TC / 64 : TX / 64;
        for (int n = 0; n < nch; ++n) {
            const int cid = (rbase >> 6) + n; const size_t rec = dn_rec(dir, cid, h);
            const bf16x8* Wf = (const bf16x8*)(WSP(unsigned char, WS_DNW) + rec * 16384) + lane;
            const bf16x8* QGf = (const bf16x8*)(WSP(unsigned char, WS_DNQG) + rec * 16384) + lane;
            const bf16x8* KDf = (const bf16x8*)(WSP(unsigned char, WS_DNKDT) + rec * 16384) + lane;
            const bf16x8* QKf = (const bf16x8*)(WSP(unsigned char, WS_DNQK) + rec * 8192) + lane;
            const float* Ut = WSP(float, WS_DNU) + (rec * 128 + 16 * w + c) * 64 + 4 * g4;
            const float egl = WSP(float, WS_EGL)[rec];
            bf16x8 Sb[4];
#pragma unroll
            for (int ks = 0; ks < 4; ++ks) { float v[8] = {S[2 * ks][0], S[2 * ks][1], S[2 * ks][2], S[2 * ks][3], S[2 * ks + 1][0], S[2 * ks + 1][1], S[2 * ks + 1][2], S[2 * ks + 1][3]}; Sb[ks] = pack8(v); }
            f32x4 vn[4], oacc[4];
#pragma unroll
            for (int mb = 0; mb < 4; ++mb) { f32x4 a = (f32x4){0.f, 0.f, 0.f, 0.f}, o = (f32x4){0.f, 0.f, 0.f, 0.f};
#pragma unroll
                for (int ks = 0; ks < 4; ++ks) { a = mfma16(Wf[(mb * 4 + ks) * 64], Sb[ks], a); o = mfma16(QGf[(mb * 4 + ks) * 64], Sb[ks], o); }
                vn[mb] = *(const f32x4*)(Ut + 16 * mb) - a; oacc[mb] = o; }
            bf16x8 Vb[2];
#pragma unroll
            for (int k2 = 0; k2 < 2; ++k2) { float v[8] = {vn[2 * k2][0], vn[2 * k2][1], vn[2 * k2][2], vn[2 * k2][3], vn[2 * k2 + 1][0], vn[2 * k2 + 1][1], vn[2 * k2 + 1][2], vn[2 * k2 + 1][3]}; Vb[k2] = pack8(v); }
#pragma unroll
            for (int mb = 0; mb < 4; ++mb) {
#pragma unroll
                for (int k2 = 0; k2 < 2; ++k2) oacc[mb] = mfma16(QKf[(mb * 2 + k2) * 64], Vb[k2], oacc[mb]);
#pragma unroll
                for (int r = 0; r < 4; ++r) O[(size_t)(rbase + 64 * n + 16 * mb + 4 * g4 + r) * 512 + 128 * h + 16 * w + c] = oacc[mb][r]; }
#pragma unroll
            for (int t = 0; t < 8; ++t) { f32x4 a = S[t] * egl;
#pragma unroll
                for (int k2 = 0; k2 < 2; ++k2) a = mfma16(KDf[(t * 2 + k2) * 64], Vb[k2], a);
                S[t] = a; }
        }
    }
}

__device__ __forceinline__ void p_ghn(Ctx& C, int l) {
    const int nrows = l == 0 ? MT : MX, lane = C.lane; const float* O = WSP(float, WS_O); const bf16* P = WSP(bf16, WS_P); bf16* Y = WSP(bf16, WS_Y);
    const float* gn = INP(11) + l * 128 + 8 * (lane & 15);
    for (int row = C.bid * NWAVE + C.wave; row < nrows; row += C.G * NWAVE) {
        const int rb = dirrow(row, 1);
        const f32x4* pf = (const f32x4*)(O + (size_t)row * 512 + 8 * lane); const f32x4* pb = (const f32x4*)(O + ((size_t)MT + rb) * 512 + 8 * lane);
        const f32x4 a = pf[0] + pb[0], b2 = pf[1] + pb[1];
        float o[8] = {a.x, a.y, a.z, a.w, b2.x, b2.y, b2.z, b2.w}, z[8]; float ss = 0.f;
#pragma unroll
        for (int c = 0; c < 8; ++c) ss += o[c] * o[c];
        const float rs = rsqrtf(sum16(ss) * (1.f / 128.f) + EPS);
        unpack8(*(const u32x4*)(P + (size_t)row * NIN + PZ + 8 * lane), z);
#pragma unroll
        for (int c = 0; c < 8; ++c) o[c] = o[c] * rs * gn[c] * silu(z[c]);
        *(bf16x8*)(Y + (size_t)row * D + 8 * lane) = pack8(o);
    }
}

__device__ __forceinline__ void p_moe_gather(Ctx& C) {
    int* R = WSP(int, WS_ROUTE); const unsigned* ctl = WSP(unsigned, WS_CTL);
    LAS int* offs = (LAS int*)C.lds;
    if (C.tid == 0) { int o = 0, nt = 0;
        for (int e = 0; e < 8; ++e) { const int cnt = (int)ctl[CW_CNT + 64 * e], tl = (cnt + 255) >> 8; offs[e] = o;
            if (C.bid == 0) for (int q = 0; q < tl; ++q) R[R_TILEE + nt + q] = e;
            nt += tl; o += tl << 8; }
        if (C.bid == 0) R[R_NT] = nt; }
    WG_BAR();
    const bf16* AN = WSP(bf16, WS_AN); bf16* AS = WSP(bf16, WS_AS);
    for (int tok = C.bid * NWAVE + C.wave; tok < MX; tok += C.G * NWAVE) {
        const int p0 = offs[R[R_TE + 2 * tok]] + R[R_RANK + 2 * tok], p1 = offs[R[R_TE + 2 * tok + 1]] + R[R_RANK + 2 * tok + 1];
        if (C.lane == 0) { R[R_POS + 2 * tok] = p0; R[R_POS + 2 * tok + 1] = p1; }
        const u32x4* src = (const u32x4*)(AN + (size_t)tok * D) + C.lane; u32x4* d0 = (u32x4*)(AS + (size_t)p0 * D) + C.lane; u32x4* d1 = (u32x4*)(AS + (size_t)p1 * D) + C.lane;
#pragma unroll
        for (int j = 0; j < 4; ++j) { const u32x4 v = src[64 * j]; d0[64 * j] = v; d1[64 * j] = v; }
    }
}

__device__ __forceinline__ void p_final(Ctx& C, float* out) {
    const int* R = WSP(int, WS_ROUTE); const float* Rf = WSP(float, WS_ROUTE); const float* XS = WSP(float, WS_XS); const float* OS = WSP(float, WS_OUTS);
    const float* mod = WSP(float, WS_MODV) + (size_t)5 * 12288; const int lane = C.lane;
    for (int tok = C.bid * NWAVE + C.wave; tok < MX; tok += C.G * NWAVE) {
        const int p0 = R[R_POS + 2 * tok], p1 = R[R_POS + 2 * tok + 1]; const float g0 = Rf[R_TG + 2 * tok], g1 = Rf[R_TG + 2 * tok + 1];
        const f32x4* xp = (const f32x4*)(XS + (size_t)tok * D) + lane; const f32x4* o0 = (const f32x4*)(OS + (size_t)p0 * D) + lane; const f32x4* o1 = (const f32x4*)(OS + (size_t)p1 * D) + lane;
        const f32x4* gf = (const f32x4*)(mod + (size_t)(tok >> 11) * 12288 + 10240) + lane; const f32x4* fg = (const f32x4*)INP(32) + lane;
        f32x4 x[8]; float ss = 0.f;
#pragma unroll
        for (int j = 0; j < 8; ++j) { x[j] = xp[64 * j] + gf[64 * j] * (o0[64 * j] * g0 + o1[64 * j] * g1); ss += (x[j].x * x[j].x + x[j].y * x[j].y) + (x[j].z * x[j].z + x[j].w * x[j].w); }
        const float rs = rsqrtf(wave_sum(ss) * (1.f / D) + EPS);
        f32x4* op = (f32x4*)(out + (size_t)tok * D) + lane;
#pragma unroll
        for (int j = 0; j < 8; ++j) op[64 * j] = x[j] * rs * fg[64 * j];
    }
}
}
namespace mk {
constexpr int NPHASE = 21;
struct Args { const float* in[33]; float* out; unsigned char* ws; int ph_lo, ph_hi; };
static_assert(sizeof(Args) == 35 * 8 + 8, "Args has no padding");

#ifdef ONLY_PHASE
#define IN(k) ((k) == ONLY_PHASE)
#else
#define IN(k) (lo <= (k) && (k) < hi)
#endif
#define SEAM(k) do { if (IN(k) && IN((k) + 1)) xcd_barrier(bar); } while (0)
template <int l>
__device__ __forceinline__ void layer_body(Ctx& C, const XcdBarrier& bar, const int lo, const int hi) {
        const int pb = l == 0 ? 1 : 10;
        const float* mod = WSP(float, WS_MODV) + (size_t)l * 5 * 12288;
        if (IN(pb + 0)) { if constexpr (l == 0) p_norm<0>(C, 0); else p_norm<1>(C, 1); } SEAM(pb + 0);
        if (IN(pb + 1)) {
            pg8::EpiStoreBf16 E{WSP(bf16, WS_P), NIN};
            pg8::Gemm g{WSP(bf16, WS_AN), WSP(bf16, WS_WIN) + (size_t)l * NIN * D, MT, NIN, D};
            if constexpr (l == 0) { pg8::StaticOrder S; S.init(MT, NIN, C.G, C.bid); pg8::gemm_phase<pg8::EpiStoreBf16, pg8::StaticOrder, true, true>(C.lds, g, S, E); }
            else { pg8::InProjL1Order S; S.init(C.G, C.bid); pg8::gemm_phase<pg8::EpiStoreBf16, pg8::InProjL1Order, true, true>(C.lds, g, S, E); }
        } SEAM(pb + 1);
        if (IN(pb + 2)) { p_mixers(C, l); } SEAM(pb + 2);
        if (IN(pb + 3)) { p_scan(C, l); } SEAM(pb + 3);
        if (IN(pb + 4)) { p_ghn(C, l); } SEAM(pb + 4);
        if (IN(pb + 5)) {
            pg8::EpiResid E{WSP(float, WS_XS), mod, 4096};
            pg8::Gemm g{WSP(bf16, WS_Y), WSP(bf16, WS_WOUT) + (size_t)l * D * D, l == 0 ? MT : MX, D, D};
            pg8::StaticOrder S; S.init(l == 0 ? MT : MX, D, C.G, C.bid);
            pg8::gemm_phase<pg8::EpiResid, pg8::StaticOrder, true, true>(C.lds, g, S, E);
        } SEAM(pb + 5);
        if (IN(pb + 6)) { if constexpr (l == 0) p_norm<2>(C, 0); else p_norm<3>(C, 1); } SEAM(pb + 6);
        if constexpr (l == 0) {
            if (IN(8)) {
                pg8::EpiSwiglu E{WSP(bf16, WS_HM), DFF, 1 << 20};
                pg8::Gemm g{WSP(bf16, WS_AN), WSP(bf16, WS_W13), MT, 2 * DFF, D};
                pg8::StaticOrder S; S.init(MT, 2 * DFF, C.G, C.bid);
                pg8::gemm_phase<pg8::EpiSwiglu, pg8::StaticOrder, true, true>(C.lds, g, S, E);
            } SEAM(8);
            if (IN(9)) {
                pg8::EpiResid E{WSP(float, WS_XS), mod, 10240};
                pg8::Gemm g{WSP(bf16, WS_HM), WSP(bf16, WS_W2), MT, D, DFF};
                pg8::StaticOrder S; S.init(MT, D, C.G, C.bid);
                pg8::gemm_phase<pg8::EpiResid, pg8::StaticOrder, true, true>(C.lds, g, S, E);
            } SEAM(9);
        } else {
            if (IN(17)) { p_moe_gather(C); } SEAM(17);
            if (IN(18)) {
                const int* R = WSP(int, WS_ROUTE);
                pg8::EpiSwiglu E{WSP(bf16, WS_HM), DFE, 56};
                pg8::Gemm g{WSP(bf16, WS_AS), WSP(bf16, WS_MW13), MSORT, 2 * DFE * NE, D};
                pg8::MoeOrder S; S.init(R[R_NT], 56, R + R_TILEE, C.G, C.bid);
                pg8::gemm_phase<pg8::EpiSwiglu, pg8::MoeOrder, true, true>(C.lds, g, S, E);
            } SEAM(18);
            if (IN(19)) {
                const int* R = WSP(int, WS_ROUTE);
                pg8::EpiStoreF32 E{WSP(float, WS_OUTS)};
                pg8::Gemm g{WSP(bf16, WS_HM), WSP(bf16, WS_MW2), MSORT, D * NE, DFE};
                pg8::MoeOrder S; S.init(R[R_NT], 8, R + R_TILEE, C.G, C.bid);
                pg8::gemm_phase<pg8::EpiStoreF32, pg8::MoeOrder, true, true>(C.lds, g, S, E);
            } SEAM(19);
        }
    }
__global__ void __launch_bounds__(NTHR, 2) fwd(Args a) {
    extern __shared__ __attribute__((aligned(16))) unsigned char lds_raw[];
    Ctx C;
    C.lds = (LAS unsigned char*)lds_raw;
    C.in = (CIN)__builtin_amdgcn_kernarg_segment_ptr();
    C.out = a.out; C.ws = a.ws; C.tid = threadIdx.x; C.lane = C.tid & 63; C.wave = __builtin_amdgcn_readfirstlane(C.tid >> 6); C.G = gridDim.x; C.bid = blockIdx.x;
    const int lo = a.ph_lo, hi = a.ph_hi;
    XcdBarrier bar; bar.bar = WSP(unsigned, WS_CTL) + CW_BAR; bar.x = 0; bar.st = (volatile LAS unsigned*)(C.lds + LDS_BARW);
    if (hi - lo > 1) {
        if (C.tid < 4) { ((volatile LAS unsigned*)(C.lds + LDS_BARW))[C.tid] = 0u; }
        __syncthreads();
        bar = xcd_barrier_post(WSP(unsigned, WS_CTL) + CW_BAR, (volatile LAS unsigned*)(C.lds + LDS_BARW));
    }
    if (IN(0)) { p_prologue(C); } SEAM(0);
    layer_body<0>(C, bar, lo, hi);
    layer_body<1>(C, bar, lo, hi);
    if (IN(20)) { p_final(C, C.out); }
}

static int g_grid = 0;
static inline bool setup(size_t ws_size, size_t need) {
    if (g_grid == 0) {
        if (ws_size < need) { fprintf(stderr, "kernel_launch: workspace too small: %zu < %zu\n", ws_size, need); g_grid = -1; return false; }
        int dev = 0, cus = 0, per_cu = 0;
        if (hipGetDevice(&dev) != hipSuccess || hipDeviceGetAttribute(&cus, hipDeviceAttributeMultiprocessorCount, dev) != hipSuccess) { g_grid = -1; return false; }
        if (hipFuncSetAttribute((const void*)fwd, hipFuncAttributeMaxDynamicSharedMemorySize, LDS_BYTES) != hipSuccess) { fprintf(stderr, "kernel_launch: hipFuncSetAttribute failed\n"); g_grid = -1; return false; }
        if (hipOccupancyMaxActiveBlocksPerMultiprocessor(&per_cu, (const void*)fwd, NTHR, LDS_BYTES) != hipSuccess || per_cu < 1) { fprintf(stderr, "kernel_launch: occupancy query says %d\n", per_cu); }
        (void)hipGetLastError();
        g_grid = cus;
    }
    return g_grid > 0;
}
static inline void launch(void* const* d_in, float* out, void* d_ws, int lo, int hi, hipStream_t stream) {
    Args a{};
    for (int i = 0; i < 33; ++i) a.in[i] = (const float*)d_in[i];
    a.out = out; a.ws = (unsigned char*)d_ws; a.ph_lo = lo; a.ph_hi = hi;
    hipLaunchKernelGGL(fwd, dim3(g_grid), dim3(NTHR), LDS_BYTES, stream, a);
}
}
#ifndef MK_DEBUG
#define MK_DEBUG 0
#endif
#ifndef MK_ONE_LAUNCH
#define MK_ONE_LAUNCH 0
#endif
#if MK_DEBUG
#ifndef DBG_LAYER
#define DBG_LAYER 0
#endif
namespace dbg {
using namespace mk;
constexpr size_t SNAP = (WS_END + 4095) & ~(size_t)4095;
constexpr size_t S_ERR = SNAP;
constexpr size_t S_MOD = S_ERR + 4096;
constexpr size_t S_AN = S_MOD + al((size_t)10 * 12288 * 2);
constexpr size_t S_AB = S_AN + al((size_t)MT * D * 2);
constexpr size_t S_P = S_AB + al((size_t)MT * 16 * 2);
constexpr size_t S_O = S_P + al((size_t)MT * NIN * 2);
constexpr size_t S_Y = S_O + al((size_t)2 * MT * 512 * 2);
constexpr size_t S_XM = S_Y + al((size_t)MT * D * 2);
constexpr size_t S_AF = S_XM + al((size_t)MT * D * 2);
constexpr size_t S_XE = S_AF + al((size_t)MT * D * 2);
constexpr size_t S_OUT2 = S_XE + al((size_t)MT * D * 2);
constexpr size_t S_END = S_OUT2 + al((size_t)MX * D * 4);
constexpr int NCK = 12;
__global__ void k_snap(const float* src, size_t lds_, bf16* dst, size_t ldd, int rows, int cols, int mode) {
    for (size_t i = (size_t)blockIdx.x * blockDim.x + threadIdx.x; i < (size_t)rows * cols; i += (size_t)gridDim.x * blockDim.x) {
        const int r = (int)(i / cols), c = (int)(i % cols); int sr = r, sc = c;
        if (mode == 1) sc = c < 1536 ? c : c + 16;
        if (mode == 2) sc = c + 1536;
        size_t dr = r;
        if (mode == 3) { const int dir = r / MT, row = r % MT; dr = (size_t)dir * MT + dirrow(row, dir); }
        dst[dr * ldd + c] = (bf16)f2bf(src[(size_t)sr * lds_ + sc]); }
}
__global__ void k_cmp(const void* a, int a_bf16, size_t lda, size_t acol0, const bf16* b, size_t ldb, size_t bcol0, int rows, int cols, float* acc) {
    float num = 0.f, den = 0.f;
    for (size_t i = (size_t)blockIdx.x * blockDim.x + threadIdx.x; i < (size_t)rows * cols; i += (size_t)gridDim.x * blockDim.x) {
        const size_t r = i / cols, c = i % cols;
        const float av = a_bf16 ? bf2f(((const bf16*)a)[r * lda + acol0 + c]) : ((const float*)a)[r * lda + acol0 + c];
        const float bv = bf2f(b[r * ldb + bcol0 + c]); const float d = av - bv;
        if (!(d == d)) { num += 1e30f; } else { num += d * d; } den += bv * bv; }
    num = wave_sum(num); den = wave_sum(den);
    if ((threadIdx.x & 63) == 0) { atomicAdd(acc, num); atomicAdd(acc + 1, den); }
}
__global__ void k_decide(float* err) {
    if (threadIdx.x != 0) return; int code = -1, level = 0;
    for (int k = 0; k < NCK; ++k) { const float num = err[2 * k], den = err[2 * k + 1]; if (den == 0.f && num == 0.f) continue;
        const float e = sqrtf(num / fmaxf(den, 1e-30f)); const float tol = (k == 4) ? 0.06f : 0.03f;
        if (!(e <= tol)) { code = k; level = !(e == e) ? 5 : e < 1e-4f ? 0 : e < 1e-3f ? 1 : e < 1e-2f ? 2 : e < 1e-1f ? 3 : e < 1.f ? 4 : 5; break; } }
    ((int*)err)[64] = code; ((int*)err)[65] = level;
}
__global__ void k_encode(float* out, const float* out2, const float* err) {
    const int code = ((const int*)err)[64], level = ((const int*)err)[65];
    for (size_t i = (size_t)blockIdx.x * blockDim.x + threadIdx.x; i < (size_t)MX * D; i += (size_t)gridDim.x * blockDim.x) {
        if (code < 0) { out[i] = out2[i]; continue; }
        const size_t row = i / D; if (row < (size_t)(code + 1) * (MX / 16)) out[i] = 0.f;
        if (i == (size_t)MX * D - 1) out[i] = (float)(16 << level); }
}
}
#endif

extern "C" void kernel_launch(void* const* d_in, const int* in_sizes, int n_in, void* d_out, int out_size, void* d_ws, size_t ws_size, hipStream_t stream) {
    using namespace mk;
#if MK_DEBUG
    if (!setup(ws_size, dbg::S_END) || n_in != 33) return;
    unsigned char* ws = (unsigned char*)d_ws;
    nv::Bufs nb; const size_t nneed = nv::carve(ws, nb);
    if (nneed > dbg::SNAP) { fprintf(stderr, "naive scratch overlaps snapshots\n"); return; }
    hipMemsetAsync(ws + dbg::S_ERR, 0, 4096, stream);
    auto snap = [&](const float* src, size_t lds_, size_t dst_off, size_t ldd, int rows, int cols, int mode) {
        hipLaunchKernelGGL(dbg::k_snap, dim3(2048), dim3(256), 0, stream, src, lds_, (bf16*)(ws + dst_off), ldd, rows, cols, mode); };
    auto hook = [&](int point, int l) {
        if (point == 0) { snap(nb.mod, 12288, dbg::S_MOD, 12288, 10, 12288, 0); return; }
        if (l != DBG_LAYER) return;
        if (point == 1) snap(nb.A, D, dbg::S_AN, D, MT, D, 0);
        if (point == 2) { snap(nb.p, nv::INW, dbg::S_P, NIN, MT, NIN, 1); snap(nb.p, nv::INW, dbg::S_AB, 16, MT, 16, 2); }
        if (point == 3) snap(nb.o, 512, dbg::S_O, 512, 2 * MT, 512, 3);
        if (point == 4) snap(nb.y, D, dbg::S_Y, D, MT, D, 0);
        if (point == 5) snap(nb.xs, D, dbg::S_XM, D, MT, D, 0);
        if (point == 6) snap(nb.A, D, dbg::S_AF, D, MT, D, 0);
        if (point == 7) snap(nb.xs, D, dbg::S_XE, D, MT, D, 0);
    };
    nv::forward(d_in, (float*)d_out, nb, stream, hook);
    hipMemsetAsync(ws + WS_CTL, 0, CTL_BYTES, stream);
    float* err = (float*)(ws + dbg::S_ERR); float* out2 = (float*)(ws + dbg::S_OUT2);
    auto cmp = [&](int k, const void* a, int a_bf16, size_t lda, size_t acol0, size_t snap_off, size_t ldb, size_t bcol0, int rows, int cols) {
        hipLaunchKernelGGL(dbg::k_cmp, dim3(1024), dim3(256), 0, stream, a, a_bf16, lda, acol0, (const bf16*)(ws + snap_off), ldb, bcol0, rows, cols, err + 2 * k); };
    const int L = DBG_LAYER, pb = L == 0 ? 1 : 10, nr = L == 0 ? MT : MX;
    for (int ph = 0; ph < NPHASE; ++ph) {
        launch(d_in, out2, d_ws, ph, ph + 1, stream);
        if (ph == 0) cmp(0, ws + WS_MODV, 0, 12288, 0, dbg::S_MOD, 12288, 0, 10, 12288);
        if (ph == pb + 0) { cmp(1, ws + WS_AN, 1, D, 0, dbg::S_AN, D, 0, MT, D); cmp(2, ws + WS_ABF, 0, 16, 0, dbg::S_AB, 16, 0, MT, 16); }
        if (ph == pb + 1) { cmp(3, ws + WS_P, 1, NIN, 0, dbg::S_P, NIN, 0, nr, NIN); if (L == 1) cmp(3, ws + WS_P + (size_t)MX * NIN * 2, 1, NIN, 0, dbg::S_P + (size_t)MX * NIN * 2, NIN, 0, MC, 1536); }
        if (ph == pb + 3) cmp(4, ws + WS_O, 0, 512, 0, dbg::S_O, 512, 0, 2 * MT, 512);
        if (ph == pb + 4) { cmp(5, ws + WS_Y, 1, D, 0, dbg::S_Y, D, 0, nr, 512); cmp(6, ws + WS_Y, 1, D, 512, dbg::S_Y, D, 512, nr, 512);
                            cmp(7, ws + WS_Y, 1, D, 1024, dbg::S_Y, D, 1024, nr, 512); cmp(8, ws + WS_Y, 1, D, 1536, dbg::S_Y, D, 1536, nr, 512); }
        if (ph == pb + 5) cmp(9, ws + WS_XS, 0, D, 0, dbg::S_XM, D, 0, nr, D);
        if (ph == pb + 6) cmp(10, ws + WS_AN, 1, D, 0, dbg::S_AF, D, 0, nr, D);
        if (L == 0 && ph == 9) cmp(11, ws + WS_XS, 0, D, 0, dbg::S_XE, D, 0, MT, D);
    }
    hipLaunchKernelGGL(dbg::k_decide, dim3(1), dim3(64), 0, stream, err);
    hipLaunchKernelGGL(dbg::k_encode, dim3(2048), dim3(256), 0, stream, (float*)d_out, out2, err);
#else
    if (!setup(ws_size, WS_END) || n_in != 33) return;
    hipMemsetAsync((unsigned char*)d_ws + WS_CTL, 0, CTL_BYTES, stream);
#if MK_ONE_LAUNCH
    launch(d_in, (float*)d_out, d_ws, 0, NPHASE, stream);
#else
    for (int ph = 0; ph < NPHASE; ++ph) launch(d_in, (float*)d_out, d_ws, ph, ph + 1, stream);
#endif
#endif
}
```

```cpp
#include <hip/hip_runtime.h>
#include <cstdio>
#include <cstdint>
#define MK_DEBUG 0
#define DBG_LAYER 0
#define MK_ONE_LAUNCH 1
#define REP_MASK 0
#ifndef BG_QUEUE
#define BG_QUEUE 0
#endif
#ifndef STATIC_FILL
#define STATIC_FILL MK_ONE_LAUNCH
#endif
#define GAS __attribute__((address_space(1)))
#define LAS __attribute__((address_space(3)))
typedef unsigned short bf16;
typedef short bf16x8 __attribute__((ext_vector_type(8)));
typedef float f32x4 __attribute__((ext_vector_type(4)));
typedef float f32x2 __attribute__((ext_vector_type(2)));
typedef unsigned u32x4 __attribute__((ext_vector_type(4)));
typedef unsigned u32x2 __attribute__((ext_vector_type(2)));

#ifndef FP8_EMU
#define FP8_EMU 0
#endif
#ifndef MOE_FP8
#define MOE_FP8 1
#endif
__device__ __forceinline__ float rne_e4m3(float x) { return __builtin_amdgcn_cvt_f32_fp8(__builtin_amdgcn_cvt_pk_fp8_f32(x, x, 0, false), 0); }
namespace mk {
constexpr int D = 2048, NB = 4, TX = 2048, TC = 256, MX = NB * TX, MC = NB * TC, MT = MX + MC;
constexpr int INW = 4624, NIN = 4608;
constexpr int PQ = 0, PK = 512, PV = 1024, PZ = 1536, PSGU = 2048, PSGV = 2560, PPOOL = 3072, PCVA = 3584, PCVG = 4096;
constexpr int DFF = 5632, NE = 8, DFE = 7168;
constexpr int NCH = MT / 64;
constexpr int MSORT = 2 * MX + NE * 256;
constexpr float EPS = 1e-6f;
constexpr int NTHR = 512, NWAVE = 8;
constexpr int LDS_BYTES = 163840;
constexpr int LDS_BARW = LDS_BYTES - 16;

constexpr size_t al(size_t x) { return (x + 4095) & ~(size_t)4095; }
constexpr size_t WS_CTL = 0, CTL_BYTES = 1u << 20;
constexpr size_t WS_MODV = WS_CTL + CTL_BYTES;
constexpr size_t WS_POS = WS_MODV + al((size_t)2 * 5 * 12288 * 4);
constexpr size_t WS_PWT = WS_POS + al((size_t)TX * D * 4);
constexpr size_t WS_WABC = WS_PWT + al((size_t)2 * 4 * 128 * 128 * 2);
constexpr size_t WS_WIN = WS_WABC + al((size_t)2 * 2048 * 16 * 4);
constexpr size_t WS_WOUT = WS_WIN + al((size_t)2 * NIN * D * 2);
constexpr size_t WS_W13 = WS_WOUT + al((size_t)2 * D * D * 2);
constexpr size_t WS_W2 = WS_W13 + al((size_t)2 * DFF * D * 2);
constexpr size_t WS_MW13 = WS_W2 + al((size_t)D * DFF * 2);
constexpr size_t WS_MW2 = WS_MW13 + al((size_t)NE * 2 * DFE * D * 2);
constexpr size_t WS_XS = WS_MW2 + al((size_t)NE * D * DFE * 2);
constexpr size_t WS_AN = WS_XS + al((size_t)MT * D * 4);
constexpr size_t WS_ABF = WS_AN + al((size_t)MT * D * 2);
constexpr size_t WS_ROUTE = WS_ABF + al((size_t)MT * 16 * 4);
constexpr size_t WS_BIG = WS_ROUTE + al((size_t)1 << 20);
constexpr size_t WS_P = WS_BIG;
constexpr size_t DN_FRAG = (size_t)2 * NCH * 4;
constexpr size_t WS_DNW = WS_P + al((size_t)MT * NIN * 2);
constexpr size_t WS_DNQG = WS_DNW + al(DN_FRAG * 16384);
constexpr size_t WS_DNKDT = WS_DNQG + al(DN_FRAG * 16384);
constexpr size_t WS_DNQK = WS_DNKDT + al(DN_FRAG * 16384);
constexpr size_t WS_DNU = WS_DNQK + al(DN_FRAG * 8192);
constexpr size_t WS_EGL = WS_DNU + al(DN_FRAG * 32768);
constexpr size_t WS_O = WS_EGL + al(DN_FRAG * 4);
constexpr size_t WS_Y = WS_O + al((size_t)2 * MT * 512 * 4);
constexpr size_t WS_MIX_END = WS_Y + al((size_t)MT * D * 2);
constexpr size_t WS_HM = WS_BIG;
constexpr size_t WS_AS = WS_HM + al((size_t)MSORT * DFE * 2);
constexpr size_t WS_OUTS = WS_AS + al((size_t)MSORT * D * 2);
constexpr size_t WS_FFN_END = WS_OUTS + al((size_t)MSORT * D * 4);
constexpr size_t WS_END = WS_FFN_END > WS_MIX_END ? WS_FFN_END : WS_MIX_END;
constexpr int R_TE = 0;
constexpr int R_TG = R_TE + MX * 2;
constexpr int R_RANK = R_TG + MX * 2;
constexpr int R_POS = R_RANK + MX * 2;
constexpr int R_TILEE = R_POS + MX * 2;
constexpr int R_NT = R_TILEE + 128;
constexpr int CW_CNT = 64;
constexpr int CW_BGHEAD = 1024;
constexpr int CW_DONE = 2048;
constexpr int CW_BAR = 4096;

__device__ __forceinline__ float silu(float x) { return x * __builtin_amdgcn_rcpf(1.f + __expf(-x)); }
__device__ __forceinline__ float sigm(float x) { return __builtin_amdgcn_rcpf(1.f + __expf(-x)); }
__device__ __forceinline__ float gelu_tanh(float x) { const float u = 0.7978845608028654f * (x + 0.044715f * x * x * x); const float e = __expf(2.f * u); return x * (1.f - __builtin_amdgcn_rcpf(1.f + e)); }
__device__ __forceinline__ float softplus(float x) { return x > 20.f ? x : log1pf(__expf(x)); }
__device__ __forceinline__ unsigned f2bf(float f) { unsigned u = __builtin_bit_cast(unsigned, f); return (u + 0x7fffu + ((u >> 16) & 1u)) >> 16; }
__device__ __forceinline__ unsigned pk2(float lo, float hi) { return f2bf(lo) | (f2bf(hi) << 16); }
__device__ __forceinline__ float bf2f(unsigned short b) { return __builtin_bit_cast(float, (unsigned)b << 16); }
__device__ __forceinline__ float bflo(unsigned w) { return __builtin_bit_cast(float, w << 16); }
__device__ __forceinline__ float bfhi(unsigned w) { return __builtin_bit_cast(float, w & 0xffff0000u); }
__device__ __forceinline__ bf16x8 pack8(const float* v) { u32x4 w; w.x = pk2(v[0], v[1]); w.y = pk2(v[2], v[3]); w.z = pk2(v[4], v[5]); w.w = pk2(v[6], v[7]); return __builtin_bit_cast(bf16x8, w); }
__device__ __forceinline__ void unpack8(u32x4 w, float* v) { v[0] = bflo(w.x); v[1] = bfhi(w.x); v[2] = bflo(w.y); v[3] = bfhi(w.y); v[4] = bflo(w.z); v[5] = bfhi(w.z); v[6] = bflo(w.w); v[7] = bfhi(w.w); }
__device__ __forceinline__ unsigned pk4_fp8(float a, float b, float c, float d) { int p = __builtin_amdgcn_cvt_pk_fp8_f32(a, b, 0, false); p = __builtin_amdgcn_cvt_pk_fp8_f32(c, d, p, true); return (unsigned)p; }
__device__ __forceinline__ float clamp448(float x) { return fminf(fmaxf(x, -448.f), 448.f); }
__device__ __forceinline__ float wave_sum(float v) {
#pragma unroll
    for (int o = 1; o < 64; o <<= 1) v += __shfl_xor(v, o);
    return v;
}
__device__ __forceinline__ float sum16(float v) {
#pragma unroll
    for (int o = 1; o < 16; o <<= 1) v += __shfl_xor(v, o);
    return v;
}
__device__ __forceinline__ void rowinfo(int row, int& base, int& T, int& t, int& mv) {
    if (row < MX) { const int b = row >> 11; base = b << 11; T = TX; t = row - base; mv = b; }
    else { const int r = row - MX, b = r >> 8; base = MX + (b << 8); T = TC; t = r - (b << 8); mv = 4; }
}
__device__ __forceinline__ int dirrow(int row, int dir) { int base, T, t, mv; rowinfo(row, base, T, t, mv); return dir ? base + (T - 1 - t) : row; }
#define LDS_WAIT() asm volatile("s_waitcnt lgkmcnt(0)" ::: "memory")
#define VM_WAIT() asm volatile("s_waitcnt vmcnt(0)" ::: "memory")
#define WG_BAR() do { __syncthreads(); } while (0)
}
#define XB_TMO      128
#define XB_XCNT(j)  (256  + 64 * (j))
#define XB_XSUB(j)  (1280 + 64 * (j))
#define XB_XGEN(j)  (2304 + 64 * (j))
#define XB_TOP      3328
#define XB_TOPGEN   3392
#define XCD_BAR_WORDS 3456
#define XB_SPIN_CAP (1u << 18)
#define LAS __attribute__((address_space(3)))

__device__ __forceinline__ unsigned xb_ld(unsigned* p)              { return __hip_atomic_load(p, __ATOMIC_RELAXED, __HIP_MEMORY_SCOPE_AGENT); }
__device__ __forceinline__ unsigned xb_add(unsigned* p, unsigned v) { return __hip_atomic_fetch_add(p, v, __ATOMIC_RELAXED, __HIP_MEMORY_SCOPE_AGENT); }
__device__ __forceinline__ unsigned xb_xcc_id() { return (unsigned)__builtin_amdgcn_s_getreg((3 << 11) | 20) & 0xFu; }
#define XB_SPIN(cond, bar) do { unsigned _sp = 0; while (cond) { __builtin_amdgcn_s_sleep(1); \
    if ((++_sp & 255u) == 0u) { if (xb_ld(&(bar)[XB_TMO])) break; if (_sp > XB_SPIN_CAP) { atomicAdd(&(bar)[XB_TMO], 1u); break; } } } } while (0)

struct XcdBarrier {
    unsigned* bar; unsigned x;
    volatile LAS unsigned* st;
};

__device__ __forceinline__ XcdBarrier xcd_barrier_post(unsigned* bar, volatile LAS unsigned* st) {
    XcdBarrier b; b.bar = bar; b.x = xb_xcc_id(); b.st = st;
    if (threadIdx.x == 0) (void)xb_add(&bar[XB_XCNT(b.x)], 1u);
    return b;
}
__device__ __forceinline__ void xcd_barrier_complete(unsigned* bar, unsigned x, unsigned& nloc, unsigned& nx) {
    const unsigned G = gridDim.x * gridDim.y * gridDim.z;
    unsigned sum, cnt, mine, sp = 0u;
    for (;;) {
        sum = 0u; cnt = 0u; mine = 0u;
#pragma unroll
        for (unsigned j = 0; j < 16; ++j) { const unsigned c = xb_ld(&bar[XB_XCNT(j)]); sum += c; cnt += (c > 0u) ? 1u : 0u; mine = (j == x) ? c : mine; }
        if (sum == G) break;
        __builtin_amdgcn_s_sleep(1);
        if ((++sp & 255u) == 0u) { if (xb_ld(&bar[XB_TMO])) break; if (sp > XB_SPIN_CAP) { atomicAdd(&bar[XB_TMO], 1u); break; } }
    }
    nloc = mine > 0u ? mine : 1u; nx = cnt > 0u ? cnt : 1u;
}

__device__ __forceinline__ void xcd_barrier(const XcdBarrier& b) {
    asm volatile("s_waitcnt vmcnt(0)" ::: "memory");
    __syncthreads();
    if (threadIdx.x == 0) {
        unsigned* bar = b.bar;
        __builtin_amdgcn_s_waitcnt(0);
        unsigned nloc = b.st[0], nx = b.st[1];
        if (nloc == 0u) { xcd_barrier_complete(bar, b.x, nloc, nx); b.st[0] = nloc; b.st[1] = nx; }
        const unsigned old = xb_add(&bar[XB_XSUB(b.x)], 1u);
        const unsigned gen = old / nloc;
        if (old + 1u == (gen + 1u) * nloc) {
            __builtin_amdgcn_fence(__ATOMIC_RELEASE, "agent");
            asm volatile("s_waitcnt vmcnt(0)" ::: "memory");
            const unsigned og = xb_add(&bar[XB_TOP], 1u);
            const unsigned tg = og / nx;
            if (og + 1u == (tg + 1u) * nx) xb_add(&bar[XB_TOPGEN], 1u);
            else XB_SPIN(xb_ld(&bar[XB_TOPGEN]) == tg, bar);
            __builtin_amdgcn_fence(__ATOMIC_ACQUIRE, "agent");
            xb_add(&bar[XB_XGEN(b.x)], 1u);
            asm volatile("s_waitcnt vmcnt(0)" ::: "memory");
        } else {
            XB_SPIN(xb_ld(&bar[XB_XGEN(b.x)]) == gen, bar);
            __builtin_amdgcn_fence(__ATOMIC_ACQUIRE, "agent");
            asm volatile("s_waitcnt vmcnt(0)" ::: "memory");
        }
    }
    __syncthreads();
}
namespace pg8 {
#define PG8_LAS __attribute__((address_space(3)))
typedef unsigned short bf16_t;
typedef short bf16x8 __attribute__((ext_vector_type(8)));
typedef float f32x4 __attribute__((ext_vector_type(4)));
typedef unsigned u32x4 __attribute__((ext_vector_type(4)));
constexpr int BM = 256, BK = 64, HALF = 128, HTB = HALF * BK * 2  , STAGE_BYTES = 8 * HTB, NXCD = 8, WGM = 8;

__host__ __device__ __forceinline__ int lds_byte(int r, int c) { const int st = (r >> 4) * 2 + (c >> 5), rr = r & 15, cc = c & 31, ob = rr * 64 + cc * 2; return st * 1024 + (ob ^ (((ob >> 9) & 1) << 5)); }
__host__ __device__ __forceinline__ void stage_rc(int b, int& R, int& C) { const int st = b / 1024, sb = b % 1024, swz = sb ^ (((sb >> 9) & 1) << 5); R = (st >> 1) * 16 + swz / 64; C = (st & 1) * 32 + (swz % 64) / 2; }
__host__ __device__ __forceinline__ int perm32(int rho) { const int n = rho >> 4, i = rho & 15; return 8 * (i >> 2) + 4 * n + (i & 3); }

struct Unit { int pm, pn; };
struct Gemm { const bf16_t* A; const bf16_t* Bt; int M, N, K; };

struct StaticOrder {
    int nM, nN, nwg, G, c;
    __host__ __device__ void init(int M, int N, int G_, int c_) { nM = M / BM; nN = N / BM; nwg = nM * nN; G = G_; c = c_; }
    __host__ __device__ bool next(int i, Unit& u) const {
        const long L = (long)i * G + c; if (L >= nwg) return false;
        int wgid = (int)L; { const int q = nwg / NXCD, r = nwg % NXCD, xcd = wgid % NXCD, off = wgid / NXCD; wgid = (xcd < r ? xcd * (q + 1) : r * (q + 1) + (xcd - r) * q) + off; }
        const int nig = WGM * nN, gid = wgid / nig, fm = gid * WGM, gsz = (nM - fm) < WGM ? (nM - fm) : WGM;
        u.pm = fm + ((wgid % nig) % gsz); u.pn = (wgid % nig) / gsz; return true;
    }
    __device__ __forceinline__ void a_ready(const Unit&) const {}
    __device__ __forceinline__ void done(const Unit&) const {}
};
__device__ __forceinline__ unsigned cvt_pk_bf16(float lo, float hi) { unsigned r; asm volatile("v_cvt_pk_bf16_f32 %0, %1, %2" : "=v"(r) : "v"(lo), "v"(hi)); return r; }
typedef float f32x2 __attribute__((ext_vector_type(2)));
typedef int pg8_v8i __attribute__((ext_vector_type(8)));
typedef int pg8_v4i __attribute__((ext_vector_type(4)));
__device__ __forceinline__ pg8_v8i pg8_cat(bf16x8 lo, bf16x8 hi) { const pg8_v4i a = __builtin_bit_cast(pg8_v4i, lo), b = __builtin_bit_cast(pg8_v4i, hi); return __builtin_shufflevector(a, b, 0, 1, 2, 3, 4, 5, 6, 7); }
constexpr int F8_WSCALE = 121;
template <class Epi, class Sched, bool ALIGN_EPI = false, bool SP2 = false, bool F8 = false>
__device__ __forceinline__ void gemm_phase(PG8_LAS unsigned char* lds, const Gemm g, const Sched& S, const Epi& E) {
    const int tid = threadIdx.x, wid = __builtin_amdgcn_readfirstlane(tid >> 6), lane = tid & 63, wr = wid >> 2, wc = wid & 3, fr = lane & 15, fq = lane >> 4;
    const int K = g.K, nt = K / BK;
    unsigned voffA[2], voffB[2];
#pragma unroll
    for (int i = 0; i < 2; ++i) { int R, C; stage_rc(tid * 16 + i * 8192, R, C); const int Rb = Epi::PERM ? ((R & ~31) + perm32(R & 31)) : R;
        voffA[i] = (unsigned)(R * K + C) * 2u; voffB[i] = (unsigned)(Rb * K + C) * 2u; }
    const size_t kstep = (size_t)(BK * 2);
    const size_t hstep = (size_t)HALF * K * 2;
    const size_t tstep = 2 * hstep;
    const unsigned ldsw = (unsigned)wid * 1024u;
    const int aoff = lds_byte(wr * 64 + fr, fq * 8), boff = lds_byte(wc * 32 + fr, fq * 8);
#define PG8_SA(b, h) (((b) * 2 + (h)) * HTB)
#define PG8_SB(b, h) ((4 + (b) * 2 + (h)) * HTB)
#define PG8_STAGE(bufoff, gbase, voff) do { _Pragma("unroll") for (int _i = 0; _i < 2; ++_i) \
        __builtin_amdgcn_global_load_lds((const unsigned*)((const char*)(gbase) + (voff)[_i]), (PG8_LAS unsigned*)(lds + (bufoff) + ldsw + _i * 8192), 16, 0, 0); } while (0)
#define PG8_LDA(dst, b, h) do { _Pragma("unroll") for (int m = 0; m < 4; ++m) { if constexpr (F8) { dst##8[m] = pg8_cat(*(const PG8_LAS bf16x8*)(lds + PG8_SA(b, h) + aoff + m * 2048), *(const PG8_LAS bf16x8*)(lds + PG8_SA(b, h) + aoff + m * 2048 + 1024)); } else { _Pragma("unroll") for (int k = 0; k < 2; ++k) dst[m][k] = *(const PG8_LAS bf16x8*)(lds + PG8_SA(b, h) + aoff + m * 2048 + k * 1024); } } } while (0)
#define PG8_LDB(dst, b, h) do { _Pragma("unroll") for (int n = 0; n < 2; ++n) { if constexpr (F8) { dst##8[n] = pg8_cat(*(const PG8_LAS bf16x8*)(lds + PG8_SB(b, h) + boff + n * 2048), *(const PG8_LAS bf16x8*)(lds + PG8_SB(b, h) + boff + n * 2048 + 1024)); } else { _Pragma("unroll") for (int k = 0; k < 2; ++k) dst[n][k] = *(const PG8_LAS bf16x8*)(lds + PG8_SB(b, h) + boff + n * 2048 + k * 1024); } } } while (0)
#define PG8_MMA(ai, bj, At, Bt) do { __builtin_amdgcn_s_setprio(1); if constexpr (F8) { _Pragma("unroll") for (int m = 0; m < 4; ++m) _Pragma("unroll") for (int n = 0; n < 2; ++n) \
        asm volatile("v_mfma_scale_f32_16x16x128_f8f6f4 %0, %1, %2, %0, %3, %4 op_sel_hi:[0,0,0]" : "+v"(acc[ai][bj][m][n]) : "v"(Bt##8[n]), "v"(At##8[m]), "v"(f8_sw), "v"(f8_sa)); } \
        else { _Pragma("unroll") for (int m = 0; m < 4; ++m) _Pragma("unroll") for (int n = 0; n < 2; ++n) _Pragma("unroll") for (int k = 0; k < 2; ++k) \
        acc[ai][bj][m][n] = __builtin_amdgcn_mfma_f32_16x16x32_bf16(Bt[n][k], At[m][k], acc[ai][bj][m][n], 0, 0, 0); } __builtin_amdgcn_s_setprio(0); } while (0)
#define PG8_WAIT_V(n) asm volatile("s_waitcnt vmcnt(" #n ")" ::: "memory")
#define PG8_WAIT_L(n) asm volatile("s_waitcnt lgkmcnt(" #n ")" ::: "memory")
#define PG8_BAR __builtin_amdgcn_s_barrier()
#define PG8_SCHED __builtin_amdgcn_sched_barrier(0)
    Unit cur, nxt; int ui = 0;
    if (!S.next(0, cur)) return;
    f32x4 acc[2][2][4][2];
#pragma unroll
    for (int a = 0; a < 2; ++a)
#pragma unroll
        for (int b = 0; b < 2; ++b)
#pragma unroll
            for (int m = 0; m < 4; ++m)
#pragma unroll
                for (int n = 0; n < 2; ++n) acc[a][b][m][n] = (f32x4){0.f, 0.f, 0.f, 0.f};
    bf16x8 At[4][2], B0[2][2], B1[2][2]; pg8_v8i At8[4], B08[2], B18[2]; const int f8_sw = F8_WSCALE, f8_sa = 127;
    const char* cA = (const char*)g.A + (size_t)cur.pm * tstep; const char* cB = (const char*)g.Bt + (size_t)cur.pn * tstep;
    S.a_ready(cur);
    if constexpr (SP2) {
        PG8_STAGE(PG8_SB(0, 0), cB, voffB); PG8_STAGE(PG8_SB(0, 1), cB + hstep, voffB); PG8_STAGE(PG8_SA(0, 0), cA, voffA); PG8_STAGE(PG8_SA(0, 1), cA + hstep, voffA);
        if (wr == 1) PG8_BAR;
        PG8_WAIT_V(2); PG8_BAR;
        PG8_STAGE(PG8_SB(1, 0), cB + kstep, voffB); PG8_STAGE(PG8_SA(1, 0), cA + kstep, voffA); PG8_STAGE(PG8_SB(1, 1), cB + hstep + kstep, voffB);
        PG8_WAIT_V(6); PG8_BAR;
    } else {
        PG8_STAGE(PG8_SB(0, 0), cB, voffB); PG8_STAGE(PG8_SA(0, 0), cA, voffA); PG8_STAGE(PG8_SB(0, 1), cB + hstep, voffB); PG8_STAGE(PG8_SA(0, 1), cA + hstep, voffA);
        if (wr == 1) PG8_BAR;
        PG8_WAIT_V(4); PG8_BAR;
        PG8_STAGE(PG8_SB(1, 0), cB + kstep, voffB); PG8_STAGE(PG8_SA(1, 0), cA + kstep, voffA); PG8_STAGE(PG8_SB(1, 1), cB + hstep + kstep, voffB);
        PG8_WAIT_V(6); PG8_BAR;
    }
    for (;;) {
        const bool has_next = S.next(ui + 1, nxt);
        const char* nA = has_next ? (const char*)g.A + (size_t)nxt.pm * tstep : cA; const char* nB = has_next ? (const char*)g.Bt + (size_t)nxt.pn * tstep : cB;
        for (int t = 0; t < nt; t += 2) {
            const bool last = (t == nt - 2);
            const char* a1 = cA + (size_t)(t + 1) * kstep;
            const char* a2 = last ? nA : cA + (size_t)(t + 2) * kstep; const char* b2 = last ? nB : cB + (size_t)(t + 2) * kstep;
            const char* a3 = a2 + kstep; const char* b3 = b2 + kstep;
            if (last && has_next) S.a_ready(nxt);
            if constexpr (SP2) {
            PG8_LDB(B0, 0, 0); PG8_LDB(B1, 0, 1); PG8_SCHED; PG8_LDA(At, 0, 0); PG8_STAGE(PG8_SA(1, 1), a1 + hstep, voffA);
            PG8_WAIT_V(8); PG8_WAIT_L(0); PG8_BAR; PG8_MMA(0, 0, At, B0); PG8_MMA(0, 1, At, B1); PG8_BAR; PG8_SCHED;
            PG8_LDA(At, 0, 1); PG8_STAGE(PG8_SB(0, 0), b2, voffB); PG8_STAGE(PG8_SB(0, 1), b2 + hstep, voffB); PG8_STAGE(PG8_SA(0, 0), a2, voffA);
            PG8_WAIT_V(8); PG8_WAIT_L(0); PG8_BAR; PG8_MMA(1, 0, At, B0); PG8_MMA(1, 1, At, B1); PG8_BAR; PG8_SCHED;
            PG8_LDB(B0, 1, 0); PG8_LDB(B1, 1, 1); PG8_SCHED; PG8_LDA(At, 1, 0); PG8_STAGE(PG8_SA(0, 1), a2 + hstep, voffA);
            PG8_WAIT_V(8); PG8_WAIT_L(0); PG8_BAR; PG8_MMA(0, 0, At, B0); PG8_MMA(0, 1, At, B1); PG8_BAR; PG8_SCHED;
            PG8_LDA(At, 1, 1); PG8_STAGE(PG8_SB(1, 0), b3, voffB); PG8_STAGE(PG8_SB(1, 1), b3 + hstep, voffB); PG8_STAGE(PG8_SA(1, 0), a3, voffA);
            PG8_WAIT_V(8); PG8_WAIT_L(0); PG8_BAR; PG8_MMA(1, 0, At, B0); PG8_MMA(1, 1, At, B1); PG8_BAR; PG8_SCHED;
            } else {
            PG8_LDB(B0, 0, 0); PG8_SCHED; PG8_LDA(At, 0, 0); PG8_STAGE(PG8_SA(1, 1), a1 + hstep, voffA);
            PG8_WAIT_L(8); PG8_BAR; PG8_WAIT_L(0); PG8_MMA(0, 0, At, B0); PG8_BAR; PG8_SCHED;
            PG8_LDB(B1, 0, 1); PG8_STAGE(PG8_SB(0, 0), b2, voffB);
            PG8_BAR; PG8_WAIT_L(0); PG8_MMA(0, 1, At, B1); PG8_BAR;
            PG8_LDA(At, 0, 1); PG8_STAGE(PG8_SA(0, 0), a2, voffA);
            PG8_BAR; PG8_WAIT_L(0); PG8_MMA(1, 0, At, B0); PG8_BAR; PG8_SCHED;
            PG8_STAGE(PG8_SB(0, 1), b2 + hstep, voffB);
            PG8_WAIT_V(6); PG8_BAR; PG8_MMA(1, 1, At, B1); PG8_BAR;
            PG8_LDB(B0, 1, 0); PG8_SCHED; PG8_LDA(At, 1, 0); PG8_STAGE(PG8_SA(0, 1), a2 + hstep, voffA);
            PG8_WAIT_L(8); PG8_BAR; PG8_WAIT_L(0); PG8_MMA(0, 0, At, B0); PG8_BAR; PG8_SCHED;
            PG8_LDB(B1, 1, 1); PG8_STAGE(PG8_SB(1, 0), b3, voffB);
            PG8_BAR; PG8_WAIT_L(0); PG8_MMA(0, 1, At, B1); PG8_BAR;
            PG8_LDA(At, 1, 1); PG8_STAGE(PG8_SA(1, 0), a3, voffA);
            PG8_BAR; PG8_WAIT_L(0); PG8_MMA(1, 0, At, B0); PG8_BAR; PG8_SCHED;
            PG8_STAGE(PG8_SB(1, 1), b3 + hstep, voffB);
            PG8_WAIT_V(6); PG8_BAR; PG8_MMA(1, 1, At, B1); PG8_BAR;
            }
        }
        if constexpr (F8) { asm volatile("s_nop 15\n\ts_nop 15" ::: "memory"); }
        if constexpr (ALIGN_EPI) { if (wr == 0) PG8_BAR; }
        if constexpr (!Epi::AFTER_DRAIN) { E(acc, cur, wr, wc, fr, fq); S.done(cur); }
        if (!has_next) break;
#pragma unroll
        for (int a = 0; a < 2; ++a)
#pragma unroll
            for (int b = 0; b < 2; ++b)
#pragma unroll
                for (int m = 0; m < 4; ++m)
#pragma unroll
                    for (int n = 0; n < 2; ++n) acc[a][b][m][n] = (f32x4){0.f, 0.f, 0.f, 0.f};
        cur = nxt; cA = nA; cB = nB; ++ui;
        if constexpr (ALIGN_EPI) { if (wr == 1) PG8_BAR; }
    }
    PG8_WAIT_V(0);
    if constexpr (!ALIGN_EPI) { if (wr == 0) PG8_BAR; }
    PG8_BAR;
    if constexpr (Epi::AFTER_DRAIN) { E.fused(acc, cur, wr, wc, fr, fq, lds, wid, lane); S.done(cur); }
#undef PG8_SA
#undef PG8_SB
#undef PG8_STAGE
#undef PG8_LDA
#undef PG8_LDB
#undef PG8_MMA
#undef PG8_WAIT_V
#undef PG8_WAIT_L
#undef PG8_BAR
#undef PG8_SCHED
}
struct EpiStoreBf16 {
    static constexpr bool PERM = true, AFTER_DRAIN = false;
    bf16_t* O; int ldc;
    __device__ __forceinline__ void operator()(const f32x4 (&acc)[2][2][4][2], const Unit& u, int wr, int wc, int fr, int fq) const {
        const int row0 = u.pm * BM + wr * 64 + fr, col0 = u.pn * BM + wc * 32 + 8 * fq;
#pragma unroll
        for (int ai = 0; ai < 2; ++ai)
#pragma unroll
            for (int m = 0; m < 4; ++m) { bf16_t* rowp = O + (size_t)(row0 + ai * HALF + m * 16) * ldc + col0;
#pragma unroll
                for (int bj = 0; bj < 2; ++bj) { const f32x4 v0 = acc[ai][bj][m][0], v1 = acc[ai][bj][m][1];
                    u32x4 w; w.x = cvt_pk_bf16(v0[0], v0[1]); w.y = cvt_pk_bf16(v0[2], v0[3]); w.z = cvt_pk_bf16(v1[0], v1[1]); w.w = cvt_pk_bf16(v1[2], v1[3]);
                    *(u32x4*)(rowp + bj * HALF) = w; } }
    }
};
struct EpiResid {
    static constexpr bool PERM = false, AFTER_DRAIN = false;
    float* X; const float* mod; int goff;
    __device__ __forceinline__ void operator()(const f32x4 (&acc)[2][2][4][2], const Unit& u, int wr, int wc, int fr, int fq) const {
        const int row0 = u.pm * BM + wr * 64 + fr, col0 = u.pn * BM + wc * 32 + 4 * fq;
        const int mv = u.pm < 32 ? (u.pm >> 3) : 4;
        const float* gp = mod + (size_t)mv * 12288 + goff + col0;
        f32x4 gv[2][2];
#pragma unroll
        for (int bj = 0; bj < 2; ++bj)
#pragma unroll
            for (int n = 0; n < 2; ++n) gv[bj][n] = *(const f32x4*)(gp + bj * HALF + n * 16);
#pragma unroll
        for (int ai = 0; ai < 2; ++ai)
#pragma unroll
            for (int m = 0; m < 4; ++m) { float* rowp = X + (size_t)(row0 + ai * HALF + m * 16) * 2048 + col0;
#pragma unroll
                for (int bj = 0; bj < 2; ++bj)
#pragma unroll
                    for (int n = 0; n < 2; ++n) { f32x4* p = (f32x4*)(rowp + bj * HALF + n * 16); *p = *p + gv[bj][n] * acc[ai][bj][m][n]; } }
    }
};
__device__ __forceinline__ float silu_f(float x) { return x * __builtin_amdgcn_rcpf(1.f + __builtin_amdgcn_exp2f(-1.4426950408889634f * x)); }
struct EpiSwiglu {
    static constexpr bool PERM = true, AFTER_DRAIN = false;
    bf16_t* H; int ldh; int ntn;
    __device__ __forceinline__ void operator()(const f32x4 (&acc)[2][2][4][2], const Unit& u, int wr, int wc, int fr, int fq) const {
        const int row0 = u.pm * BM + wr * 64 + fr, hcol0 = (u.pn % ntn) * HALF + wc * 32 + 8 * fq;
#pragma unroll
        for (int ai = 0; ai < 2; ++ai)
#pragma unroll
            for (int m = 0; m < 4; ++m) { bf16_t* rowp = H + (size_t)(row0 + ai * HALF + m * 16) * ldh + hcol0;
                const f32x4 a0 = acc[ai][0][m][0], a1 = acc[ai][0][m][1], b0 = acc[ai][1][m][0], b1 = acc[ai][1][m][1];
                float h[8];
#pragma unroll
                for (int j = 0; j < 4; ++j) { if (FP8_EMU && ntn == 56) { const float q = 1.f / 64.f; h[j] = rne_e4m3(silu_f(a0[j] * q) * (b0[j] * q)); h[4 + j] = rne_e4m3(silu_f(a1[j] * q) * (b1[j] * q)); } else { h[j] = silu_f(a0[j]) * b0[j]; h[4 + j] = silu_f(a1[j]) * b1[j]; } }
                u32x4 w; w.x = cvt_pk_bf16(h[0], h[1]); w.y = cvt_pk_bf16(h[2], h[3]); w.z = cvt_pk_bf16(h[4], h[5]); w.w = cvt_pk_bf16(h[6], h[7]);
                *(u32x4*)rowp = w; }
    }
};
struct EpiSwiglu8 {
    static constexpr bool PERM = true, AFTER_DRAIN = false;
    unsigned char* H; int ldh; int ntn;
    __device__ __forceinline__ void operator()(const f32x4 (&acc)[2][2][4][2], const Unit& u, int wr, int wc, int fr, int fq) const {
        const int row0 = u.pm * BM + wr * 64 + fr, hcol0 = (u.pn % ntn) * HALF + wc * 32 + 8 * fq;
#pragma unroll
        for (int ai = 0; ai < 2; ++ai)
#pragma unroll
            for (int m = 0; m < 4; ++m) { unsigned char* rowp = H + (size_t)(row0 + ai * HALF + m * 16) * ldh + hcol0;
                const f32x4 a0 = acc[ai][0][m][0], a1 = acc[ai][0][m][1], b0 = acc[ai][1][m][0], b1 = acc[ai][1][m][1];
                float h[8];
#pragma unroll
                for (int j = 0; j < 4; ++j) { h[j] = fminf(fmaxf(silu_f(a0[j]) * b0[j], -448.f), 448.f); h[4 + j] = fminf(fmaxf(silu_f(a1[j]) * b1[j], -448.f), 448.f); }
                int p0 = __builtin_amdgcn_cvt_pk_fp8_f32(h[0], h[1], 0, false); p0 = __builtin_amdgcn_cvt_pk_fp8_f32(h[2], h[3], p0, true);
                int p1 = __builtin_amdgcn_cvt_pk_fp8_f32(h[4], h[5], 0, false); p1 = __builtin_amdgcn_cvt_pk_fp8_f32(h[6], h[7], p1, true);
                u32x2 w; w.x = (unsigned)p0; w.y = (unsigned)p1; *(u32x2*)rowp = w; }
    }
};
struct EpiStoreF32 {
    static constexpr bool PERM = false, AFTER_DRAIN = false;
    float* C;
    __device__ __forceinline__ void operator()(const f32x4 (&acc)[2][2][4][2], const Unit& u, int wr, int wc, int fr, int fq) const {
        const int row0 = u.pm * BM + wr * 64 + fr, col0 = (u.pn & 7) * BM + wc * 32 + 4 * fq;
#pragma unroll
        for (int ai = 0; ai < 2; ++ai)
#pragma unroll
            for (int m = 0; m < 4; ++m) { float* rowp = C + (size_t)(row0 + ai * HALF + m * 16) * 2048 + col0;
#pragma unroll
                for (int bj = 0; bj < 2; ++bj)
#pragma unroll
                    for (int n = 0; n < 2; ++n) *(f32x4*)(rowp + bj * HALF + n * 16) = FP8_EMU ? acc[ai][bj][m][n] * (1.f / 64.f) : acc[ai][bj][m][n]; }
    }
};
struct InProjL1Order {
    StaticOrder so; int G, c;
    __device__ void init(int G_, int c_) { so.init(8192, 4608, G_, c_); G = G_; c = c_; }
    __device__ bool next(int i, Unit& u) const {
        const int L = i * G + c;
        if (L < so.nwg) return so.next(i, u);
        const int L2 = L - so.nwg; if (L2 >= 24) return false;
        u.pm = 32 + (L2 & 3); u.pn = L2 >> 2; return true;
    }
    __device__ __forceinline__ void a_ready(const Unit&) const {}
    __device__ __forceinline__ void done(const Unit&) const {}
};
struct MoeOrder {
    StaticOrder so; const int* tile_e; int NT;
    __device__ void init(int ntiles, int NT_, const int* te, int G_, int c_) { so.nM = ntiles; so.nN = NT_; so.nwg = ntiles * NT_; so.G = G_; so.c = c_; tile_e = te; NT = NT_; }
    __device__ bool next(int i, Unit& u) const { if (!so.next(i, u)) return false; u.pn += tile_e[u.pm] * NT; return true; }
    __device__ __forceinline__ void a_ready(const Unit&) const {}
    __device__ __forceinline__ void done(const Unit&) const {}
};
}
namespace mk {
typedef const float* KP;
typedef __attribute__((address_space(4))) KP const* CIN;
struct Ctx {
    LAS unsigned char* lds;
    CIN in; float* out; unsigned char* ws;
    int tid, lane, wave, G, bid;
};
#define WSP(T, off) ((T*)(C.ws + (off)))
__device__ __forceinline__ const float* inp_(CIN p, int k) { asm volatile("" : "+s"(p)); return p[k]; }
#define INP(k) inp_(C.in, (k))

__device__ __forceinline__ void tr_item(const float* W, int ldw, int k0, int ncol0, bf16* WT, int ldt, int drow0, LAS float* scr, int lane, bool f8 = false) {
    f32x4 v[16];
#pragma unroll
    for (int i = 0; i < 16; ++i) { const int idx = lane + 64 * i, kk = idx >> 4, c4 = idx & 15; v[i] = *(const f32x4*)(W + (size_t)(k0 + kk) * ldw + ncol0 + 4 * c4); }
    if (FP8_EMU && f8) {
#pragma unroll
        for (int i = 0; i < 16; ++i) { v[i].x = rne_e4m3(v[i].x * 64.f); v[i].y = rne_e4m3(v[i].y * 64.f); v[i].z = rne_e4m3(v[i].z * 64.f); v[i].w = rne_e4m3(v[i].w * 64.f); } }
#pragma unroll
    for (int i = 0; i < 16; ++i) { const int idx = lane + 64 * i, kk = idx >> 4, c4 = idx & 15; LAS float* p = scr + kk * 65 + 4 * c4; p[0] = v[i].x; p[1] = v[i].y; p[2] = v[i].z; p[3] = v[i].w; }
    LDS_WAIT(); asm volatile("" ::: "memory");
    const int c = lane & 7;
#pragma unroll
    for (int jj = 0; jj < 8; ++jj) { const int n = (lane >> 3) + 8 * jj; const LAS float* s = scr + (8 * c) * 65 + n;
        u32x4 o; o.x = pk2(s[0], s[65]); o.y = pk2(s[2 * 65], s[3 * 65]); o.z = pk2(s[4 * 65], s[5 * 65]); o.w = pk2(s[6 * 65], s[7 * 65]);
        *(u32x4*)(WT + (size_t)(drow0 + n) * ldt + k0 + 8 * c) = o; }
    LDS_WAIT(); asm volatile("" ::: "memory");
}
__device__ __forceinline__ void tr_item8(const float* W, int ldw, int k0, int ncol0, unsigned char* WT, int ldt, int drow0, LAS float* scr, int lane) {
    f32x4 v[16];
#pragma unroll
    for (int i = 0; i < 16; ++i) { const int idx = lane + 64 * i, kk = idx >> 3, c4 = idx & 7; v[i] = *(const f32x4*)(W + (size_t)(k0 + kk) * ldw + ncol0 + 4 * c4); }
#pragma unroll
    for (int i = 0; i < 16; ++i) { const int idx = lane + 64 * i, kk = idx >> 3, c4 = idx & 7; LAS float* p = scr + kk * 33 + 4 * c4; p[0] = v[i].x * 64.f; p[1] = v[i].y * 64.f; p[2] = v[i].z * 64.f; p[3] = v[i].w * 64.f; }
    LDS_WAIT(); asm volatile("" ::: "memory");
    const int c = lane & 7;
#pragma unroll
    for (int jj = 0; jj < 4; ++jj) { const int n = (lane >> 3) + 8 * jj; const LAS float* s = scr + (16 * c) * 33 + n;
        u32x4 o; o.x = pk4_fp8(s[0], s[33], s[2 * 33], s[3 * 33]); o.y = pk4_fp8(s[4 * 33], s[5 * 33], s[6 * 33], s[7 * 33]);
        o.z = pk4_fp8(s[8 * 33], s[9 * 33], s[10 * 33], s[11 * 33]); o.w = pk4_fp8(s[12 * 33], s[13 * 33], s[14 * 33], s[15 * 33]);
        *(u32x4*)(WT + (size_t)(drow0 + n) * ldt + k0 + 16 * c) = o; }
    LDS_WAIT(); asm volatile("" ::: "memory");
}
constexpr int IT_WIN = 32 * 72, IT_WOUT = 32 * 32, IT_W1 = 32 * 88, IT_W2 = 88 * 32, IT_MW1 = 32 * 112, IT_MW2 = 112 * 32, IT_PW = 2 * 2;
constexpr int IT_PRO = IT_WIN + 8 * IT_PW;
constexpr int BG_WOUT0 = 0, BG_W13 = BG_WOUT0 + IT_WOUT, BG_W2 = BG_W13 + 2 * IT_W1, BG_WIN1 = BG_W2 + IT_W2, BG_WOUT1 = BG_WIN1 + IT_WIN, BG_MOE = BG_WOUT1 + IT_WOUT, NBG = BG_MOE + 16 * IT_MW1 + 8 * IT_MW2;
constexpr int IT_TOTAL = IT_PRO + NBG;
__device__ __forceinline__ void tr_dispatch(Ctx& C, int it, LAS float* scr) {
    const float* W; int ldw, k0, nc0, ldt, dr0; bf16* WT; int r = it;
    if (r < IT_WIN) { const int kb = r / 72, nb = r % 72; W = INP(7); ldw = INW; k0 = 64 * kb; nc0 = nb < 24 ? 64 * nb : 1552 + 64 * (nb - 24); WT = WSP(bf16, WS_WIN); ldt = D; dr0 = nb < 24 ? 64 * nb : 1536 + 64 * (nb - 24); }
    else if (r < IT_PRO) { r -= IT_WIN; const int m = r / IT_PW, q = r % IT_PW; W = INP(16) + (size_t)m * 128 * 128; ldw = 128; k0 = 64 * (q >> 1); nc0 = 64 * (q & 1); WT = WSP(bf16, WS_PWT) + (size_t)m * 128 * 128; ldt = 128; dr0 = 64 * (q & 1); }
    else { r -= IT_PRO;
        if (r < BG_W13) { const int kb = r / 32, nb = r % 32; W = INP(22); ldw = D; k0 = 64 * kb; nc0 = 64 * nb; WT = WSP(bf16, WS_WOUT); ldt = D; dr0 = 64 * nb; }
        else if (r < BG_W2) { r -= BG_W13; const int s = r / IT_W1; r -= s * IT_W1; const int kb = r / 88, nb = r % 88; W = INP(24 + s); ldw = DFF; k0 = 64 * kb; nc0 = 64 * nb; WT = WSP(bf16, WS_W13); ldt = D; dr0 = 256 * (nb >> 1) + 128 * s + 64 * (nb & 1); }
        else if (r < BG_WIN1) { r -= BG_W2; const int kb = r / 32, nb = r % 32; W = INP(26); ldw = D; k0 = 64 * kb; nc0 = 64 * nb; WT = WSP(bf16, WS_W2); ldt = DFF; dr0 = 64 * nb; }
        else if (r < BG_WOUT1) { r -= BG_WIN1; const int kb = r / 72, nb = r % 72; W = INP(7) + (size_t)D * INW; ldw = INW; k0 = 64 * kb; nc0 = nb < 24 ? 64 * nb : 1552 + 64 * (nb - 24); WT = WSP(bf16, WS_WIN) + (size_t)NIN * D; ldt = D; dr0 = nb < 24 ? 64 * nb : 1536 + 64 * (nb - 24); }
        else if (r < BG_MOE) { r -= BG_WOUT1; const int kb = r / 32, nb = r % 32; W = INP(22) + (size_t)D * D; ldw = D; k0 = 64 * kb; nc0 = 64 * nb; WT = WSP(bf16, WS_WOUT) + (size_t)D * D; ldt = D; dr0 = 64 * nb; }
        else { r -= BG_MOE;
            if (MOE_FP8) {
                if (r < 16 * IT_MW1) { const int j = r / IT_MW1; r -= j * IT_MW1; const int s = j >> 3, e = j & 7, kb = r / 224, nb = r % 224, h0 = 32 * nb;
                    tr_item8(INP(29 + s) + (size_t)e * D * DFE, DFE, 128 * kb, h0, WSP(unsigned char, WS_MW13) + (size_t)e * 2 * DFE * D, D, 256 * (h0 >> 7) + 128 * s + (h0 & 127), scr, C.lane); }
                else { r -= 16 * IT_MW1; const int e = r / IT_MW2; r -= e * IT_MW2; const int kb = r / 64, nb = r % 64;
                    tr_item8(INP(31) + (size_t)e * DFE * D, D, 128 * kb, 32 * nb, WSP(unsigned char, WS_MW2) + (size_t)e * D * DFE, DFE, 32 * nb, scr, C.lane); }
                return; }
            if (r < 16 * IT_MW1) { const int j = r / IT_MW1; r -= j * IT_MW1; const int s = j >> 3, e = j & 7, kb = r / 112, nb = r % 112;
                W = INP(29 + s) + (size_t)e * D * DFE; ldw = DFE; k0 = 64 * kb; nc0 = 64 * nb; WT = WSP(bf16, WS_MW13) + (size_t)e * 2 * DFE * D; ldt = D; dr0 = 256 * (nb >> 1) + 128 * s + 64 * (nb & 1); }
            else { r -= 16 * IT_MW1; const int e = r / IT_MW2; r -= e * IT_MW2; const int kb = r / 32, nb = r % 32;
                W = INP(31) + (size_t)e * DFE * D; ldw = D; k0 = 64 * kb; nc0 = 64 * nb; WT = WSP(bf16, WS_MW2) + (size_t)e * D * DFE; ldt = DFE; dr0 = 64 * nb; } } }
    tr_item(W, ldw, k0, nc0, WT, ldt, dr0, scr, C.lane, it >= IT_PRO + BG_MOE);
}
#ifndef BG_BATCH_N
#define BG_BATCH_N 1
#endif
constexpr int BG_BATCH = BG_BATCH_N;
__device__ __forceinline__ void bg_work(Ctx& C, int limit, int poll_phase) {
    unsigned* ctl = WSP(unsigned, WS_CTL);
    volatile LAS unsigned* flag = (volatile LAS unsigned*)(C.lds + LDS_BARW + 8);
    VM_WAIT(); __syncthreads();
    if (C.tid == 0) { flag[0] = 0u; flag[1] = __hip_atomic_load(ctl + CW_BGHEAD, __ATOMIC_RELAXED, __HIP_MEMORY_SCOPE_AGENT) >= (unsigned)NBG ? 1u : 0u;
        if (poll_phase >= 0) __hip_atomic_fetch_add(ctl + CW_DONE + 64 * poll_phase, 1u, __ATOMIC_RELAXED, __HIP_MEMORY_SCOPE_AGENT); }
    __syncthreads();
    if (flag[1] != 0u) return;
    LAS float* scr = (LAS float*)(C.lds + C.wave * 16896);
    for (;;) {
        if (C.tid == 0) { unsigned base = 0xffffffffu;
            const unsigned head = __hip_atomic_load(ctl + CW_BGHEAD, __ATOMIC_RELAXED, __HIP_MEMORY_SCOPE_AGENT);
            bool go = head < (unsigned)limit;
            if (!go && poll_phase >= 0 && head < (unsigned)NBG) go = __hip_atomic_load(ctl + CW_DONE + 64 * poll_phase, __ATOMIC_RELAXED, __HIP_MEMORY_SCOPE_AGENT) < (unsigned)C.G;
            if (go) base = __hip_atomic_fetch_add(ctl + CW_BGHEAD, (unsigned)NWAVE, __ATOMIC_RELAXED, __HIP_MEMORY_SCOPE_AGENT);
            flag[0] = base; }
        __syncthreads();
        const unsigned base = flag[0];
        if (base >= (unsigned)NBG) break;
        if (base + C.wave < (unsigned)NBG) tr_dispatch(C, IT_PRO + (int)base + C.wave, scr);
        __syncthreads();
    }
}
__device__ __forceinline__ void mod_unit(Ctx& C, int unit, LAS float* sv  , LAS float* red  ) {
    const int l = unit / 192, col0 = (unit % 192) * 64, cq = C.tid & 15, ks = C.tid >> 4;
    const float* w = INP(4) + ((size_t)l * D + ks * 64) * 12288 + col0 + 4 * cq;
    f32x4 acc[5];
#pragma unroll
    for (int v = 0; v < 5; ++v) acc[v] = (f32x4){0.f, 0.f, 0.f, 0.f};
#pragma unroll 8
    for (int k = 0; k < 64; ++k) { const f32x4 wv = *(const f32x4*)(w + (size_t)k * 12288);
#pragma unroll
        for (int v = 0; v < 5; ++v) acc[v] += wv * sv[v * 2048 + ks * 64 + k]; }
#pragma unroll
    for (int v = 0; v < 5; ++v) *(LAS f32x4*)(red + (ks * 5 + v) * 64 + 4 * cq) = acc[v];
    WG_BAR();
    if (C.tid < 320) { const int v = C.tid >> 6, c = C.tid & 63; float s = 0.f;
#pragma unroll 8
        for (int k = 0; k < 32; ++k) s += red[(k * 5 + v) * 64 + c];
        WSP(float, WS_MODV)[((size_t)l * 5 + v) * 12288 + col0 + c] = s + INP(5)[l * 12288 + col0 + c]; }
    WG_BAR();
}
__device__ __forceinline__ void p_prologue(Ctx& C) {
    LAS float* sv = (LAS float*)C.lds; LAS float* red = sv + 5 * 2048;
    for (int i = C.tid; i < 5 * 2048; i += NTHR) { const float x = i < 4 * 2048 ? INP(1)[i] : INP(3)[i - 4 * 2048]; sv[i] = x / (1.f + expf(-x)); }
    WG_BAR();
    for (int u = C.bid; u < 384; u += C.G) mod_unit(C, u, sv, red);
    for (int i = C.bid * NTHR + C.tid; i < 2 * 2048 * 4; i += C.G * NTHR) { const int lk = i >> 2, q = i & 3; *(f32x4*)(WSP(float, WS_WABC) + (size_t)lk * 16 + 4 * q) = *(const f32x4*)(INP(7) + (size_t)lk * INW + 1536 + 4 * q); }
    { float* pos = WSP(float, WS_POS);
      for (size_t i = (size_t)C.bid * NTHR + C.tid; i < (size_t)TX * D; i += (size_t)C.G * NTHR) {
          const int t = (int)(i >> 11), d = (int)(i & 2047), r = t >> 6, cc = t & 63, part = d >> 9, fi = d & 511;
          const float freq = expf(-9.210340371976184f * (float)fi / 512.f);
          const float ang = (part < 2 ? (float)r : (float)cc) * freq;
          pos[i] = (part & 1) ? cosf(ang) : sinf(ang); } }
    WG_BAR();
    LAS float* scr = (LAS float*)(C.lds + C.wave * 16896);
    const int gw = C.bid * NWAVE + C.wave, NGW = C.G * NWAVE;
    const int nit = (STATIC_FILL && C.G == 256) ? IT_PRO + BG_MOE : IT_TOTAL;
    for (int it = gw; it < nit; it += NGW) tr_dispatch(C, it, scr);
}
__device__ __forceinline__ void fill_static(Ctx& C, int first, int n, int b0) {
    if (!(STATIC_FILL && C.G == 256) || C.bid < b0 || n <= 0) return;
    VM_WAIT(); __syncthreads();
    LAS float* scr = (LAS float*)(C.lds + C.wave * 16896);
    const int nb = C.G - b0;
    for (int it = first + (C.bid - b0) * NWAVE + C.wave; it < first + n; it += nb * NWAVE) tr_dispatch(C, IT_PRO + BG_MOE + it, scr);
}

template <int MODE>
__device__ __forceinline__ void p_norm(Ctx& C, int l) {
    const float* mod = WSP(float, WS_MODV) + (size_t)l * 5 * 12288;
    float* XS = WSP(float, WS_XS); bf16* AN = WSP(bf16, WS_AN);
    const bool mix = MODE <= 1;
    const float* gain = (mix ? INP(6) : INP(23)) + l * D;
    const int sh_off = mix ? 0 : 6144, sc_off = mix ? 2048 : 8192;
    LAS f32x4* wl = (LAS f32x4*)C.lds;
    if (mix) { const float* wsrc = WSP(float, WS_WABC) + (size_t)l * 2048 * 16;
        for (int idx = C.tid; idx < 2048 * 4; idx += NTHR) { const int k = idx >> 2, q = idx & 3, ln = (k & 255) >> 2, i = k & 3, j = k >> 8;
            wl[((j * 4 + i) * 4 + q) * 64 + ln] = *(const f32x4*)(wsrc + (size_t)k * 16 + 4 * q); }
    } else if (MODE == 3) { const float* wsrc = INP(27);
        for (int idx = C.tid; idx < 2048 * 2; idx += NTHR) { const int k = idx >> 1, q = idx & 1, ln = (k & 255) >> 2, i = k & 3, j = k >> 8;
            wl[((j * 4 + i) * 2 + q) * 64 + ln] = *(const f32x4*)(wsrc + (size_t)k * 8 + 4 * q); } }
    WG_BAR();
    const int nrows = MODE == 3 ? MX : MT;
    const int gw = C.bid * NWAVE + C.wave, NGW = C.G * NWAVE, lane = C.lane;
    for (int row = gw; row < nrows; row += NGW) {
        int base, T, t, mv; rowinfo(row, base, T, t, mv);
        f32x4 x[8]; float ss = 0.f;
        if (MODE == 0) {
            if (row < MX) { const f32x4* xi = (const f32x4*)(INP(0) + (size_t)row * D) + lane; const f32x4* pp = (const f32x4*)(WSP(float, WS_POS) + (size_t)t * D) + lane;
#pragma unroll
                for (int j = 0; j < 8; ++j) x[j] = xi[64 * j] + pp[64 * j]; }
            else { const f32x4* xi = (const f32x4*)(INP(2) + (size_t)(row - MX) * D) + lane;
#pragma unroll
                for (int j = 0; j < 8; ++j) x[j] = xi[64 * j]; }
            f32x4* xo = (f32x4*)(XS + (size_t)row * D) + lane;
#pragma unroll
            for (int j = 0; j < 8; ++j) xo[64 * j] = x[j];
        } else { const f32x4* xi = (const f32x4*)(XS + (size_t)row * D) + lane;
#pragma unroll
            for (int j = 0; j < 8; ++j) x[j] = xi[64 * j]; }
#pragma unroll
        for (int j = 0; j < 8; ++j) ss += (x[j].x * x[j].x + x[j].y * x[j].y) + (x[j].z * x[j].z + x[j].w * x[j].w);
        const float rs = rsqrtf(wave_sum(ss) * (1.f / D) + EPS);
        const f32x4* gp = (const f32x4*)gain + lane; const f32x4* shp = (const f32x4*)(mod + (size_t)mv * 12288 + sh_off) + lane; const f32x4* scp = (const f32x4*)(mod + (size_t)mv * 12288 + sc_off) + lane;
        u32x2* ao = (u32x2*)(AN + (size_t)row * D) + lane;
#pragma unroll
        for (int j = 0; j < 8; ++j) { const f32x4 g = gp[64 * j], sh = shp[64 * j], sc = scp[64 * j];
            x[j] = x[j] * rs * g * (sc + 1.f) + sh;
            u32x2 w; w.x = pk2(x[j].x, x[j].y); w.y = pk2(x[j].z, x[j].w); ao[64 * j] = w; }
        if (mix) {
            f32x4 acc[4];
#pragma unroll
            for (int q = 0; q < 4; ++q) acc[q] = (f32x4){0.f, 0.f, 0.f, 0.f};
#pragma unroll
            for (int j = 0; j < 8; ++j)
#pragma unroll
                for (int i = 0; i < 4; ++i) { const float a = x[j][i];
#pragma unroll
                    for (int q = 0; q < 4; ++q) acc[q] += wl[((j * 4 + i) * 4 + q) * 64 + lane] * a; asm volatile("" ::: "memory"); }
#pragma unroll
            for (int q = 0; q < 4; ++q)
#pragma unroll
                for (int e = 0; e < 4; ++e) acc[q][e] = wave_sum(acc[q][e]);
            if (lane < 4) { f32x4 o = lane == 0 ? acc[0] : lane == 1 ? acc[1] : lane == 2 ? acc[2] : acc[3]; *(f32x4*)(WSP(float, WS_ABF) + (size_t)row * 16 + 4 * lane) = o; }
        }
        if (MODE == 3) {
            f32x4 acc[2] = {(f32x4){0.f, 0.f, 0.f, 0.f}, (f32x4){0.f, 0.f, 0.f, 0.f}};
#pragma unroll
            for (int j = 0; j < 8; ++j)
#pragma unroll
                for (int i = 0; i < 4; ++i) { const float a = x[j][i];
#pragma unroll
                    for (int q = 0; q < 2; ++q) acc[q] += wl[((j * 4 + i) * 2 + q) * 64 + lane] * a; asm volatile("" ::: "memory"); }
            float lg[8];
#pragma unroll
            for (int e = 0; e < 8; ++e) lg[e] = wave_sum(acc[e >> 2][e & 3]) + INP(28)[e];
            if (lane == 0) { int i1 = 0;
#pragma unroll
                for (int e = 1; e < 8; ++e) if (lg[e] > lg[i1]) i1 = e;
                int i2 = i1 == 0 ? 1 : 0;
#pragma unroll
                for (int e = 0; e < 8; ++e) if (e != i1 && lg[e] > lg[i2]) i2 = e;
                float v1 = lg[0], v2 = lg[0];
#pragma unroll
                for (int e = 0; e < 8; ++e) { v1 = e == i1 ? lg[e] : v1; v2 = e == i2 ? lg[e] : v2; }
                const float g2 = 1.f / (1.f + expf(v1 - v2));
                int* R = WSP(int, WS_ROUTE); float* Rf = WSP(float, WS_ROUTE); unsigned* ctl = WSP(unsigned, WS_CTL);
                R[R_TE + 2 * row] = i1; R[R_TE + 2 * row + 1] = i2; Rf[R_TG + 2 * row] = 1.f - g2; Rf[R_TG + 2 * row + 1] = g2;
                R[R_RANK + 2 * row] = (int)atomicAdd(ctl + CW_CNT + 64 * i1, 1u); R[R_RANK + 2 * row + 1] = (int)atomicAdd(ctl + CW_CNT + 64 * i2, 1u); }
        }
    }
}
}
namespace mk {
__device__ __forceinline__ f32x4 mfma16(bf16x8 a, bf16x8 b, f32x4 c) { return __builtin_amdgcn_mfma_f32_16x16x32_bf16(a, b, c, 0, 0, 0); }

constexpr int DP_PITCH = 132;
constexpr int DP_Q = 0, DP_K = 33792, DP_V = 67584;
constexpr int DP_L = 101376;
constexpr int DP_QK = DP_L + 32768;
constexpr int DP_SM = DP_QK + 16384;
static_assert(DP_SM + 2048 <= LDS_BARW, "DN prep LDS map");
__device__ __forceinline__ size_t dn_rec(int dir, int cid, int h) { return ((size_t)dir * NCH + cid) * 4 + h; }

__device__ __forceinline__ void dnprep_unit(Ctx& C, int l, int cidx, int h) {
    LAS float* Qs = (LAS float*)(C.lds + DP_Q); LAS float* Ks = (LAS float*)(C.lds + DP_K); LAS float* Vs = (LAS float*)(C.lds + DP_V);
    LAS float* Ls = (LAS float*)(C.lds + DP_L); LAS bf16* QKi = (LAS bf16*)(C.lds + DP_QK); LAS float* sm = (LAS float*)(C.lds + DP_SM);
    LAS float* Gs = sm; LAS float* Bs = sm + 128; LAS float* EGs = sm + 256; LAS float* EGRs = sm + 384;
    const bf16* P = WSP(bf16, WS_P);
    const int tid = C.tid, lane = C.lane, wave = C.wave;
    const int r0 = cidx * 64; int sbase, T, t0, mv; rowinfo(r0, sbase, T, t0, mv);
    const int nloc = t0 >> 6, nch = T >> 6, cbase = sbase >> 6;
#ifndef DP_SKIP
#define DP_SKIP 0
#endif
    if (!(DP_SKIP & 1)) { if (tid < 384) {
        const int o = tid % 48, tg = tid / 48, wh = o >> 4, oc = o & 15, ch = wh * 512 + h * 128 + 8 * oc;
        float w[5][8];
        const float* cw = INP(8) + (size_t)l * 5 * 1536 + ch;
#pragma unroll
        for (int k = 0; k < 5; ++k) { const f32x4 a = *(const f32x4*)(cw + k * 1536), b = *(const f32x4*)(cw + k * 1536 + 4);
            w[k][0] = a.x; w[k][1] = a.y; w[k][2] = a.z; w[k][3] = a.w; w[k][4] = b.x; w[k][5] = b.y; w[k][6] = b.z; w[k][7] = b.w; }
#pragma unroll 1
        for (int hf = 0; hf < 2; ++hf) {
        float xin[8][8];
#pragma unroll
        for (int i = 0; i < 8; ++i) { const int t = t0 + 8 * tg + 4 * hf + i - 2;
            if (t >= 0 && t < T) { const u32x4 raw = *(const u32x4*)(P + (size_t)(sbase + t) * NIN + ch); unpack8(raw, xin[i]); }
            else {
#pragma unroll
                for (int c = 0; c < 8; ++c) xin[i][c] = 0.f; } }
#pragma unroll
        for (int i = 0; i < 4; ++i) { float ov[8]; float ss = 0.f;
#pragma unroll
            for (int c = 0; c < 8; ++c) { float s = 0.f;
#pragma unroll
                for (int k = 0; k < 5; ++k) s += w[k][c] * xin[i + k][c];
                ov[c] = silu(s); ss += ov[c] * ov[c]; }
            ss = sum16(ss);
            const float sc = wh == 0 ? rsqrtf(ss + EPS) * 0.08838834764831845f : wh == 1 ? rsqrtf(ss + EPS) : 1.f;
            LAS float* dst = (wh == 0 ? Qs : wh == 1 ? Ks : Vs) + (8 * tg + 4 * hf + i) * DP_PITCH + 8 * oc;
            *(LAS f32x4*)dst = (f32x4){ov[0] * sc, ov[1] * sc, ov[2] * sc, ov[3] * sc}; *(LAS f32x4*)(dst + 4) = (f32x4){ov[4] * sc, ov[5] * sc, ov[6] * sc, ov[7] * sc}; }
        }
    } else {
        const int d = wave - 6, s = lane, i = d ? 63 - s : s; const float* ab = WSP(float, WS_ABF) + (size_t)(r0 + i) * 16;
        const float la = -expf(INP(9)[l * 8 + d * 4 + h]) * softplus(ab[d * 4 + h] + INP(10)[l * 8 + d * 4 + h]);
        const float be = sigm(ab[8 + d * 4 + h]);
        float g = la;
#pragma unroll
        for (int o = 1; o < 64; o <<= 1) { const float up = __shfl_up(g, o); if (lane >= o) g += up; }
        const float gl = __shfl(g, 63);
        Gs[d * 64 + s] = g; Bs[d * 64 + s] = be; EGs[d * 64 + s] = expf(g); EGRs[d * 64 + s] = expf(gl - g);
        if (lane == 63) { const int cid = d ? cbase + (nch - 1 - nloc) : cidx; WSP(float, WS_EGL)[dn_rec(d, cid, h)] = expf(gl); }
    } }
    WG_BAR();
    if (!(DP_SKIP & 2)) {
        const int wh = wave >> 2, mb = wave & 3, c = lane & 15, g4 = lane >> 4;
        const LAS float* Am = wh ? Qs : Ks;
        f32x4 acc[4];
#pragma unroll
        for (int nb = 0; nb < 4; ++nb) acc[nb] = (f32x4){0.f, 0.f, 0.f, 0.f};
#pragma unroll
        for (int ks = 0; ks < 4; ++ks) {
            float av[8]; { const LAS float* p = Am + (16 * mb + c) * DP_PITCH + 32 * ks + 8 * g4; const f32x4 a = *(const LAS f32x4*)p, b = *(const LAS f32x4*)(p + 4);
                av[0] = a.x; av[1] = a.y; av[2] = a.z; av[3] = a.w; av[4] = b.x; av[5] = b.y; av[6] = b.z; av[7] = b.w; }
            const bf16x8 af = pack8(av);
#pragma unroll
            for (int nb = 0; nb < 4; ++nb) { float bv[8]; const LAS float* p = Ks + (16 * nb + c) * DP_PITCH + 32 * ks + 8 * g4; const f32x4 a = *(const LAS f32x4*)p, b = *(const LAS f32x4*)(p + 4);
                bv[0] = a.x; bv[1] = a.y; bv[2] = a.z; bv[3] = a.w; bv[4] = b.x; bv[5] = b.y; bv[6] = b.z; bv[7] = b.w;
                acc[nb] = mfma16(af, pack8(bv), acc[nb]); }
        }
        if (wh == 0) {
#pragma unroll
            for (int d = 0; d < 2; ++d) { const LAS float* Gd = Gs + d * 64; const LAS float* Bd = Bs + d * 64; LAS float* Ld = Ls + d * 4096;
#pragma unroll
                for (int r = 0; r < 4; ++r) { const int i = 16 * mb + 4 * g4 + r, s = d ? 63 - i : i; const float gs = Gd[s], bs = Bd[s];
#pragma unroll
                    for (int nb = 0; nb < 4; ++nb) { const int ip = 16 * nb + c, sp = d ? 63 - ip : ip;
                        Ld[s * 64 + sp] = s > sp ? bs * acc[nb][r] * __expf(gs - Gd[sp]) : 0.f; } } }
        } else {
#pragma unroll
            for (int d = 0; d < 2; ++d) { const LAS float* Gd = Gs + d * 64; LAS bf16* Qd = QKi + d * 4096;
#pragma unroll
                for (int r = 0; r < 4; ++r) { const int i = 16 * mb + 4 * g4 + r, s = d ? 63 - i : i; const float gs = Gd[s];
#pragma unroll
                    for (int nb = 0; nb < 4; ++nb) { const int ip = 16 * nb + c, sp = d ? 63 - ip : ip;
                        const float qk = s >= sp ? acc[nb][r] * __expf(gs - Gd[sp]) : 0.f;
                        const int lp = ((sp & 15) >> 2) * 16 + (s & 15), jp = 4 * ((sp >> 4) & 1) + (sp & 3);
                        Qd[(((s >> 4) * 2 + (sp >> 5)) * 64 + lp) * 8 + jp] = (bf16)f2bf(qk); } } }
        }
    }
    WG_BAR();
    if (!(DP_SKIP & 4)) {
        const int d = tid >> 8, col = tid & 255;
        float X[64];
        const LAS float* src = col < 128 ? Vs + col : Ks + (col - 128);
        const LAS float* Bd = Bs + d * 64; const LAS float* Ed = EGs + d * 64;
        if (d == 0) {
#pragma unroll
            for (int s = 0; s < 64; ++s) { const float sc = col < 128 ? Bd[s] : Bd[s] * Ed[s]; X[s] = sc * src[s * DP_PITCH]; if ((s & 7) == 7) asm volatile("" ::: "memory"); }
        } else {
#pragma unroll
            for (int s = 0; s < 64; ++s) { const float sc = col < 128 ? Bd[s] : Bd[s] * Ed[s]; X[s] = sc * src[(63 - s) * DP_PITCH]; if ((s & 7) == 7) asm volatile("" ::: "memory"); }
        }
        WG_BAR();
        const LAS float* Ld = Ls + d * 4096;
#pragma unroll
        for (int s = 1; s < 64; ++s) { float a0 = X[s], a1 = 0.f, a2 = 0.f, a3 = 0.f;
#pragma unroll
            for (int j4 = 0; j4 < (s + 3) / 4; ++j4) { const f32x4 lv = *(const LAS f32x4*)(Ld + s * 64 + 4 * j4);
                if (4 * j4 + 0 < s) a0 -= lv.x * X[4 * j4 + 0];
                if (4 * j4 + 1 < s) a1 -= lv.y * X[4 * j4 + 1];
                if (4 * j4 + 2 < s) a2 -= lv.z * X[4 * j4 + 2];
                if (4 * j4 + 3 < s) a3 -= lv.w * X[4 * j4 + 3]; }
            X[s] = (a0 + a1) + (a2 + a3); asm volatile("" ::: "memory"); }
        const int cid = d ? cbase + (nch - 1 - nloc) : cidx; const size_t rec = dn_rec(d, cid, h);
        if (col < 128) { f32x4* up = (f32x4*)(WSP(float, WS_DNU) + (rec * 128 + col) * 64);
#pragma unroll
            for (int q = 0; q < 16; ++q) up[q] = (f32x4){X[4 * q], X[4 * q + 1], X[4 * q + 2], X[4 * q + 3]}; }
        else { const int dk = col - 128, ks = dk >> 5, q = dk & 31, j = 4 * (q >> 4) + (q & 3), g4 = (q & 15) >> 2;
            LAS bf16* Wi = (LAS bf16*)(C.lds + DP_V) + d * 8192;
#pragma unroll
            for (int s = 0; s < 64; ++s) Wi[(((s >> 4) * 4 + ks) * 64 + g4 * 16 + (s & 15)) * 8 + j] = (bf16)f2bf(X[s]); }
    }
    WG_BAR();
    if (!(DP_SKIP & 8)) {
        for (int ci = tid; ci < 2048; ci += NTHR) { const int d = ci >> 10, cc = ci & 1023; const int cid = d ? cbase + (nch - 1 - nloc) : cidx;
            ((u32x4*)(WSP(unsigned char, WS_DNW) + dn_rec(d, cid, h) * 16384))[cc] = ((const LAS u32x4*)(C.lds + DP_V + d * 16384))[cc]; }
        for (int ci = tid; ci < 1024; ci += NTHR) { const int d = ci >> 9, cc = ci & 511; const int cid = d ? cbase + (nch - 1 - nloc) : cidx;
            ((u32x4*)(WSP(unsigned char, WS_DNQK) + dn_rec(d, cid, h) * 8192))[cc] = ((const LAS u32x4*)(C.lds + DP_QK + d * 8192))[cc]; }
        for (int ci = tid; ci < 2048; ci += NTHR) { const int d = ci >> 10, cc = ci & 1023, mb = cc >> 8, ks = (cc >> 6) & 3, lp = cc & 63, c = lp & 15, g4 = lp >> 4;
            const int s = 16 * mb + c, i = d ? 63 - s : s; const float e = EGs[d * 64 + s];
            const LAS float* p = Qs + i * DP_PITCH + 32 * ks + 4 * g4; const f32x4 a = *(const LAS f32x4*)p, b = *(const LAS f32x4*)(p + 16);
            float v[8] = {a.x * e, a.y * e, a.z * e, a.w * e, b.x * e, b.y * e, b.z * e, b.w * e};
            const int cid = d ? cbase + (nch - 1 - nloc) : cidx;
            ((bf16x8*)(WSP(unsigned char, WS_DNQG) + dn_rec(d, cid, h) * 16384))[cc] = pack8(v); }
        for (int ci = tid; ci < 2048; ci += NTHR) { const int d = ci >> 10, cc = ci & 1023, tt = cc >> 7, ks2 = (cc >> 6) & 1, lp = cc & 63, c = lp & 15, g4 = lp >> 4;
            float v[8];
#pragma unroll
            for (int j = 0; j < 8; ++j) { const int s = 32 * ks2 + 16 * (j >> 2) + 4 * g4 + (j & 3), i = d ? 63 - s : s; v[j] = Ks[i * DP_PITCH + 16 * tt + c] * EGRs[d * 64 + s]; }
            const int cid = d ? cbase + (nch - 1 - nloc) : cidx;
            ((bf16x8*)(WSP(unsigned char, WS_DNKDT) + dn_rec(d, cid, h) * 16384))[cc] = pack8(v); }
    }
    WG_BAR();
}

constexpr int SG_VT = 0, SG_VPITCH = 136;
__device__ __forceinline__ void sg_unit(Ctx& C, int l, int cb, int h) {
    LAS bf16* vT = (LAS bf16*)(C.lds + SG_VT);
    const bf16* P = WSP(bf16, WS_P); bf16* Y = WSP(bf16, WS_Y);
    const int lane = C.lane, wave = C.wave, r0 = cb * 128;
    const float* lg = INP(12) + l * 512; const float* lb = INP(13) + l * 512;
    for (int q = 0; q < 16; ++q) { const int j = 16 * wave + q; float v[8];
        unpack8(*(const u32x4*)(P + (size_t)(r0 + j) * NIN + PSGV + 8 * lane), v);
        float s = 0.f;
#pragma unroll
        for (int c = 0; c < 8; ++c) { v[c] = gelu_tanh(v[c]); s += v[c]; }
        const float mu = wave_sum(s) * (1.f / 512.f); float s2 = 0.f;
#pragma unroll
        for (int c = 0; c < 8; ++c) { v[c] -= mu; s2 += v[c] * v[c]; }
        const float rs = rsqrtf(wave_sum(s2) * (1.f / 512.f) + EPS);
        if ((lane >> 4) == h) { const int d0 = 8 * (lane & 15);
#pragma unroll
            for (int c = 0; c < 8; ++c) vT[(d0 + c) * SG_VPITCH + j] = (bf16)f2bf(v[c] * rs * lg[128 * h + d0 + c] + lb[128 * h + d0 + c]); } }
    WG_BAR();
    const int c = lane & 15, g4 = lane >> 4;
    const float* W = INP(14) + ((size_t)(l * 4 + h) * 128 + 16 * wave + c) * 128;
    f32x4 acc[8];
#pragma unroll
    for (int nb = 0; nb < 8; ++nb) acc[nb] = (f32x4){0.f, 0.f, 0.f, 0.f};
#pragma unroll
    for (int ks = 0; ks < 4; ++ks) { const f32x4 a = *(const f32x4*)(W + 32 * ks + 8 * g4), b = *(const f32x4*)(W + 32 * ks + 8 * g4 + 4);
        float av[8] = {a.x, a.y, a.z, a.w, b.x, b.y, b.z, b.w}; const bf16x8 af = pack8(av);
#pragma unroll
        for (int nb = 0; nb < 8; ++nb) { const bf16x8 bfr = *(const LAS bf16x8*)(vT + (16 * nb + c) * SG_VPITCH + 32 * ks + 8 * g4); acc[nb] = mfma16(af, bfr, acc[nb]); } }
    const float* bs = INP(15) + (l * 4 + h) * 128;
#pragma unroll
    for (int r = 0; r < 4; ++r) { const int i = 16 * wave + 4 * g4 + r; const float bi = bs[i]; const size_t row = (size_t)(r0 + i);
#pragma unroll
        for (int nb = 0; nb < 8; ++nb) { const int d = 16 * nb + c; const float u = gelu_tanh(bf2f(P[row * NIN + PSGU + 128 * h + d]));
            Y[row * D + 512 + 128 * h + d] = (bf16)f2bf(u * (acc[nb][r] + bi)); } }
    WG_BAR();
}

__device__ __forceinline__ void pool_unit(Ctx& C, int l, int cidx, int g) {
    const bf16* P = WSP(bf16, WS_P); bf16* Y = WSP(bf16, WS_Y); const bf16* PW = WSP(bf16, WS_PWT) + (size_t)(l * 4 + g) * 128 * 128;
    const int lane = C.lane, wave = C.wave, c = lane & 15, g4 = lane >> 4, mb = wave & 3, nh = wave >> 2;
    const int r0 = cidx * 64; int sbase, T, t0, mv; rowinfo(r0, sbase, T, t0, mv);
    const int t = t0 + 16 * mb + c, hw = 1 << g;
    const int lo = t - hw < 0 ? 0 : t - hw, hi = t + hw > T ? T : t + hw; const float inv = 1.f / (float)(hi - lo);
    f32x4 acc[4];
#pragma unroll
    for (int nb = 0; nb < 4; ++nb) acc[nb] = (f32x4){0.f, 0.f, 0.f, 0.f};
#pragma unroll
    for (int ks = 0; ks < 4; ++ks) { const bf16* pc = P + PPOOL + 128 * g + 32 * ks + 8 * g4; float s[8] = {0, 0, 0, 0, 0, 0, 0, 0}, x[8];
        for (int tt = lo; tt < hi; ++tt) { float v[8]; unpack8(*(const u32x4*)(pc + (size_t)(sbase + tt) * NIN), v);
#pragma unroll
            for (int q = 0; q < 8; ++q) s[q] += v[q]; }
        unpack8(*(const u32x4*)(pc + (size_t)(sbase + t) * NIN), x);
#pragma unroll
        for (int q = 0; q < 8; ++q) s[q] = s[q] * inv - x[q];
        const bf16x8 af = pack8(s);
#pragma unroll
        for (int nb = 0; nb < 4; ++nb) { const bf16x8 bfr = *(const bf16x8*)(PW + (size_t)(16 * (4 * nh + nb) + c) * 128 + 32 * ks + 8 * g4); acc[nb] = mfma16(af, bfr, acc[nb]); } }
    const float* psc = INP(17) + l * 512 + 128 * g;
#pragma unroll
    for (int nb = 0; nb < 4; ++nb) { const int e = 16 * (4 * nh + nb) + c; const float sc = psc[e];
#pragma unroll
        for (int r = 0; r < 4; ++r) Y[(size_t)(r0 + 16 * mb + 4 * g4 + r) * D + 1024 + 128 * g + e] = (bf16)f2bf(acc[nb][r] * sc); }
}

__device__ __forceinline__ void conf_unit(Ctx& C, int l, int cidx) {
    const bf16* P = WSP(bf16, WS_P); bf16* Y = WSP(bf16, WS_Y); LAS float* hb = (LAS float*)C.lds;
    const int ch = C.tid, r0 = cidx * 64; int sbase, T, t0, mv; rowinfo(r0, sbase, T, t0, mv);
    float w[31];
#pragma unroll
    for (int k = 0; k < 31; ++k) w[k] = INP(18)[((size_t)l * 31 + k) * 512 + ch];
    const float cb = INP(19)[l * 512 + ch];
#pragma unroll 1
    for (int grp = 0; grp < 4; ++grp) {
        float glu[46];
#pragma unroll
        for (int q = 0; q < 46; ++q) { const int t = t0 + 16 * grp + q - 15; float v = 0.f;
            if (t >= 0 && t < T) { const bf16* pr = P + (size_t)(sbase + t) * NIN; v = bf2f(pr[PCVA + ch]) * sigm(bf2f(pr[PCVG + ch])); }
            glu[q] = v; }
#pragma unroll
        for (int i = 0; i < 16; ++i) { float a = cb;
#pragma unroll
            for (int k = 0; k < 31; ++k) a += w[k] * glu[i + k];
            hb[(16 * grp + i) * 512 + ch] = a; }
    }
    WG_BAR();
    const float* lg = INP(20) + l * 512 + 8 * C.lane; const float* lb = INP(21) + l * 512 + 8 * C.lane;
    for (int q = 0; q < 8; ++q) { const int i = 8 * C.wave + q; const LAS float* p = hb + i * 512 + 8 * C.lane; const f32x4 a = *(const LAS f32x4*)p, b = *(const LAS f32x4*)(p + 4);
        float v[8] = {a.x, a.y, a.z, a.w, b.x, b.y, b.z, b.w}; float s = 0.f;
#pragma unroll
        for (int c = 0; c < 8; ++c) s += v[c];
        const float mu = wave_sum(s) * (1.f / 512.f); float s2 = 0.f;
#pragma unroll
        for (int c = 0; c < 8; ++c) { v[c] -= mu; s2 += v[c] * v[c]; }
        const float rs = rsqrtf(wave_sum(s2) * (1.f / 512.f) + EPS);
#pragma unroll
        for (int c = 0; c < 8; ++c) v[c] = silu(v[c] * rs * lg[c] + lb[c]);
        *(bf16x8*)(Y + (size_t)(r0 + i) * D + 1536 + 8 * C.lane) = pack8(v); }
    WG_BAR();
}

__device__ __forceinline__ void p_mixers(Ctx& C, int l) {
    const int nchk = l == 0 ? NCH : MX / 64;
    for (int u = C.bid; u < NCH * 4; u += C.G) dnprep_unit(C, l, u >> 2, u & 3);
    for (int u = (C.bid + 3 * C.G / 4) % C.G; u < nchk; u += C.G) conf_unit(C, l, u);
    for (int u = (C.bid + 3 * C.G / 16) % C.G; u < (nchk / 2) * 4; u += C.G) sg_unit(C, l, u >> 2, u & 3);
    for (int u = (C.bid + 3 * C.G / 16) % C.G; u < nchk * 4; u += C.G) pool_unit(C, l, u >> 2, u & 3);
}

__device__ __forceinline__ void p_scan(Ctx& C, int l) {
    if (C.bid >= 32) return;
    const int b = C.bid >> 3, h = (C.bid >> 1) & 3, dir = C.bid & 1, lane = C.lane, w = C.wave, c = lane & 15, g4 = lane >> 4;
    float* O = WSP(float, WS_O) + (size_t)dir * MT * 512;
    f32x4 S[8];
#pragma unroll
    for (int t = 0; t < 8; ++t) S[t] = (f32x4){0.f, 0.f, 0.f, 0.f};
    for (int seg = 0; seg < 2; ++seg) {
        const int rbase = seg == 0 ? MX + b * TC : b * TX, nch = seg == 0 ? TC / 64 : TX / 64;
        for (int n = 0; n < nch; ++n) {
            const int cid = (rbase >> 6) + n; const size_t rec = dn_rec(dir, cid, h);
            const bf16x8* Wf = (const bf16x8*)(WSP(unsigned char, WS_DNW) + rec * 16384) + lane;
            const bf16x8* QGf = (const bf16x8*)(WSP(unsigned char, WS_DNQG) + rec * 16384) + lane;
            const bf16x8* KDf = (const bf16x8*)(WSP(unsigned char, WS_DNKDT) + rec * 16384) + lane;
            const bf16x8* QKf = (const bf16x8*)(WSP(unsigned char, WS_DNQK) + rec * 8192) + lane;
            const float* Ut = WSP(float, WS_DNU) + (rec * 128 + 16 * w + c) * 64 + 4 * g4;
            const float egl = WSP(float, WS_EGL)[rec];
            bf16x8 Sb[4];
#pragma unroll
            for (int ks = 0; ks < 4; ++ks) { float v[8] = {S[2 * ks][0], S[2 * ks][1], S[2 * ks][2], S[2 * ks][3], S[2 * ks + 1][0], S[2 * ks + 1][1], S[2 * ks + 1][2], S[2 * ks + 1][3]}; Sb[ks] = pack8(v); }
            f32x4 vn[4], oacc[4];
#pragma unroll
            for (int mb = 0; mb < 4; ++mb) { f32x4 a = (f32x4){0.f, 0.f, 0.f, 0.f}, o = (f32x4){0.f, 0.f, 0.f, 0.f};
#pragma unroll
                for (int ks = 0; ks < 4; ++ks) { a = mfma16(Wf[(mb * 4 + ks) * 64], Sb[ks], a); o = mfma16(QGf[(mb * 4 + ks) * 64], Sb[ks], o); }
                vn[mb] = *(const f32x4*)(Ut + 16 * mb) - a; oacc[mb] = o; }
            bf16x8 Vb[2];
#pragma unroll
            for (int k2 = 0; k2 < 2; ++k2) { float v[8] = {vn[2 * k2][0], vn[2 * k2][1], vn[2 * k2][2], vn[2 * k2][3], vn[2 * k2 + 1][0], vn[2 * k2 + 1][1], vn[2 * k2 + 1][2], vn[2 * k2 + 1][3]}; Vb[k2] = pack8(v); }
#pragma unroll
            for (int mb = 0; mb < 4; ++mb) {
#pragma unroll
                for (int k2 = 0; k2 < 2; ++k2) oacc[mb] = mfma16(QKf[(mb * 2 + k2) * 64], Vb[k2], oacc[mb]);
#pragma unroll
                for (int r = 0; r < 4; ++r) O[(size_t)(rbase + 64 * n + 16 * mb + 4 * g4 + r) * 512 + 128 * h + 16 * w + c] = oacc[mb][r]; }
#pragma unroll
            for (int t = 0; t < 8; ++t) { f32x4 a = S[t] * egl;
#pragma unroll
                for (int k2 = 0; k2 < 2; ++k2) a = mfma16(KDf[(t * 2 + k2) * 64], Vb[k2], a);
                S[t] = a; }
        }
    }
}

__device__ __forceinline__ void p_ghn(Ctx& C, int l) {
    const int nrows = l == 0 ? MT : MX, lane = C.lane; const float* O = WSP(float, WS_O); const bf16* P = WSP(bf16, WS_P); bf16* Y = WSP(bf16, WS_Y);
    const float* gn = INP(11) + l * 128 + 8 * (lane & 15);
    for (int row = C.bid * NWAVE + C.wave; row < nrows; row += C.G * NWAVE) {
        const int rb = dirrow(row, 1);
        const f32x4* pf = (const f32x4*)(O + (size_t)row * 512 + 8 * lane); const f32x4* pb = (const f32x4*)(O + ((size_t)MT + rb) * 512 + 8 * lane);
        const f32x4 a = pf[0] + pb[0], b2 = pf[1] + pb[1];
        float o[8] = {a.x, a.y, a.z, a.w, b2.x, b2.y, b2.z, b2.w}, z[8]; float ss = 0.f;
#pragma unroll
        for (int c = 0; c < 8; ++c) ss += o[c] * o[c];
        const float rs = rsqrtf(sum16(ss) * (1.f / 128.f) + EPS);
        unpack8(*(const u32x4*)(P + (size_t)row * NIN + PZ + 8 * lane), z);
#pragma unroll
        for (int c = 0; c < 8; ++c) o[c] = o[c] * rs * gn[c] * silu(z[c]);
        *(bf16x8*)(Y + (size_t)row * D + 8 * lane) = pack8(o);
    }
}

__device__ __forceinline__ void p_moe_gather(Ctx& C) {
    int* R = WSP(int, WS_ROUTE); const unsigned* ctl = WSP(unsigned, WS_CTL);
    LAS int* offs = (LAS int*)C.lds;
    if (C.tid == 0) { int o = 0, nt = 0;
        for (int e = 0; e < 8; ++e) { const int cnt = (int)ctl[CW_CNT + 64 * e], tl = (cnt + 255) >> 8; offs[e] = o;
            if (C.bid == 0) for (int q = 0; q < tl; ++q) R[R_TILEE + nt + q] = e;
            nt += tl; o += tl << 8; }
        if (C.bid == 0) R[R_NT] = nt; }
    WG_BAR();
    const bf16* AN = WSP(bf16, WS_AN); bf16* AS = WSP(bf16, WS_AS);
    for (int tok = C.bid * NWAVE + C.wave; tok < MX; tok += C.G * NWAVE) {
        const int p0 = offs[R[R_TE + 2 * tok]] + R[R_RANK + 2 * tok], p1 = offs[R[R_TE + 2 * tok + 1]] + R[R_RANK + 2 * tok + 1];
        if (C.lane == 0) { R[R_POS + 2 * tok] = p0; R[R_POS + 2 * tok + 1] = p1; }
        if (MOE_FP8) {
            const u32x4* src = (const u32x4*)(AN + (size_t)tok * D) + 4 * C.lane; float f[32];
#pragma unroll
            for (int j = 0; j < 4; ++j) unpack8(src[j], f + 8 * j);
            u32x4 o[2];
#pragma unroll
            for (int j = 0; j < 2; ++j) { const float* q = f + 16 * j;
                o[j].x = pk4_fp8(clamp448(q[0]), clamp448(q[1]), clamp448(q[2]), clamp448(q[3])); o[j].y = pk4_fp8(clamp448(q[4]), clamp448(q[5]), clamp448(q[6]), clamp448(q[7]));
                o[j].z = pk4_fp8(clamp448(q[8]), clamp448(q[9]), clamp448(q[10]), clamp448(q[11])); o[j].w = pk4_fp8(clamp448(q[12]), clamp448(q[13]), clamp448(q[14]), clamp448(q[15])); }
            u32x4* d0 = (u32x4*)((unsigned char*)AS + (size_t)p0 * D) + 2 * C.lane; u32x4* d1 = (u32x4*)((unsigned char*)AS + (size_t)p1 * D) + 2 * C.lane;
            d0[0] = o[0]; d0[1] = o[1]; d1[0] = o[0]; d1[1] = o[1];
        } else {
        const u32x4* src = (const u32x4*)(AN + (size_t)tok * D) + C.lane; u32x4* d0 = (u32x4*)(AS + (size_t)p0 * D) + C.lane; u32x4* d1 = (u32x4*)(AS + (size_t)p1 * D) + C.lane;
#pragma unroll
        for (int j = 0; j < 4; ++j) { u32x4 v = src[64 * j];
            if (FP8_EMU) { float f[8]; unpack8(v, f);
#pragma unroll
                for (int q = 0; q < 8; ++q) f[q] = rne_e4m3(f[q]);
                v = __builtin_bit_cast(u32x4, pack8(f)); }
            d0[64 * j] = v; d1[64 * j] = v; } }
    }
}

__device__ __forceinline__ void p_final(Ctx& C, float* out) {
    const int* R = WSP(int, WS_ROUTE); const float* Rf = WSP(float, WS_ROUTE); const float* XS = WSP(float, WS_XS); const float* OS = WSP(float, WS_OUTS);
    const float* mod = WSP(float, WS_MODV) + (size_t)5 * 12288; const int lane = C.lane;
    for (int tok = C.bid * NWAVE + C.wave; tok < MX; tok += C.G * NWAVE) {
        const int p0 = R[R_POS + 2 * tok], p1 = R[R_POS + 2 * tok + 1]; const float g0 = Rf[R_TG + 2 * tok], g1 = Rf[R_TG + 2 * tok + 1];
        const f32x4* xp = (const f32x4*)(XS + (size_t)tok * D) + lane; const f32x4* o0 = (const f32x4*)(OS + (size_t)p0 * D) + lane; const f32x4* o1 = (const f32x4*)(OS + (size_t)p1 * D) + lane;
        const f32x4* gf = (const f32x4*)(mod + (size_t)(tok >> 11) * 12288 + 10240) + lane; const f32x4* fg = (const f32x4*)INP(32) + lane;
        f32x4 x[8]; float ss = 0.f;
#pragma unroll
        for (int j = 0; j < 8; ++j) { x[j] = xp[64 * j] + gf[64 * j] * (o0[64 * j] * g0 + o1[64 * j] * g1); ss += (x[j].x * x[j].x + x[j].y * x[j].y) + (x[j].z * x[j].z + x[j].w * x[j].w); }
        const float rs = rsqrtf(wave_sum(ss) * (1.f / D) + EPS);
        f32x4* op = (f32x4*)(out + (size_t)tok * D) + lane;
#pragma unroll
        for (int j = 0; j < 8; ++j) op[64 * j] = x[j] * rs * fg[64 * j];
    }
}
}
namespace mk {
constexpr int NPHASE = 21;
struct Args { const float* in[33]; float* out; unsigned char* ws; int ph_lo, ph_hi; };
static_assert(sizeof(Args) == 35 * 8 + 8, "Args has no padding");

#ifdef ONLY_PHASE
#define IN(k) ((k) == ONLY_PHASE)
#else
#define IN(k) (lo <= (k) && (k) < hi)
#endif
__device__ __forceinline__ constexpr int bg_need(int k) { return k >= 18 ? NBG : k >= 15 ? BG_MOE : k >= 11 ? BG_WOUT1 : k >= 9 ? BG_WIN1 : k >= 8 ? BG_W2 : k >= 6 ? BG_W13 : 0; }
#ifndef BG_FILL_MASK
#define BG_FILL_MASK ((1 << 2) | (1 << 4) | (1 << 6) | (1 << 8) | (1 << 9) | (1 << 11) | (1 << 13))
#endif
#define SEAM(k) do { if (IN(k) && IN((k) + 1)) { if (BG_QUEUE) bg_work(C, bg_need((k) + 1), ((BG_FILL_MASK >> (k)) & 1) ? (k) : -1); xcd_barrier(bar); } } while (0)
constexpr int NMOE = 16 * IT_MW1 + 8 * IT_MW2;
#ifndef FILL_R
#define FILL_R 6, 18, 2, 3, 10, 4, 9
#endif
constexpr int fill_rounds[7] = {FILL_R};
constexpr int FB2 = 136, FB4 = 32, FB6 = 32, FB8 = 48, FB9 = 32, FB11 = 88, FB13 = 32;
constexpr int FN2 = fill_rounds[0] * (256 - FB2) * 8, FN4 = fill_rounds[1] * (256 - FB4) * 8, FN6 = fill_rounds[2] * (256 - FB6) * 8, FN8 = fill_rounds[3] * (256 - FB8) * 8,
              FN9 = fill_rounds[4] * (256 - FB9) * 8, FN11 = fill_rounds[5] * (256 - FB11) * 8;
constexpr int FS2 = 0, FS4 = FS2 + FN2, FS6 = FS4 + FN4, FS8 = FS6 + FN6, FS9 = FS8 + FN8, FS11 = FS9 + FN9, FS13 = FS11 + FN11, FN13 = fill_rounds[6] * (256 - FB13) * 8 < NMOE - FS13 ? fill_rounds[6] * (256 - FB13) * 8 : NMOE - FS13, FS17 = FS13 + FN13, FN17 = NMOE - FS17;
static_assert(FN13 >= 0 && FN17 >= 0, "fill schedule exceeds the MoE items");
template <int l>
__device__ __forceinline__ void layer_body(Ctx& C, const XcdBarrier& bar, const int lo, const int hi) {
        const int pb = l == 0 ? 1 : 10;
        const float* mod = WSP(float, WS_MODV) + (size_t)l * 5 * 12288;
        if (IN(pb + 0)) { if constexpr (l == 0) p_norm<0>(C, 0); else p_norm<1>(C, 1); } SEAM(pb + 0);
        if (IN(pb + 1)) {
            pg8::EpiStoreBf16 E{WSP(bf16, WS_P), NIN};
            pg8::Gemm g{WSP(bf16, WS_AN), WSP(bf16, WS_WIN) + (size_t)l * NIN * D, MT, NIN, D};
            if constexpr (l == 0) { pg8::StaticOrder S; S.init(MT, NIN, C.G, C.bid); pg8::gemm_phase<pg8::EpiStoreBf16, pg8::StaticOrder, true, true>(C.lds, g, S, E); }
            else { pg8::InProjL1Order S; S.init(C.G, C.bid); pg8::gemm_phase<pg8::EpiStoreBf16, pg8::InProjL1Order, true, true>(C.lds, g, S, E); }
            if constexpr (l == 0) fill_static(C, FS2, FN2, FB2); else fill_static(C, FS11, FN11, FB11);
        } SEAM(pb + 1);
        if (IN(pb + 2)) { p_mixers(C, l); } SEAM(pb + 2);
        if (IN(pb + 3)) { p_scan(C, l); if constexpr (l == 0) fill_static(C, FS4, FN4, FB4); else fill_static(C, FS13, FN13, FB13); } SEAM(pb + 3);
        if (IN(pb + 4)) { p_ghn(C, l); } SEAM(pb + 4);
        if (IN(pb + 5)) {
            pg8::EpiResid E{WSP(float, WS_XS), mod, 4096};
            pg8::Gemm g{WSP(bf16, WS_Y), WSP(bf16, WS_WOUT) + (size_t)l * D * D, l == 0 ? MT : MX, D, D};
            pg8::StaticOrder S; S.init(l == 0 ? MT : MX, D, C.G, C.bid);
            pg8::gemm_phase<pg8::EpiResid, pg8::StaticOrder, true, true>(C.lds, g, S, E);
            if constexpr (l == 0) fill_static(C, FS6, FN6, FB6);
        } SEAM(pb + 5);
        if (IN(pb + 6)) { if constexpr (l == 0) p_norm<2>(C, 0); else p_norm<3>(C, 1); } SEAM(pb + 6);
        if constexpr (l == 0) {
            if (IN(8)) {
                pg8::EpiSwiglu E{WSP(bf16, WS_HM), DFF, 1 << 20};
                pg8::Gemm g{WSP(bf16, WS_AN), WSP(bf16, WS_W13), MT, 2 * DFF, D};
                pg8::StaticOrder S; S.init(MT, 2 * DFF, C.G, C.bid);
                pg8::gemm_phase<pg8::EpiSwiglu, pg8::StaticOrder, true, true>(C.lds, g, S, E);
                fill_static(C, FS8, FN8, FB8);
            } SEAM(8);
            if (IN(9)) {
                pg8::EpiResid E{WSP(float, WS_XS), mod, 10240};
                pg8::Gemm g{WSP(bf16, WS_HM), WSP(bf16, WS_W2), MT, D, DFF};
                pg8::StaticOrder S; S.init(MT, D, C.G, C.bid);
                pg8::gemm_phase<pg8::EpiResid, pg8::StaticOrder, true, true>(C.lds, g, S, E);
                fill_static(C, FS9, FN9, FB9);
            } SEAM(9);
        } else {
            if (IN(17)) { p_moe_gather(C); fill_static(C, FS17, FN17, 0); } SEAM(17);
            if (IN(18)) {
                const int* R = WSP(int, WS_ROUTE);
                pg8::MoeOrder S; S.init(R[R_NT], 56, R + R_TILEE, C.G, C.bid);
                if (MOE_FP8) { pg8::EpiSwiglu8 E{WSP(unsigned char, WS_HM), DFE, 56};
                    pg8::Gemm g{WSP(bf16, WS_AS), WSP(bf16, WS_MW13), MSORT, 2 * DFE * NE, D / 2};
                    pg8::gemm_phase<pg8::EpiSwiglu8, pg8::MoeOrder, true, true, true>(C.lds, g, S, E); }
                else { pg8::EpiSwiglu E{WSP(bf16, WS_HM), DFE, 56};
                    pg8::Gemm g{WSP(bf16, WS_AS), WSP(bf16, WS_MW13), MSORT, 2 * DFE * NE, D};
                    pg8::gemm_phase<pg8::EpiSwiglu, pg8::MoeOrder, true, true>(C.lds, g, S, E); }
            } SEAM(18);
            if (IN(19)) {
                const int* R = WSP(int, WS_ROUTE);
                pg8::EpiStoreF32 E{WSP(float, WS_OUTS)};
                pg8::MoeOrder S; S.init(R[R_NT], 8, R + R_TILEE, C.G, C.bid);
                if (MOE_FP8) { pg8::Gemm g{WSP(bf16, WS_HM), WSP(bf16, WS_MW2), MSORT, D * NE, DFE / 2};
                    pg8::gemm_phase<pg8::EpiStoreF32, pg8::MoeOrder, true, true, true>(C.lds, g, S, E); }
                else { pg8::Gemm g{WSP(bf16, WS_HM), WSP(bf16, WS_MW2), MSORT, D * NE, DFE};
                    pg8::gemm_phase<pg8::EpiStoreF32, pg8::MoeOrder, true, true>(C.lds, g, S, E); }
            } SEAM(19);
        }
    }
__global__ void __launch_bounds__(NTHR, 2) fwd(Args a) {
    extern __shared__ __attribute__((aligned(16))) unsigned char lds_raw[];
    Ctx C;
    C.lds = (LAS unsigned char*)lds_raw;
    C.in = (CIN)__builtin_amdgcn_kernarg_segment_ptr();
    C.out = a.out; C.ws = a.ws; C.tid = threadIdx.x; C.lane = C.tid & 63; C.wave = __builtin_amdgcn_readfirstlane(C.tid >> 6); C.G = gridDim.x; C.bid = blockIdx.x;
    const int lo = a.ph_lo, hi = a.ph_hi;
    XcdBarrier bar; bar.bar = WSP(unsigned, WS_CTL) + CW_BAR; bar.x = 0; bar.st = (volatile LAS unsigned*)(C.lds + LDS_BARW);
    if (hi - lo > 1) {
        if (C.tid < 4) { ((volatile LAS unsigned*)(C.lds + LDS_BARW))[C.tid] = 0u; }
        __syncthreads();
        bar = xcd_barrier_post(WSP(unsigned, WS_CTL) + CW_BAR, (volatile LAS unsigned*)(C.lds + LDS_BARW));
    }
    if (IN(0)) { p_prologue(C); } SEAM(0);
    layer_body<0>(C, bar, lo, hi);
    layer_body<1>(C, bar, lo, hi);
    if (IN(20)) { p_final(C, C.out); }
}

static int g_grid = 0;
static inline bool setup(size_t ws_size, size_t need) {
    if (g_grid == 0) {
        if (ws_size < need) { fprintf(stderr, "kernel_launch: workspace too small: %zu < %zu\n", ws_size, need); g_grid = -1; return false; }
        int dev = 0, cus = 0, per_cu = 0;
        if (hipGetDevice(&dev) != hipSuccess || hipDeviceGetAttribute(&cus, hipDeviceAttributeMultiprocessorCount, dev) != hipSuccess) { g_grid = -1; return false; }
        if (hipFuncSetAttribute((const void*)fwd, hipFuncAttributeMaxDynamicSharedMemorySize, LDS_BYTES) != hipSuccess) { fprintf(stderr, "kernel_launch: hipFuncSetAttribute failed\n"); g_grid = -1; return false; }
        if (hipOccupancyMaxActiveBlocksPerMultiprocessor(&per_cu, (const void*)fwd, NTHR, LDS_BYTES) != hipSuccess || per_cu < 1) { fprintf(stderr, "kernel_launch: occupancy query says %d\n", per_cu); }
        (void)hipGetLastError();
        g_grid = cus;
    }
    return g_grid > 0;
}
static inline void launch(void* const* d_in, float* out, void* d_ws, int lo, int hi, hipStream_t stream) {
    Args a{};
    for (int i = 0; i < 33; ++i) a.in[i] = (const float*)d_in[i];
    a.out = out; a.ws = (unsigned char*)d_ws; a.ph_lo = lo; a.ph_hi = hi;
    hipLaunchKernelGGL(fwd, dim3(g_grid), dim3(NTHR), LDS_BYTES, stream, a);
}
}
#ifndef MK_DEBUG
#define MK_DEBUG 0
#endif
#ifndef MK_ONE_LAUNCH
#define MK_ONE_LAUNCH 0
#endif
#if MK_DEBUG
#ifndef DBG_LAYER
#define DBG_LAYER 0
#endif
namespace dbg {
using namespace mk;
constexpr size_t SNAP = (WS_END + 4095) & ~(size_t)4095;
constexpr size_t S_ERR = SNAP;
constexpr size_t S_MOD = S_ERR + 4096;
constexpr size_t S_AN = S_MOD + al((size_t)10 * 12288 * 2);
constexpr size_t S_AB = S_AN + al((size_t)MT * D * 2);
constexpr size_t S_P = S_AB + al((size_t)MT * 16 * 2);
constexpr size_t S_O = S_P + al((size_t)MT * NIN * 2);
constexpr size_t S_Y = S_O + al((size_t)2 * MT * 512 * 2);
constexpr size_t S_XM = S_Y + al((size_t)MT * D * 2);
constexpr size_t S_AF = S_XM + al((size_t)MT * D * 2);
constexpr size_t S_XE = S_AF + al((size_t)MT * D * 2);
constexpr size_t S_OUT2 = S_XE + al((size_t)MT * D * 2);
constexpr size_t S_END = S_OUT2 + al((size_t)MX * D * 4);
constexpr int NCK = 12;
__global__ void k_snap(const float* src, size_t lds_, bf16* dst, size_t ldd, int rows, int cols, int mode) {
    for (size_t i = (size_t)blockIdx.x * blockDim.x + threadIdx.x; i < (size_t)rows * cols; i += (size_t)gridDim.x * blockDim.x) {
        const int r = (int)(i / cols), c = (int)(i % cols); int sr = r, sc = c;
        if (mode == 1) sc = c < 1536 ? c : c + 16;
        if (mode == 2) sc = c + 1536;
        size_t dr = r;
        if (mode == 3) { const int dir = r / MT, row = r % MT; dr = (size_t)dir * MT + dirrow(row, dir); }
        dst[dr * ldd + c] = (bf16)f2bf(src[(size_t)sr * lds_ + sc]); }
}
__global__ void k_cmp(const void* a, int a_bf16, size_t lda, size_t acol0, const bf16* b, size_t ldb, size_t bcol0, int rows, int cols, float* acc) {
    float num = 0.f, den = 0.f;
    for (size_t i = (size_t)blockIdx.x * blockDim.x + threadIdx.x; i < (size_t)rows * cols; i += (size_t)gridDim.x * blockDim.x) {
        const size_t r = i / cols, c = i % cols;
        const float av = a_bf16 ? bf2f(((const bf16*)a)[r * lda + acol0 + c]) : ((const float*)a)[r * lda + acol0 + c];
        const float bv = bf2f(b[r * ldb + bcol0 + c]); const float d = av - bv;
        if (!(d == d)) { num += 1e30f; } else { num += d * d; } den += bv * bv; }
    num = wave_sum(num); den = wave_sum(den);
    if ((threadIdx.x & 63) == 0) { atomicAdd(acc, num); atomicAdd(acc + 1, den); }
}
__global__ void k_decide(float* err) {
    if (threadIdx.x != 0) return; int code = -1, level = 0;
    for (int k = 0; k < NCK; ++k) { const float num = err[2 * k], den = err[2 * k + 1]; if (den == 0.f && num == 0.f) continue;
        const float e = sqrtf(num / fmaxf(den, 1e-30f)); const float tol = (k == 4) ? 0.06f : 0.03f;
        if (!(e <= tol)) { code = k; level = !(e == e) ? 5 : e < 1e-4f ? 0 : e < 1e-3f ? 1 : e < 1e-2f ? 2 : e < 1e-1f ? 3 : e < 1.f ? 4 : 5; break; } }
    ((int*)err)[64] = code; ((int*)err)[65] = level;
}
__global__ void k_encode(float* out, const float* out2, const float* err) {
    const int code = ((const int*)err)[64], level = ((const int*)err)[65];
    for (size_t i = (size_t)blockIdx.x * blockDim.x + threadIdx.x; i < (size_t)MX * D; i += (size_t)gridDim.x * blockDim.x) {
        if (code < 0) { out[i] = out2[i]; continue; }
        const size_t row = i / D; if (row < (size_t)(code + 1) * (MX / 16)) out[i] = 0.f;
        if (i == (size_t)MX * D - 1) out[i] = (float)(16 << level); }
}
}
#endif

extern "C" void kernel_launch(void* const* d_in, const int* in_sizes, int n_in, void* d_out, int out_size, void* d_ws, size_t ws_size, hipStream_t stream) {
    using namespace mk;
#if MK_DEBUG
    if (!setup(ws_size, dbg::S_END) || n_in != 33) return;
    unsigned char* ws = (unsigned char*)d_ws;
    nv::Bufs nb; const size_t nneed = nv::carve(ws, nb);
    if (nneed > dbg::SNAP) { fprintf(stderr, "naive scratch overlaps snapshots\n"); return; }
    hipMemsetAsync(ws + dbg::S_ERR, 0, 4096, stream);
    auto snap = [&](const float* src, size_t lds_, size_t dst_off, size_t ldd, int rows, int cols, int mode) {
        hipLaunchKernelGGL(dbg::k_snap, dim3(2048), dim3(256), 0, stream, src, lds_, (bf16*)(ws + dst_off), ldd, rows, cols, mode); };
    auto hook = [&](int point, int l) {
        if (point == 0) { snap(nb.mod, 12288, dbg::S_MOD, 12288, 10, 12288, 0); return; }
        if (l != DBG_LAYER) return;
        if (point == 1) snap(nb.A, D, dbg::S_AN, D, MT, D, 0);
        if (point == 2) { snap(nb.p, nv::INW, dbg::S_P, NIN, MT, NIN, 1); snap(nb.p, nv::INW, dbg::S_AB, 16, MT, 16, 2); }
        if (point == 3) snap(nb.o, 512, dbg::S_O, 512, 2 * MT, 512, 3);
        if (point == 4) snap(nb.y, D, dbg::S_Y, D, MT, D, 0);
        if (point == 5) snap(nb.xs, D, dbg::S_XM, D, MT, D, 0);
        if (point == 6) snap(nb.A, D, dbg::S_AF, D, MT, D, 0);
        if (point == 7) snap(nb.xs, D, dbg::S_XE, D, MT, D, 0);
    };
    nv::forward(d_in, (float*)d_out, nb, stream, hook);
    hipMemsetAsync(ws + WS_CTL, 0, CTL_BYTES, stream);
    float* err = (float*)(ws + dbg::S_ERR); float* out2 = (float*)(ws + dbg::S_OUT2);
    auto cmp = [&](int k, const void* a, int a_bf16, size_t lda, size_t acol0, size_t snap_off, size_t ldb, size_t bcol0, int rows, int cols) {
        hipLaunchKernelGGL(dbg::k_cmp, dim3(1024), dim3(256), 0, stream, a, a_bf16, lda, acol0, (const bf16*)(ws + snap_off), ldb, bcol0, rows, cols, err + 2 * k); };
    const int L = DBG_LAYER, pb = L == 0 ? 1 : 10, nr = L == 0 ? MT : MX;
    for (int ph = 0; ph < NPHASE; ++ph) {
        launch(d_in, out2, d_ws, ph, ph + 1, stream);
        if (ph == 0) cmp(0, ws + WS_MODV, 0, 12288, 0, dbg::S_MOD, 12288, 0, 10, 12288);
        if (ph == pb + 0) { cmp(1, ws + WS_AN, 1, D, 0, dbg::S_AN, D, 0, MT, D); cmp(2, ws + WS_ABF, 0, 16, 0, dbg::S_AB, 16, 0, MT, 16); }
        if (ph == pb + 1) { cmp(3, ws + WS_P, 1, NIN, 0, dbg::S_P, NIN, 0, nr, NIN); if (L == 1) cmp(3, ws + WS_P + (size_t)MX * NIN * 2, 1, NIN, 0, dbg::S_P + (size_t)MX * NIN * 2, NIN, 0, MC, 1536); }
        if (ph == pb + 3) cmp(4, ws + WS_O, 0, 512, 0, dbg::S_O, 512, 0, 2 * MT, 512);
        if (ph == pb + 4) { cmp(5, ws + WS_Y, 1, D, 0, dbg::S_Y, D, 0, nr, 512); cmp(6, ws + WS_Y, 1, D, 512, dbg::S_Y, D, 512, nr, 512);
                            cmp(7, ws + WS_Y, 1, D, 1024, dbg::S_Y, D, 1024, nr, 512); cmp(8, ws + WS_Y, 1, D, 1536, dbg::S_Y, D, 1536, nr, 512); }
        if (ph == pb + 5) cmp(9, ws + WS_XS, 0, D, 0, dbg::S_XM, D, 0, nr, D);
        if (ph == pb + 6) cmp(10, ws + WS_AN, 1, D, 0, dbg::S_AF, D, 0, nr, D);
        if (L == 0 && ph == 9) cmp(11, ws + WS_XS, 0, D, 0, dbg::S_XE, D, 0, MT, D);
    }
    hipLaunchKernelGGL(dbg::k_decide, dim3(1), dim3(64), 0, stream, err);
    hipLaunchKernelGGL(dbg::k_encode, dim3(2048), dim3(256), 0, stream, (float*)d_out, out2, err);
#else
    if (!setup(ws_size, WS_END) || n_in != 33) return;
    hipMemsetAsync((unsigned char*)d_ws + WS_CTL, 0, CTL_BYTES, stream);
#if MK_ONE_LAUNCH
    launch(d_in, (float*)d_out, d_ws, 0, NPHASE, stream);
#else
#ifndef REP_MASK
#define REP_MASK 0
#endif
    for (int ph = 0; ph < NPHASE; ++ph) { launch(d_in, (float*)d_out, d_ws, ph, ph + 1, stream); if ((REP_MASK >> ph) & 1) launch(d_in, (float*)d_out, d_ws, ph, ph + 1, stream); }
#endif
#endif
}
```

```cpp
#include <hip/hip_runtime.h>
#include <cstdio>
#include <cstdint>
#define MK_DEBUG 0
#define DBG_LAYER 0
#define MK_ONE_LAUNCH 1
#define REP_MASK 0
#ifndef BG_QUEUE
#define BG_QUEUE 0
#endif
#ifndef STATIC_FILL
#define STATIC_FILL MK_ONE_LAUNCH
#endif
#define GAS __attribute__((address_space(1)))
#define LAS __attribute__((address_space(3)))
typedef unsigned short bf16;
typedef short bf16x8 __attribute__((ext_vector_type(8)));
typedef float f32x4 __attribute__((ext_vector_type(4)));
typedef float f32x2 __attribute__((ext_vector_type(2)));
typedef unsigned u32x4 __attribute__((ext_vector_type(4)));
typedef unsigned u32x2 __attribute__((ext_vector_type(2)));

#ifndef FP8_EMU
#define FP8_EMU 0
#endif
#ifndef MOE_FP8
#define MOE_FP8 1
#endif
__device__ __forceinline__ float rne_e4m3(float x) { return __builtin_amdgcn_cvt_f32_fp8(__builtin_amdgcn_cvt_pk_fp8_f32(x, x, 0, false), 0); }
namespace mk {
constexpr int D = 2048, NB = 4, TX = 2048, TC = 256, MX = NB * TX, MC = NB * TC, MT = MX + MC;
constexpr int INW = 4624, NIN = 4608;
constexpr int PQ = 0, PK = 512, PV = 1024, PZ = 1536, PSGU = 2048, PSGV = 2560, PPOOL = 3072, PCVA = 3584, PCVG = 4096;
constexpr int DFF = 5632, NE = 8, DFE = 7168;
constexpr int NCH = MT / 64;
constexpr int MSORT = 2 * MX + NE * 256;
constexpr float EPS = 1e-6f;
constexpr int NTHR = 512, NWAVE = 8;
constexpr int LDS_BYTES = 163840;
constexpr int LDS_BARW = LDS_BYTES - 16;

constexpr size_t al(size_t x) { return (x + 4095) & ~(size_t)4095; }
constexpr size_t WS_CTL = 0, CTL_BYTES = 1u << 20;
constexpr size_t WS_MODV = WS_CTL + CTL_BYTES;
constexpr size_t WS_POS = WS_MODV + al((size_t)2 * 5 * 12288 * 4);
constexpr size_t WS_PWT = WS_POS + al((size_t)TX * D * 4);
constexpr size_t WS_WABC = WS_PWT + al((size_t)2 * 4 * 128 * 128 * 2);
constexpr size_t WS_WIN = WS_WABC + al((size_t)2 * 2048 * 16 * 4);
constexpr size_t WS_WOUT = WS_WIN + al((size_t)2 * NIN * D * 2);
constexpr size_t WS_W13 = WS_WOUT + al((size_t)2 * D * D * 2);
constexpr size_t WS_W2 = WS_W13 + al((size_t)2 * DFF * D * 2);
constexpr size_t WS_MW13 = WS_W2 + al((size_t)D * DFF * 2);
constexpr size_t WS_MW2 = WS_MW13 + al((size_t)NE * 2 * DFE * D * 2);
constexpr size_t WS_XS = WS_MW2 + al((size_t)NE * D * DFE * 2);
constexpr size_t WS_AN = WS_XS + al((size_t)MT * D * 4);
constexpr size_t WS_ABF = WS_AN + al((size_t)MT * D * 2);
constexpr size_t WS_PART = WS_ABF + al((size_t)MT * 16 * 4);
constexpr size_t WS_ROUTE = WS_PART + al((size_t)4 * MC * D * 4);
constexpr size_t WS_BIG = WS_ROUTE + al((size_t)1 << 20);
constexpr size_t WS_P = WS_BIG;
constexpr size_t DN_FRAG = (size_t)2 * NCH * 4;
constexpr size_t WS_DNW = WS_P + al((size_t)MT * NIN * 2);
constexpr size_t WS_DNQG = WS_DNW + al(DN_FRAG * 16384);
constexpr size_t WS_DNKDT = WS_DNQG + al(DN_FRAG * 16384);
constexpr size_t WS_DNQK = WS_DNKDT + al(DN_FRAG * 16384);
constexpr size_t WS_DNU = WS_DNQK + al(DN_FRAG * 8192);
constexpr size_t WS_EGL = WS_DNU + al(DN_FRAG * 32768);
constexpr size_t WS_O = WS_EGL + al(DN_FRAG * 16);
constexpr size_t WS_Y = WS_O + al((size_t)2 * MT * 512 * 4);
constexpr size_t WS_CVH = WS_Y + al((size_t)MT * D * 2);
constexpr size_t WS_MIX_END = WS_CVH + al((size_t)MT * 512 * 4);
constexpr size_t WS_HM = WS_BIG;
constexpr size_t WS_AS = WS_HM + al((size_t)MSORT * DFE * 2);
constexpr size_t WS_OUTS = WS_AS + al((size_t)MSORT * D * 2);
constexpr size_t WS_FFN_END = WS_OUTS + al((size_t)MSORT * D * 4);
constexpr size_t WS_END = WS_FFN_END > WS_MIX_END ? WS_FFN_END : WS_MIX_END;
constexpr int R_TE = 0;
constexpr int R_TG = R_TE + MX * 2;
constexpr int R_RANK = R_TG + MX * 2;
constexpr int R_POS = R_RANK + MX * 2;
constexpr int R_TILEE = R_POS + MX * 2;
constexpr int R_NT = R_TILEE + 128;
constexpr int CW_CNT = 64;
constexpr int CW_BGHEAD = 1024;
constexpr int CW_DONE = 2048;
constexpr int CW_BAR = 4096;

__device__ __forceinline__ float silu(float x) { return x * __builtin_amdgcn_rcpf(1.f + __expf(-x)); }
__device__ __forceinline__ float sigm(float x) { return __builtin_amdgcn_rcpf(1.f + __expf(-x)); }
__device__ __forceinline__ float gelu_tanh(float x) { const float u = 0.7978845608028654f * (x + 0.044715f * x * x * x); const float e = __expf(2.f * u); return x * (1.f - __builtin_amdgcn_rcpf(1.f + e)); }
__device__ __forceinline__ float softplus(float x) { return x > 20.f ? x : log1pf(__expf(x)); }
__device__ __forceinline__ unsigned f2bf(float f) { unsigned u = __builtin_bit_cast(unsigned, f); return (u + 0x7fffu + ((u >> 16) & 1u)) >> 16; }
__device__ __forceinline__ unsigned pk2(float lo, float hi) { return f2bf(lo) | (f2bf(hi) << 16); }
__device__ __forceinline__ float bf2f(unsigned short b) { return __builtin_bit_cast(float, (unsigned)b << 16); }
__device__ __forceinline__ float bflo(unsigned w) { return __builtin_bit_cast(float, w << 16); }
__device__ __forceinline__ float bfhi(unsigned w) { return __builtin_bit_cast(float, w & 0xffff0000u); }
__device__ __forceinline__ bf16x8 pack8(const float* v) { u32x4 w; w.x = pk2(v[0], v[1]); w.y = pk2(v[2], v[3]); w.z = pk2(v[4], v[5]); w.w = pk2(v[6], v[7]); return __builtin_bit_cast(bf16x8, w); }
__device__ __forceinline__ void unpack8(u32x4 w, float* v) { v[0] = bflo(w.x); v[1] = bfhi(w.x); v[2] = bflo(w.y); v[3] = bfhi(w.y); v[4] = bflo(w.z); v[5] = bfhi(w.z); v[6] = bflo(w.w); v[7] = bfhi(w.w); }
__device__ __forceinline__ unsigned pk4_fp8(float a, float b, float c, float d) { int p = __builtin_amdgcn_cvt_pk_fp8_f32(a, b, 0, false); p = __builtin_amdgcn_cvt_pk_fp8_f32(c, d, p, true); return (unsigned)p; }
__device__ __forceinline__ float clamp448(float x) { return fminf(fmaxf(x, -448.f), 448.f); }
__device__ __forceinline__ float wave_sum(float v) {
#pragma unroll
    for (int o = 1; o < 64; o <<= 1) v += __shfl_xor(v, o);
    return v;
}
__device__ __forceinline__ float sum16(float v) {
#pragma unroll
    for (int o = 1; o < 16; o <<= 1) v += __shfl_xor(v, o);
    return v;
}
__device__ __forceinline__ void rowinfo(int row, int& base, int& T, int& t, int& mv) {
    if (row < MX) { const int b = row >> 11; base = b << 11; T = TX; t = row - base; mv = b; }
    else { const int r = row - MX, b = r >> 8; base = MX + (b << 8); T = TC; t = r - (b << 8); mv = 4; }
}
__device__ __forceinline__ int dirrow(int row, int dir) { int base, T, t, mv; rowinfo(row, base, T, t, mv); return dir ? base + (T - 1 - t) : row; }
#define LDS_WAIT() asm volatile("s_waitcnt lgkmcnt(0)" ::: "memory")
#define VM_WAIT() asm volatile("s_waitcnt vmcnt(0)" ::: "memory")
#define WG_BAR() do { __syncthreads(); } while (0)
}
#define XB_TMO      128
#define XB_XCNT(j)  (256  + 64 * (j))
#define XB_XSUB(j)  (1280 + 64 * (j))
#define XB_XGEN(j)  (2304 + 64 * (j))
#define XB_TOP      3328
#define XB_TOPGEN   3392
#define XCD_BAR_WORDS 3456
#define XB_SPIN_CAP (1u << 18)
#define LAS __attribute__((address_space(3)))

__device__ __forceinline__ unsigned xb_ld(unsigned* p)              { return __hip_atomic_load(p, __ATOMIC_RELAXED, __HIP_MEMORY_SCOPE_AGENT); }
__device__ __forceinline__ unsigned xb_add(unsigned* p, unsigned v) { return __hip_atomic_fetch_add(p, v, __ATOMIC_RELAXED, __HIP_MEMORY_SCOPE_AGENT); }
__device__ __forceinline__ unsigned xb_xcc_id() { return (unsigned)__builtin_amdgcn_s_getreg((3 << 11) | 20) & 0xFu; }
#define XB_SPIN(cond, bar) do { unsigned _sp = 0; while (cond) { __builtin_amdgcn_s_sleep(1); \
    if ((++_sp & 255u) == 0u) { if (xb_ld(&(bar)[XB_TMO])) break; if (_sp > XB_SPIN_CAP) { atomicAdd(&(bar)[XB_TMO], 1u); break; } } } } while (0)

struct XcdBarrier {
    unsigned* bar; unsigned x;
    volatile LAS unsigned* st;
};

__device__ __forceinline__ XcdBarrier xcd_barrier_post(unsigned* bar, volatile LAS unsigned* st) {
    XcdBarrier b; b.bar = bar; b.x = xb_xcc_id(); b.st = st;
    if (threadIdx.x == 0) (void)xb_add(&bar[XB_XCNT(b.x)], 1u);
    return b;
}
__device__ __forceinline__ void xcd_barrier_complete(unsigned* bar, unsigned x, unsigned& nloc, unsigned& nx) {
    const unsigned G = gridDim.x * gridDim.y * gridDim.z;
    unsigned sum, cnt, mine, sp = 0u;
    for (;;) {
        sum = 0u; cnt = 0u; mine = 0u;
#pragma unroll
        for (unsigned j = 0; j < 16; ++j) { const unsigned c = xb_ld(&bar[XB_XCNT(j)]); sum += c; cnt += (c > 0u) ? 1u : 0u; mine = (j == x) ? c : mine; }
        if (sum == G) break;
        __builtin_amdgcn_s_sleep(1);
        if ((++sp & 255u) == 0u) { if (xb_ld(&bar[XB_TMO])) break; if (sp > XB_SPIN_CAP) { atomicAdd(&bar[XB_TMO], 1u); break; } }
    }
    nloc = mine > 0u ? mine : 1u; nx = cnt > 0u ? cnt : 1u;
}

__device__ __forceinline__ void xcd_barrier(const XcdBarrier& b) {
    asm volatile("s_waitcnt vmcnt(0)" ::: "memory");
    __syncthreads();
    if (threadIdx.x == 0) {
        unsigned* bar = b.bar;
        __builtin_amdgcn_s_waitcnt(0);
        unsigned nloc = b.st[0], nx = b.st[1];
        if (nloc == 0u) { xcd_barrier_complete(bar, b.x, nloc, nx); b.st[0] = nloc; b.st[1] = nx; }
        const unsigned old = xb_add(&bar[XB_XSUB(b.x)], 1u);
        const unsigned gen = old / nloc;
        if (old + 1u == (gen + 1u) * nloc) {
            __builtin_amdgcn_fence(__ATOMIC_RELEASE, "agent");
            asm volatile("s_waitcnt vmcnt(0)" ::: "memory");
            const unsigned og = xb_add(&bar[XB_TOP], 1u);
            const unsigned tg = og / nx;
            if (og + 1u == (tg + 1u) * nx) xb_add(&bar[XB_TOPGEN], 1u);
            else XB_SPIN(xb_ld(&bar[XB_TOPGEN]) == tg, bar);
            __builtin_amdgcn_fence(__ATOMIC_ACQUIRE, "agent");
            xb_add(&bar[XB_XGEN(b.x)], 1u);
            asm volatile("s_waitcnt vmcnt(0)" ::: "memory");
        } else {
            XB_SPIN(xb_ld(&bar[XB_XGEN(b.x)]) == gen, bar);
            __builtin_amdgcn_fence(__ATOMIC_ACQUIRE, "agent");
            asm volatile("s_waitcnt vmcnt(0)" ::: "memory");
        }
    }
    __syncthreads();
}
namespace pg8 {
#define PG8_LAS __attribute__((address_space(3)))
typedef unsigned short bf16_t;
typedef short bf16x8 __attribute__((ext_vector_type(8)));
typedef float f32x4 __attribute__((ext_vector_type(4)));
typedef unsigned u32x4 __attribute__((ext_vector_type(4)));
constexpr int BM = 256, BK = 64, HALF = 128, HTB = HALF * BK * 2  , STAGE_BYTES = 8 * HTB, NXCD = 8, WGM = 8;

__host__ __device__ __forceinline__ int lds_byte(int r, int c) { const int st = (r >> 4) * 2 + (c >> 5), rr = r & 15, cc = c & 31, ob = rr * 64 + cc * 2; return st * 1024 + (ob ^ (((ob >> 9) & 1) << 5)); }
__host__ __device__ __forceinline__ void stage_rc(int b, int& R, int& C) { const int st = b / 1024, sb = b % 1024, swz = sb ^ (((sb >> 9) & 1) << 5); R = (st >> 1) * 16 + swz / 64; C = (st & 1) * 32 + (swz % 64) / 2; }
__host__ __device__ __forceinline__ int perm32(int rho) { const int n = rho >> 4, i = rho & 15; return 8 * (i >> 2) + 4 * n + (i & 3); }

struct Unit { int pm, pn, k0, nk; };
struct Gemm { const bf16_t* A; const bf16_t* Bt; int M, N, K; };

struct StaticOrder {
    int nM, nN, nwg, G, c;
    __host__ __device__ void init(int M, int N, int G_, int c_) { nM = M / BM; nN = N / BM; nwg = nM * nN; G = G_; c = c_; }
    __host__ __device__ bool next(int i, Unit& u) const {
        const long L = (long)i * G + c; if (L >= nwg) return false;
        int wgid = (int)L; { const int q = nwg / NXCD, r = nwg % NXCD, xcd = wgid % NXCD, off = wgid / NXCD; wgid = (xcd < r ? xcd * (q + 1) : r * (q + 1) + (xcd - r) * q) + off; }
        const int nig = WGM * nN, gid = wgid / nig, fm = gid * WGM, gsz = (nM - fm) < WGM ? (nM - fm) : WGM;
        u.pm = fm + ((wgid % nig) % gsz); u.pn = (wgid % nig) / gsz; u.k0 = 0; u.nk = 0; return true;
    }
    __device__ __forceinline__ void a_ready(const Unit&) const {}
    __device__ __forceinline__ void done(const Unit&) const {}
};
__device__ __forceinline__ unsigned cvt_pk_bf16(float lo, float hi) { unsigned r; asm volatile("v_cvt_pk_bf16_f32 %0, %1, %2" : "=v"(r) : "v"(lo), "v"(hi)); return r; }
typedef float f32x2 __attribute__((ext_vector_type(2)));
typedef int pg8_v8i __attribute__((ext_vector_type(8)));
typedef int pg8_v4i __attribute__((ext_vector_type(4)));
__device__ __forceinline__ pg8_v8i pg8_cat(bf16x8 lo, bf16x8 hi) { const pg8_v4i a = __builtin_bit_cast(pg8_v4i, lo), b = __builtin_bit_cast(pg8_v4i, hi); return __builtin_shufflevector(a, b, 0, 1, 2, 3, 4, 5, 6, 7); }
constexpr int F8_WSCALE = 121;
template <class Epi, class Sched, bool ALIGN_EPI = false, bool SP2 = false, bool F8 = false>
__device__ __forceinline__ void gemm_phase(PG8_LAS unsigned char* lds, const Gemm g, const Sched& S, const Epi& E) {
    const int tid = threadIdx.x, wid = __builtin_amdgcn_readfirstlane(tid >> 6), lane = tid & 63, wr = wid >> 2, wc = wid & 3, fr = lane & 15, fq = lane >> 4;
    const int K = g.K, nt = K / BK;
    unsigned voffA[2], voffB[2];
#pragma unroll
    for (int i = 0; i < 2; ++i) { int R, C; stage_rc(tid * 16 + i * 8192, R, C); const int Rb = Epi::PERM ? ((R & ~31) + perm32(R & 31)) : R;
        voffA[i] = (unsigned)(R * K + C) * 2u; voffB[i] = (unsigned)(Rb * K + C) * 2u; }
    const size_t kstep = (size_t)(BK * 2);
    const size_t hstep = (size_t)HALF * K * 2;
    const size_t tstep = 2 * hstep;
    const unsigned ldsw = (unsigned)wid * 1024u;
    const int aoff = lds_byte(wr * 64 + fr, fq * 8), boff = lds_byte(wc * 32 + fr, fq * 8);
#define PG8_SA(b, h) (((b) * 2 + (h)) * HTB)
#define PG8_SB(b, h) ((4 + (b) * 2 + (h)) * HTB)
#define PG8_STAGE(bufoff, gbase, voff) do { _Pragma("unroll") for (int _i = 0; _i < 2; ++_i) \
        __builtin_amdgcn_global_load_lds((const unsigned*)((const char*)(gbase) + (voff)[_i]), (PG8_LAS unsigned*)(lds + (bufoff) + ldsw + _i * 8192), 16, 0, 0); } while (0)
#define PG8_LDA(dst, b, h) do { _Pragma("unroll") for (int m = 0; m < 4; ++m) { if constexpr (F8) { dst##8[m] = pg8_cat(*(const PG8_LAS bf16x8*)(lds + PG8_SA(b, h) + aoff + m * 2048), *(const PG8_LAS bf16x8*)(lds + PG8_SA(b, h) + aoff + m * 2048 + 1024)); } else { _Pragma("unroll") for (int k = 0; k < 2; ++k) dst[m][k] = *(const PG8_LAS bf16x8*)(lds + PG8_SA(b, h) + aoff + m * 2048 + k * 1024); } } } while (0)
#define PG8_LDB(dst, b, h) do { _Pragma("unroll") for (int n = 0; n < 2; ++n) { if constexpr (F8) { dst##8[n] = pg8_cat(*(const PG8_LAS bf16x8*)(lds + PG8_SB(b, h) + boff + n * 2048), *(const PG8_LAS bf16x8*)(lds + PG8_SB(b, h) + boff + n * 2048 + 1024)); } else { _Pragma("unroll") for (int k = 0; k < 2; ++k) dst[n][k] = *(const PG8_LAS bf16x8*)(lds + PG8_SB(b, h) + boff + n * 2048 + k * 1024); } } } while (0)
#define PG8_MMA(ai, bj, At, Bt) do { __builtin_amdgcn_s_setprio(1); if constexpr (F8) { _Pragma("unroll") for (int m = 0; m < 4; ++m) _Pragma("unroll") for (int n = 0; n < 2; ++n) \
        asm volatile("v_mfma_scale_f32_16x16x128_f8f6f4 %0, %1, %2, %0, %3, %4 op_sel_hi:[0,0,0]" : "+v"(acc[ai][bj][m][n]) : "v"(Bt##8[n]), "v"(At##8[m]), "v"(f8_sw), "v"(f8_sa)); } \
        else { _Pragma("unroll") for (int m = 0; m < 4; ++m) _Pragma("unroll") for (int n = 0; n < 2; ++n) _Pragma("unroll") for (int k = 0; k < 2; ++k) \
        acc[ai][bj][m][n] = __builtin_amdgcn_mfma_f32_16x16x32_bf16(Bt[n][k], At[m][k], acc[ai][bj][m][n], 0, 0, 0); } __builtin_amdgcn_s_setprio(0); } while (0)
#define PG8_WAIT_V(n) asm volatile("s_waitcnt vmcnt(" #n ")" ::: "memory")
#define PG8_WAIT_L(n) asm volatile("s_waitcnt lgkmcnt(" #n ")" ::: "memory")
#define PG8_BAR __builtin_amdgcn_s_barrier()
#define PG8_SCHED __builtin_amdgcn_sched_barrier(0)
    Unit cur, nxt; int ui = 0;
    if (!S.next(0, cur)) return;
    f32x4 acc[2][2][4][2];
#pragma unroll
    for (int a = 0; a < 2; ++a)
#pragma unroll
        for (int b = 0; b < 2; ++b)
#pragma unroll
            for (int m = 0; m < 4; ++m)
#pragma unroll
                for (int n = 0; n < 2; ++n) acc[a][b][m][n] = (f32x4){0.f, 0.f, 0.f, 0.f};
    bf16x8 At[4][2], B0[2][2], B1[2][2]; pg8_v8i At8[4], B08[2], B18[2]; const int f8_sw = F8_WSCALE, f8_sa = 127;
    const char* cA = (const char*)g.A + (size_t)cur.pm * tstep + (size_t)cur.k0 * 2; const char* cB = (const char*)g.Bt + (size_t)cur.pn * tstep + (size_t)cur.k0 * 2;
    S.a_ready(cur);
    if constexpr (SP2) {
        PG8_STAGE(PG8_SB(0, 0), cB, voffB); PG8_STAGE(PG8_SB(0, 1), cB + hstep, voffB); PG8_STAGE(PG8_SA(0, 0), cA, voffA); PG8_STAGE(PG8_SA(0, 1), cA + hstep, voffA);
        if (wr == 1) PG8_BAR;
        PG8_WAIT_V(2); PG8_BAR;
        PG8_STAGE(PG8_SB(1, 0), cB + kstep, voffB); PG8_STAGE(PG8_SA(1, 0), cA + kstep, voffA); PG8_STAGE(PG8_SB(1, 1), cB + hstep + kstep, voffB);
        PG8_WAIT_V(6); PG8_BAR;
    } else {
        PG8_STAGE(PG8_SB(0, 0), cB, voffB); PG8_STAGE(PG8_SA(0, 0), cA, voffA); PG8_STAGE(PG8_SB(0, 1), cB + hstep, voffB); PG8_STAGE(PG8_SA(0, 1), cA + hstep, voffA);
        if (wr == 1) PG8_BAR;
        PG8_WAIT_V(4); PG8_BAR;
        PG8_STAGE(PG8_SB(1, 0), cB + kstep, voffB); PG8_STAGE(PG8_SA(1, 0), cA + kstep, voffA); PG8_STAGE(PG8_SB(1, 1), cB + hstep + kstep, voffB);
        PG8_WAIT_V(6); PG8_BAR;
    }
    for (;;) {
        const bool has_next = S.next(ui + 1, nxt);
        const char* nA = has_next ? (const char*)g.A + (size_t)nxt.pm * tstep + (size_t)nxt.k0 * 2 : cA; const char* nB = has_next ? (const char*)g.Bt + (size_t)nxt.pn * tstep + (size_t)nxt.k0 * 2 : cB;
        const int ntc = cur.nk ? cur.nk : nt;
        for (int t = 0; t < ntc; t += 2) {
            const bool last = (t == ntc - 2);
            const char* a1 = cA + (size_t)(t + 1) * kstep;
            const char* a2 = last ? nA : cA + (size_t)(t + 2) * kstep; const char* b2 = last ? nB : cB + (size_t)(t + 2) * kstep;
            const char* a3 = a2 + kstep; const char* b3 = b2 + kstep;
            if (last && has_next) S.a_ready(nxt);
            if constexpr (SP2) {
            PG8_LDB(B0, 0, 0); PG8_LDB(B1, 0, 1); PG8_SCHED; PG8_LDA(At, 0, 0); PG8_STAGE(PG8_SA(1, 1), a1 + hstep, voffA);
            PG8_WAIT_V(8); PG8_WAIT_L(0); PG8_BAR; PG8_MMA(0, 0, At, B0); PG8_MMA(0, 1, At, B1); PG8_BAR; PG8_SCHED;
            PG8_LDA(At, 0, 1); PG8_STAGE(PG8_SB(0, 0), b2, voffB); PG8_STAGE(PG8_SB(0, 1), b2 + hstep, voffB); PG8_STAGE(PG8_SA(0, 0), a2, voffA);
            PG8_WAIT_V(8); PG8_WAIT_L(0); PG8_BAR; PG8_MMA(1, 0, At, B0); PG8_MMA(1, 1, At, B1); PG8_BAR; PG8_SCHED;
            PG8_LDB(B0, 1, 0); PG8_LDB(B1, 1, 1); PG8_SCHED; PG8_LDA(At, 1, 0); PG8_STAGE(PG8_SA(0, 1), a2 + hstep, voffA);
            PG8_WAIT_V(8); PG8_WAIT_L(0); PG8_BAR; PG8_MMA(0, 0, At, B0); PG8_MMA(0, 1, At, B1); PG8_BAR; PG8_SCHED;
            PG8_LDA(At, 1, 1); PG8_STAGE(PG8_SB(1, 0), b3, voffB); PG8_STAGE(PG8_SB(1, 1), b3 + hstep, voffB); PG8_STAGE(PG8_SA(1, 0), a3, voffA);
            PG8_WAIT_V(8); PG8_WAIT_L(0); PG8_BAR; PG8_MMA(1, 0, At, B0); PG8_MMA(1, 1, At, B1); PG8_BAR; PG8_SCHED;
            } else {
            PG8_LDB(B0, 0, 0); PG8_SCHED; PG8_LDA(At, 0, 0); PG8_STAGE(PG8_SA(1, 1), a1 + hstep, voffA);
            PG8_WAIT_L(8); PG8_BAR; PG8_WAIT_L(0); PG8_MMA(0, 0, At, B0); PG8_BAR; PG8_SCHED;
            PG8_LDB(B1, 0, 1); PG8_STAGE(PG8_SB(0, 0), b2, voffB);
            PG8_BAR; PG8_WAIT_L(0); PG8_MMA(0, 1, At, B1); PG8_BAR;
            PG8_LDA(At, 0, 1); PG8_STAGE(PG8_SA(0, 0), a2, voffA);
            PG8_BAR; PG8_WAIT_L(0); PG8_MMA(1, 0, At, B0); PG8_BAR; PG8_SCHED;
            PG8_STAGE(PG8_SB(0, 1), b2 + hstep, voffB);
            PG8_WAIT_V(6); PG8_BAR; PG8_MMA(1, 1, At, B1); PG8_BAR;
            PG8_LDB(B0, 1, 0); PG8_SCHED; PG8_LDA(At, 1, 0); PG8_STAGE(PG8_SA(0, 1), a2 + hstep, voffA);
            PG8_WAIT_L(8); PG8_BAR; PG8_WAIT_L(0); PG8_MMA(0, 0, At, B0); PG8_BAR; PG8_SCHED;
            PG8_LDB(B1, 1, 1); PG8_STAGE(PG8_SB(1, 0), b3, voffB);
            PG8_BAR; PG8_WAIT_L(0); PG8_MMA(0, 1, At, B1); PG8_BAR;
            PG8_LDA(At, 1, 1); PG8_STAGE(PG8_SA(1, 0), a3, voffA);
            PG8_BAR; PG8_WAIT_L(0); PG8_MMA(1, 0, At, B0); PG8_BAR; PG8_SCHED;
            PG8_STAGE(PG8_SB(1, 1), b3 + hstep, voffB);
            PG8_WAIT_V(6); PG8_BAR; PG8_MMA(1, 1, At, B1); PG8_BAR;
            }
        }
        if constexpr (F8) { asm volatile("s_nop 15\n\ts_nop 15" ::: "memory"); }
        if constexpr (ALIGN_EPI) { if (wr == 0) PG8_BAR; }
        if constexpr (!Epi::AFTER_DRAIN) { E(acc, cur, wr, wc, fr, fq); S.done(cur); }
        if (!has_next) break;
#pragma unroll
        for (int a = 0; a < 2; ++a)
#pragma unroll
            for (int b = 0; b < 2; ++b)
#pragma unroll
                for (int m = 0; m < 4; ++m)
#pragma unroll
                    for (int n = 0; n < 2; ++n) acc[a][b][m][n] = (f32x4){0.f, 0.f, 0.f, 0.f};
        cur = nxt; cA = nA; cB = nB; ++ui;
        if constexpr (ALIGN_EPI) { if (wr == 1) PG8_BAR; }
    }
    PG8_WAIT_V(0);
    if constexpr (!ALIGN_EPI) { if (wr == 0) PG8_BAR; }
    PG8_BAR;
    if constexpr (Epi::AFTER_DRAIN) { E.fused(acc, cur, wr, wc, fr, fq, lds, wid, lane); S.done(cur); }
#undef PG8_SA
#undef PG8_SB
#undef PG8_STAGE
#undef PG8_LDA
#undef PG8_LDB
#undef PG8_MMA
#undef PG8_WAIT_V
#undef PG8_WAIT_L
#undef PG8_BAR
#undef PG8_SCHED
}
struct EpiStoreBf16 {
    static constexpr bool PERM = true, AFTER_DRAIN = false;
    bf16_t* O; int ldc;
    __device__ __forceinline__ void operator()(const f32x4 (&acc)[2][2][4][2], const Unit& u, int wr, int wc, int fr, int fq) const {
        const int row0 = u.pm * BM + wr * 64 + fr, col0 = u.pn * BM + wc * 32 + 8 * fq;
#pragma unroll
        for (int ai = 0; ai < 2; ++ai)
#pragma unroll
            for (int m = 0; m < 4; ++m) { bf16_t* rowp = O + (size_t)(row0 + ai * HALF + m * 16) * ldc + col0;
#pragma unroll
                for (int bj = 0; bj < 2; ++bj) { const f32x4 v0 = acc[ai][bj][m][0], v1 = acc[ai][bj][m][1];
                    u32x4 w; w.x = cvt_pk_bf16(v0[0], v0[1]); w.y = cvt_pk_bf16(v0[2], v0[3]); w.z = cvt_pk_bf16(v1[0], v1[1]); w.w = cvt_pk_bf16(v1[2], v1[3]);
                    *(u32x4*)(rowp + bj * HALF) = w; } }
    }
};
struct EpiResid {
    static constexpr bool PERM = false, AFTER_DRAIN = false;
    float* X; const float* mod; int goff; float* part; int kslice;
    __device__ __forceinline__ void operator()(const f32x4 (&acc)[2][2][4][2], const Unit& u, int wr, int wc, int fr, int fq) const {
        const int row0 = u.pm * BM + wr * 64 + fr, col0 = u.pn * BM + wc * 32 + 4 * fq;
        const int mv = u.pm < 32 ? (u.pm >> 3) : 4;
        const float* gp = mod + (size_t)mv * 12288 + goff + col0;
        f32x4 gv[2][2];
#pragma unroll
        for (int bj = 0; bj < 2; ++bj)
#pragma unroll
            for (int n = 0; n < 2; ++n) gv[bj][n] = *(const f32x4*)(gp + bj * HALF + n * 16);
        if (u.nk != 0) { float* pb = part + ((size_t)(u.k0 / kslice) * 1024 + (row0 - 8192)) * 2048 + col0;
#pragma unroll
            for (int ai = 0; ai < 2; ++ai)
#pragma unroll
                for (int m = 0; m < 4; ++m) { float* rowp = pb + (size_t)(ai * HALF + m * 16) * 2048;
#pragma unroll
                    for (int bj = 0; bj < 2; ++bj)
#pragma unroll
                        for (int n = 0; n < 2; ++n) *(f32x4*)(rowp + bj * HALF + n * 16) = gv[bj][n] * acc[ai][bj][m][n]; }
            return; }
#pragma unroll
        for (int ai = 0; ai < 2; ++ai)
#pragma unroll
            for (int m = 0; m < 4; ++m) { float* rowp = X + (size_t)(row0 + ai * HALF + m * 16) * 2048 + col0;
#pragma unroll
                for (int bj = 0; bj < 2; ++bj)
#pragma unroll
                    for (int n = 0; n < 2; ++n) { f32x4* p = (f32x4*)(rowp + bj * HALF + n * 16); *p = *p + gv[bj][n] * acc[ai][bj][m][n]; } }
    }
};
struct ResidOrder {
    StaticOrder so; int G, c, kslice;
    __device__ void init(int K, int G_, int c_) { so.init(8192, 2048, G_, c_); G = G_; c = c_; kslice = K / 4; }
    __device__ bool next(int i, Unit& u) const {
        const int L = i * G + c;
        if (L < so.nwg) return so.next(i, u);
        const int j = L - so.nwg; if (j >= 128) return false;
        const int t = j >> 2; u.pm = 32 + (t >> 3); u.pn = t & 7; u.k0 = (j & 3) * kslice; u.nk = kslice / BK; return true;
    }
    __device__ __forceinline__ void a_ready(const Unit&) const {}
    __device__ __forceinline__ void done(const Unit&) const {}
};
__device__ __forceinline__ float silu_f(float x) { return x * __builtin_amdgcn_rcpf(1.f + __builtin_amdgcn_exp2f(-1.4426950408889634f * x)); }
struct EpiSwiglu {
    static constexpr bool PERM = true, AFTER_DRAIN = false;
    bf16_t* H; int ldh; int ntn;
    __device__ __forceinline__ void operator()(const f32x4 (&acc)[2][2][4][2], const Unit& u, int wr, int wc, int fr, int fq) const {
        const int row0 = u.pm * BM + wr * 64 + fr, hcol0 = (u.pn % ntn) * HALF + wc * 32 + 8 * fq;
#pragma unroll
        for (int ai = 0; ai < 2; ++ai)
#pragma unroll
            for (int m = 0; m < 4; ++m) { bf16_t* rowp = H + (size_t)(row0 + ai * HALF + m * 16) * ldh + hcol0;
                const f32x4 a0 = acc[ai][0][m][0], a1 = acc[ai][0][m][1], b0 = acc[ai][1][m][0], b1 = acc[ai][1][m][1];
                float h[8];
#pragma unroll
                for (int j = 0; j < 4; ++j) { if (FP8_EMU && ntn == 56) { const float q = 1.f / 64.f; h[j] = rne_e4m3(silu_f(a0[j] * q) * (b0[j] * q)); h[4 + j] = rne_e4m3(silu_f(a1[j] * q) * (b1[j] * q)); } else { h[j] = silu_f(a0[j]) * b0[j]; h[4 + j] = silu_f(a1[j]) * b1[j]; } }
                u32x4 w; w.x = cvt_pk_bf16(h[0], h[1]); w.y = cvt_pk_bf16(h[2], h[3]); w.z = cvt_pk_bf16(h[4], h[5]); w.w = cvt_pk_bf16(h[6], h[7]);
                *(u32x4*)rowp = w; }
    }
};
struct EpiSwiglu8 {
    static constexpr bool PERM = true, AFTER_DRAIN = false;
    unsigned char* H; int ldh; int ntn;
    __device__ __forceinline__ void operator()(const f32x4 (&acc)[2][2][4][2], const Unit& u, int wr, int wc, int fr, int fq) const {
        const int row0 = u.pm * BM + wr * 64 + fr, hcol0 = (u.pn % ntn) * HALF + wc * 32 + 8 * fq;
#pragma unroll
        for (int ai = 0; ai < 2; ++ai)
#pragma unroll
            for (int m = 0; m < 4; ++m) { unsigned char* rowp = H + (size_t)(row0 + ai * HALF + m * 16) * ldh + hcol0;
                const f32x4 a0 = acc[ai][0][m][0], a1 = acc[ai][0][m][1], b0 = acc[ai][1][m][0], b1 = acc[ai][1][m][1];
                float h[8];
#pragma unroll
                for (int j = 0; j < 4; ++j) { h[j] = fminf(fmaxf(silu_f(a0[j]) * b0[j], -448.f), 448.f); h[4 + j] = fminf(fmaxf(silu_f(a1[j]) * b1[j], -448.f), 448.f); }
                int p0 = __builtin_amdgcn_cvt_pk_fp8_f32(h[0], h[1], 0, false); p0 = __builtin_amdgcn_cvt_pk_fp8_f32(h[2], h[3], p0, true);
                int p1 = __builtin_amdgcn_cvt_pk_fp8_f32(h[4], h[5], 0, false); p1 = __builtin_amdgcn_cvt_pk_fp8_f32(h[6], h[7], p1, true);
                u32x2 w; w.x = (unsigned)p0; w.y = (unsigned)p1; *(u32x2*)rowp = w; }
    }
};
struct EpiStoreF32 {
    static constexpr bool PERM = false, AFTER_DRAIN = false;
    float* C;
    __device__ __forceinline__ void operator()(const f32x4 (&acc)[2][2][4][2], const Unit& u, int wr, int wc, int fr, int fq) const {
        const int row0 = u.pm * BM + wr * 64 + fr, col0 = (u.pn & 7) * BM + wc * 32 + 4 * fq;
#pragma unroll
        for (int ai = 0; ai < 2; ++ai)
#pragma unroll
            for (int m = 0; m < 4; ++m) { float* rowp = C + (size_t)(row0 + ai * HALF + m * 16) * 2048 + col0;
#pragma unroll
                for (int bj = 0; bj < 2; ++bj)
#pragma unroll
                    for (int n = 0; n < 2; ++n) *(f32x4*)(rowp + bj * HALF + n * 16) = FP8_EMU ? acc[ai][bj][m][n] * (1.f / 64.f) : acc[ai][bj][m][n]; }
    }
};
struct InProjL1Order {
    StaticOrder so; int G, c;
    __device__ void init(int G_, int c_) { so.init(8192, 4608, G_, c_); G = G_; c = c_; }
    __device__ bool next(int i, Unit& u) const {
        const int L = i * G + c;
        if (L < so.nwg) return so.next(i, u);
        const int L2 = L - so.nwg; if (L2 >= 24) return false;
        u.pm = 32 + (L2 & 3); u.pn = L2 >> 2; u.k0 = 0; u.nk = 0; return true;
    }
    __device__ __forceinline__ void a_ready(const Unit&) const {}
    __device__ __forceinline__ void done(const Unit&) const {}
};
struct MoeOrder {
    StaticOrder so; const int* tile_e; int NT;
    __device__ void init(int ntiles, int NT_, const int* te, int G_, int c_) { so.nM = ntiles; so.nN = NT_; so.nwg = ntiles * NT_; so.G = G_; so.c = c_; tile_e = te; NT = NT_; }
    __device__ bool next(int i, Unit& u) const { if (!so.next(i, u)) return false; u.pn += tile_e[u.pm] * NT; return true; }
    __device__ __forceinline__ void a_ready(const Unit&) const {}
    __device__ __forceinline__ void done(const Unit&) const {}
};
}
namespace mk {
typedef const float* KP;
typedef __attribute__((address_space(4))) KP const* CIN;
struct Ctx {
    LAS unsigned char* lds;
    CIN in; float* out; unsigned char* ws;
    int tid, lane, wave, G, bid;
};
#define WSP(T, off) ((T*)(C.ws + (off)))
__device__ __forceinline__ const float* inp_(CIN p, int k) { asm volatile("" : "+s"(p)); return p[k]; }
#define INP(k) inp_(C.in, (k))

__device__ __forceinline__ void tr_item(const float* W, int ldw, int k0, int ncol0, bf16* WT, int ldt, int drow0, LAS float* scr, int lane, bool f8 = false) {
    f32x4 v[16];
#pragma unroll
    for (int i = 0; i < 16; ++i) { const int idx = lane + 64 * i, kk = idx >> 4, c4 = idx & 15; v[i] = *(const f32x4*)(W + (size_t)(k0 + kk) * ldw + ncol0 + 4 * c4); }
    if (FP8_EMU && f8) {
#pragma unroll
        for (int i = 0; i < 16; ++i) { v[i].x = rne_e4m3(v[i].x * 64.f); v[i].y = rne_e4m3(v[i].y * 64.f); v[i].z = rne_e4m3(v[i].z * 64.f); v[i].w = rne_e4m3(v[i].w * 64.f); } }
#pragma unroll
    for (int i = 0; i < 16; ++i) { const int idx = lane + 64 * i, kk = idx >> 4, c4 = idx & 15; LAS float* p = scr + kk * 65 + 4 * c4; p[0] = v[i].x; p[1] = v[i].y; p[2] = v[i].z; p[3] = v[i].w; }
    LDS_WAIT(); asm volatile("" ::: "memory");
    const int c = lane & 7;
#pragma unroll
    for (int jj = 0; jj < 8; ++jj) { const int n = (lane >> 3) + 8 * jj; const LAS float* s = scr + (8 * c) * 65 + n;
        u32x4 o; o.x = pk2(s[0], s[65]); o.y = pk2(s[2 * 65], s[3 * 65]); o.z = pk2(s[4 * 65], s[5 * 65]); o.w = pk2(s[6 * 65], s[7 * 65]);
        *(u32x4*)(WT + (size_t)(drow0 + n) * ldt + k0 + 8 * c) = o; }
    LDS_WAIT(); asm volatile("" ::: "memory");
}
__device__ __forceinline__ void tr_item8(const float* W, int ldw, int k0, int ncol0, unsigned char* WT, int ldt, int drow0, LAS float* scr, int lane) {
    f32x4 v[16];
#pragma unroll
    for (int i = 0; i < 16; ++i) { const int idx = lane + 64 * i, kk = idx >> 3, c4 = idx & 7; v[i] = *(const f32x4*)(W + (size_t)(k0 + kk) * ldw + ncol0 + 4 * c4); }
#pragma unroll
    for (int i = 0; i < 16; ++i) { const int idx = lane + 64 * i, kk = idx >> 3, c4 = idx & 7; LAS float* p = scr + kk * 33 + 4 * c4; p[0] = v[i].x * 64.f; p[1] = v[i].y * 64.f; p[2] = v[i].z * 64.f; p[3] = v[i].w * 64.f; }
    LDS_WAIT(); asm volatile("" ::: "memory");
    const int c = lane & 7;
#pragma unroll
    for (int jj = 0; jj < 4; ++jj) { const int n = (lane >> 3) + 8 * jj; const LAS float* s = scr + (16 * c) * 33 + n;
        u32x4 o; o.x = pk4_fp8(s[0], s[33], s[2 * 33], s[3 * 33]); o.y = pk4_fp8(s[4 * 33], s[5 * 33], s[6 * 33], s[7 * 33]);
        o.z = pk4_fp8(s[8 * 33], s[9 * 33], s[10 * 33], s[11 * 33]); o.w = pk4_fp8(s[12 * 33], s[13 * 33], s[14 * 33], s[15 * 33]);
        *(u32x4*)(WT + (size_t)(drow0 + n) * ldt + k0 + 16 * c) = o; }
    LDS_WAIT(); asm volatile("" ::: "memory");
}
constexpr int IT_WIN = 32 * 72, IT_WOUT = 32 * 32, IT_W1 = 32 * 88, IT_W2 = 88 * 32, IT_MW1 = 32 * 112, IT_MW2 = 112 * 32, IT_PW = 2 * 2;
constexpr int IT_PRO = IT_WIN + 8 * IT_PW;
constexpr int BG_WOUT0 = 0, BG_W13 = BG_WOUT0 + IT_WOUT, BG_W2 = BG_W13 + 2 * IT_W1, BG_WIN1 = BG_W2 + IT_W2, BG_WOUT1 = BG_WIN1 + IT_WIN, BG_MOE = BG_WOUT1 + IT_WOUT, NBG = BG_MOE + 16 * IT_MW1 + 8 * IT_MW2;
constexpr int IT_TOTAL = IT_PRO + NBG;
__device__ __forceinline__ void tr_dispatch(Ctx& C, int it, LAS float* scr) {
    const float* W; int ldw, k0, nc0, ldt, dr0; bf16* WT; int r = it;
    if (r < IT_WIN) { const int kb = r / 72, nb = r % 72; W = INP(7); ldw = INW; k0 = 64 * kb; nc0 = nb < 24 ? 64 * nb : 1552 + 64 * (nb - 24); WT = WSP(bf16, WS_WIN); ldt = D; dr0 = nb < 24 ? 64 * nb : 1536 + 64 * (nb - 24); }
    else if (r < IT_PRO) { r -= IT_WIN; const int m = r / IT_PW, q = r % IT_PW; W = INP(16) + (size_t)m * 128 * 128; ldw = 128; k0 = 64 * (q >> 1); nc0 = 64 * (q & 1); WT = WSP(bf16, WS_PWT) + (size_t)m * 128 * 128; ldt = 128; dr0 = 64 * (q & 1); }
    else { r -= IT_PRO;
        if (r < BG_W13) { const int kb = r / 32, nb = r % 32; W = INP(22); ldw = D; k0 = 64 * kb; nc0 = 64 * nb; WT = WSP(bf16, WS_WOUT); ldt = D; dr0 = 64 * nb; }
        else if (r < BG_W2) { r -= BG_W13; const int s = r / IT_W1; r -= s * IT_W1; const int kb = r / 88, nb = r % 88; W = INP(24 + s); ldw = DFF; k0 = 64 * kb; nc0 = 64 * nb; WT = WSP(bf16, WS_W13); ldt = D; dr0 = 256 * (nb >> 1) + 128 * s + 64 * (nb & 1); }
        else if (r < BG_WIN1) { r -= BG_W2; const int kb = r / 32, nb = r % 32; W = INP(26); ldw = D; k0 = 64 * kb; nc0 = 64 * nb; WT = WSP(bf16, WS_W2); ldt = DFF; dr0 = 64 * nb; }
        else if (r < BG_WOUT1) { r -= BG_WIN1; const int kb = r / 72, nb = r % 72; W = INP(7) + (size_t)D * INW; ldw = INW; k0 = 64 * kb; nc0 = nb < 24 ? 64 * nb : 1552 + 64 * (nb - 24); WT = WSP(bf16, WS_WIN) + (size_t)NIN * D; ldt = D; dr0 = nb < 24 ? 64 * nb : 1536 + 64 * (nb - 24); }
        else if (r < BG_MOE) { r -= BG_WOUT1; const int kb = r / 32, nb = r % 32; W = INP(22) + (size_t)D * D; ldw = D; k0 = 64 * kb; nc0 = 64 * nb; WT = WSP(bf16, WS_WOUT) + (size_t)D * D; ldt = D; dr0 = 64 * nb; }
        else { r -= BG_MOE;
            if (MOE_FP8) {
                if (r < 16 * IT_MW1) { const int j = r / IT_MW1; r -= j * IT_MW1; const int s = j >> 3, e = j & 7, kb = r / 224, nb = r % 224, h0 = 32 * nb;
                    tr_item8(INP(29 + s) + (size_t)e * D * DFE, DFE, 128 * kb, h0, WSP(unsigned char, WS_MW13) + (size_t)e * 2 * DFE * D, D, 256 * (h0 >> 7) + 128 * s + (h0 & 127), scr, C.lane); }
                else { r -= 16 * IT_MW1; const int e = r / IT_MW2; r -= e * IT_MW2; const int kb = r / 64, nb = r % 64;
                    tr_item8(INP(31) + (size_t)e * DFE * D, D, 128 * kb, 32 * nb, WSP(unsigned char, WS_MW2) + (size_t)e * D * DFE, DFE, 32 * nb, scr, C.lane); }
                return; }
            if (r < 16 * IT_MW1) { const int j = r / IT_MW1; r -= j * IT_MW1; const int s = j >> 3, e = j & 7, kb = r / 112, nb = r % 112;
                W = INP(29 + s) + (size_t)e * D * DFE; ldw = DFE; k0 = 64 * kb; nc0 = 64 * nb; WT = WSP(bf16, WS_MW13) + (size_t)e * 2 * DFE * D; ldt = D; dr0 = 256 * (nb >> 1) + 128 * s + 64 * (nb & 1); }
            else { r -= 16 * IT_MW1; const int e = r / IT_MW2; r -= e * IT_MW2; const int kb = r / 32, nb = r % 32;
                W = INP(31) + (size_t)e * DFE * D; ldw = D; k0 = 64 * kb; nc0 = 64 * nb; WT = WSP(bf16, WS_MW2) + (size_t)e * D * DFE; ldt = DFE; dr0 = 64 * nb; } } }
    tr_item(W, ldw, k0, nc0, WT, ldt, dr0, scr, C.lane, it >= IT_PRO + BG_MOE);
}
#ifndef BG_BATCH_N
#define BG_BATCH_N 1
#endif
constexpr int BG_BATCH = BG_BATCH_N;
__device__ __forceinline__ void bg_work(Ctx& C, int limit, int poll_phase) {
    unsigned* ctl = WSP(unsigned, WS_CTL);
    volatile LAS unsigned* flag = (volatile LAS unsigned*)(C.lds + LDS_BARW + 8);
    VM_WAIT(); __syncthreads();
    if (C.tid == 0) { flag[0] = 0u; flag[1] = __hip_atomic_load(ctl + CW_BGHEAD, __ATOMIC_RELAXED, __HIP_MEMORY_SCOPE_AGENT) >= (unsigned)NBG ? 1u : 0u;
        if (poll_phase >= 0) __hip_atomic_fetch_add(ctl + CW_DONE + 64 * poll_phase, 1u, __ATOMIC_RELAXED, __HIP_MEMORY_SCOPE_AGENT); }
    __syncthreads();
    if (flag[1] != 0u) return;
    LAS float* scr = (LAS float*)(C.lds + C.wave * 16896);
    for (;;) {
        if (C.tid == 0) { unsigned base = 0xffffffffu;
            const unsigned head = __hip_atomic_load(ctl + CW_BGHEAD, __ATOMIC_RELAXED, __HIP_MEMORY_SCOPE_AGENT);
            bool go = head < (unsigned)limit;
            if (!go && poll_phase >= 0 && head < (unsigned)NBG) go = __hip_atomic_load(ctl + CW_DONE + 64 * poll_phase, __ATOMIC_RELAXED, __HIP_MEMORY_SCOPE_AGENT) < (unsigned)C.G;
            if (go) base = __hip_atomic_fetch_add(ctl + CW_BGHEAD, (unsigned)NWAVE, __ATOMIC_RELAXED, __HIP_MEMORY_SCOPE_AGENT);
            flag[0] = base; }
        __syncthreads();
        const unsigned base = flag[0];
        if (base >= (unsigned)NBG) break;
        if (base + C.wave < (unsigned)NBG) tr_dispatch(C, IT_PRO + (int)base + C.wave, scr);
        __syncthreads();
    }
}
__device__ __forceinline__ void mod_unit(Ctx& C, int unit, LAS float* sv  , LAS float* red  ) {
    const int l = unit / 192, col0 = (unit % 192) * 64, cq = C.tid & 15, ks = C.tid >> 4;
    const float* w = INP(4) + ((size_t)l * D + ks * 64) * 12288 + col0 + 4 * cq;
    f32x4 acc[5];
#pragma unroll
    for (int v = 0; v < 5; ++v) acc[v] = (f32x4){0.f, 0.f, 0.f, 0.f};
#pragma unroll 8
    for (int k = 0; k < 64; ++k) { const f32x4 wv = *(const f32x4*)(w + (size_t)k * 12288);
#pragma unroll
        for (int v = 0; v < 5; ++v) acc[v] += wv * sv[v * 2048 + ks * 64 + k]; }
#pragma unroll
    for (int v = 0; v < 5; ++v) *(LAS f32x4*)(red + (ks * 5 + v) * 64 + 4 * cq) = acc[v];
    WG_BAR();
    if (C.tid < 320) { const int v = C.tid >> 6, c = C.tid & 63; float s = 0.f;
#pragma unroll 8
        for (int k = 0; k < 32; ++k) s += red[(k * 5 + v) * 64 + c];
        WSP(float, WS_MODV)[((size_t)l * 5 + v) * 12288 + col0 + c] = s + INP(5)[l * 12288 + col0 + c]; }
    WG_BAR();
}
__device__ __forceinline__ void p_prologue(Ctx& C) {
    LAS float* sv = (LAS float*)C.lds; LAS float* red = sv + 5 * 2048;
    for (int i = C.tid; i < 5 * 2048; i += NTHR) { const float x = i < 4 * 2048 ? INP(1)[i] : INP(3)[i - 4 * 2048]; sv[i] = x / (1.f + expf(-x)); }
    WG_BAR();
    for (int u = C.bid; u < 384; u += C.G) mod_unit(C, u, sv, red);
    for (int i = C.bid * NTHR + C.tid; i < 2 * 2048 * 4; i += C.G * NTHR) { const int lk = i >> 2, q = i & 3; *(f32x4*)(WSP(float, WS_WABC) + (size_t)lk * 16 + 4 * q) = *(const f32x4*)(INP(7) + (size_t)lk * INW + 1536 + 4 * q); }
    { float* pos = WSP(float, WS_POS);
      for (size_t i = (size_t)C.bid * NTHR + C.tid; i < (size_t)TX * D; i += (size_t)C.G * NTHR) {
          const int t = (int)(i >> 11), d = (int)(i & 2047), r = t >> 6, cc = t & 63, part = d >> 9, fi = d & 511;
          const float freq = expf(-9.210340371976184f * (float)fi / 512.f);
          const float ang = (part < 2 ? (float)r : (float)cc) * freq;
          pos[i] = (part & 1) ? cosf(ang) : sinf(ang); } }
    WG_BAR();
    LAS float* scr = (LAS float*)(C.lds + C.wave * 16896);
    const int gw = C.bid * NWAVE + C.wave, NGW = C.G * NWAVE;
    const int nit = (STATIC_FILL && C.G == 256) ? IT_PRO + BG_MOE : IT_TOTAL;
    for (int it = gw; it < nit; it += NGW) tr_dispatch(C, it, scr);
}
__device__ __forceinline__ void fill_static(Ctx& C, int first, int n, int b0) {
    if (!(STATIC_FILL && C.G == 256) || C.bid < b0 || n <= 0) return;
    VM_WAIT(); __syncthreads();
    LAS float* scr = (LAS float*)(C.lds + C.wave * 16896);
    const int nb = C.G - b0;
    for (int it = first + (C.bid - b0) * NWAVE + C.wave; it < first + n; it += nb * NWAVE) tr_dispatch(C, IT_PRO + BG_MOE + it, scr);
}

template <int MODE>
__device__ __forceinline__ void p_norm(Ctx& C, int l) {
    const float* mod = WSP(float, WS_MODV) + (size_t)l * 5 * 12288;
    float* XS = WSP(float, WS_XS); bf16* AN = WSP(bf16, WS_AN);
    const bool mix = MODE <= 1;
    const float* gain = (mix ? INP(6) : INP(23)) + l * D;
    const int sh_off = mix ? 0 : 6144, sc_off = mix ? 2048 : 8192;
    LAS f32x4* wl = (LAS f32x4*)C.lds;
    if (mix) { const float* wsrc = WSP(float, WS_WABC) + (size_t)l * 2048 * 16;
        for (int idx = C.tid; idx < 2048 * 4; idx += NTHR) { const int k = idx >> 2, q = idx & 3, ln = (k & 255) >> 2, i = k & 3, j = k >> 8;
            wl[((j * 4 + i) * 4 + q) * 64 + ln] = *(const f32x4*)(wsrc + (size_t)k * 16 + 4 * q); }
    } else if (MODE == 3) { const float* wsrc = INP(27);
        for (int idx = C.tid; idx < 2048 * 2; idx += NTHR) { const int k = idx >> 1, q = idx & 1, ln = (k & 255) >> 2, i = k & 3, j = k >> 8;
            wl[((j * 4 + i) * 2 + q) * 64 + ln] = *(const f32x4*)(wsrc + (size_t)k * 8 + 4 * q); } }
    WG_BAR();
    const int nrows = MODE == 3 ? MX : MT;
    const int gw = C.bid * NWAVE + C.wave, NGW = C.G * NWAVE, lane = C.lane;
    for (int row = gw; row < nrows; row += NGW) {
        int base, T, t, mv; rowinfo(row, base, T, t, mv);
        f32x4 x[8]; float ss = 0.f;
        if (MODE == 0) {
            if (row < MX) { const f32x4* xi = (const f32x4*)(INP(0) + (size_t)row * D) + lane; const f32x4* pp = (const f32x4*)(WSP(float, WS_POS) + (size_t)t * D) + lane;
#pragma unroll
                for (int j = 0; j < 8; ++j) x[j] = xi[64 * j] + pp[64 * j]; }
            else { const f32x4* xi = (const f32x4*)(INP(2) + (size_t)(row - MX) * D) + lane;
#pragma unroll
                for (int j = 0; j < 8; ++j) x[j] = xi[64 * j]; }
            f32x4* xo = (f32x4*)(XS + (size_t)row * D) + lane;
#pragma unroll
            for (int j = 0; j < 8; ++j) xo[64 * j] = x[j];
        } else { const f32x4* xi = (const f32x4*)(XS + (size_t)row * D) + lane;
#pragma unroll
            for (int j = 0; j < 8; ++j) x[j] = xi[64 * j];
            if ((MODE == 1 || (MODE == 2 && l == 0)) && row >= MX) {
#pragma unroll
                for (int ks = 0; ks < 4; ++ks) { const f32x4* pp = (const f32x4*)(WSP(float, WS_PART) + ((size_t)ks * MC + (row - MX)) * D) + lane;
#pragma unroll
                    for (int j = 0; j < 8; ++j) x[j] += pp[64 * j]; }
                f32x4* xo = (f32x4*)(XS + (size_t)row * D) + lane;
#pragma unroll
                for (int j = 0; j < 8; ++j) xo[64 * j] = x[j]; } }
#pragma unroll
        for (int j = 0; j < 8; ++j) ss += (x[j].x * x[j].x + x[j].y * x[j].y) + (x[j].z * x[j].z + x[j].w * x[j].w);
        const float rs = rsqrtf(wave_sum(ss) * (1.f / D) + EPS);
        const f32x4* gp = (const f32x4*)gain + lane; const f32x4* shp = (const f32x4*)(mod + (size_t)mv * 12288 + sh_off) + lane; const f32x4* scp = (const f32x4*)(mod + (size_t)mv * 12288 + sc_off) + lane;
        u32x2* ao = (u32x2*)(AN + (size_t)row * D) + lane;
#pragma unroll
        for (int j = 0; j < 8; ++j) { const f32x4 g = gp[64 * j], sh = shp[64 * j], sc = scp[64 * j];
            x[j] = x[j] * rs * g * (sc + 1.f) + sh;
            u32x2 w; w.x = pk2(x[j].x, x[j].y); w.y = pk2(x[j].z, x[j].w); ao[64 * j] = w; }
        if (mix) {
            f32x4 acc[4];
#pragma unroll
            for (int q = 0; q < 4; ++q) acc[q] = (f32x4){0.f, 0.f, 0.f, 0.f};
#pragma unroll
            for (int j = 0; j < 8; ++j)
#pragma unroll
                for (int i = 0; i < 4; ++i) { const float a = x[j][i];
#pragma unroll
                    for (int q = 0; q < 4; ++q) acc[q] += wl[((j * 4 + i) * 4 + q) * 64 + lane] * a; asm volatile("" ::: "memory"); }
#pragma unroll
            for (int q = 0; q < 4; ++q)
#pragma unroll
                for (int e = 0; e < 4; ++e) acc[q][e] = wave_sum(acc[q][e]);
            if (lane < 4) { f32x4 o = lane == 0 ? acc[0] : lane == 1 ? acc[1] : lane == 2 ? acc[2] : acc[3]; *(f32x4*)(WSP(float, WS_ABF) + (size_t)row * 16 + 4 * lane) = o; }
        }
        if (MODE == 3) {
            f32x4 acc[2] = {(f32x4){0.f, 0.f, 0.f, 0.f}, (f32x4){0.f, 0.f, 0.f, 0.f}};
#pragma unroll
            for (int j = 0; j < 8; ++j)
#pragma unroll
                for (int i = 0; i < 4; ++i) { const float a = x[j][i];
#pragma unroll
                    for (int q = 0; q < 2; ++q) acc[q] += wl[((j * 4 + i) * 2 + q) * 64 + lane] * a; asm volatile("" ::: "memory"); }
            float lg[8];
#pragma unroll
            for (int e = 0; e < 8; ++e) lg[e] = wave_sum(acc[e >> 2][e & 3]) + INP(28)[e];
            if (lane == 0) { int i1 = 0;
#pragma unroll
                for (int e = 1; e < 8; ++e) if (lg[e] > lg[i1]) i1 = e;
                int i2 = i1 == 0 ? 1 : 0;
#pragma unroll
                for (int e = 0; e < 8; ++e) if (e != i1 && lg[e] > lg[i2]) i2 = e;
                float v1 = lg[0], v2 = lg[0];
#pragma unroll
                for (int e = 0; e < 8; ++e) { v1 = e == i1 ? lg[e] : v1; v2 = e == i2 ? lg[e] : v2; }
                const float g2 = 1.f / (1.f + expf(v1 - v2));
                int* R = WSP(int, WS_ROUTE); float* Rf = WSP(float, WS_ROUTE); unsigned* ctl = WSP(unsigned, WS_CTL);
                R[R_TE + 2 * row] = i1; R[R_TE + 2 * row + 1] = i2; Rf[R_TG + 2 * row] = 1.f - g2; Rf[R_TG + 2 * row + 1] = g2;
                R[R_RANK + 2 * row] = (int)atomicAdd(ctl + CW_CNT + 64 * i1, 1u); R[R_RANK + 2 * row + 1] = (int)atomicAdd(ctl + CW_CNT + 64 * i2, 1u); }
        }
    }
}
}
namespace mk {
__device__ __forceinline__ f32x4 mfma16(bf16x8 a, bf16x8 b, f32x4 c) { return __builtin_amdgcn_mfma_f32_16x16x32_bf16(a, b, c, 0, 0, 0); }

constexpr int DP_PITCH = 132;
constexpr int DP_Q = 0, DP_K = 33792, DP_V = 67584;
constexpr int DP_L = 101376;
constexpr int DP_QK = DP_L + 32768;
constexpr int DP_SM = DP_QK + 16384;
static_assert(DP_SM + 2048 <= LDS_BARW, "DN prep LDS map");
__device__ __forceinline__ size_t dn_rec(int dir, int cid, int h) { return ((size_t)dir * NCH + cid) * 4 + h; }

__device__ __forceinline__ void dnprep_unit(Ctx& C, int l, int cidx, int h) {
    LAS float* Qs = (LAS float*)(C.lds + DP_Q); LAS float* Ks = (LAS float*)(C.lds + DP_K); LAS float* Vs = (LAS float*)(C.lds + DP_V);
    LAS float* Ls = (LAS float*)(C.lds + DP_L); LAS bf16* QKi = (LAS bf16*)(C.lds + DP_QK); LAS float* sm = (LAS float*)(C.lds + DP_SM);
    LAS float* Gs = sm; LAS float* Bs = sm + 128; LAS float* EGs = sm + 256; LAS float* EGRs = sm + 384;
    const bf16* P = WSP(bf16, WS_P);
    const int tid = C.tid, lane = C.lane, wave = C.wave;
    const int r0 = cidx * 64; int sbase, T, t0, mv; rowinfo(r0, sbase, T, t0, mv);
    const int nloc = t0 >> 6, nch = T >> 6, cbase = sbase >> 6;
#ifndef DP_SKIP
#define DP_SKIP 0
#endif
    if (!(DP_SKIP & 1)) { if (tid < 384) {
        const int o = tid % 48, tg = tid / 48, wh = o >> 4, oc = o & 15, ch = wh * 512 + h * 128 + 8 * oc;
        float w[5][8];
        const float* cw = INP(8) + (size_t)l * 5 * 1536 + ch;
#pragma unroll
        for (int k = 0; k < 5; ++k) { const f32x4 a = *(const f32x4*)(cw + k * 1536), b = *(const f32x4*)(cw + k * 1536 + 4);
            w[k][0] = a.x; w[k][1] = a.y; w[k][2] = a.z; w[k][3] = a.w; w[k][4] = b.x; w[k][5] = b.y; w[k][6] = b.z; w[k][7] = b.w; }
#pragma unroll 1
        for (int hf = 0; hf < 2; ++hf) {
        float xin[8][8];
#pragma unroll
        for (int i = 0; i < 8; ++i) { const int t = t0 + 8 * tg + 4 * hf + i - 2;
            if (t >= 0 && t < T) { const u32x4 raw = *(const u32x4*)(P + (size_t)(sbase + t) * NIN + ch); unpack8(raw, xin[i]); }
            else {
#pragma unroll
                for (int c = 0; c < 8; ++c) xin[i][c] = 0.f; } }
#pragma unroll
        for (int i = 0; i < 4; ++i) { float ov[8]; float ss = 0.f;
#pragma unroll
            for (int c = 0; c < 8; ++c) { float s = 0.f;
#pragma unroll
                for (int k = 0; k < 5; ++k) s += w[k][c] * xin[i + k][c];
                ov[c] = silu(s); ss += ov[c] * ov[c]; }
            ss = sum16(ss);
            const float sc = wh == 0 ? rsqrtf(ss + EPS) * 0.08838834764831845f : wh == 1 ? rsqrtf(ss + EPS) : 1.f;
            LAS float* dst = (wh == 0 ? Qs : wh == 1 ? Ks : Vs) + (8 * tg + 4 * hf + i) * DP_PITCH + 8 * oc;
            *(LAS f32x4*)dst = (f32x4){ov[0] * sc, ov[1] * sc, ov[2] * sc, ov[3] * sc}; *(LAS f32x4*)(dst + 4) = (f32x4){ov[4] * sc, ov[5] * sc, ov[6] * sc, ov[7] * sc}; }
        }
    } else {
        const int d = wave - 6, s = lane, i = d ? 63 - s : s; const float* ab = WSP(float, WS_ABF) + (size_t)(r0 + i) * 16;
        const float la = -expf(INP(9)[l * 8 + d * 4 + h]) * softplus(ab[d * 4 + h] + INP(10)[l * 8 + d * 4 + h]);
        const float be = sigm(ab[8 + d * 4 + h]);
        float g = la;
#pragma unroll
        for (int o = 1; o < 64; o <<= 1) { const float up = __shfl_up(g, o); if (lane >= o) g += up; }
        const float gl = __shfl(g, 63);
        Gs[d * 64 + s] = g; Bs[d * 64 + s] = be; EGs[d * 64 + s] = expf(g); EGRs[d * 64 + s] = expf(gl - g);
        if (lane == 63) { const int cid = d ? cbase + (nch - 1 - nloc) : cidx; const float e = expf(gl); *(f32x4*)(WSP(float, WS_EGL) + dn_rec(d, cid, h) * 4) = (f32x4){e, e, e, e}; }
    } }
    WG_BAR();
    if (!(DP_SKIP & 2)) {
        const int wh = wave >> 2, mb = wave & 3, c = lane & 15, g4 = lane >> 4;
        const LAS float* Am = wh ? Qs : Ks;
        f32x4 acc[4];
#pragma unroll
        for (int nb = 0; nb < 4; ++nb) acc[nb] = (f32x4){0.f, 0.f, 0.f, 0.f};
#pragma unroll
        for (int ks = 0; ks < 4; ++ks) {
            float av[8]; { const LAS float* p = Am + (16 * mb + c) * DP_PITCH + 32 * ks + 8 * g4; const f32x4 a = *(const LAS f32x4*)p, b = *(const LAS f32x4*)(p + 4);
                av[0] = a.x; av[1] = a.y; av[2] = a.z; av[3] = a.w; av[4] = b.x; av[5] = b.y; av[6] = b.z; av[7] = b.w; }
            const bf16x8 af = pack8(av);
#pragma unroll
            for (int nb = 0; nb < 4; ++nb) { float bv[8]; const LAS float* p = Ks + (16 * nb + c) * DP_PITCH + 32 * ks + 8 * g4; const f32x4 a = *(const LAS f32x4*)p, b = *(const LAS f32x4*)(p + 4);
                bv[0] = a.x; bv[1] = a.y; bv[2] = a.z; bv[3] = a.w; bv[4] = b.x; bv[5] = b.y; bv[6] = b.z; bv[7] = b.w;
                acc[nb] = mfma16(af, pack8(bv), acc[nb]); }
        }
        if (wh == 0) {
#pragma unroll
            for (int d = 0; d < 2; ++d) { const LAS float* Gd = Gs + d * 64; const LAS float* Bd = Bs + d * 64; LAS float* Ld = Ls + d * 4096;
#pragma unroll
                for (int r = 0; r < 4; ++r) { const int i = 16 * mb + 4 * g4 + r, s = d ? 63 - i : i; const float gs = Gd[s], bs = Bd[s];
#pragma unroll
                    for (int nb = 0; nb < 4; ++nb) { const int ip = 16 * nb + c, sp = d ? 63 - ip : ip;
                        Ld[s * 64 + sp] = s > sp ? bs * acc[nb][r] * __expf(gs - Gd[sp]) : 0.f; } } }
        } else {
#pragma unroll
            for (int d = 0; d < 2; ++d) { const LAS float* Gd = Gs + d * 64; LAS bf16* Qd = QKi + d * 4096;
#pragma unroll
                for (int r = 0; r < 4; ++r) { const int i = 16 * mb + 4 * g4 + r, s = d ? 63 - i : i; const float gs = Gd[s];
#pragma unroll
                    for (int nb = 0; nb < 4; ++nb) { const int ip = 16 * nb + c, sp = d ? 63 - ip : ip;
                        const float qk = s >= sp ? acc[nb][r] * __expf(gs - Gd[sp]) : 0.f;
                        const int lp = ((sp & 15) >> 2) * 16 + (s & 15), jp = 4 * ((sp >> 4) & 1) + (sp & 3);
                        Qd[(((s >> 4) * 2 + (sp >> 5)) * 64 + lp) * 8 + jp] = (bf16)f2bf(qk); } } }
        }
    }
    WG_BAR();
    if (!(DP_SKIP & 4)) {
        const int d = tid >> 8, col = tid & 255;
        float X[64];
        const LAS float* src = col < 128 ? Vs + col : Ks + (col - 128);
        const LAS float* Bd = Bs + d * 64; const LAS float* Ed = EGs + d * 64;
        if (d == 0) {
#pragma unroll
            for (int s = 0; s < 64; ++s) { const float sc = col < 128 ? Bd[s] : Bd[s] * Ed[s]; X[s] = sc * src[s * DP_PITCH]; if ((s & 7) == 7) asm volatile("" ::: "memory"); }
        } else {
#pragma unroll
            for (int s = 0; s < 64; ++s) { const float sc = col < 128 ? Bd[s] : Bd[s] * Ed[s]; X[s] = sc * src[(63 - s) * DP_PITCH]; if ((s & 7) == 7) asm volatile("" ::: "memory"); }
        }
        WG_BAR();
        const LAS float* Ld = Ls + d * 4096;
#pragma unroll
        for (int s = 1; s < 64; ++s) { float a0 = X[s], a1 = 0.f, a2 = 0.f, a3 = 0.f;
#pragma unroll
            for (int j4 = 0; j4 < (s + 3) / 4; ++j4) { const f32x4 lv = *(const LAS f32x4*)(Ld + s * 64 + 4 * j4);
                if (4 * j4 + 0 < s) a0 -= lv.x * X[4 * j4 + 0];
                if (4 * j4 + 1 < s) a1 -= lv.y * X[4 * j4 + 1];
                if (4 * j4 + 2 < s) a2 -= lv.z * X[4 * j4 + 2];
                if (4 * j4 + 3 < s) a3 -= lv.w * X[4 * j4 + 3]; }
            X[s] = (a0 + a1) + (a2 + a3); asm volatile("" ::: "memory"); }
        const int cid = d ? cbase + (nch - 1 - nloc) : cidx; const size_t rec = dn_rec(d, cid, h);
        if (col < 128) { f32x4* up = (f32x4*)(WSP(float, WS_DNU) + (rec * 128 + col) * 64);
#pragma unroll
            for (int q = 0; q < 16; ++q) up[q] = (f32x4){X[4 * q], X[4 * q + 1], X[4 * q + 2], X[4 * q + 3]}; }
        else { const int dk = col - 128, ks = dk >> 5, q = dk & 31, j = 4 * (q >> 4) + (q & 3), g4 = (q & 15) >> 2;
            LAS bf16* Wi = (LAS bf16*)(C.lds + DP_V) + d * 8192;
#pragma unroll
            for (int s = 0; s < 64; ++s) Wi[(((s >> 4) * 4 + ks) * 64 + g4 * 16 + (s & 15)) * 8 + j] = (bf16)f2bf(X[s]); }
    }
    WG_BAR();
    if (!(DP_SKIP & 8)) {
        for (int ci = tid; ci < 2048; ci += NTHR) { const int d = ci >> 10, cc = ci & 1023; const int cid = d ? cbase + (nch - 1 - nloc) : cidx;
            ((u32x4*)(WSP(unsigned char, WS_DNW) + dn_rec(d, cid, h) * 16384))[cc] = ((const LAS u32x4*)(C.lds + DP_V + d * 16384))[cc]; }
        for (int ci = tid; ci < 1024; ci += NTHR) { const int d = ci >> 9, cc = ci & 511; const int cid = d ? cbase + (nch - 1 - nloc) : cidx;
            ((u32x4*)(WSP(unsigned char, WS_DNQK) + dn_rec(d, cid, h) * 8192))[cc] = ((const LAS u32x4*)(C.lds + DP_QK + d * 8192))[cc]; }
        for (int ci = tid; ci < 2048; ci += NTHR) { const int d = ci >> 10, cc = ci & 1023, mb = cc >> 8, ks = (cc >> 6) & 3, lp = cc & 63, c = lp & 15, g4 = lp >> 4;
            const int s = 16 * mb + c, i = d ? 63 - s : s; const float e = EGs[d * 64 + s];
            const LAS float* p = Qs + i * DP_PITCH + 32 * ks + 4 * g4; const f32x4 a = *(const LAS f32x4*)p, b = *(const LAS f32x4*)(p + 16);
            float v[8] = {a.x * e, a.y * e, a.z * e, a.w * e, b.x * e, b.y * e, b.z * e, b.w * e};
            const int cid = d ? cbase + (nch - 1 - nloc) : cidx;
            ((bf16x8*)(WSP(unsigned char, WS_DNQG) + dn_rec(d, cid, h) * 16384))[cc] = pack8(v); }
        for (int ci = tid; ci < 2048; ci += NTHR) { const int d = ci >> 10, cc = ci & 1023, tt = cc >> 7, ks2 = (cc >> 6) & 1, lp = cc & 63, c = lp & 15, g4 = lp >> 4;
            float v[8];
#pragma unroll
            for (int j = 0; j < 8; ++j) { const int s = 32 * ks2 + 16 * (j >> 2) + 4 * g4 + (j & 3), i = d ? 63 - s : s; v[j] = Ks[i * DP_PITCH + 16 * tt + c] * EGRs[d * 64 + s]; }
            const int cid = d ? cbase + (nch - 1 - nloc) : cidx;
            ((bf16x8*)(WSP(unsigned char, WS_DNKDT) + dn_rec(d, cid, h) * 16384))[cc] = pack8(v); }
    }
    WG_BAR();
}

constexpr int SG_VT = 0, SG_VPITCH = 136;
__device__ __forceinline__ void sg_unit(Ctx& C, int l, int cb, int h) {
    LAS bf16* vT = (LAS bf16*)(C.lds + SG_VT);
    const bf16* P = WSP(bf16, WS_P); bf16* Y = WSP(bf16, WS_Y);
    const int lane = C.lane, wave = C.wave, r0 = cb * 128;
    const float* lg = INP(12) + l * 512; const float* lb = INP(13) + l * 512;
    for (int q = 0; q < 16; ++q) { const int j = 16 * wave + q; float v[8];
        unpack8(*(const u32x4*)(P + (size_t)(r0 + j) * NIN + PSGV + 8 * lane), v);
        float s = 0.f;
#pragma unroll
        for (int c = 0; c < 8; ++c) { v[c] = gelu_tanh(v[c]); s += v[c]; }
        const float mu = wave_sum(s) * (1.f / 512.f); float s2 = 0.f;
#pragma unroll
        for (int c = 0; c < 8; ++c) { v[c] -= mu; s2 += v[c] * v[c]; }
        const float rs = rsqrtf(wave_sum(s2) * (1.f / 512.f) + EPS);
        if ((lane >> 4) == h) { const int d0 = 8 * (lane & 15);
#pragma unroll
            for (int c = 0; c < 8; ++c) vT[(d0 + c) * SG_VPITCH + j] = (bf16)f2bf(v[c] * rs * lg[128 * h + d0 + c] + lb[128 * h + d0 + c]); } }
    WG_BAR();
    const int c = lane & 15, g4 = lane >> 4;
    const float* W = INP(14) + ((size_t)(l * 4 + h) * 128 + 16 * wave + c) * 128;
    f32x4 acc[8];
#pragma unroll
    for (int nb = 0; nb < 8; ++nb) acc[nb] = (f32x4){0.f, 0.f, 0.f, 0.f};
#pragma unroll
    for (int ks = 0; ks < 4; ++ks) { const f32x4 a = *(const f32x4*)(W + 32 * ks + 8 * g4), b = *(const f32x4*)(W + 32 * ks + 8 * g4 + 4);
        float av[8] = {a.x, a.y, a.z, a.w, b.x, b.y, b.z, b.w}; const bf16x8 af = pack8(av);
#pragma unroll
        for (int nb = 0; nb < 8; ++nb) { const bf16x8 bfr = *(const LAS bf16x8*)(vT + (16 * nb + c) * SG_VPITCH + 32 * ks + 8 * g4); acc[nb] = mfma16(af, bfr, acc[nb]); } }
    const float* bs = INP(15) + (l * 4 + h) * 128;
#pragma unroll
    for (int r = 0; r < 4; ++r) { const int i = 16 * wave + 4 * g4 + r; const float bi = bs[i]; const size_t row = (size_t)(r0 + i);
#pragma unroll
        for (int nb = 0; nb < 8; ++nb) { const int d = 16 * nb + c; const float u = gelu_tanh(bf2f(P[row * NIN + PSGU + 128 * h + d]));
            Y[row * D + 512 + 128 * h + d] = (bf16)f2bf(u * (acc[nb][r] + bi)); } }
    WG_BAR();
}

__device__ __forceinline__ void pool_unit(Ctx& C, int l, int cidx, int g) {
    const bf16* P = WSP(bf16, WS_P); bf16* Y = WSP(bf16, WS_Y); const bf16* PW = WSP(bf16, WS_PWT) + (size_t)(l * 4 + g) * 128 * 128;
    const int lane = C.lane, wave = C.wave, c = lane & 15, g4 = lane >> 4, mb = wave & 3, nh = wave >> 2;
    const int r0 = cidx * 64; int sbase, T, t0, mv; rowinfo(r0, sbase, T, t0, mv);
    const int t = t0 + 16 * mb + c, hw = 1 << g;
    const int lo = t - hw < 0 ? 0 : t - hw, hi = t + hw > T ? T : t + hw; const float inv = 1.f / (float)(hi - lo);
    f32x4 acc[4];
#pragma unroll
    for (int nb = 0; nb < 4; ++nb) acc[nb] = (f32x4){0.f, 0.f, 0.f, 0.f};
#pragma unroll
    for (int ks = 0; ks < 4; ++ks) { const bf16* pc = P + PPOOL + 128 * g + 32 * ks + 8 * g4; float s[8] = {0, 0, 0, 0, 0, 0, 0, 0}, x[8];
        for (int tt = lo; tt < hi; ++tt) { float v[8]; unpack8(*(const u32x4*)(pc + (size_t)(sbase + tt) * NIN), v);
#pragma unroll
            for (int q = 0; q < 8; ++q) s[q] += v[q]; }
        unpack8(*(const u32x4*)(pc + (size_t)(sbase + t) * NIN), x);
#pragma unroll
        for (int q = 0; q < 8; ++q) s[q] = s[q] * inv - x[q];
        const bf16x8 af = pack8(s);
#pragma unroll
        for (int nb = 0; nb < 4; ++nb) { const bf16x8 bfr = *(const bf16x8*)(PW + (size_t)(16 * (4 * nh + nb) + c) * 128 + 32 * ks + 8 * g4); acc[nb] = mfma16(af, bfr, acc[nb]); } }
    const float* psc = INP(17) + l * 512 + 128 * g;
#pragma unroll
    for (int nb = 0; nb < 4; ++nb) { const int e = 16 * (4 * nh + nb) + c; const float sc = psc[e];
#pragma unroll
        for (int r = 0; r < 4; ++r) Y[(size_t)(r0 + 16 * mb + 4 * g4 + r) * D + 1024 + 128 * g + e] = (bf16)f2bf(acc[nb][r] * sc); }
}

__device__ __forceinline__ void conf_unit(Ctx& C, int l, int cidx, int cq) {
    const bf16* P = WSP(bf16, WS_P); float* H = WSP(float, WS_CVH);
    const int ch = 128 * cq + (C.tid & 127), grp = C.tid >> 7, r0 = cidx * 64; int sbase, T, t0, mv; rowinfo(r0, sbase, T, t0, mv);
    float w[31];
#pragma unroll
    for (int k = 0; k < 31; ++k) w[k] = INP(18)[((size_t)l * 31 + k) * 512 + ch];
    const float cb = INP(19)[l * 512 + ch];
    float glu[46];
#pragma unroll
    for (int q = 0; q < 46; ++q) { const int t = t0 + 16 * grp + q - 15; float v = 0.f;
        if (t >= 0 && t < T) { const bf16* pr = P + (size_t)(sbase + t) * NIN; v = bf2f(pr[PCVA + ch]) * sigm(bf2f(pr[PCVG + ch])); }
        glu[q] = v; }
#pragma unroll
    for (int i = 0; i < 16; ++i) { float a = cb;
#pragma unroll
        for (int k = 0; k < 31; ++k) a += w[k] * glu[i + k];
        H[(size_t)(r0 + 16 * grp + i) * 512 + ch] = a; }
}

__device__ __forceinline__ void p_mixers(Ctx& C, int l) {
    const int nchk = l == 0 ? NCH : MX / 64;
    for (int u = C.bid; u < NCH * 4; u += C.G) dnprep_unit(C, l, u >> 2, u & 3);
}
__device__ __forceinline__ void p_mixers_bcd(Ctx& C, int l, int vb, int nb) {
    const int nchk = l == 0 ? NCH : MX / 64;
    const int o2 = (nchk * 4) % nb, o3 = (o2 + (nchk / 2) * 4) % nb;
    for (int u = vb; u < nchk * 4; u += nb) conf_unit(C, l, u >> 2, u & 3);
    for (int u = (vb + nb - o2) % nb; u < (nchk / 2) * 4; u += nb) sg_unit(C, l, u >> 2, u & 3);
    for (int u = (vb + nb - o3) % nb; u < nchk * 4; u += nb) pool_unit(C, l, u >> 2, u & 3);
}

constexpr int SC_SLOT = 58368, SC_U = 2 * SC_SLOT;
static_assert(SC_U + 32768 <= LDS_BARW, "scan LDS map");
__device__ __forceinline__ void p_scan(Ctx& C, int l) {
    if (C.bid >= 32) { if (C.G > 32) p_mixers_bcd(C, l, C.bid - 32, C.G - 32); return; }
    const int b = C.bid >> 3, h = (C.bid >> 1) & 3, dir = C.bid & 1, lane = C.lane, w = C.wave, c = lane & 15, g4 = lane >> 4;
    float* O = WSP(float, WS_O) + (size_t)dir * MT * 512;
    f32x4 S[8];
#pragma unroll
    for (int t = 0; t < 8; ++t) S[t] = (f32x4){0.f, 0.f, 0.f, 0.f};
    auto rec_of = [&](int st) -> size_t { const int rb = st < 4 ? MX + b * TC : b * TX, n = st < 4 ? st : st - 4; return dn_rec(dir, (rb >> 6) + n, h); };
#define SC_ISSUE(st_, SL) do { const size_t rec_ = rec_of(st_); \
        _Pragma("unroll") for (int q = 0; q < 7; ++q) { const int ch = w + 8 * q; \
            const unsigned char* src = ch < 16 ? WSP(unsigned char, WS_DNW) + rec_ * 16384 + ch * 1024 : ch < 32 ? WSP(unsigned char, WS_DNQG) + rec_ * 16384 + (ch - 16) * 1024 \
                                     : ch < 48 ? WSP(unsigned char, WS_DNKDT) + rec_ * 16384 + (ch - 32) * 1024 : WSP(unsigned char, WS_DNQK) + rec_ * 8192 + (ch - 48) * 1024; \
            __builtin_amdgcn_global_load_lds((const unsigned*)(src + lane * 16), (LAS unsigned*)(C.lds + (SL) * SC_SLOT + w * 1024 + q * 8192), 16, 0, 0); } \
        if (w == 0) __builtin_amdgcn_global_load_lds((const unsigned*)(WSP(unsigned char, WS_EGL) + rec_ * 16), (LAS unsigned*)(C.lds + (SL) * SC_SLOT + 57344), 16, 0, 0); } while (0)
#define SC_ISSUE_U(st_) do { const float* Ut_ = WSP(float, WS_DNU) + (rec_of(st_) * 128 + 16 * w + c) * 64 + 4 * g4; \
        _Pragma("unroll") for (int mb = 0; mb < 4; ++mb) __builtin_amdgcn_global_load_lds((const unsigned*)(Ut_ + 16 * mb), (LAS unsigned*)(C.lds + SC_U + w * 4096 + mb * 1024), 16, 0, 0); } while (0)
#define SC_STEP(st_, SL) do { const int st = (st_); \
        if (st == 0) asm volatile("s_waitcnt vmcnt(0)" ::: "memory"); else asm volatile("s_waitcnt vmcnt(16)" ::: "memory"); \
        __builtin_amdgcn_s_barrier(); asm volatile("" ::: "memory"); \
        if (st + 1 < 36) SC_ISSUE(st + 1, 1 - (SL)); \
        const LAS bf16x8* Wf = (const LAS bf16x8*)(C.lds + (SL) * SC_SLOT) + lane; const LAS bf16x8* QGf = Wf + 1024; const LAS bf16x8* KDf = Wf + 2048; const LAS bf16x8* QKf = Wf + 3072; \
        const float egl = *(const LAS float*)(C.lds + (SL) * SC_SLOT + 57344); \
        const int rbase = st < 4 ? MX + b * TC + 64 * st : b * TX + 64 * (st - 4); \
        bf16x8 Sb[4]; \
        _Pragma("unroll") for (int ks = 0; ks < 4; ++ks) { float v[8] = {S[2 * ks][0], S[2 * ks][1], S[2 * ks][2], S[2 * ks][3], S[2 * ks + 1][0], S[2 * ks + 1][1], S[2 * ks + 1][2], S[2 * ks + 1][3]}; Sb[ks] = pack8(v); } \
        f32x4 vn[4], oacc[4]; \
        _Pragma("unroll") for (int mb = 0; mb < 4; ++mb) { f32x4 a = (f32x4){0.f, 0.f, 0.f, 0.f}, o = (f32x4){0.f, 0.f, 0.f, 0.f}; \
            _Pragma("unroll") for (int ks = 0; ks < 4; ++ks) { a = mfma16(Wf[(mb * 4 + ks) * 64], Sb[ks], a); o = mfma16(QGf[(mb * 4 + ks) * 64], Sb[ks], o); } \
            vn[mb] = *(const LAS f32x4*)(C.lds + SC_U + w * 4096 + mb * 1024 + lane * 16) - a; oacc[mb] = o; } \
        asm volatile("s_waitcnt lgkmcnt(0)" ::: "memory"); __builtin_amdgcn_s_barrier(); asm volatile("" ::: "memory"); \
        if (st + 1 < 36) SC_ISSUE_U(st + 1); \
        bf16x8 Vb[2]; \
        _Pragma("unroll") for (int k2 = 0; k2 < 2; ++k2) { float v[8] = {vn[2 * k2][0], vn[2 * k2][1], vn[2 * k2][2], vn[2 * k2][3], vn[2 * k2 + 1][0], vn[2 * k2 + 1][1], vn[2 * k2 + 1][2], vn[2 * k2 + 1][3]}; Vb[k2] = pack8(v); } \
        _Pragma("unroll") for (int t = 0; t < 8; ++t) { f32x4 a = S[t] * egl; \
            _Pragma("unroll") for (int k2 = 0; k2 < 2; ++k2) a = mfma16(KDf[(t * 2 + k2) * 64], Vb[k2], a); \
            S[t] = a; } \
        _Pragma("unroll") for (int mb = 0; mb < 4; ++mb) { \
            _Pragma("unroll") for (int k2 = 0; k2 < 2; ++k2) oacc[mb] = mfma16(QKf[(mb * 2 + k2) * 64], Vb[k2], oacc[mb]); \
            _Pragma("unroll") for (int r = 0; r < 4; ++r) O[(size_t)(rbase + 16 * mb + 4 * g4 + r) * 512 + 128 * h + 16 * w + c] = oacc[mb][r]; } } while (0)
    SC_ISSUE(0, 0); SC_ISSUE_U(0);
#pragma unroll 1
    for (int s2 = 0; s2 < 36; s2 += 2) { SC_STEP(s2, 0); SC_STEP(s2 + 1, 1); }
    asm volatile("s_waitcnt vmcnt(0)" ::: "memory");
#undef SC_ISSUE
#undef SC_ISSUE_U
#undef SC_STEP
}

__device__ __forceinline__ void p_ghn(Ctx& C, int l) {
    const int nrows = l == 0 ? MT : MX, lane = C.lane; const float* O = WSP(float, WS_O); const bf16* P = WSP(bf16, WS_P); bf16* Y = WSP(bf16, WS_Y);
    const float* gn = INP(11) + l * 128 + 8 * (lane & 15);
    for (int row = C.bid * NWAVE + C.wave; row < nrows; row += C.G * NWAVE) {
        const int rb = dirrow(row, 1);
        const f32x4* pf = (const f32x4*)(O + (size_t)row * 512 + 8 * lane); const f32x4* pb = (const f32x4*)(O + ((size_t)MT + rb) * 512 + 8 * lane);
        const f32x4 a = pf[0] + pb[0], b2 = pf[1] + pb[1];
        float o[8] = {a.x, a.y, a.z, a.w, b2.x, b2.y, b2.z, b2.w}, z[8]; float ss = 0.f;
#pragma unroll
        for (int c = 0; c < 8; ++c) ss += o[c] * o[c];
        const float rs = rsqrtf(sum16(ss) * (1.f / 128.f) + EPS);
        unpack8(*(const u32x4*)(P + (size_t)row * NIN + PZ + 8 * lane), z);
#pragma unroll
        for (int c = 0; c < 8; ++c) o[c] = o[c] * rs * gn[c] * silu(z[c]);
        *(bf16x8*)(Y + (size_t)row * D + 8 * lane) = pack8(o);
        { const float* hp = WSP(float, WS_CVH) + (size_t)row * 512 + 8 * lane; const f32x4 a = *(const f32x4*)hp, b2 = *(const f32x4*)(hp + 4);
          float v[8] = {a.x, a.y, a.z, a.w, b2.x, b2.y, b2.z, b2.w}; float s = 0.f;
#pragma unroll
          for (int c = 0; c < 8; ++c) s += v[c];
          const float mu = wave_sum(s) * (1.f / 512.f); float s2 = 0.f;
#pragma unroll
          for (int c = 0; c < 8; ++c) { v[c] -= mu; s2 += v[c] * v[c]; }
          const float rs = rsqrtf(wave_sum(s2) * (1.f / 512.f) + EPS);
          const float* lg = INP(20) + l * 512 + 8 * lane; const float* lb = INP(21) + l * 512 + 8 * lane;
#pragma unroll
          for (int c = 0; c < 8; ++c) v[c] = silu(v[c] * rs * lg[c] + lb[c]);
          *(bf16x8*)(Y + (size_t)row * D + 1536 + 8 * lane) = pack8(v); }
    }
}

__device__ __forceinline__ void p_moe_gather(Ctx& C) {
    int* R = WSP(int, WS_ROUTE); const unsigned* ctl = WSP(unsigned, WS_CTL);
    LAS int* offs = (LAS int*)C.lds;
    if (C.tid == 0) { int o = 0, nt = 0;
        for (int e = 0; e < 8; ++e) { const int cnt = (int)ctl[CW_CNT + 64 * e], tl = (cnt + 255) >> 8; offs[e] = o;
            if (C.bid == 0) for (int q = 0; q < tl; ++q) R[R_TILEE + nt + q] = e;
            nt += tl; o += tl << 8; }
        if (C.bid == 0) R[R_NT] = nt; }
    WG_BAR();
    const bf16* AN = WSP(bf16, WS_AN); bf16* AS = WSP(bf16, WS_AS);
    for (int tok = C.bid * NWAVE + C.wave; tok < MX; tok += C.G * NWAVE) {
        const int p0 = offs[R[R_TE + 2 * tok]] + R[R_RANK + 2 * tok], p1 = offs[R[R_TE + 2 * tok + 1]] + R[R_RANK + 2 * tok + 1];
        if (C.lane == 0) { R[R_POS + 2 * tok] = p0; R[R_POS + 2 * tok + 1] = p1; }
        if (MOE_FP8) {
            const u32x4* src = (const u32x4*)(AN + (size_t)tok * D) + 4 * C.lane; float f[32];
#pragma unroll
            for (int j = 0; j < 4; ++j) unpack8(src[j], f + 8 * j);
            u32x4 o[2];
#pragma unroll
            for (int j = 0; j < 2; ++j) { const float* q = f + 16 * j;
                o[j].x = pk4_fp8(clamp448(q[0]), clamp448(q[1]), clamp448(q[2]), clamp448(q[3])); o[j].y = pk4_fp8(clamp448(q[4]), clamp448(q[5]), clamp448(q[6]), clamp448(q[7]));
                o[j].z = pk4_fp8(clamp448(q[8]), clamp448(q[9]), clamp448(q[10]), clamp448(q[11])); o[j].w = pk4_fp8(clamp448(q[12]), clamp448(q[13]), clamp448(q[14]), clamp448(q[15])); }
            u32x4* d0 = (u32x4*)((unsigned char*)AS + (size_t)p0 * D) + 2 * C.lane; u32x4* d1 = (u32x4*)((unsigned char*)AS + (size_t)p1 * D) + 2 * C.lane;
            d0[0] = o[0]; d0[1] = o[1]; d1[0] = o[0]; d1[1] = o[1];
        } else {
        const u32x4* src = (const u32x4*)(AN + (size_t)tok * D) + C.lane; u32x4* d0 = (u32x4*)(AS + (size_t)p0 * D) + C.lane; u32x4* d1 = (u32x4*)(AS + (size_t)p1 * D) + C.lane;
#pragma unroll
        for (int j = 0; j < 4; ++j) { u32x4 v = src[64 * j];
            if (FP8_EMU) { float f[8]; unpack8(v, f);
#pragma unroll
                for (int q = 0; q < 8; ++q) f[q] = rne_e4m3(f[q]);
                v = __builtin_bit_cast(u32x4, pack8(f)); }
            d0[64 * j] = v; d1[64 * j] = v; } }
    }
}

__device__ __forceinline__ void p_final(Ctx& C, float* out) {
    const int* R = WSP(int, WS_ROUTE); const float* Rf = WSP(float, WS_ROUTE); const float* XS = WSP(float, WS_XS); const float* OS = WSP(float, WS_OUTS);
    const float* mod = WSP(float, WS_MODV) + (size_t)5 * 12288; const int lane = C.lane;
    for (int tok = C.bid * NWAVE + C.wave; tok < MX; tok += C.G * NWAVE) {
        const int p0 = R[R_POS + 2 * tok], p1 = R[R_POS + 2 * tok + 1]; const float g0 = Rf[R_TG + 2 * tok], g1 = Rf[R_TG + 2 * tok + 1];
        const f32x4* xp = (const f32x4*)(XS + (size_t)tok * D) + lane; const f32x4* o0 = (const f32x4*)(OS + (size_t)p0 * D) + lane; const f32x4* o1 = (const f32x4*)(OS + (size_t)p1 * D) + lane;
        const f32x4* gf = (const f32x4*)(mod + (size_t)(tok >> 11) * 12288 + 10240) + lane; const f32x4* fg = (const f32x4*)INP(32) + lane;
        f32x4 x[8]; float ss = 0.f;
#pragma unroll
        for (int j = 0; j < 8; ++j) { x[j] = xp[64 * j] + gf[64 * j] * (o0[64 * j] * g0 + o1[64 * j] * g1); ss += (x[j].x * x[j].x + x[j].y * x[j].y) + (x[j].z * x[j].z + x[j].w * x[j].w); }
        const float rs = rsqrtf(wave_sum(ss) * (1.f / D) + EPS);
        f32x4* op = (f32x4*)(out + (size_t)tok * D) + lane;
#pragma unroll
        for (int j = 0; j < 8; ++j) op[64 * j] = x[j] * rs * fg[64 * j];
    }
}
}
namespace mk {
constexpr int NPHASE = 21;
struct Args { const float* in[33]; float* out; unsigned char* ws; int ph_lo, ph_hi; };
static_assert(sizeof(Args) == 35 * 8 + 8, "Args has no padding");

#ifdef ONLY_PHASE
#define IN(k) ((k) == ONLY_PHASE)
#else
#define IN(k) (lo <= (k) && (k) < hi)
#endif
__device__ __forceinline__ constexpr int bg_need(int k) { return k >= 18 ? NBG : k >= 15 ? BG_MOE : k >= 11 ? BG_WOUT1 : k >= 9 ? BG_WIN1 : k >= 8 ? BG_W2 : k >= 6 ? BG_W13 : 0; }
#ifndef BG_FILL_MASK
#define BG_FILL_MASK ((1 << 2) | (1 << 4) | (1 << 6) | (1 << 8) | (1 << 9) | (1 << 11) | (1 << 13))
#endif
#define SEAM(k) do { if (IN(k) && IN((k) + 1)) { if (BG_QUEUE) bg_work(C, bg_need((k) + 1), ((BG_FILL_MASK >> (k)) & 1) ? (k) : -1); xcd_barrier(bar); } } while (0)
constexpr int NMOE = 16 * IT_MW1 + 8 * IT_MW2;
#ifndef FILL_R
#define FILL_R 6, 0, 2, 3, 10, 4, 0
#endif
constexpr int fill_rounds[7] = {FILL_R};
constexpr int FB2 = 136, FB4 = 32, FB6 = 128, FB8 = 48, FB9 = 128, FB11 = 88, FB13 = 32;
constexpr int FN2 = fill_rounds[0] * (256 - FB2) * 8, FN4 = fill_rounds[1] * (256 - FB4) * 8, FN6 = fill_rounds[2] * (256 - FB6) * 8, FN8 = fill_rounds[3] * (256 - FB8) * 8,
              FN9 = fill_rounds[4] * (256 - FB9) * 8, FN11 = fill_rounds[5] * (256 - FB11) * 8;
constexpr int FS2 = 0, FS4 = FS2 + FN2, FS6 = FS4 + FN4, FS8 = FS6 + FN6, FS9 = FS8 + FN8, FS11 = FS9 + FN9, FS13 = FS11 + FN11, FN13 = fill_rounds[6] * (256 - FB13) * 8 < NMOE - FS13 ? fill_rounds[6] * (256 - FB13) * 8 : NMOE - FS13, FS17 = FS13 + FN13, FN17 = NMOE - FS17;
static_assert(FN13 >= 0 && FN17 >= 0, "fill schedule exceeds the MoE items");
template <int l>
__device__ __forceinline__ void layer_body(Ctx& C, const XcdBarrier& bar, const int lo, const int hi) {
        const int pb = l == 0 ? 1 : 10;
        const float* mod = WSP(float, WS_MODV) + (size_t)l * 5 * 12288;
        if (IN(pb + 0)) { if constexpr (l == 0) p_norm<0>(C, 0); else p_norm<1>(C, 1); } SEAM(pb + 0);
        if (IN(pb + 1)) {
            pg8::EpiStoreBf16 E{WSP(bf16, WS_P), NIN};
            pg8::Gemm g{WSP(bf16, WS_AN), WSP(bf16, WS_WIN) + (size_t)l * NIN * D, MT, NIN, D};
            if constexpr (l == 0) { pg8::StaticOrder S; S.init(MT, NIN, C.G, C.bid); pg8::gemm_phase<pg8::EpiStoreBf16, pg8::StaticOrder, true, true>(C.lds, g, S, E); }
            else { pg8::InProjL1Order S; S.init(C.G, C.bid); pg8::gemm_phase<pg8::EpiStoreBf16, pg8::InProjL1Order, true, true>(C.lds, g, S, E); }
            if constexpr (l == 0) fill_static(C, FS2, FN2, FB2); else fill_static(C, FS11, FN11, FB11);
        } SEAM(pb + 1);
        if (IN(pb + 2)) { p_mixers(C, l); } SEAM(pb + 2);
        if (IN(pb + 3)) { p_scan(C, l); if constexpr (l == 0) fill_static(C, FS4, FN4, FB4); else fill_static(C, FS13, FN13, FB13); } SEAM(pb + 3);
        if (IN(pb + 4)) { p_ghn(C, l); } SEAM(pb + 4);
        if (IN(pb + 5)) {
            pg8::EpiResid E{WSP(float, WS_XS), mod, 4096, WSP(float, WS_PART), D / 4};
            pg8::Gemm g{WSP(bf16, WS_Y), WSP(bf16, WS_WOUT) + (size_t)l * D * D, l == 0 ? MT : MX, D, D};
            if constexpr (l == 0) { pg8::ResidOrder S; S.init(D, C.G, C.bid); pg8::gemm_phase<pg8::EpiResid, pg8::ResidOrder, true, true>(C.lds, g, S, E); fill_static(C, FS6, FN6, FB6); }
            else { pg8::StaticOrder S; S.init(MX, D, C.G, C.bid); pg8::gemm_phase<pg8::EpiResid, pg8::StaticOrder, true, true>(C.lds, g, S, E); }
        } SEAM(pb + 5);
        if (IN(pb + 6)) { if constexpr (l == 0) p_norm<2>(C, 0); else p_norm<3>(C, 1); } SEAM(pb + 6);
        if constexpr (l == 0) {
            if (IN(8)) {
                pg8::EpiSwiglu E{WSP(bf16, WS_HM), DFF, 1 << 20};
                pg8::Gemm g{WSP(bf16, WS_AN), WSP(bf16, WS_W13), MT, 2 * DFF, D};
                pg8::StaticOrder S; S.init(MT, 2 * DFF, C.G, C.bid);
                pg8::gemm_phase<pg8::EpiSwiglu, pg8::StaticOrder, true, true>(C.lds, g, S, E);
                fill_static(C, FS8, FN8, FB8);
            } SEAM(8);
            if (IN(9)) {
                pg8::EpiResid E{WSP(float, WS_XS), mod, 10240, WSP(float, WS_PART), DFF / 4};
                pg8::Gemm g{WSP(bf16, WS_HM), WSP(bf16, WS_W2), MT, D, DFF};
                pg8::ResidOrder S; S.init(DFF, C.G, C.bid);
                pg8::gemm_phase<pg8::EpiResid, pg8::ResidOrder, true, true>(C.lds, g, S, E);
                fill_static(C, FS9, FN9, FB9);
            } SEAM(9);
        } else {
            if (IN(17)) { p_moe_gather(C); fill_static(C, FS17, FN17, 0); } SEAM(17);
            if (IN(18)) {
                const int* R = WSP(int, WS_ROUTE);
                pg8::MoeOrder S; S.init(R[R_NT], 56, R + R_TILEE, C.G, C.bid);
                if (MOE_FP8) { pg8::EpiSwiglu8 E{WSP(unsigned char, WS_HM), DFE, 56};
                    pg8::Gemm g{WSP(bf16, WS_AS), WSP(bf16, WS_MW13), MSORT, 2 * DFE * NE, D / 2};
                    pg8::gemm_phase<pg8::EpiSwiglu8, pg8::MoeOrder, true, true, true>(C.lds, g, S, E); }
                else { pg8::EpiSwiglu E{WSP(bf16, WS_HM), DFE, 56};
                    pg8::Gemm g{WSP(bf16, WS_AS), WSP(bf16, WS_MW13), MSORT, 2 * DFE * NE, D};
                    pg8::gemm_phase<pg8::EpiSwiglu, pg8::MoeOrder, true, true>(C.lds, g, S, E); }
            } SEAM(18);
            if (IN(19)) {
                const int* R = WSP(int, WS_ROUTE);
                pg8::EpiStoreF32 E{WSP(float, WS_OUTS)};
                pg8::MoeOrder S; S.init(R[R_NT], 8, R + R_TILEE, C.G, C.bid);
                if (MOE_FP8) { pg8::Gemm g{WSP(bf16, WS_HM), WSP(bf16, WS_MW2), MSORT, D * NE, DFE / 2};
                    pg8::gemm_phase<pg8::EpiStoreF32, pg8::MoeOrder, true, true, true>(C.lds, g, S, E); }
                else { pg8::Gemm g{WSP(bf16, WS_HM), WSP(bf16, WS_MW2), MSORT, D * NE, DFE};
                    pg8::gemm_phase<pg8::EpiStoreF32, pg8::MoeOrder, true, true>(C.lds, g, S, E); }
            } SEAM(19);
        }
    }
__global__ void __launch_bounds__(NTHR, 2) fwd(Args a) {
    extern __shared__ __attribute__((aligned(16))) unsigned char lds_raw[];
    Ctx C;
    C.lds = (LAS unsigned char*)lds_raw;
    C.in = (CIN)__builtin_amdgcn_kernarg_segment_ptr();
    C.out = a.out; C.ws = a.ws; C.tid = threadIdx.x; C.lane = C.tid & 63; C.wave = __builtin_amdgcn_readfirstlane(C.tid >> 6); C.G = gridDim.x; C.bid = blockIdx.x;
    const int lo = a.ph_lo, hi = a.ph_hi;
    XcdBarrier bar; bar.bar = WSP(unsigned, WS_CTL) + CW_BAR; bar.x = 0; bar.st = (volatile LAS unsigned*)(C.lds + LDS_BARW);
    if (hi - lo > 1) {
        if (C.tid < 4) { ((volatile LAS unsigned*)(C.lds + LDS_BARW))[C.tid] = 0u; }
        __syncthreads();
        bar = xcd_barrier_post(WSP(unsigned, WS_CTL) + CW_BAR, (volatile LAS unsigned*)(C.lds + LDS_BARW));
    }
    if (IN(0)) { p_prologue(C); } SEAM(0);
    layer_body<0>(C, bar, lo, hi);
    layer_body<1>(C, bar, lo, hi);
    if (IN(20)) { p_final(C, C.out); }
}

static int g_grid = 0;
static inline bool setup(size_t ws_size, size_t need) {
    if (g_grid == 0) {
        if (ws_size < need) { fprintf(stderr, "kernel_launch: workspace too small: %zu < %zu\n", ws_size, need); g_grid = -1; return false; }
        int dev = 0, cus = 0, per_cu = 0;
        if (hipGetDevice(&dev) != hipSuccess || hipDeviceGetAttribute(&cus, hipDeviceAttributeMultiprocessorCount, dev) != hipSuccess) { g_grid = -1; return false; }
        if (hipFuncSetAttribute((const void*)fwd, hipFuncAttributeMaxDynamicSharedMemorySize, LDS_BYTES) != hipSuccess) { fprintf(stderr, "kernel_launch: hipFuncSetAttribute failed\n"); g_grid = -1; return false; }
        if (hipOccupancyMaxActiveBlocksPerMultiprocessor(&per_cu, (const void*)fwd, NTHR, LDS_BYTES) != hipSuccess || per_cu < 1) { fprintf(stderr, "kernel_launch: occupancy query says %d\n", per_cu); }
        (void)hipGetLastError();
        g_grid = cus;
    }
    return g_grid > 0;
}
static inline void launch(void* const* d_in, float* out, void* d_ws, int lo, int hi, hipStream_t stream) {
    Args a{};
    for (int i = 0; i < 33; ++i) a.in[i] = (const float*)d_in[i];
    a.out = out; a.ws = (unsigned char*)d_ws; a.ph_lo = lo; a.ph_hi = hi;
    hipLaunchKernelGGL(fwd, dim3(g_grid), dim3(NTHR), LDS_BYTES, stream, a);
}
}
#ifndef MK_DEBUG
#define MK_DEBUG 0
#endif
#ifndef MK_ONE_LAUNCH
#define MK_ONE_LAUNCH 0
#endif
#if MK_DEBUG
#ifndef DBG_LAYER
#define DBG_LAYER 0
#endif
namespace dbg {
using namespace mk;
constexpr size_t SNAP = (WS_END + 4095) & ~(size_t)4095;
constexpr size_t S_ERR = SNAP;
constexpr size_t S_MOD = S_ERR + 4096;
constexpr size_t S_AN = S_MOD + al((size_t)10 * 12288 * 2);
constexpr size_t S_AB = S_AN + al((size_t)MT * D * 2);
constexpr size_t S_P = S_AB + al((size_t)MT * 16 * 2);
constexpr size_t S_O = S_P + al((size_t)MT * NIN * 2);
constexpr size_t S_Y = S_O + al((size_t)2 * MT * 512 * 2);
constexpr size_t S_XM = S_Y + al((size_t)MT * D * 2);
constexpr size_t S_AF = S_XM + al((size_t)MT * D * 2);
constexpr size_t S_XE = S_AF + al((size_t)MT * D * 2);
constexpr size_t S_OUT2 = S_XE + al((size_t)MT * D * 2);
constexpr size_t S_END = S_OUT2 + al((size_t)MX * D * 4);
constexpr int NCK = 12;
__global__ void k_snap(const float* src, size_t lds_, bf16* dst, size_t ldd, int rows, int cols, int mode) {
    for (size_t i = (size_t)blockIdx.x * blockDim.x + threadIdx.x; i < (size_t)rows * cols; i += (size_t)gridDim.x * blockDim.x) {
        const int r = (int)(i / cols), c = (int)(i % cols); int sr = r, sc = c;
        if (mode == 1) sc = c < 1536 ? c : c + 16;
        if (mode == 2) sc = c + 1536;
        size_t dr = r;
        if (mode == 3) { const int dir = r / MT, row = r % MT; dr = (size_t)dir * MT + dirrow(row, dir); }
        dst[dr * ldd + c] = (bf16)f2bf(src[(size_t)sr * lds_ + sc]); }
}
__global__ void k_cmp(const void* a, int a_bf16, size_t lda, size_t acol0, const bf16* b, size_t ldb, size_t bcol0, int rows, int cols, float* acc) {
    float num = 0.f, den = 0.f;
    for (size_t i = (size_t)blockIdx.x * blockDim.x + threadIdx.x; i < (size_t)rows * cols; i += (size_t)gridDim.x * blockDim.x) {
        const size_t r = i / cols, c = i % cols;
        const float av = a_bf16 ? bf2f(((const bf16*)a)[r * lda + acol0 + c]) : ((const float*)a)[r * lda + acol0 + c];
        const float bv = bf2f(b[r * ldb + bcol0 + c]); const float d = av - bv;
        if (!(d == d)) { num += 1e30f; } else { num += d * d; } den += bv * bv; }
    num = wave_sum(num); den = wave_sum(den);
    if ((threadIdx.x & 63) == 0) { atomicAdd(acc, num); atomicAdd(acc + 1, den); }
}
__global__ void k_decide(float* err) {
    if (threadIdx.x != 0) return; int code = -1, level = 0;
    for (int k = 0; k < NCK; ++k) { const float num = err[2 * k], den = err[2 * k + 1]; if (den == 0.f && num == 0.f) continue;
        const float e = sqrtf(num / fmaxf(den, 1e-30f)); const float tol = (k == 4) ? 0.06f : 0.03f;
        if (!(e <= tol)) { code = k; level = !(e == e) ? 5 : e < 1e-4f ? 0 : e < 1e-3f ? 1 : e < 1e-2f ? 2 : e < 1e-1f ? 3 : e < 1.f ? 4 : 5; break; } }
    ((int*)err)[64] = code; ((int*)err)[65] = level;
}
__global__ void k_encode(float* out, const float* out2, const float* err) {
    const int code = ((const int*)err)[64], level = ((const int*)err)[65];
    for (size_t i = (size_t)blockIdx.x * blockDim.x + threadIdx.x; i < (size_t)MX * D; i += (size_t)gridDim.x * blockDim.x) {
        if (code < 0) { out[i] = out2[i]; continue; }
        const size_t row = i / D; if (row < (size_t)(code + 1) * (MX / 16)) out[i] = 0.f;
        if (i == (size_t)MX * D - 1) out[i] = (float)(16 << level); }
}
}
#endif

extern "C" void kernel_launch(void* const* d_in, const int* in_sizes, int n_in, void* d_out, int out_size, void* d_ws, size_t ws_size, hipStream_t stream) {
    using namespace mk;
#if MK_DEBUG
    if (!setup(ws_size, dbg::S_END) || n_in != 33) return;
    unsigned char* ws = (unsigned char*)d_ws;
    nv::Bufs nb; const size_t nneed = nv::carve(ws, nb);
    if (nneed > dbg::SNAP) { fprintf(stderr, "naive scratch overlaps snapshots\n"); return; }
    hipMemsetAsync(ws + dbg::S_ERR, 0, 4096, stream);
    auto snap = [&](const float* src, size_t lds_, size_t dst_off, size_t ldd, int rows, int cols, int mode) {
        hipLaunchKernelGGL(dbg::k_snap, dim3(2048), dim3(256), 0, stream, src, lds_, (bf16*)(ws + dst_off), ldd, rows, cols, mode); };
    auto hook = [&](int point, int l) {
        if (point == 0) { snap(nb.mod, 12288, dbg::S_MOD, 12288, 10, 12288, 0); return; }
        if (l != DBG_LAYER) return;
        if (point == 1) snap(nb.A, D, dbg::S_AN, D, MT, D, 0);
        if (point == 2) { snap(nb.p, nv::INW, dbg::S_P, NIN, MT, NIN, 1); snap(nb.p, nv::INW, dbg::S_AB, 16, MT, 16, 2); }
        if (point == 3) snap(nb.o, 512, dbg::S_O, 512, 2 * MT, 512, 3);
        if (point == 4) snap(nb.y, D, dbg::S_Y, D, MT, D, 0);
        if (point == 5) snap(nb.xs, D, dbg::S_XM, D, MT, D, 0);
        if (point == 6) snap(nb.A, D, dbg::S_AF, D, MT, D, 0);
        if (point == 7) snap(nb.xs, D, dbg::S_XE, D, MT, D, 0);
    };
    nv::forward(d_in, (float*)d_out, nb, stream, hook);
    hipMemsetAsync(ws + WS_CTL, 0, CTL_BYTES, stream);
    float* err = (float*)(ws + dbg::S_ERR); float* out2 = (float*)(ws + dbg::S_OUT2);
    auto cmp = [&](int k, const void* a, int a_bf16, size_t lda, size_t acol0, size_t snap_off, size_t ldb, size_t bcol0, int rows, int cols) {
        hipLaunchKernelGGL(dbg::k_cmp, dim3(1024), dim3(256), 0, stream, a, a_bf16, lda, acol0, (const bf16*)(ws + snap_off), ldb, bcol0, rows, cols, err + 2 * k); };
    const int L = DBG_LAYER, pb = L == 0 ? 1 : 10, nr = L == 0 ? MT : MX;
    for (int ph = 0; ph < NPHASE; ++ph) {
        launch(d_in, out2, d_ws, ph, ph + 1, stream);
        if (ph == 0) cmp(0, ws + WS_MODV, 0, 12288, 0, dbg::S_MOD, 12288, 0, 10, 12288);
        if (ph == pb + 0) { cmp(1, ws + WS_AN, 1, D, 0, dbg::S_AN, D, 0, MT, D); cmp(2, ws + WS_ABF, 0, 16, 0, dbg::S_AB, 16, 0, MT, 16); }
        if (ph == pb + 1) { cmp(3, ws + WS_P, 1, NIN, 0, dbg::S_P, NIN, 0, nr, NIN); if (L == 1) cmp(3, ws + WS_P + (size_t)MX * NIN * 2, 1, NIN, 0, dbg::S_P + (size_t)MX * NIN * 2, NIN, 0, MC, 1536); }
        if (ph == pb + 3) cmp(4, ws + WS_O, 0, 512, 0, dbg::S_O, 512, 0, 2 * MT, 512);
        if (ph == pb + 4) { cmp(5, ws + WS_Y, 1, D, 0, dbg::S_Y, D, 0, nr, 512); cmp(6, ws + WS_Y, 1, D, 512, dbg::S_Y, D, 512, nr, 512);
                            cmp(7, ws + WS_Y, 1, D, 1024, dbg::S_Y, D, 1024, nr, 512); cmp(8, ws + WS_Y, 1, D, 1536, dbg::S_Y, D, 1536, nr, 512); }
        if (ph == pb + 5) cmp(9, ws + WS_XS, 0, D, 0, dbg::S_XM, D, 0, nr, D);
        if (ph == pb + 6) cmp(10, ws + WS_AN, 1, D, 0, dbg::S_AF, D, 0, nr, D);
        if (L == 0 && ph == 9) cmp(11, ws + WS_XS, 0, D, 0, dbg::S_XE, D, 0, MT, D);
    }
    hipLaunchKernelGGL(dbg::k_decide, dim3(1), dim3(64), 0, stream, err);
    hipLaunchKernelGGL(dbg::k_encode, dim3(2048), dim3(256), 0, stream, (float*)d_out, out2, err);
#else
    if (!setup(ws_size, WS_END) || n_in != 33) return;
    hipMemsetAsync((unsigned char*)d_ws + WS_CTL, 0, CTL_BYTES, stream);
#if MK_ONE_LAUNCH
    launch(d_in, (float*)d_out, d_ws, 0, NPHASE, stream);
#else
#ifndef REP_MASK
#define REP_MASK 0
#endif
    for (int ph = 0; ph < NPHASE; ++ph) { launch(d_in, (float*)d_out, d_ws, ph, ph + 1, stream); if ((REP_MASK >> ph) & 1) launch(d_in, (float*)d_out, d_ws, ph, ph + 1, stream); }
#endif
#endif
}
```

```cpp
#include <hip/hip_runtime.h>
#include <cstdio>
#include <cstdint>
#define MK_DEBUG 0
#define DBG_LAYER 0
#define MK_ONE_LAUNCH 1
#define REP_MASK 0
#ifndef BG_QUEUE
#define BG_QUEUE 0
#endif
#ifndef STATIC_FILL
#define STATIC_FILL MK_ONE_LAUNCH
#endif
#define GAS __attribute__((address_space(1)))
#define LAS __attribute__((address_space(3)))
typedef unsigned short bf16;
typedef short bf16x8 __attribute__((ext_vector_type(8)));
typedef float f32x4 __attribute__((ext_vector_type(4)));
typedef float f32x2 __attribute__((ext_vector_type(2)));
typedef unsigned u32x4 __attribute__((ext_vector_type(4)));
typedef unsigned u32x2 __attribute__((ext_vector_type(2)));

#ifndef FP8_EMU
#define FP8_EMU 0
#endif
#ifndef MOE_FP8
#define MOE_FP8 1
#endif
__device__ __forceinline__ float rne_e4m3(float x) { return __builtin_amdgcn_cvt_f32_fp8(__builtin_amdgcn_cvt_pk_fp8_f32(x, x, 0, false), 0); }
namespace mk {
constexpr int D = 2048, NB = 4, TX = 2048, TC = 256, MX = NB * TX, MC = NB * TC, MT = MX + MC;
constexpr int INW = 4624, NIN = 4608, NINP = 4864;
constexpr int PQ = 0, PK = 512, PV = 1024, PZ = 1536, PSGU = 2048, PSGV = 2560, PPOOL = 3072, PCVA = 3584, PCVG = 4096;
constexpr int DFF = 5632, NE = 8, DFE = 7168;
constexpr int NCH = MT / 64;
constexpr int MSORT = 2 * MX + NE * 256;
constexpr float EPS = 1e-6f;
constexpr int NTHR = 512, NWAVE = 8;
constexpr int LDS_BYTES = 163840;
constexpr int LDS_BARW = LDS_BYTES - 16;

constexpr size_t al(size_t x) { return (x + 4095) & ~(size_t)4095; }
constexpr size_t WS_CTL = 0, CTL_BYTES = 1u << 20;
constexpr size_t WS_MODV = WS_CTL + CTL_BYTES;
constexpr size_t WS_POS = WS_MODV + al((size_t)2 * 5 * 12288 * 4);
constexpr size_t WS_PWT = WS_POS + al((size_t)TX * D * 4);
constexpr size_t WS_WABC = WS_PWT + al((size_t)2 * 4 * 128 * 128 * 2);
constexpr size_t WS_WIN = WS_WABC + al((size_t)2 * 2048 * 16 * 4);
constexpr size_t WS_WOUT = WS_WIN + al((size_t)2 * NINP * D * 2);
constexpr size_t WS_W13 = WS_WOUT + al((size_t)2 * D * D * 2);
constexpr size_t WS_W2 = WS_W13 + al((size_t)2 * DFF * D * 2);
constexpr size_t WS_MW13 = WS_W2 + al((size_t)D * DFF * 2);
constexpr size_t WS_MW2 = WS_MW13 + al((size_t)NE * 2 * DFE * D * 2);
constexpr size_t WS_XS = WS_MW2 + al((size_t)NE * D * DFE * 2);
constexpr size_t WS_AN = WS_XS + al((size_t)MT * D * 4);
constexpr size_t WS_ABF = WS_AN + al((size_t)MT * D * 2);
constexpr size_t WS_PART = WS_ABF + al((size_t)MT * 16 * 4);
constexpr size_t WS_ROUTE = WS_PART + al((size_t)4 * MC * D * 4);
constexpr size_t WS_BIG = WS_ROUTE + al((size_t)1 << 20);
constexpr size_t WS_P = WS_BIG;
constexpr size_t DN_FRAG = (size_t)2 * NCH * 4;
constexpr size_t WS_DNW = WS_P + al((size_t)MT * NIN * 2);
constexpr size_t WS_DNQG = WS_DNW + al(DN_FRAG * 16384);
constexpr size_t WS_DNKDT = WS_DNQG + al(DN_FRAG * 16384);
constexpr size_t WS_DNQK = WS_DNKDT + al(DN_FRAG * 16384);
constexpr size_t WS_DNU = WS_DNQK + al(DN_FRAG * 8192);
constexpr size_t WS_EGL = WS_DNU + al(DN_FRAG * 32768);
constexpr size_t WS_O = WS_EGL + al(DN_FRAG * 16);
constexpr size_t WS_Y = WS_O + al((size_t)2 * MT * 512 * 4);
constexpr size_t WS_CVH = WS_Y + al((size_t)MT * D * 2);
constexpr size_t WS_MIX_END = WS_CVH + al((size_t)MT * 512 * 4);
constexpr size_t WS_HM = WS_BIG;
constexpr size_t WS_AS = WS_HM + al((size_t)MSORT * DFE * 2);
constexpr size_t WS_OUTS = WS_AS + al((size_t)MSORT * D * 2);
constexpr size_t WS_PARTO = WS_OUTS + al((size_t)MSORT * D * 4);
constexpr size_t WS_FFN_END = WS_PARTO + al((size_t)4 * 2048 * D * 4);
constexpr size_t WS_END = WS_FFN_END > WS_MIX_END ? WS_FFN_END : WS_MIX_END;
constexpr int R_TE = 0;
constexpr int R_TG = R_TE + MX * 2;
constexpr int R_RANK = R_TG + MX * 2;
constexpr int R_POS = R_RANK + MX * 2;
constexpr int R_TILEE = R_POS + MX * 2;
constexpr int R_NT = R_TILEE + 128;
constexpr int CW_CNT = 64;
constexpr int CW_BGHEAD = 1024;
constexpr int CW_DONE = 2048;
constexpr int CW_BAR = 4096;

__device__ __forceinline__ float silu(float x) { return x * __builtin_amdgcn_rcpf(1.f + __expf(-x)); }
__device__ __forceinline__ float sigm(float x) { return __builtin_amdgcn_rcpf(1.f + __expf(-x)); }
__device__ __forceinline__ float gelu_tanh(float x) { const float u = 0.7978845608028654f * (x + 0.044715f * x * x * x); const float e = __expf(2.f * u); return x * (1.f - __builtin_amdgcn_rcpf(1.f + e)); }
__device__ __forceinline__ float softplus(float x) { return x > 20.f ? x : log1pf(__expf(x)); }
__device__ __forceinline__ unsigned f2bf(float f) { unsigned u = __builtin_bit_cast(unsigned, f); return (u + 0x7fffu + ((u >> 16) & 1u)) >> 16; }
__device__ __forceinline__ unsigned pk2(float lo, float hi) { return f2bf(lo) | (f2bf(hi) << 16); }
__device__ __forceinline__ float bf2f(unsigned short b) { return __builtin_bit_cast(float, (unsigned)b << 16); }
__device__ __forceinline__ float bflo(unsigned w) { return __builtin_bit_cast(float, w << 16); }
__device__ __forceinline__ float bfhi(unsigned w) { return __builtin_bit_cast(float, w & 0xffff0000u); }
__device__ __forceinline__ bf16x8 pack8(const float* v) { u32x4 w; w.x = pk2(v[0], v[1]); w.y = pk2(v[2], v[3]); w.z = pk2(v[4], v[5]); w.w = pk2(v[6], v[7]); return __builtin_bit_cast(bf16x8, w); }
__device__ __forceinline__ void unpack8(u32x4 w, float* v) { v[0] = bflo(w.x); v[1] = bfhi(w.x); v[2] = bflo(w.y); v[3] = bfhi(w.y); v[4] = bflo(w.z); v[5] = bfhi(w.z); v[6] = bflo(w.w); v[7] = bfhi(w.w); }
__device__ __forceinline__ unsigned pk4_fp8(float a, float b, float c, float d) { int p = __builtin_amdgcn_cvt_pk_fp8_f32(a, b, 0, false); p = __builtin_amdgcn_cvt_pk_fp8_f32(c, d, p, true); return (unsigned)p; }
__device__ __forceinline__ float clamp448(float x) { return fminf(fmaxf(x, -448.f), 448.f); }
__device__ __forceinline__ float wave_sum(float v) {
#pragma unroll
    for (int o = 1; o < 64; o <<= 1) v += __shfl_xor(v, o);
    return v;
}
__device__ __forceinline__ float sum16(float v) {
#pragma unroll
    for (int o = 1; o < 16; o <<= 1) v += __shfl_xor(v, o);
    return v;
}
__device__ __forceinline__ void rowinfo(int row, int& base, int& T, int& t, int& mv) {
    if (row < MX) { const int b = row >> 11; base = b << 11; T = TX; t = row - base; mv = b; }
    else { const int r = row - MX, b = r >> 8; base = MX + (b << 8); T = TC; t = r - (b << 8); mv = 4; }
}
__device__ __forceinline__ int dirrow(int row, int dir) { int base, T, t, mv; rowinfo(row, base, T, t, mv); return dir ? base + (T - 1 - t) : row; }
#define LDS_WAIT() asm volatile("s_waitcnt lgkmcnt(0)" ::: "memory")
#define VM_WAIT() asm volatile("s_waitcnt vmcnt(0)" ::: "memory")
#define WG_BAR() do { __syncthreads(); } while (0)
}
#define XB_TMO      128
#define XB_XCNT(j)  (256  + 64 * (j))
#define XB_XSUB(j)  (1280 + 64 * (j))
#define XB_XGEN(j)  (2304 + 64 * (j))
#define XB_TOP      3328
#define XB_TOPGEN   3392
#define XCD_BAR_WORDS 3456
#define XB_SPIN_CAP (1u << 18)
#define LAS __attribute__((address_space(3)))

__device__ __forceinline__ unsigned xb_ld(unsigned* p)              { return __hip_atomic_load(p, __ATOMIC_RELAXED, __HIP_MEMORY_SCOPE_AGENT); }
__device__ __forceinline__ unsigned xb_add(unsigned* p, unsigned v) { return __hip_atomic_fetch_add(p, v, __ATOMIC_RELAXED, __HIP_MEMORY_SCOPE_AGENT); }
__device__ __forceinline__ unsigned xb_xcc_id() { return (unsigned)__builtin_amdgcn_s_getreg((3 << 11) | 20) & 0xFu; }
#define XB_SPIN(cond, bar) do { unsigned _sp = 0; while (cond) { __builtin_amdgcn_s_sleep(1); \
    if ((++_sp & 255u) == 0u) { if (xb_ld(&(bar)[XB_TMO])) break; if (_sp > XB_SPIN_CAP) { atomicAdd(&(bar)[XB_TMO], 1u); break; } } } } while (0)

struct XcdBarrier {
    unsigned* bar; unsigned x;
    volatile LAS unsigned* st;
};

__device__ __forceinline__ XcdBarrier xcd_barrier_post(unsigned* bar, volatile LAS unsigned* st) {
    XcdBarrier b; b.bar = bar; b.x = xb_xcc_id(); b.st = st;
    if (threadIdx.x == 0) (void)xb_add(&bar[XB_XCNT(b.x)], 1u);
    return b;
}
__device__ __forceinline__ void xcd_barrier_complete(unsigned* bar, unsigned x, unsigned& nloc, unsigned& nx) {
    const unsigned G = gridDim.x * gridDim.y * gridDim.z;
    unsigned sum, cnt, mine, sp = 0u;
    for (;;) {
        sum = 0u; cnt = 0u; mine = 0u;
#pragma unroll
        for (unsigned j = 0; j < 16; ++j) { const unsigned c = xb_ld(&bar[XB_XCNT(j)]); sum += c; cnt += (c > 0u) ? 1u : 0u; mine = (j == x) ? c : mine; }
        if (sum == G) break;
        __builtin_amdgcn_s_sleep(1);
        if ((++sp & 255u) == 0u) { if (xb_ld(&bar[XB_TMO])) break; if (sp > XB_SPIN_CAP) { atomicAdd(&bar[XB_TMO], 1u); break; } }
    }
    nloc = mine > 0u ? mine : 1u; nx = cnt > 0u ? cnt : 1u;
}

__device__ __forceinline__ void xcd_barrier(const XcdBarrier& b) {
    asm volatile("s_waitcnt vmcnt(0)" ::: "memory");
    __syncthreads();
    if (threadIdx.x == 0) {
        unsigned* bar = b.bar;
        __builtin_amdgcn_s_waitcnt(0);
        unsigned nloc = b.st[0], nx = b.st[1];
        if (nloc == 0u) { xcd_barrier_complete(bar, b.x, nloc, nx); b.st[0] = nloc; b.st[1] = nx; }
        const unsigned old = xb_add(&bar[XB_XSUB(b.x)], 1u);
        const unsigned gen = old / nloc;
        if (old + 1u == (gen + 1u) * nloc) {
            __builtin_amdgcn_fence(__ATOMIC_RELEASE, "agent");
            asm volatile("s_waitcnt vmcnt(0)" ::: "memory");
            const unsigned og = xb_add(&bar[XB_TOP], 1u);
            const unsigned tg = og / nx;
            if (og + 1u == (tg + 1u) * nx) xb_add(&bar[XB_TOPGEN], 1u);
            else XB_SPIN(xb_ld(&bar[XB_TOPGEN]) == tg, bar);
            __builtin_amdgcn_fence(__ATOMIC_ACQUIRE, "agent");
            xb_add(&bar[XB_XGEN(b.x)], 1u);
            asm volatile("s_waitcnt vmcnt(0)" ::: "memory");
        } else {
            XB_SPIN(xb_ld(&bar[XB_XGEN(b.x)]) == gen, bar);
            __builtin_amdgcn_fence(__ATOMIC_ACQUIRE, "agent");
            asm volatile("s_waitcnt vmcnt(0)" ::: "memory");
        }
    }
    __syncthreads();
}
namespace pg8 {
#define PG8_LAS __attribute__((address_space(3)))
typedef unsigned short bf16_t;
typedef short bf16x8 __attribute__((ext_vector_type(8)));
typedef float f32x4 __attribute__((ext_vector_type(4)));
typedef unsigned u32x4 __attribute__((ext_vector_type(4)));
constexpr int BM = 256, BK = 64, HALF = 128, HTB = HALF * BK * 2  , STAGE_BYTES = 8 * HTB, NXCD = 8, WGM = 8;

__host__ __device__ __forceinline__ int lds_byte(int r, int c) { const int st = (r >> 4) * 2 + (c >> 5), rr = r & 15, cc = c & 31, ob = rr * 64 + cc * 2; return st * 1024 + (ob ^ (((ob >> 9) & 1) << 5)); }
__host__ __device__ __forceinline__ void stage_rc(int b, int& R, int& C) { const int st = b / 1024, sb = b % 1024, swz = sb ^ (((sb >> 9) & 1) << 5); R = (st >> 1) * 16 + swz / 64; C = (st & 1) * 32 + (swz % 64) / 2; }
__host__ __device__ __forceinline__ int perm32(int rho) { const int n = rho >> 4, i = rho & 15; return 8 * (i >> 2) + 4 * n + (i & 3); }

struct Unit { int pm, pn, k0, nk; };
struct Gemm { const bf16_t* A; const bf16_t* Bt; int M, N, K; };

struct StaticOrder {
    int nM, nN, nwg, G, c;
    __host__ __device__ void init(int M, int N, int G_, int c_) { nM = M / BM; nN = N / BM; nwg = nM * nN; G = G_; c = c_; }
    __host__ __device__ bool next(int i, Unit& u) const {
        const long L = (long)i * G + c; if (L >= nwg) return false;
        int wgid = (int)L; { const int q = nwg / NXCD, r = nwg % NXCD, xcd = wgid % NXCD, off = wgid / NXCD; wgid = (xcd < r ? xcd * (q + 1) : r * (q + 1) + (xcd - r) * q) + off; }
        const int nig = WGM * nN, gid = wgid / nig, fm = gid * WGM, gsz = (nM - fm) < WGM ? (nM - fm) : WGM;
        u.pm = fm + ((wgid % nig) % gsz); u.pn = (wgid % nig) / gsz; u.k0 = 0; u.nk = 0; return true;
    }
    __device__ __forceinline__ void a_ready(const Unit&) const {}
    __device__ __forceinline__ void done(const Unit&) const {}
};
__device__ __forceinline__ unsigned cvt_pk_bf16(float lo, float hi) { unsigned r; asm volatile("v_cvt_pk_bf16_f32 %0, %1, %2" : "=v"(r) : "v"(lo), "v"(hi)); return r; }
typedef float f32x2 __attribute__((ext_vector_type(2)));
typedef int pg8_v8i __attribute__((ext_vector_type(8)));
typedef int pg8_v4i __attribute__((ext_vector_type(4)));
__device__ __forceinline__ pg8_v8i pg8_cat(bf16x8 lo, bf16x8 hi) { const pg8_v4i a = __builtin_bit_cast(pg8_v4i, lo), b = __builtin_bit_cast(pg8_v4i, hi); return __builtin_shufflevector(a, b, 0, 1, 2, 3, 4, 5, 6, 7); }
constexpr int F8_WSCALE = 121;
template <class Epi, class Sched, bool ALIGN_EPI = false, bool SP2 = false, bool F8 = false>
__device__ __forceinline__ void gemm_phase(PG8_LAS unsigned char* lds, const Gemm g, const Sched& S, const Epi& E) {
    const int tid = threadIdx.x, wid = __builtin_amdgcn_readfirstlane(tid >> 6), lane = tid & 63, wr = wid >> 2, wc = wid & 3, fr = lane & 15, fq = lane >> 4;
    const int K = g.K, nt = K / BK;
    unsigned voffA[2], voffB[2];
#pragma unroll
    for (int i = 0; i < 2; ++i) { int R, C; stage_rc(tid * 16 + i * 8192, R, C); const int Rb = Epi::PERM ? ((R & ~31) + perm32(R & 31)) : R;
        voffA[i] = (unsigned)(R * K + C) * 2u; voffB[i] = (unsigned)(Rb * K + C) * 2u; }
    const size_t kstep = (size_t)(BK * 2);
    const size_t hstep = (size_t)HALF * K * 2;
    const size_t tstep = 2 * hstep;
    const unsigned ldsw = (unsigned)wid * 1024u;
    const int aoff = lds_byte(wr * 64 + fr, fq * 8), boff = lds_byte(wc * 32 + fr, fq * 8);
#define PG8_SA(b, h) (((b) * 2 + (h)) * HTB)
#define PG8_SB(b, h) ((4 + (b) * 2 + (h)) * HTB)
#define PG8_STAGE(bufoff, gbase, voff) do { _Pragma("unroll") for (int _i = 0; _i < 2; ++_i) \
        __builtin_amdgcn_global_load_lds((const unsigned*)((const char*)(gbase) + (voff)[_i]), (PG8_LAS unsigned*)(lds + (bufoff) + ldsw + _i * 8192), 16, 0, 0); } while (0)
#define PG8_LDA(dst, b, h) do { _Pragma("unroll") for (int m = 0; m < 4; ++m) { if constexpr (F8) { dst##8[m] = pg8_cat(*(const PG8_LAS bf16x8*)(lds + PG8_SA(b, h) + aoff + m * 2048), *(const PG8_LAS bf16x8*)(lds + PG8_SA(b, h) + aoff + m * 2048 + 1024)); } else { _Pragma("unroll") for (int k = 0; k < 2; ++k) dst[m][k] = *(const PG8_LAS bf16x8*)(lds + PG8_SA(b, h) + aoff + m * 2048 + k * 1024); } } } while (0)
#define PG8_LDB(dst, b, h) do { _Pragma("unroll") for (int n = 0; n < 2; ++n) { if constexpr (F8) { dst##8[n] = pg8_cat(*(const PG8_LAS bf16x8*)(lds + PG8_SB(b, h) + boff + n * 2048), *(const PG8_LAS bf16x8*)(lds + PG8_SB(b, h) + boff + n * 2048 + 1024)); } else { _Pragma("unroll") for (int k = 0; k < 2; ++k) dst[n][k] = *(const PG8_LAS bf16x8*)(lds + PG8_SB(b, h) + boff + n * 2048 + k * 1024); } } } while (0)
#define PG8_MMA(ai, bj, At, Bt) do { __builtin_amdgcn_s_setprio(1); if constexpr (F8) { _Pragma("unroll") for (int m = 0; m < 4; ++m) _Pragma("unroll") for (int n = 0; n < 2; ++n) \
        asm volatile("v_mfma_scale_f32_16x16x128_f8f6f4 %0, %1, %2, %0, %3, %4 op_sel_hi:[0,0,0]" : "+v"(acc[ai][bj][m][n]) : "v"(Bt##8[n]), "v"(At##8[m]), "v"(f8_sw), "v"(f8_sa)); } \
        else { _Pragma("unroll") for (int m = 0; m < 4; ++m) _Pragma("unroll") for (int n = 0; n < 2; ++n) _Pragma("unroll") for (int k = 0; k < 2; ++k) \
        acc[ai][bj][m][n] = __builtin_amdgcn_mfma_f32_16x16x32_bf16(Bt[n][k], At[m][k], acc[ai][bj][m][n], 0, 0, 0); } __builtin_amdgcn_s_setprio(0); } while (0)
#define PG8_WAIT_V(n) asm volatile("s_waitcnt vmcnt(" #n ")" ::: "memory")
#define PG8_WAIT_L(n) asm volatile("s_waitcnt lgkmcnt(" #n ")" ::: "memory")
#define PG8_BAR __builtin_amdgcn_s_barrier()
#define PG8_SCHED __builtin_amdgcn_sched_barrier(0)
    Unit cur, nxt; int ui = 0;
    if (!S.next(0, cur)) return;
    f32x4 acc[2][2][4][2];
#pragma unroll
    for (int a = 0; a < 2; ++a)
#pragma unroll
        for (int b = 0; b < 2; ++b)
#pragma unroll
            for (int m = 0; m < 4; ++m)
#pragma unroll
                for (int n = 0; n < 2; ++n) acc[a][b][m][n] = (f32x4){0.f, 0.f, 0.f, 0.f};
    bf16x8 At[4][2], B0[2][2], B1[2][2]; pg8_v8i At8[4], B08[2], B18[2]; const int f8_sw = F8_WSCALE, f8_sa = 127;
    const char* cA = (const char*)g.A + (size_t)cur.pm * tstep + (size_t)cur.k0 * 2; const char* cB = (const char*)g.Bt + (size_t)cur.pn * tstep + (size_t)cur.k0 * 2;
    S.a_ready(cur);
    if constexpr (SP2) {
        PG8_STAGE(PG8_SB(0, 0), cB, voffB); PG8_STAGE(PG8_SB(0, 1), cB + hstep, voffB); PG8_STAGE(PG8_SA(0, 0), cA, voffA); PG8_STAGE(PG8_SA(0, 1), cA + hstep, voffA);
        if (wr == 1) PG8_BAR;
        PG8_WAIT_V(2); PG8_BAR;
        PG8_STAGE(PG8_SB(1, 0), cB + kstep, voffB); PG8_STAGE(PG8_SA(1, 0), cA + kstep, voffA); PG8_STAGE(PG8_SB(1, 1), cB + hstep + kstep, voffB);
        PG8_WAIT_V(6); PG8_BAR;
    } else {
        PG8_STAGE(PG8_SB(0, 0), cB, voffB); PG8_STAGE(PG8_SA(0, 0), cA, voffA); PG8_STAGE(PG8_SB(0, 1), cB + hstep, voffB); PG8_STAGE(PG8_SA(0, 1), cA + hstep, voffA);
        if (wr == 1) PG8_BAR;
        PG8_WAIT_V(4); PG8_BAR;
        PG8_STAGE(PG8_SB(1, 0), cB + kstep, voffB); PG8_STAGE(PG8_SA(1, 0), cA + kstep, voffA); PG8_STAGE(PG8_SB(1, 1), cB + hstep + kstep, voffB);
        PG8_WAIT_V(6); PG8_BAR;
    }
    for (;;) {
        const bool has_next = S.next(ui + 1, nxt);
        const char* nA = has_next ? (const char*)g.A + (size_t)nxt.pm * tstep + (size_t)nxt.k0 * 2 : cA; const char* nB = has_next ? (const char*)g.Bt + (size_t)nxt.pn * tstep + (size_t)nxt.k0 * 2 : cB;
        const int ntc = cur.nk ? cur.nk : nt;
        for (int t = 0; t < ntc; t += 2) {
            const bool last = (t == ntc - 2);
            const char* a1 = cA + (size_t)(t + 1) * kstep;
            const char* a2 = last ? nA : cA + (size_t)(t + 2) * kstep; const char* b2 = last ? nB : cB + (size_t)(t + 2) * kstep;
            const char* a3 = a2 + kstep; const char* b3 = b2 + kstep;
            if (last && has_next) S.a_ready(nxt);
            if constexpr (SP2) {
            PG8_LDB(B0, 0, 0); PG8_LDB(B1, 0, 1); PG8_SCHED; PG8_LDA(At, 0, 0); PG8_STAGE(PG8_SA(1, 1), a1 + hstep, voffA);
            PG8_WAIT_V(8); PG8_WAIT_L(0); PG8_BAR; PG8_MMA(0, 0, At, B0); PG8_MMA(0, 1, At, B1); PG8_BAR; PG8_SCHED;
            PG8_LDA(At, 0, 1); PG8_STAGE(PG8_SB(0, 0), b2, voffB); PG8_STAGE(PG8_SB(0, 1), b2 + hstep, voffB); PG8_STAGE(PG8_SA(0, 0), a2, voffA);
            PG8_WAIT_V(8); PG8_WAIT_L(0); PG8_BAR; PG8_MMA(1, 0, At, B0); PG8_MMA(1, 1, At, B1); PG8_BAR; PG8_SCHED;
            PG8_LDB(B0, 1, 0); PG8_LDB(B1, 1, 1); PG8_SCHED; PG8_LDA(At, 1, 0); PG8_STAGE(PG8_SA(0, 1), a2 + hstep, voffA);
            PG8_WAIT_V(8); PG8_WAIT_L(0); PG8_BAR; PG8_MMA(0, 0, At, B0); PG8_MMA(0, 1, At, B1); PG8_BAR; PG8_SCHED;
            PG8_LDA(At, 1, 1); PG8_STAGE(PG8_SB(1, 0), b3, voffB); PG8_STAGE(PG8_SB(1, 1), b3 + hstep, voffB); PG8_STAGE(PG8_SA(1, 0), a3, voffA);
            PG8_WAIT_V(8); PG8_WAIT_L(0); PG8_BAR; PG8_MMA(1, 0, At, B0); PG8_MMA(1, 1, At, B1); PG8_BAR; PG8_SCHED;
            } else {
            PG8_LDB(B0, 0, 0); PG8_SCHED; PG8_LDA(At, 0, 0); PG8_STAGE(PG8_SA(1, 1), a1 + hstep, voffA);
            PG8_WAIT_L(8); PG8_BAR; PG8_WAIT_L(0); PG8_MMA(0, 0, At, B0); PG8_BAR; PG8_SCHED;
            PG8_LDB(B1, 0, 1); PG8_STAGE(PG8_SB(0, 0), b2, voffB);
            PG8_BAR; PG8_WAIT_L(0); PG8_MMA(0, 1, At, B1); PG8_BAR;
            PG8_LDA(At, 0, 1); PG8_STAGE(PG8_SA(0, 0), a2, voffA);
            PG8_BAR; PG8_WAIT_L(0); PG8_MMA(1, 0, At, B0); PG8_BAR; PG8_SCHED;
            PG8_STAGE(PG8_SB(0, 1), b2 + hstep, voffB);
            PG8_WAIT_V(6); PG8_BAR; PG8_MMA(1, 1, At, B1); PG8_BAR;
            PG8_LDB(B0, 1, 0); PG8_SCHED; PG8_LDA(At, 1, 0); PG8_STAGE(PG8_SA(0, 1), a2 + hstep, voffA);
            PG8_WAIT_L(8); PG8_BAR; PG8_WAIT_L(0); PG8_MMA(0, 0, At, B0); PG8_BAR; PG8_SCHED;
            PG8_LDB(B1, 1, 1); PG8_STAGE(PG8_SB(1, 0), b3, voffB);
            PG8_BAR; PG8_WAIT_L(0); PG8_MMA(0, 1, At, B1); PG8_BAR;
            PG8_LDA(At, 1, 1); PG8_STAGE(PG8_SA(1, 0), a3, voffA);
            PG8_BAR; PG8_WAIT_L(0); PG8_MMA(1, 0, At, B0); PG8_BAR; PG8_SCHED;
            PG8_STAGE(PG8_SB(1, 1), b3 + hstep, voffB);
            PG8_WAIT_V(6); PG8_BAR; PG8_MMA(1, 1, At, B1); PG8_BAR;
            }
        }
        if constexpr (F8) { asm volatile("s_nop 15\n\ts_nop 15" ::: "memory"); }
        if constexpr (ALIGN_EPI) { if (wr == 0) PG8_BAR; }
        if constexpr (!Epi::AFTER_DRAIN) { E(acc, cur, wr, wc, fr, fq); S.done(cur); }
        if (!has_next) break;
#pragma unroll
        for (int a = 0; a < 2; ++a)
#pragma unroll
            for (int b = 0; b < 2; ++b)
#pragma unroll
                for (int m = 0; m < 4; ++m)
#pragma unroll
                    for (int n = 0; n < 2; ++n) acc[a][b][m][n] = (f32x4){0.f, 0.f, 0.f, 0.f};
        cur = nxt; cA = nA; cB = nB; ++ui;
        if constexpr (ALIGN_EPI) { if (wr == 1) PG8_BAR; }
    }
    PG8_WAIT_V(0);
    if constexpr (!ALIGN_EPI) { if (wr == 0) PG8_BAR; }
    PG8_BAR;
    if constexpr (Epi::AFTER_DRAIN) { E.fused(acc, cur, wr, wc, fr, fq, lds, wid, lane); S.done(cur); }
#undef PG8_SA
#undef PG8_SB
#undef PG8_STAGE
#undef PG8_LDA
#undef PG8_LDB
#undef PG8_MMA
#undef PG8_WAIT_V
#undef PG8_WAIT_L
#undef PG8_BAR
#undef PG8_SCHED
}
struct EpiStoreBf16 {
    static constexpr bool PERM = true, AFTER_DRAIN = false;
    bf16_t* O; int ldc; float* AB;
    __device__ __forceinline__ void operator()(const f32x4 (&acc)[2][2][4][2], const Unit& u, int wr, int wc, int fr, int fq) const {
        const int row0 = u.pm * BM + wr * 64 + fr, col0 = u.pn * BM + wc * 32 + 8 * fq;
        if (u.pn == 18) { if (wc == 0 && fq < 2) {
#pragma unroll
            for (int ai = 0; ai < 2; ++ai)
#pragma unroll
                for (int m = 0; m < 4; ++m) { float* rp = AB + (size_t)(row0 + ai * HALF + m * 16) * 16 + 8 * fq; *(f32x4*)rp = acc[ai][0][m][0]; *(f32x4*)(rp + 4) = acc[ai][0][m][1]; } }
            return; }
#pragma unroll
        for (int ai = 0; ai < 2; ++ai)
#pragma unroll
            for (int m = 0; m < 4; ++m) { bf16_t* rowp = O + (size_t)(row0 + ai * HALF + m * 16) * ldc + col0;
#pragma unroll
                for (int bj = 0; bj < 2; ++bj) { const f32x4 v0 = acc[ai][bj][m][0], v1 = acc[ai][bj][m][1];
                    u32x4 w; w.x = cvt_pk_bf16(v0[0], v0[1]); w.y = cvt_pk_bf16(v0[2], v0[3]); w.z = cvt_pk_bf16(v1[0], v1[1]); w.w = cvt_pk_bf16(v1[2], v1[3]);
                    *(u32x4*)(rowp + bj * HALF) = w; } }
    }
};
struct EpiResid {
    static constexpr bool PERM = false, AFTER_DRAIN = false;
    float* X; const float* mod; int goff; float* part; int kslice;
    __device__ __forceinline__ void operator()(const f32x4 (&acc)[2][2][4][2], const Unit& u, int wr, int wc, int fr, int fq) const {
        const int row0 = u.pm * BM + wr * 64 + fr, col0 = u.pn * BM + wc * 32 + 4 * fq;
        const int mv = u.pm < 32 ? (u.pm >> 3) : 4;
        const float* gp = mod + (size_t)mv * 12288 + goff + col0;
        f32x4 gv[2][2];
#pragma unroll
        for (int bj = 0; bj < 2; ++bj)
#pragma unroll
            for (int n = 0; n < 2; ++n) gv[bj][n] = *(const f32x4*)(gp + bj * HALF + n * 16);
        if (u.nk != 0) { float* pb = part + ((size_t)(u.k0 / kslice) * 1024 + (row0 - 8192)) * 2048 + col0;
#pragma unroll
            for (int ai = 0; ai < 2; ++ai)
#pragma unroll
                for (int m = 0; m < 4; ++m) { float* rowp = pb + (size_t)(ai * HALF + m * 16) * 2048;
#pragma unroll
                    for (int bj = 0; bj < 2; ++bj)
#pragma unroll
                        for (int n = 0; n < 2; ++n) *(f32x4*)(rowp + bj * HALF + n * 16) = gv[bj][n] * acc[ai][bj][m][n]; }
            return; }
#pragma unroll
        for (int ai = 0; ai < 2; ++ai)
#pragma unroll
            for (int m = 0; m < 4; ++m) { float* rowp = X + (size_t)(row0 + ai * HALF + m * 16) * 2048 + col0;
#pragma unroll
                for (int bj = 0; bj < 2; ++bj)
#pragma unroll
                    for (int n = 0; n < 2; ++n) { f32x4* p = (f32x4*)(rowp + bj * HALF + n * 16); *p = *p + gv[bj][n] * acc[ai][bj][m][n]; } }
    }
};
struct ResidOrder {
    StaticOrder so; int G, c, kslice;
    __device__ void init(int K, int G_, int c_) { so.init(8192, 2048, G_, c_); G = G_; c = c_; kslice = K / 4; }
    __device__ bool next(int i, Unit& u) const {
        const int L = i * G + c;
        if (L < so.nwg) return so.next(i, u);
        const int j = L - so.nwg; if (j >= 128) return false;
        const int t = j >> 2; u.pm = 32 + (t >> 3); u.pn = t & 7; u.k0 = (j & 3) * kslice; u.nk = kslice / BK; return true;
    }
    __device__ __forceinline__ void a_ready(const Unit&) const {}
    __device__ __forceinline__ void done(const Unit&) const {}
};
__device__ __forceinline__ float silu_f(float x) { return x * __builtin_amdgcn_rcpf(1.f + __builtin_amdgcn_exp2f(-1.4426950408889634f * x)); }
struct EpiSwiglu {
    static constexpr bool PERM = true, AFTER_DRAIN = false;
    bf16_t* H; int ldh; int ntn;
    __device__ __forceinline__ void operator()(const f32x4 (&acc)[2][2][4][2], const Unit& u, int wr, int wc, int fr, int fq) const {
        const int row0 = u.pm * BM + wr * 64 + fr, hcol0 = (u.pn % ntn) * HALF + wc * 32 + 8 * fq;
#pragma unroll
        for (int ai = 0; ai < 2; ++ai)
#pragma unroll
            for (int m = 0; m < 4; ++m) { bf16_t* rowp = H + (size_t)(row0 + ai * HALF + m * 16) * ldh + hcol0;
                const f32x4 a0 = acc[ai][0][m][0], a1 = acc[ai][0][m][1], b0 = acc[ai][1][m][0], b1 = acc[ai][1][m][1];
                float h[8];
#pragma unroll
                for (int j = 0; j < 4; ++j) { if (FP8_EMU && ntn == 56) { const float q = 1.f / 64.f; h[j] = rne_e4m3(silu_f(a0[j] * q) * (b0[j] * q)); h[4 + j] = rne_e4m3(silu_f(a1[j] * q) * (b1[j] * q)); } else { h[j] = silu_f(a0[j]) * b0[j]; h[4 + j] = silu_f(a1[j]) * b1[j]; } }
                u32x4 w; w.x = cvt_pk_bf16(h[0], h[1]); w.y = cvt_pk_bf16(h[2], h[3]); w.z = cvt_pk_bf16(h[4], h[5]); w.w = cvt_pk_bf16(h[6], h[7]);
                *(u32x4*)rowp = w; }
    }
};
struct EpiSwiglu8 {
    static constexpr bool PERM = true, AFTER_DRAIN = false;
    unsigned char* H; int ldh; int ntn;
    __device__ __forceinline__ void operator()(const f32x4 (&acc)[2][2][4][2], const Unit& u, int wr, int wc, int fr, int fq) const {
        const int row0 = u.pm * BM + wr * 64 + fr, hcol0 = (u.pn % ntn) * HALF + wc * 32 + 8 * fq;
#pragma unroll
        for (int ai = 0; ai < 2; ++ai)
#pragma unroll
            for (int m = 0; m < 4; ++m) { unsigned char* rowp = H + (size_t)(row0 + ai * HALF + m * 16) * ldh + hcol0;
                const f32x4 a0 = acc[ai][0][m][0], a1 = acc[ai][0][m][1], b0 = acc[ai][1][m][0], b1 = acc[ai][1][m][1];
                float h[8];
#pragma unroll
                for (int j = 0; j < 4; ++j) { h[j] = fminf(fmaxf(silu_f(a0[j]) * b0[j], -448.f), 448.f); h[4 + j] = fminf(fmaxf(silu_f(a1[j]) * b1[j], -448.f), 448.f); }
                int p0 = __builtin_amdgcn_cvt_pk_fp8_f32(h[0], h[1], 0, false); p0 = __builtin_amdgcn_cvt_pk_fp8_f32(h[2], h[3], p0, true);
                int p1 = __builtin_amdgcn_cvt_pk_fp8_f32(h[4], h[5], 0, false); p1 = __builtin_amdgcn_cvt_pk_fp8_f32(h[6], h[7], p1, true);
                u32x2 w; w.x = (unsigned)p0; w.y = (unsigned)p1; *(u32x2*)rowp = w; }
    }
};
struct EpiStoreF32 {
    static constexpr bool PERM = false, AFTER_DRAIN = false;
    float* C; float* part; int kslice;
    __device__ __forceinline__ void operator()(const f32x4 (&acc)[2][2][4][2], const Unit& u, int wr, int wc, int fr, int fq) const {
        const int row0 = u.pm * BM + wr * 64 + fr, col0 = (u.pn & 7) * BM + wc * 32 + 4 * fq;
        float* base = u.nk != 0 ? part + ((size_t)(u.k0 / kslice) * 2048 + (row0 - 16384)) * 2048 + col0 : C + (size_t)row0 * 2048 + col0;
#pragma unroll
        for (int ai = 0; ai < 2; ++ai)
#pragma unroll
            for (int m = 0; m < 4; ++m) { float* rowp = base + (size_t)(ai * HALF + m * 16) * 2048;
#pragma unroll
                for (int bj = 0; bj < 2; ++bj)
#pragma unroll
                    for (int n = 0; n < 2; ++n) *(f32x4*)(rowp + bj * HALF + n * 16) = FP8_EMU ? acc[ai][bj][m][n] * (1.f / 64.f) : acc[ai][bj][m][n]; }
    }
};
struct InProjL1Order {
    StaticOrder so; int G, c;
    __device__ void init(int G_, int c_) { so.init(8192, 4864, G_, c_); G = G_; c = c_; }
    __device__ bool next(int i, Unit& u) const {
        const int L = i * G + c;
        if (L < so.nwg) return so.next(i, u);
        const int L2 = L - so.nwg; if (L2 >= 28) return false;
        u.pm = 32 + (L2 & 3); u.pn = (L2 >> 2) == 6 ? 18 : (L2 >> 2); u.k0 = 0; u.nk = 0; return true;
    }
    __device__ __forceinline__ void a_ready(const Unit&) const {}
    __device__ __forceinline__ void done(const Unit&) const {}
};
struct MoeOrder {
    StaticOrder so; const int* tile_e; int NT;
    __device__ void init(int ntiles, int NT_, const int* te, int G_, int c_) { so.nM = ntiles; so.nN = NT_; so.nwg = ntiles * NT_; so.G = G_; so.c = c_; tile_e = te; NT = NT_; }
    __device__ bool next(int i, Unit& u) const { if (!so.next(i, u)) return false; u.pn += tile_e[u.pm] * NT; return true; }
    __device__ __forceinline__ void a_ready(const Unit&) const {}
    __device__ __forceinline__ void done(const Unit&) const {}
};
struct MoeDownOrder {
    StaticOrder so; const int* tile_e; int ntiles, G, c, kslice;
    __device__ void init(int ntiles_, const int* te, int K, int G_, int c_) { ntiles = ntiles_; const int nm = ntiles_ < 64 ? ntiles_ : 64; so.nM = nm; so.nN = 8; so.nwg = nm * 8; so.G = G_; so.c = c_; tile_e = te; G = G_; c = c_; kslice = K / 4; }
    __device__ bool next(int i, Unit& u) const {
        const int L = i * G + c;
        if (L < so.nwg) { so.next(i, u); u.pn += tile_e[u.pm] * 8; return true; }
        const int j = L - so.nwg; if (j >= (ntiles - so.nM) * 32) return false;
        const int t = j >> 2; u.pm = 64 + (t >> 3); u.pn = tile_e[u.pm] * 8 + (t & 7); u.k0 = (j & 3) * kslice; u.nk = kslice / BK; return true;
    }
    __device__ __forceinline__ void a_ready(const Unit&) const {}
    __device__ __forceinline__ void done(const Unit&) const {}
};
}
namespace mk {
typedef const float* KP;
typedef __attribute__((address_space(4))) KP const* CIN;
struct Ctx {
    LAS unsigned char* lds;
    CIN in; float* out; unsigned char* ws;
    int tid, lane, wave, G, bid;
};
#define WSP(T, off) ((T*)(C.ws + (off)))
__device__ __forceinline__ const float* inp_(CIN p, int k) { asm volatile("" : "+s"(p)); return p[k]; }
#define INP(k) inp_(C.in, (k))

__device__ __forceinline__ void tr_item(const float* W, int ldw, int k0, int ncol0, bf16* WT, int ldt, int drow0, LAS float* scr, int lane, bool f8 = false) {
    f32x4 v[16];
#pragma unroll
    for (int i = 0; i < 16; ++i) { const int idx = lane + 64 * i, kk = idx >> 4, c4 = idx & 15; v[i] = *(const f32x4*)(W + (size_t)(k0 + kk) * ldw + ncol0 + 4 * c4); }
    if (FP8_EMU && f8) {
#pragma unroll
        for (int i = 0; i < 16; ++i) { v[i].x = rne_e4m3(v[i].x * 64.f); v[i].y = rne_e4m3(v[i].y * 64.f); v[i].z = rne_e4m3(v[i].z * 64.f); v[i].w = rne_e4m3(v[i].w * 64.f); } }
#pragma unroll
    for (int i = 0; i < 16; ++i) { const int idx = lane + 64 * i, kk = idx >> 4, c4 = idx & 15; LAS float* p = scr + kk * 65 + 4 * c4; p[0] = v[i].x; p[1] = v[i].y; p[2] = v[i].z; p[3] = v[i].w; }
    LDS_WAIT(); asm volatile("" ::: "memory");
    const int c = lane & 7;
#pragma unroll
    for (int jj = 0; jj < 8; ++jj) { const int n = (lane >> 3) + 8 * jj; const LAS float* s = scr + (8 * c) * 65 + n;
        u32x4 o; o.x = pk2(s[0], s[65]); o.y = pk2(s[2 * 65], s[3 * 65]); o.z = pk2(s[4 * 65], s[5 * 65]); o.w = pk2(s[6 * 65], s[7 * 65]);
        *(u32x4*)(WT + (size_t)(drow0 + n) * ldt + k0 + 8 * c) = o; }
    LDS_WAIT(); asm volatile("" ::: "memory");
}
__device__ __forceinline__ void tr_item8(const float* W, int ldw, int k0, int ncol0, unsigned char* WT, int ldt, int drow0, LAS float* scr, int lane) {
    f32x4 v[16];
#pragma unroll
    for (int i = 0; i < 16; ++i) { const int idx = lane + 64 * i, kk = idx >> 3, c4 = idx & 7; v[i] = *(const f32x4*)(W + (size_t)(k0 + kk) * ldw + ncol0 + 4 * c4); }
#pragma unroll
    for (int i = 0; i < 16; ++i) { const int idx = lane + 64 * i, kk = idx >> 3, c4 = idx & 7; LAS float* p = scr + kk * 33 + 4 * c4; p[0] = v[i].x * 64.f; p[1] = v[i].y * 64.f; p[2] = v[i].z * 64.f; p[3] = v[i].w * 64.f; }
    LDS_WAIT(); asm volatile("" ::: "memory");
    const int c = lane & 7;
#pragma unroll
    for (int jj = 0; jj < 4; ++jj) { const int n = (lane >> 3) + 8 * jj; const LAS float* s = scr + (16 * c) * 33 + n;
        u32x4 o; o.x = pk4_fp8(s[0], s[33], s[2 * 33], s[3 * 33]); o.y = pk4_fp8(s[4 * 33], s[5 * 33], s[6 * 33], s[7 * 33]);
        o.z = pk4_fp8(s[8 * 33], s[9 * 33], s[10 * 33], s[11 * 33]); o.w = pk4_fp8(s[12 * 33], s[13 * 33], s[14 * 33], s[15 * 33]);
        *(u32x4*)(WT + (size_t)(drow0 + n) * ldt + k0 + 16 * c) = o; }
    LDS_WAIT(); asm volatile("" ::: "memory");
}
constexpr int IT_WIN = 32 * 73, IT_WOUT = 32 * 32, IT_W1 = 32 * 88, IT_W2 = 88 * 32, IT_MW1 = 32 * 112, IT_MW2 = 112 * 32, IT_PW = 2 * 2;
constexpr int IT_PRO = IT_WIN + 8 * IT_PW;
constexpr int BG_WOUT0 = 0, BG_W13 = BG_WOUT0 + IT_WOUT, BG_W2 = BG_W13 + 2 * IT_W1, BG_WIN1 = BG_W2 + IT_W2, BG_WOUT1 = BG_WIN1 + IT_WIN, BG_MOE = BG_WOUT1 + IT_WOUT, NBG = BG_MOE + 16 * IT_MW1 + 8 * IT_MW2;
constexpr int IT_TOTAL = IT_PRO + NBG;
__device__ __forceinline__ void tr_dispatch(Ctx& C, int it, LAS float* scr) {
    const float* W; int ldw, k0, nc0, ldt, dr0; bf16* WT; int r = it;
    if (r < IT_WIN) { const int kb = r / 73, nb = r % 73; W = INP(7); ldw = INW; k0 = 64 * kb; nc0 = nb == 72 ? 1536 : nb < 24 ? 64 * nb : 1552 + 64 * (nb - 24); WT = WSP(bf16, WS_WIN); ldt = D; dr0 = nb == 72 ? 4608 : nb < 24 ? 64 * nb : 1536 + 64 * (nb - 24); }
    else if (r < IT_PRO) { r -= IT_WIN; const int m = r / IT_PW, q = r % IT_PW; W = INP(16) + (size_t)m * 128 * 128; ldw = 128; k0 = 64 * (q >> 1); nc0 = 64 * (q & 1); WT = WSP(bf16, WS_PWT) + (size_t)m * 128 * 128; ldt = 128; dr0 = 64 * (q & 1); }
    else { r -= IT_PRO;
        if (r < BG_W13) { const int kb = r / 32, nb = r % 32; W = INP(22); ldw = D; k0 = 64 * kb; nc0 = 64 * nb; WT = WSP(bf16, WS_WOUT); ldt = D; dr0 = 64 * nb; }
        else if (r < BG_W2) { r -= BG_W13; const int s = r / IT_W1; r -= s * IT_W1; const int kb = r / 88, nb = r % 88; W = INP(24 + s); ldw = DFF; k0 = 64 * kb; nc0 = 64 * nb; WT = WSP(bf16, WS_W13); ldt = D; dr0 = 256 * (nb >> 1) + 128 * s + 64 * (nb & 1); }
        else if (r < BG_WIN1) { r -= BG_W2; const int kb = r / 32, nb = r % 32; W = INP(26); ldw = D; k0 = 64 * kb; nc0 = 64 * nb; WT = WSP(bf16, WS_W2); ldt = DFF; dr0 = 64 * nb; }
        else if (r < BG_WOUT1) { r -= BG_WIN1; const int kb = r / 73, nb = r % 73; W = INP(7) + (size_t)D * INW; ldw = INW; k0 = 64 * kb; nc0 = nb == 72 ? 1536 : nb < 24 ? 64 * nb : 1552 + 64 * (nb - 24); WT = WSP(bf16, WS_WIN) + (size_t)NINP * D; ldt = D; dr0 = nb == 72 ? 4608 : nb < 24 ? 64 * nb : 1536 + 64 * (nb - 24); }
        else if (r < BG_MOE) { r -= BG_WOUT1; const int kb = r / 32, nb = r % 32; W = INP(22) + (size_t)D * D; ldw = D; k0 = 64 * kb; nc0 = 64 * nb; WT = WSP(bf16, WS_WOUT) + (size_t)D * D; ldt = D; dr0 = 64 * nb; }
        else { r -= BG_MOE;
            if (MOE_FP8) {
                if (r < 16 * IT_MW1) { const int j = r / IT_MW1; r -= j * IT_MW1; const int s = j >> 3, e = j & 7, kb = r / 224, nb = r % 224, h0 = 32 * nb;
                    tr_item8(INP(29 + s) + (size_t)e * D * DFE, DFE, 128 * kb, h0, WSP(unsigned char, WS_MW13) + (size_t)e * 2 * DFE * D, D, 256 * (h0 >> 7) + 128 * s + (h0 & 127), scr, C.lane); }
                else { r -= 16 * IT_MW1; const int e = r / IT_MW2; r -= e * IT_MW2; const int kb = r / 64, nb = r % 64;
                    tr_item8(INP(31) + (size_t)e * DFE * D, D, 128 * kb, 32 * nb, WSP(unsigned char, WS_MW2) + (size_t)e * D * DFE, DFE, 32 * nb, scr, C.lane); }
                return; }
            if (r < 16 * IT_MW1) { const int j = r / IT_MW1; r -= j * IT_MW1; const int s = j >> 3, e = j & 7, kb = r / 112, nb = r % 112;
                W = INP(29 + s) + (size_t)e * D * DFE; ldw = DFE; k0 = 64 * kb; nc0 = 64 * nb; WT = WSP(bf16, WS_MW13) + (size_t)e * 2 * DFE * D; ldt = D; dr0 = 256 * (nb >> 1) + 128 * s + 64 * (nb & 1); }
            else { r -= 16 * IT_MW1; const int e = r / IT_MW2; r -= e * IT_MW2; const int kb = r / 32, nb = r % 32;
                W = INP(31) + (size_t)e * DFE * D; ldw = D; k0 = 64 * kb; nc0 = 64 * nb; WT = WSP(bf16, WS_MW2) + (size_t)e * D * DFE; ldt = DFE; dr0 = 64 * nb; } } }
    tr_item(W, ldw, k0, nc0, WT, ldt, dr0, scr, C.lane, it >= IT_PRO + BG_MOE);
}
#ifndef BG_BATCH_N
#define BG_BATCH_N 1
#endif
constexpr int BG_BATCH = BG_BATCH_N;
__device__ __forceinline__ void bg_work(Ctx& C, int limit, int poll_phase) {
    unsigned* ctl = WSP(unsigned, WS_CTL);
    volatile LAS unsigned* flag = (volatile LAS unsigned*)(C.lds + LDS_BARW + 8);
    VM_WAIT(); __syncthreads();
    if (C.tid == 0) { flag[0] = 0u; flag[1] = __hip_atomic_load(ctl + CW_BGHEAD, __ATOMIC_RELAXED, __HIP_MEMORY_SCOPE_AGENT) >= (unsigned)NBG ? 1u : 0u;
        if (poll_phase >= 0) __hip_atomic_fetch_add(ctl + CW_DONE + 64 * poll_phase, 1u, __ATOMIC_RELAXED, __HIP_MEMORY_SCOPE_AGENT); }
    __syncthreads();
    if (flag[1] != 0u) return;
    LAS float* scr = (LAS float*)(C.lds + C.wave * 16896);
    for (;;) {
        if (C.tid == 0) { unsigned base = 0xffffffffu;
            const unsigned head = __hip_atomic_load(ctl + CW_BGHEAD, __ATOMIC_RELAXED, __HIP_MEMORY_SCOPE_AGENT);
            bool go = head < (unsigned)limit;
            if (!go && poll_phase >= 0 && head < (unsigned)NBG) go = __hip_atomic_load(ctl + CW_DONE + 64 * poll_phase, __ATOMIC_RELAXED, __HIP_MEMORY_SCOPE_AGENT) < (unsigned)C.G;
            if (go) base = __hip_atomic_fetch_add(ctl + CW_BGHEAD, (unsigned)NWAVE, __ATOMIC_RELAXED, __HIP_MEMORY_SCOPE_AGENT);
            flag[0] = base; }
        __syncthreads();
        const unsigned base = flag[0];
        if (base >= (unsigned)NBG) break;
        if (base + C.wave < (unsigned)NBG) tr_dispatch(C, IT_PRO + (int)base + C.wave, scr);
        __syncthreads();
    }
}
__device__ __forceinline__ void mod_unit(Ctx& C, int unit, LAS float* sv  , LAS float* red  ) {
    const int l = unit / 192, col0 = (unit % 192) * 64, cq = C.tid & 15, ks = C.tid >> 4;
    const float* w = INP(4) + ((size_t)l * D + ks * 64) * 12288 + col0 + 4 * cq;
    f32x4 acc[5];
#pragma unroll
    for (int v = 0; v < 5; ++v) acc[v] = (f32x4){0.f, 0.f, 0.f, 0.f};
#pragma unroll 8
    for (int k = 0; k < 64; ++k) { const f32x4 wv = *(const f32x4*)(w + (size_t)k * 12288);
#pragma unroll
        for (int v = 0; v < 5; ++v) acc[v] += wv * sv[v * 2048 + ks * 64 + k]; }
#pragma unroll
    for (int v = 0; v < 5; ++v) *(LAS f32x4*)(red + (ks * 5 + v) * 64 + 4 * cq) = acc[v];
    WG_BAR();
    if (C.tid < 320) { const int v = C.tid >> 6, c = C.tid & 63; float s = 0.f;
#pragma unroll 8
        for (int k = 0; k < 32; ++k) s += red[(k * 5 + v) * 64 + c];
        WSP(float, WS_MODV)[((size_t)l * 5 + v) * 12288 + col0 + c] = s + INP(5)[l * 12288 + col0 + c]; }
    WG_BAR();
}
__device__ __forceinline__ void p_prologue(Ctx& C) {
    LAS float* sv = (LAS float*)C.lds; LAS float* red = sv + 5 * 2048;
    for (int i = C.tid; i < 5 * 2048; i += NTHR) { const float x = i < 4 * 2048 ? INP(1)[i] : INP(3)[i - 4 * 2048]; sv[i] = x / (1.f + expf(-x)); }
    WG_BAR();
    for (int u = C.bid; u < 384; u += C.G) mod_unit(C, u, sv, red);
    for (int i = C.bid * NTHR + C.tid; i < 2 * 2048 * 4; i += C.G * NTHR) { const int lk = i >> 2, q = i & 3; *(f32x4*)(WSP(float, WS_WABC) + (size_t)lk * 16 + 4 * q) = *(const f32x4*)(INP(7) + (size_t)lk * INW + 1536 + 4 * q); }
    { float* pos = WSP(float, WS_POS);
      for (size_t i = (size_t)C.bid * NTHR + C.tid; i < (size_t)TX * D; i += (size_t)C.G * NTHR) {
          const int t = (int)(i >> 11), d = (int)(i & 2047), r = t >> 6, cc = t & 63, part = d >> 9, fi = d & 511;
          const float freq = expf(-9.210340371976184f * (float)fi / 512.f);
          const float ang = (part < 2 ? (float)r : (float)cc) * freq;
          pos[i] = (part & 1) ? cosf(ang) : sinf(ang); } }
    WG_BAR();
    LAS float* scr = (LAS float*)(C.lds + C.wave * 16896);
    const int gw = C.bid * NWAVE + C.wave, NGW = C.G * NWAVE;
    const int nit = (STATIC_FILL && C.G == 256) ? IT_PRO + BG_MOE : IT_TOTAL;
    for (int it = gw; it < nit; it += NGW) tr_dispatch(C, it, scr);
}
__device__ __forceinline__ void fill_static(Ctx& C, int first, int n, int b0) {
    if (!(STATIC_FILL && C.G == 256) || C.bid < b0 || n <= 0) return;
    VM_WAIT(); __syncthreads();
    LAS float* scr = (LAS float*)(C.lds + C.wave * 16896);
    const int nb = C.G - b0;
    for (int it = first + (C.bid - b0) * NWAVE + C.wave; it < first + n; it += nb * NWAVE) tr_dispatch(C, IT_PRO + BG_MOE + it, scr);
}

template <int MODE>
__device__ __forceinline__ void p_norm(Ctx& C, int l) {
    const float* mod = WSP(float, WS_MODV) + (size_t)l * 5 * 12288;
    float* XS = WSP(float, WS_XS); bf16* AN = WSP(bf16, WS_AN);
    const bool mix = MODE <= 1;
    const float* gain = (mix ? INP(6) : INP(23)) + l * D;
    const int sh_off = mix ? 0 : 6144, sc_off = mix ? 2048 : 8192;
    LAS f32x4* wl = (LAS f32x4*)C.lds;
    if (MODE == 3) { const float* wsrc = INP(27);
        for (int idx = C.tid; idx < 2048 * 2; idx += NTHR) { const int k = idx >> 1, q = idx & 1, ln = (k & 255) >> 2, i = k & 3, j = k >> 8;
            wl[((j * 4 + i) * 2 + q) * 64 + ln] = *(const f32x4*)(wsrc + (size_t)k * 8 + 4 * q); } }
    WG_BAR();
    const int nrows = MODE == 3 ? MX : MT;
    const int gw = C.bid * NWAVE + C.wave, NGW = C.G * NWAVE, lane = C.lane;
    for (int row = gw; row < nrows; row += NGW) {
        int base, T, t, mv; rowinfo(row, base, T, t, mv);
        f32x4 x[8]; float ss = 0.f;
        if (MODE == 0) {
            if (row < MX) { const f32x4* xi = (const f32x4*)(INP(0) + (size_t)row * D) + lane; const f32x4* pp = (const f32x4*)(WSP(float, WS_POS) + (size_t)t * D) + lane;
#pragma unroll
                for (int j = 0; j < 8; ++j) x[j] = xi[64 * j] + pp[64 * j]; }
            else { const f32x4* xi = (const f32x4*)(INP(2) + (size_t)(row - MX) * D) + lane;
#pragma unroll
                for (int j = 0; j < 8; ++j) x[j] = xi[64 * j]; }
            f32x4* xo = (f32x4*)(XS + (size_t)row * D) + lane;
#pragma unroll
            for (int j = 0; j < 8; ++j) xo[64 * j] = x[j];
        } else { const f32x4* xi = (const f32x4*)(XS + (size_t)row * D) + lane;
#pragma unroll
            for (int j = 0; j < 8; ++j) x[j] = xi[64 * j];
            if ((MODE == 1 || (MODE == 2 && l == 0)) && row >= MX) {
#pragma unroll
                for (int ks = 0; ks < 4; ++ks) { const f32x4* pp = (const f32x4*)(WSP(float, WS_PART) + ((size_t)ks * MC + (row - MX)) * D) + lane;
#pragma unroll
                    for (int j = 0; j < 8; ++j) x[j] += pp[64 * j]; }
                f32x4* xo = (f32x4*)(XS + (size_t)row * D) + lane;
#pragma unroll
                for (int j = 0; j < 8; ++j) xo[64 * j] = x[j]; } }
#pragma unroll
        for (int j = 0; j < 8; ++j) ss += (x[j].x * x[j].x + x[j].y * x[j].y) + (x[j].z * x[j].z + x[j].w * x[j].w);
        const float rs = rsqrtf(wave_sum(ss) * (1.f / D) + EPS);
        const f32x4* gp = (const f32x4*)gain + lane; const f32x4* shp = (const f32x4*)(mod + (size_t)mv * 12288 + sh_off) + lane; const f32x4* scp = (const f32x4*)(mod + (size_t)mv * 12288 + sc_off) + lane;
        u32x2* ao = (u32x2*)(AN + (size_t)row * D) + lane;
#pragma unroll
        for (int j = 0; j < 8; ++j) { const f32x4 g = gp[64 * j], sh = shp[64 * j], sc = scp[64 * j];
            x[j] = x[j] * rs * g * (sc + 1.f) + sh;
            u32x2 w; w.x = pk2(x[j].x, x[j].y); w.y = pk2(x[j].z, x[j].w); ao[64 * j] = w; }
        if (MODE == 3) {
            f32x4 acc[2] = {(f32x4){0.f, 0.f, 0.f, 0.f}, (f32x4){0.f, 0.f, 0.f, 0.f}};
#pragma unroll
            for (int j = 0; j < 8; ++j)
#pragma unroll
                for (int i = 0; i < 4; ++i) { const float a = x[j][i];
#pragma unroll
                    for (int q = 0; q < 2; ++q) acc[q] += wl[((j * 4 + i) * 2 + q) * 64 + lane] * a; asm volatile("" ::: "memory"); }
            float lg[8];
#pragma unroll
            for (int e = 0; e < 8; ++e) lg[e] = wave_sum(acc[e >> 2][e & 3]) + INP(28)[e];
            if (lane == 0) { int i1 = 0;
#pragma unroll
                for (int e = 1; e < 8; ++e) if (lg[e] > lg[i1]) i1 = e;
                int i2 = i1 == 0 ? 1 : 0;
#pragma unroll
                for (int e = 0; e < 8; ++e) if (e != i1 && lg[e] > lg[i2]) i2 = e;
                float v1 = lg[0], v2 = lg[0];
#pragma unroll
                for (int e = 0; e < 8; ++e) { v1 = e == i1 ? lg[e] : v1; v2 = e == i2 ? lg[e] : v2; }
                const float g2 = 1.f / (1.f + expf(v1 - v2));
                int* R = WSP(int, WS_ROUTE); float* Rf = WSP(float, WS_ROUTE); unsigned* ctl = WSP(unsigned, WS_CTL);
                R[R_TE + 2 * row] = i1; R[R_TE + 2 * row + 1] = i2; Rf[R_TG + 2 * row] = 1.f - g2; Rf[R_TG + 2 * row + 1] = g2;
                R[R_RANK + 2 * row] = (int)atomicAdd(ctl + CW_CNT + 64 * i1, 1u); R[R_RANK + 2 * row + 1] = (int)atomicAdd(ctl + CW_CNT + 64 * i2, 1u); }
        }
    }
}
}
namespace mk {
__device__ __forceinline__ f32x4 mfma16(bf16x8 a, bf16x8 b, f32x4 c) { return __builtin_amdgcn_mfma_f32_16x16x32_bf16(a, b, c, 0, 0, 0); }

constexpr int DP_PITCH = 132;
constexpr int DP_Q = 0, DP_K = 33792, DP_V = 67584;
constexpr int DP_L = 101376;
constexpr int DP_QK = DP_L + 32768;
constexpr int DP_SM = DP_QK + 16384;
static_assert(DP_SM + 2048 <= LDS_BARW, "DN prep LDS map");
__device__ __forceinline__ size_t dn_rec(int dir, int cid, int h) { return ((size_t)dir * NCH + cid) * 4 + h; }

__device__ __forceinline__ void dnprep_unit(Ctx& C, int l, int cidx, int h) {
    LAS float* Qs = (LAS float*)(C.lds + DP_Q); LAS float* Ks = (LAS float*)(C.lds + DP_K); LAS float* Vs = (LAS float*)(C.lds + DP_V);
    LAS float* Ls = (LAS float*)(C.lds + DP_L); LAS bf16* QKi = (LAS bf16*)(C.lds + DP_QK); LAS float* sm = (LAS float*)(C.lds + DP_SM);
    LAS float* Gs = sm; LAS float* Bs = sm + 128; LAS float* EGs = sm + 256; LAS float* EGRs = sm + 384;
    const bf16* P = WSP(bf16, WS_P);
    const int tid = C.tid, lane = C.lane, wave = C.wave;
    const int r0 = cidx * 64; int sbase, T, t0, mv; rowinfo(r0, sbase, T, t0, mv);
    const int nloc = t0 >> 6, nch = T >> 6, cbase = sbase >> 6;
#ifndef DP_SKIP
#define DP_SKIP 0
#endif
    if (!(DP_SKIP & 1)) { if (tid < 384) {
        const int o = tid % 48, tg = tid / 48, wh = o >> 4, oc = o & 15, ch = wh * 512 + h * 128 + 8 * oc;
        float w[5][8];
        const float* cw = INP(8) + (size_t)l * 5 * 1536 + ch;
#pragma unroll
        for (int k = 0; k < 5; ++k) { const f32x4 a = *(const f32x4*)(cw + k * 1536), b = *(const f32x4*)(cw + k * 1536 + 4);
            w[k][0] = a.x; w[k][1] = a.y; w[k][2] = a.z; w[k][3] = a.w; w[k][4] = b.x; w[k][5] = b.y; w[k][6] = b.z; w[k][7] = b.w; }
#pragma unroll 1
        for (int hf = 0; hf < 2; ++hf) {
        float xin[8][8];
#pragma unroll
        for (int i = 0; i < 8; ++i) { const int t = t0 + 8 * tg + 4 * hf + i - 2;
            if (t >= 0 && t < T) { const u32x4 raw = *(const u32x4*)(P + (size_t)(sbase + t) * NIN + ch); unpack8(raw, xin[i]); }
            else {
#pragma unroll
                for (int c = 0; c < 8; ++c) xin[i][c] = 0.f; } }
#pragma unroll
        for (int i = 0; i < 4; ++i) { float ov[8]; float ss = 0.f;
#pragma unroll
            for (int c = 0; c < 8; ++c) { float s = 0.f;
#pragma unroll
                for (int k = 0; k < 5; ++k) s += w[k][c] * xin[i + k][c];
                ov[c] = silu(s); ss += ov[c] * ov[c]; }
            ss = sum16(ss);
            const float sc = wh == 0 ? rsqrtf(ss + EPS) * 0.08838834764831845f : wh == 1 ? rsqrtf(ss + EPS) : 1.f;
            LAS float* dst = (wh == 0 ? Qs : wh == 1 ? Ks : Vs) + (8 * tg + 4 * hf + i) * DP_PITCH + 8 * oc;
            *(LAS f32x4*)dst = (f32x4){ov[0] * sc, ov[1] * sc, ov[2] * sc, ov[3] * sc}; *(LAS f32x4*)(dst + 4) = (f32x4){ov[4] * sc, ov[5] * sc, ov[6] * sc, ov[7] * sc}; }
        }
    } else {
        const int d = wave - 6, s = lane, i = d ? 63 - s : s; const float* ab = WSP(float, WS_ABF) + (size_t)(r0 + i) * 16;
        const float la = -expf(INP(9)[l * 8 + d * 4 + h]) * softplus(ab[d * 4 + h] + INP(10)[l * 8 + d * 4 + h]);
        const float be = sigm(ab[8 + d * 4 + h]);
        float g = la;
#pragma unroll
        for (int o = 1; o < 64; o <<= 1) { const float up = __shfl_up(g, o); if (lane >= o) g += up; }
        const float gl = __shfl(g, 63);
        Gs[d * 64 + s] = g; Bs[d * 64 + s] = be; EGs[d * 64 + s] = expf(g); EGRs[d * 64 + s] = expf(gl - g);
        if (lane == 63) { const int cid = d ? cbase + (nch - 1 - nloc) : cidx; const float e = expf(gl); *(f32x4*)(WSP(float, WS_EGL) + dn_rec(d, cid, h) * 4) = (f32x4){e, e, e, e}; }
    } }
    WG_BAR();
    if (!(DP_SKIP & 2)) {
        const int wh = wave >> 2, mb = wave & 3, c = lane & 15, g4 = lane >> 4;
        const LAS float* Am = wh ? Qs : Ks;
        f32x4 acc[4];
#pragma unroll
        for (int nb = 0; nb < 4; ++nb) acc[nb] = (f32x4){0.f, 0.f, 0.f, 0.f};
#pragma unroll
        for (int ks = 0; ks < 4; ++ks) {
            float av[8]; { const LAS float* p = Am + (16 * mb + c) * DP_PITCH + 32 * ks + 8 * g4; const f32x4 a = *(const LAS f32x4*)p, b = *(const LAS f32x4*)(p + 4);
                av[0] = a.x; av[1] = a.y; av[2] = a.z; av[3] = a.w; av[4] = b.x; av[5] = b.y; av[6] = b.z; av[7] = b.w; }
            const bf16x8 af = pack8(av);
#pragma unroll
            for (int nb = 0; nb < 4; ++nb) { float bv[8]; const LAS float* p = Ks + (16 * nb + c) * DP_PITCH + 32 * ks + 8 * g4; const f32x4 a = *(const LAS f32x4*)p, b = *(const LAS f32x4*)(p + 4);
                bv[0] = a.x; bv[1] = a.y; bv[2] = a.z; bv[3] = a.w; bv[4] = b.x; bv[5] = b.y; bv[6] = b.z; bv[7] = b.w;
                acc[nb] = mfma16(af, pack8(bv), acc[nb]); }
        }
        if (wh == 0) {
#pragma unroll
            for (int d = 0; d < 2; ++d) { const LAS float* Gd = Gs + d * 64; const LAS float* Bd = Bs + d * 64; LAS float* Ld = Ls + d * 4096;
#pragma unroll
                for (int r = 0; r < 4; ++r) { const int i = 16 * mb + 4 * g4 + r, s = d ? 63 - i : i; const float gs = Gd[s], bs = Bd[s];
#pragma unroll
                    for (int nb = 0; nb < 4; ++nb) { const int ip = 16 * nb + c, sp = d ? 63 - ip : ip;
                        Ld[s * 64 + sp] = s > sp ? bs * acc[nb][r] * __expf(gs - Gd[sp]) : 0.f; } } }
        } else {
#pragma unroll
            for (int d = 0; d < 2; ++d) { const LAS float* Gd = Gs + d * 64; LAS bf16* Qd = QKi + d * 4096;
#pragma unroll
                for (int r = 0; r < 4; ++r) { const int i = 16 * mb + 4 * g4 + r, s = d ? 63 - i : i; const float gs = Gd[s];
#pragma unroll
                    for (int nb = 0; nb < 4; ++nb) { const int ip = 16 * nb + c, sp = d ? 63 - ip : ip;
                        const float qk = s >= sp ? acc[nb][r] * __expf(gs - Gd[sp]) : 0.f;
                        const int lp = ((sp & 15) >> 2) * 16 + (s & 15), jp = 4 * ((sp >> 4) & 1) + (sp & 3);
                        Qd[(((s >> 4) * 2 + (sp >> 5)) * 64 + lp) * 8 + jp] = (bf16)f2bf(qk); } } }
        }
    }
    WG_BAR();
    if (!(DP_SKIP & 4)) {
        const int d = tid >> 8, col = tid & 255;
        float X[64];
        const LAS float* src = col < 128 ? Vs + col : Ks + (col - 128);
        const LAS float* Bd = Bs + d * 64; const LAS float* Ed = EGs + d * 64;
        if (d == 0) {
#pragma unroll
            for (int s = 0; s < 64; ++s) { const float sc = col < 128 ? Bd[s] : Bd[s] * Ed[s]; X[s] = sc * src[s * DP_PITCH]; if ((s & 7) == 7) asm volatile("" ::: "memory"); }
        } else {
#pragma unroll
            for (int s = 0; s < 64; ++s) { const float sc = col < 128 ? Bd[s] : Bd[s] * Ed[s]; X[s] = sc * src[(63 - s) * DP_PITCH]; if ((s & 7) == 7) asm volatile("" ::: "memory"); }
        }
        WG_BAR();
        const LAS float* Ld = Ls + d * 4096;
#pragma unroll
        for (int s = 1; s < 64; ++s) { float a0 = X[s], a1 = 0.f, a2 = 0.f, a3 = 0.f;
#pragma unroll
            for (int j4 = 0; j4 < (s + 3) / 4; ++j4) { const f32x4 lv = *(const LAS f32x4*)(Ld + s * 64 + 4 * j4);
                if (4 * j4 + 0 < s) a0 -= lv.x * X[4 * j4 + 0];
                if (4 * j4 + 1 < s) a1 -= lv.y * X[4 * j4 + 1];
                if (4 * j4 + 2 < s) a2 -= lv.z * X[4 * j4 + 2];
                if (4 * j4 + 3 < s) a3 -= lv.w * X[4 * j4 + 3]; }
            X[s] = (a0 + a1) + (a2 + a3); asm volatile("" ::: "memory"); }
        const int cid = d ? cbase + (nch - 1 - nloc) : cidx; const size_t rec = dn_rec(d, cid, h);
        if (col < 128) { f32x4* up = (f32x4*)(WSP(float, WS_DNU) + (rec * 128 + col) * 64);
#pragma unroll
            for (int q = 0; q < 16; ++q) up[q] = (f32x4){X[4 * q], X[4 * q + 1], X[4 * q + 2], X[4 * q + 3]}; }
        else { const int dk = col - 128, ks = dk >> 5, q = dk & 31, j = 4 * (q >> 4) + (q & 3), g4 = (q & 15) >> 2;
            LAS bf16* Wi = (LAS bf16*)(C.lds + DP_V) + d * 8192;
#pragma unroll
            for (int s = 0; s < 64; ++s) Wi[(((s >> 4) * 4 + ks) * 64 + g4 * 16 + (s & 15)) * 8 + j] = (bf16)f2bf(X[s]); }
    }
    WG_BAR();
    if (!(DP_SKIP & 8)) {
        for (int ci = tid; ci < 2048; ci += NTHR) { const int d = ci >> 10, cc = ci & 1023; const int cid = d ? cbase + (nch - 1 - nloc) : cidx;
            ((u32x4*)(WSP(unsigned char, WS_DNW) + dn_rec(d, cid, h) * 16384))[cc] = ((const LAS u32x4*)(C.lds + DP_V + d * 16384))[cc]; }
        for (int ci = tid; ci < 1024; ci += NTHR) { const int d = ci >> 9, cc = ci & 511; const int cid = d ? cbase + (nch - 1 - nloc) : cidx;
            ((u32x4*)(WSP(unsigned char, WS_DNQK) + dn_rec(d, cid, h) * 8192))[cc] = ((const LAS u32x4*)(C.lds + DP_QK + d * 8192))[cc]; }
        for (int ci = tid; ci < 2048; ci += NTHR) { const int d = ci >> 10, cc = ci & 1023, mb = cc >> 8, ks = (cc >> 6) & 3, lp = cc & 63, c = lp & 15, g4 = lp >> 4;
            const int s = 16 * mb + c, i = d ? 63 - s : s; const float e = EGs[d * 64 + s];
            const LAS float* p = Qs + i * DP_PITCH + 32 * ks + 4 * g4; const f32x4 a = *(const LAS f32x4*)p, b = *(const LAS f32x4*)(p + 16);
            float v[8] = {a.x * e, a.y * e, a.z * e, a.w * e, b.x * e, b.y * e, b.z * e, b.w * e};
            const int cid = d ? cbase + (nch - 1 - nloc) : cidx;
            ((bf16x8*)(WSP(unsigned char, WS_DNQG) + dn_rec(d, cid, h) * 16384))[cc] = pack8(v); }
        for (int ci = tid; ci < 2048; ci += NTHR) { const int d = ci >> 10, cc = ci & 1023, tt = cc >> 7, ks2 = (cc >> 6) & 1, lp = cc & 63, c = lp & 15, g4 = lp >> 4;
            float v[8];
#pragma unroll
            for (int j = 0; j < 8; ++j) { const int s = 32 * ks2 + 16 * (j >> 2) + 4 * g4 + (j & 3), i = d ? 63 - s : s; v[j] = Ks[i * DP_PITCH + 16 * tt + c] * EGRs[d * 64 + s]; }
            const int cid = d ? cbase + (nch - 1 - nloc) : cidx;
            ((bf16x8*)(WSP(unsigned char, WS_DNKDT) + dn_rec(d, cid, h) * 16384))[cc] = pack8(v); }
    }
    WG_BAR();
}

constexpr int SG_VT = 0, SG_VPITCH = 136;
__device__ __forceinline__ void sg_unit(Ctx& C, int l, int cb, int h) {
    LAS bf16* vT = (LAS bf16*)(C.lds + SG_VT);
    const bf16* P = WSP(bf16, WS_P); bf16* Y = WSP(bf16, WS_Y);
    const int lane = C.lane, wave = C.wave, r0 = cb * 128;
    const float* lg = INP(12) + l * 512; const float* lb = INP(13) + l * 512;
    for (int q = 0; q < 16; ++q) { const int j = 16 * wave + q; float v[8];
        unpack8(*(const u32x4*)(P + (size_t)(r0 + j) * NIN + PSGV + 8 * lane), v);
        float s = 0.f;
#pragma unroll
        for (int c = 0; c < 8; ++c) { v[c] = gelu_tanh(v[c]); s += v[c]; }
        const float mu = wave_sum(s) * (1.f / 512.f); float s2 = 0.f;
#pragma unroll
        for (int c = 0; c < 8; ++c) { v[c] -= mu; s2 += v[c] * v[c]; }
        const float rs = rsqrtf(wave_sum(s2) * (1.f / 512.f) + EPS);
        if ((lane >> 4) == h) { const int d0 = 8 * (lane & 15);
#pragma unroll
            for (int c = 0; c < 8; ++c) vT[(d0 + c) * SG_VPITCH + j] = (bf16)f2bf(v[c] * rs * lg[128 * h + d0 + c] + lb[128 * h + d0 + c]); } }
    WG_BAR();
    const int c = lane & 15, g4 = lane >> 4;
    const float* W = INP(14) + ((size_t)(l * 4 + h) * 128 + 16 * wave + c) * 128;
    f32x4 acc[8];
#pragma unroll
    for (int nb = 0; nb < 8; ++nb) acc[nb] = (f32x4){0.f, 0.f, 0.f, 0.f};
#pragma unroll
    for (int ks = 0; ks < 4; ++ks) { const f32x4 a = *(const f32x4*)(W + 32 * ks + 8 * g4), b = *(const f32x4*)(W + 32 * ks + 8 * g4 + 4);
        float av[8] = {a.x, a.y, a.z, a.w, b.x, b.y, b.z, b.w}; const bf16x8 af = pack8(av);
#pragma unroll
        for (int nb = 0; nb < 8; ++nb) { const bf16x8 bfr = *(const LAS bf16x8*)(vT + (16 * nb + c) * SG_VPITCH + 32 * ks + 8 * g4); acc[nb] = mfma16(af, bfr, acc[nb]); } }
    const float* bs = INP(15) + (l * 4 + h) * 128;
#pragma unroll
    for (int r = 0; r < 4; ++r) { const int i = 16 * wave + 4 * g4 + r; const float bi = bs[i]; const size_t row = (size_t)(r0 + i);
#pragma unroll
        for (int nb = 0; nb < 8; ++nb) { const int d = 16 * nb + c; const float u = gelu_tanh(bf2f(P[row * NIN + PSGU + 128 * h + d]));
            Y[row * D + 512 + 128 * h + d] = (bf16)f2bf(u * (acc[nb][r] + bi)); } }
    WG_BAR();
}

__device__ __forceinline__ void pool_unit(Ctx& C, int l, int cidx, int g) {
    const bf16* P = WSP(bf16, WS_P); bf16* Y = WSP(bf16, WS_Y); const bf16* PW = WSP(bf16, WS_PWT) + (size_t)(l * 4 + g) * 128 * 128;
    const int lane = C.lane, wave = C.wave, c = lane & 15, g4 = lane >> 4, mb = wave & 3, nh = wave >> 2;
    const int r0 = cidx * 64; int sbase, T, t0, mv; rowinfo(r0, sbase, T, t0, mv);
    const int t = t0 + 16 * mb + c, hw = 1 << g;
    const int lo = t - hw < 0 ? 0 : t - hw, hi = t + hw > T ? T : t + hw; const float inv = 1.f / (float)(hi - lo);
    f32x4 acc[4];
#pragma unroll
    for (int nb = 0; nb < 4; ++nb) acc[nb] = (f32x4){0.f, 0.f, 0.f, 0.f};
#pragma unroll
    for (int ks = 0; ks < 4; ++ks) { const bf16* pc = P + PPOOL + 128 * g + 32 * ks + 8 * g4; float s[8] = {0, 0, 0, 0, 0, 0, 0, 0}, x[8];
        for (int tt = lo; tt < hi; ++tt) { float v[8]; unpack8(*(const u32x4*)(pc + (size_t)(sbase + tt) * NIN), v);
#pragma unroll
            for (int q = 0; q < 8; ++q) s[q] += v[q]; }
        unpack8(*(const u32x4*)(pc + (size_t)(sbase + t) * NIN), x);
#pragma unroll
        for (int q = 0; q < 8; ++q) s[q] = s[q] * inv - x[q];
        const bf16x8 af = pack8(s);
#pragma unroll
        for (int nb = 0; nb < 4; ++nb) { const bf16x8 bfr = *(const bf16x8*)(PW + (size_t)(16 * (4 * nh + nb) + c) * 128 + 32 * ks + 8 * g4); acc[nb] = mfma16(af, bfr, acc[nb]); } }
    const float* psc = INP(17) + l * 512 + 128 * g;
#pragma unroll
    for (int nb = 0; nb < 4; ++nb) { const int e = 16 * (4 * nh + nb) + c; const float sc = psc[e];
#pragma unroll
        for (int r = 0; r < 4; ++r) Y[(size_t)(r0 + 16 * mb + 4 * g4 + r) * D + 1024 + 128 * g + e] = (bf16)f2bf(acc[nb][r] * sc); }
}

__device__ __forceinline__ void conf_unit(Ctx& C, int l, int cidx, int cq) {
    const bf16* P = WSP(bf16, WS_P); float* H = WSP(float, WS_CVH);
    const int ch = 128 * cq + (C.tid & 127), grp = C.tid >> 7, r0 = cidx * 64; int sbase, T, t0, mv; rowinfo(r0, sbase, T, t0, mv);
    float w[31];
#pragma unroll
    for (int k = 0; k < 31; ++k) w[k] = INP(18)[((size_t)l * 31 + k) * 512 + ch];
    const float cb = INP(19)[l * 512 + ch];
    float glu[46];
#pragma unroll
    for (int q = 0; q < 46; ++q) { const int t = t0 + 16 * grp + q - 15; float v = 0.f;
        if (t >= 0 && t < T) { const bf16* pr = P + (size_t)(sbase + t) * NIN; v = bf2f(pr[PCVA + ch]) * sigm(bf2f(pr[PCVG + ch])); }
        glu[q] = v; }
#pragma unroll
    for (int i = 0; i < 16; ++i) { float a = cb;
#pragma unroll
        for (int k = 0; k < 31; ++k) a += w[k] * glu[i + k];
        H[(size_t)(r0 + 16 * grp + i) * 512 + ch] = a; }
}

__device__ __forceinline__ void p_mixers(Ctx& C, int l) {
    const int nchk = l == 0 ? NCH : MX / 64;
    for (int u = C.bid; u < NCH * 4; u += C.G) dnprep_unit(C, l, u >> 2, u & 3);
}
__device__ __forceinline__ void p_mixers_bcd(Ctx& C, int l, int vb, int nb) {
    const int nchk = l == 0 ? NCH : MX / 64;
    const int o2 = (nchk * 4) % nb, o3 = (o2 + (nchk / 2) * 4) % nb;
    for (int u = vb; u < nchk * 4; u += nb) conf_unit(C, l, u >> 2, u & 3);
    for (int u = (vb + nb - o2) % nb; u < (nchk / 2) * 4; u += nb) sg_unit(C, l, u >> 2, u & 3);
    for (int u = (vb + nb - o3) % nb; u < nchk * 4; u += nb) pool_unit(C, l, u >> 2, u & 3);
}

constexpr int SC_SLOT = 58368, SC_U = 2 * SC_SLOT;
static_assert(SC_U + 32768 <= LDS_BARW, "scan LDS map");
__device__ __forceinline__ void p_scan(Ctx& C, int l) {
    if (C.bid >= 32) { if (C.G > 32) p_mixers_bcd(C, l, C.bid - 32, C.G - 32); return; }
    const int b = C.bid >> 3, h = (C.bid >> 1) & 3, dir = C.bid & 1, lane = C.lane, w = C.wave, c = lane & 15, g4 = lane >> 4;
    float* O = WSP(float, WS_O) + (size_t)dir * MT * 512;
    f32x4 S[8];
#pragma unroll
    for (int t = 0; t < 8; ++t) S[t] = (f32x4){0.f, 0.f, 0.f, 0.f};
    auto rec_of = [&](int st) -> size_t { const int rb = st < 4 ? MX + b * TC : b * TX, n = st < 4 ? st : st - 4; return dn_rec(dir, (rb >> 6) + n, h); };
#define SC_ISSUE(st_, SL) do { const size_t rec_ = rec_of(st_); \
        _Pragma("unroll") for (int q = 0; q < 7; ++q) { const int ch = w + 8 * q; \
            const unsigned char* src = ch < 16 ? WSP(unsigned char, WS_DNW) + rec_ * 16384 + ch * 1024 : ch < 32 ? WSP(unsigned char, WS_DNQG) + rec_ * 16384 + (ch - 16) * 1024 \
                                     : ch < 48 ? WSP(unsigned char, WS_DNKDT) + rec_ * 16384 + (ch - 32) * 1024 : WSP(unsigned char, WS_DNQK) + rec_ * 8192 + (ch - 48) * 1024; \
            __builtin_amdgcn_global_load_lds((const unsigned*)(src + lane * 16), (LAS unsigned*)(C.lds + (SL) * SC_SLOT + w * 1024 + q * 8192), 16, 0, 0); } \
        if (w == 0) __builtin_amdgcn_global_load_lds((const unsigned*)(WSP(unsigned char, WS_EGL) + rec_ * 16), (LAS unsigned*)(C.lds + (SL) * SC_SLOT + 57344), 16, 0, 0); } while (0)
#define SC_ISSUE_U(st_) do { const float* Ut_ = WSP(float, WS_DNU) + (rec_of(st_) * 128 + 16 * w + c) * 64 + 4 * g4; \
        _Pragma("unroll") for (int mb = 0; mb < 4; ++mb) __builtin_amdgcn_global_load_lds((const unsigned*)(Ut_ + 16 * mb), (LAS unsigned*)(C.lds + SC_U + w * 4096 + mb * 1024), 16, 0, 0); } while (0)
#define SC_STEP(st_, SL) do { const int st = (st_); \
        if (st == 0) asm volatile("s_waitcnt vmcnt(0)" ::: "memory"); else asm volatile("s_waitcnt vmcnt(16)" ::: "memory"); \
        __builtin_amdgcn_s_barrier(); asm volatile("" ::: "memory"); \
        if (st + 1 < 36) SC_ISSUE(st + 1, 1 - (SL)); \
        const LAS bf16x8* Wf = (const LAS bf16x8*)(C.lds + (SL) * SC_SLOT) + lane; const LAS bf16x8* QGf = Wf + 1024; const LAS bf16x8* KDf = Wf + 2048; const LAS bf16x8* QKf = Wf + 3072; \
        const float egl = *(const LAS float*)(C.lds + (SL) * SC_SLOT + 57344); \
        const int rbase = st < 4 ? MX + b * TC + 64 * st : b * TX + 64 * (st - 4); \
        bf16x8 Sb[4]; \
        _Pragma("unroll") for (int ks = 0; ks < 4; ++ks) { float v[8] = {S[2 * ks][0], S[2 * ks][1], S[2 * ks][2], S[2 * ks][3], S[2 * ks + 1][0], S[2 * ks + 1][1], S[2 * ks + 1][2], S[2 * ks + 1][3]}; Sb[ks] = pack8(v); } \
        f32x4 vn[4], oacc[4]; \
        _Pragma("unroll") for (int mb = 0; mb < 4; ++mb) { f32x4 a = (f32x4){0.f, 0.f, 0.f, 0.f}, o = (f32x4){0.f, 0.f, 0.f, 0.f}; \
            _Pragma("unroll") for (int ks = 0; ks < 4; ++ks) { a = mfma16(Wf[(mb * 4 + ks) * 64], Sb[ks], a); o = mfma16(QGf[(mb * 4 + ks) * 64], Sb[ks], o); } \
            vn[mb] = *(const LAS f32x4*)(C.lds + SC_U + w * 4096 + mb * 1024 + lane * 16) - a; oacc[mb] = o; } \
        asm volatile("s_waitcnt lgkmcnt(0)" ::: "memory"); __builtin_amdgcn_s_barrier(); asm volatile("" ::: "memory"); \
        if (st + 1 < 36) SC_ISSUE_U(st + 1); \
        bf16x8 Vb[2]; \
        _Pragma("unroll") for (int k2 = 0; k2 < 2; ++k2) { float v[8] = {vn[2 * k2][0], vn[2 * k2][1], vn[2 * k2][2], vn[2 * k2][3], vn[2 * k2 + 1][0], vn[2 * k2 + 1][1], vn[2 * k2 + 1][2], vn[2 * k2 + 1][3]}; Vb[k2] = pack8(v); } \
        _Pragma("unroll") for (int t = 0; t < 8; ++t) { f32x4 a = S[t] * egl; \
            _Pragma("unroll") for (int k2 = 0; k2 < 2; ++k2) a = mfma16(KDf[(t * 2 + k2) * 64], Vb[k2], a); \
            S[t] = a; } \
        _Pragma("unroll") for (int mb = 0; mb < 4; ++mb) { \
            _Pragma("unroll") for (int k2 = 0; k2 < 2; ++k2) oacc[mb] = mfma16(QKf[(mb * 2 + k2) * 64], Vb[k2], oacc[mb]); \
            _Pragma("unroll") for (int r = 0; r < 4; ++r) O[(size_t)(rbase + 16 * mb + 4 * g4 + r) * 512 + 128 * h + 16 * w + c] = oacc[mb][r]; } } while (0)
    SC_ISSUE(0, 0); SC_ISSUE_U(0);
#pragma unroll 1
    for (int s2 = 0; s2 < 36; s2 += 2) { SC_STEP(s2, 0); SC_STEP(s2 + 1, 1); }
    asm volatile("s_waitcnt vmcnt(0)" ::: "memory");
#undef SC_ISSUE
#undef SC_ISSUE_U
#undef SC_STEP
}

__device__ __forceinline__ void p_ghn(Ctx& C, int l) {
    const int nrows = l == 0 ? MT : MX, lane = C.lane; const float* O = WSP(float, WS_O); const bf16* P = WSP(bf16, WS_P); bf16* Y = WSP(bf16, WS_Y);
    const float* gn = INP(11) + l * 128 + 8 * (lane & 15);
    for (int row = C.bid * NWAVE + C.wave; row < nrows; row += C.G * NWAVE) {
        const int rb = dirrow(row, 1);
        const f32x4* pf = (const f32x4*)(O + (size_t)row * 512 + 8 * lane); const f32x4* pb = (const f32x4*)(O + ((size_t)MT + rb) * 512 + 8 * lane);
        const f32x4 a = pf[0] + pb[0], b2 = pf[1] + pb[1];
        float o[8] = {a.x, a.y, a.z, a.w, b2.x, b2.y, b2.z, b2.w}, z[8]; float ss = 0.f;
#pragma unroll
        for (int c = 0; c < 8; ++c) ss += o[c] * o[c];
        const float rs = rsqrtf(sum16(ss) * (1.f / 128.f) + EPS);
        unpack8(*(const u32x4*)(P + (size_t)row * NIN + PZ + 8 * lane), z);
#pragma unroll
        for (int c = 0; c < 8; ++c) o[c] = o[c] * rs * gn[c] * silu(z[c]);
        *(bf16x8*)(Y + (size_t)row * D + 8 * lane) = pack8(o);
        { const float* hp = WSP(float, WS_CVH) + (size_t)row * 512 + 8 * lane; const f32x4 a = *(const f32x4*)hp, b2 = *(const f32x4*)(hp + 4);
          float v[8] = {a.x, a.y, a.z, a.w, b2.x, b2.y, b2.z, b2.w}; float s = 0.f;
#pragma unroll
          for (int c = 0; c < 8; ++c) s += v[c];
          const float mu = wave_sum(s) * (1.f / 512.f); float s2 = 0.f;
#pragma unroll
          for (int c = 0; c < 8; ++c) { v[c] -= mu; s2 += v[c] * v[c]; }
          const float rs = rsqrtf(wave_sum(s2) * (1.f / 512.f) + EPS);
          const float* lg = INP(20) + l * 512 + 8 * lane; const float* lb = INP(21) + l * 512 + 8 * lane;
#pragma unroll
          for (int c = 0; c < 8; ++c) v[c] = silu(v[c] * rs * lg[c] + lb[c]);
          *(bf16x8*)(Y + (size_t)row * D + 1536 + 8 * lane) = pack8(v); }
    }
}

__device__ __forceinline__ void p_moe_gather(Ctx& C) {
    int* R = WSP(int, WS_ROUTE); const unsigned* ctl = WSP(unsigned, WS_CTL);
    LAS int* offs = (LAS int*)C.lds;
    if (C.tid == 0) { int o = 0, nt = 0;
        for (int e = 0; e < 8; ++e) { const int cnt = (int)ctl[CW_CNT + 64 * e], tl = (cnt + 255) >> 8; offs[e] = o;
            if (C.bid == 0) for (int q = 0; q < tl; ++q) R[R_TILEE + nt + q] = e;
            nt += tl; o += tl << 8; }
        if (C.bid == 0) R[R_NT] = nt; }
    WG_BAR();
    const bf16* AN = WSP(bf16, WS_AN); bf16* AS = WSP(bf16, WS_AS);
    for (int tok = C.bid * NWAVE + C.wave; tok < MX; tok += C.G * NWAVE) {
        const int p0 = offs[R[R_TE + 2 * tok]] + R[R_RANK + 2 * tok], p1 = offs[R[R_TE + 2 * tok + 1]] + R[R_RANK + 2 * tok + 1];
        if (C.lane == 0) { R[R_POS + 2 * tok] = p0; R[R_POS + 2 * tok + 1] = p1; }
        if (MOE_FP8) {
            const u32x4* src = (const u32x4*)(AN + (size_t)tok * D) + 4 * C.lane; float f[32];
#pragma unroll
            for (int j = 0; j < 4; ++j) unpack8(src[j], f + 8 * j);
            u32x4 o[2];
#pragma unroll
            for (int j = 0; j < 2; ++j) { const float* q = f + 16 * j;
                o[j].x = pk4_fp8(clamp448(q[0]), clamp448(q[1]), clamp448(q[2]), clamp448(q[3])); o[j].y = pk4_fp8(clamp448(q[4]), clamp448(q[5]), clamp448(q[6]), clamp448(q[7]));
                o[j].z = pk4_fp8(clamp448(q[8]), clamp448(q[9]), clamp448(q[10]), clamp448(q[11])); o[j].w = pk4_fp8(clamp448(q[12]), clamp448(q[13]), clamp448(q[14]), clamp448(q[15])); }
            u32x4* d0 = (u32x4*)((unsigned char*)AS + (size_t)p0 * D) + 2 * C.lane; u32x4* d1 = (u32x4*)((unsigned char*)AS + (size_t)p1 * D) + 2 * C.lane;
            d0[0] = o[0]; d0[1] = o[1]; d1[0] = o[0]; d1[1] = o[1];
        } else {
        const u32x4* src = (const u32x4*)(AN + (size_t)tok * D) + C.lane; u32x4* d0 = (u32x4*)(AS + (size_t)p0 * D) + C.lane; u32x4* d1 = (u32x4*)(AS + (size_t)p1 * D) + C.lane;
#pragma unroll
        for (int j = 0; j < 4; ++j) { u32x4 v = src[64 * j];
            if (FP8_EMU) { float f[8]; unpack8(v, f);
#pragma unroll
                for (int q = 0; q < 8; ++q) f[q] = rne_e4m3(f[q]);
                v = __builtin_bit_cast(u32x4, pack8(f)); }
            d0[64 * j] = v; d1[64 * j] = v; } }
    }
}

__device__ __forceinline__ void p_final(Ctx& C, float* out) {
    const int* R = WSP(int, WS_ROUTE); const float* Rf = WSP(float, WS_ROUTE); const float* XS = WSP(float, WS_XS); const float* OS = WSP(float, WS_OUTS);
    const float* mod = WSP(float, WS_MODV) + (size_t)5 * 12288; const int lane = C.lane;
    for (int tok = C.bid * NWAVE + C.wave; tok < MX; tok += C.G * NWAVE) {
        const int p0 = R[R_POS + 2 * tok], p1 = R[R_POS + 2 * tok + 1]; const float g0 = Rf[R_TG + 2 * tok], g1 = Rf[R_TG + 2 * tok + 1];
        const f32x4* xp = (const f32x4*)(XS + (size_t)tok * D) + lane; const f32x4* o0 = (const f32x4*)(OS + (size_t)p0 * D) + lane; const f32x4* o1 = (const f32x4*)(OS + (size_t)p1 * D) + lane;
        const f32x4* gf = (const f32x4*)(mod + (size_t)(tok >> 11) * 12288 + 10240) + lane; const f32x4* fg = (const f32x4*)INP(32) + lane;
        f32x4 x[8]; float ss = 0.f;
        f32x4 e0[8], e1[8];
        if (p0 < 16384) {
#pragma unroll
            for (int j = 0; j < 8; ++j) e0[j] = o0[64 * j];
        } else { const f32x4* q = (const f32x4*)(WSP(float, WS_PARTO) + (size_t)(p0 - 16384) * D) + lane;
#pragma unroll
            for (int j = 0; j < 8; ++j) e0[j] = (q[64 * j] + q[64 * j + (size_t)2048 * 512]) + (q[64 * j + (size_t)2 * 2048 * 512] + q[64 * j + (size_t)3 * 2048 * 512]); }
        if (p1 < 16384) {
#pragma unroll
            for (int j = 0; j < 8; ++j) e1[j] = o1[64 * j];
        } else { const f32x4* q = (const f32x4*)(WSP(float, WS_PARTO) + (size_t)(p1 - 16384) * D) + lane;
#pragma unroll
            for (int j = 0; j < 8; ++j) e1[j] = (q[64 * j] + q[64 * j + (size_t)2048 * 512]) + (q[64 * j + (size_t)2 * 2048 * 512] + q[64 * j + (size_t)3 * 2048 * 512]); }
#pragma unroll
        for (int j = 0; j < 8; ++j) { x[j] = xp[64 * j] + gf[64 * j] * (e0[j] * g0 + e1[j] * g1); ss += (x[j].x * x[j].x + x[j].y * x[j].y) + (x[j].z * x[j].z + x[j].w * x[j].w); }
        const float rs = rsqrtf(wave_sum(ss) * (1.f / D) + EPS);
        f32x4* op = (f32x4*)(out + (size_t)tok * D) + lane;
#pragma unroll
        for (int j = 0; j < 8; ++j) op[64 * j] = x[j] * rs * fg[64 * j];
    }
}
}
namespace mk {
constexpr int NPHASE = 21;
struct Args { const float* in[33]; float* out; unsigned char* ws; int ph_lo, ph_hi; };
static_assert(sizeof(Args) == 35 * 8 + 8, "Args has no padding");

#ifdef ONLY_PHASE
#define IN(k) ((k) == ONLY_PHASE)
#else
#define IN(k) (lo <= (k) && (k) < hi)
#endif
__device__ __forceinline__ constexpr int bg_need(int k) { return k >= 18 ? NBG : k >= 15 ? BG_MOE : k >= 11 ? BG_WOUT1 : k >= 9 ? BG_WIN1 : k >= 8 ? BG_W2 : k >= 6 ? BG_W13 : 0; }
#ifndef BG_FILL_MASK
#define BG_FILL_MASK ((1 << 2) | (1 << 4) | (1 << 6) | (1 << 8) | (1 << 9) | (1 << 11) | (1 << 13))
#endif
#define SEAM(k) do { if (IN(k) && IN((k) + 1)) { if (BG_QUEUE) bg_work(C, bg_need((k) + 1), ((BG_FILL_MASK >> (k)) & 1) ? (k) : -1); xcd_barrier(bar); } } while (0)
constexpr int NMOE = 16 * IT_MW1 + 8 * IT_MW2;
#ifndef FILL_R
#define FILL_R 25, 0, 2, 65, 10, 25, 0
#endif
#ifndef FILL_R2
#define FILL_R2 16, 16
#endif
constexpr int fill_rounds[7] = {FILL_R}; constexpr int fill_rounds2[2] = {FILL_R2};
constexpr int FB2 = 228, FB4 = 32, FB6 = 128, FB8 = 227, FB9 = 128, FB11 = 212, FB13 = 32;
constexpr int FN2 = fill_rounds[0] * (256 - FB2) * 8, FN4 = fill_rounds[1] * (256 - FB4) * 8, FN6 = fill_rounds[2] * (256 - FB6) * 8, FN8 = fill_rounds[3] * (256 - FB8) * 8,
              FN9 = fill_rounds[4] * (256 - FB9) * 8, FN11 = fill_rounds[5] * (256 - FB11) * 8;
constexpr int FS2 = 0, FS4 = FS2 + FN2, FS6 = FS4 + FN4, FS8 = FS6 + FN6, FS9 = FS8 + FN8, FS11 = FS9 + FN9, FS13 = FS11 + FN11, FN13 = fill_rounds[6] * (256 - FB13) * 8 < NMOE - FS13 ? fill_rounds[6] * (256 - FB13) * 8 : NMOE - FS13, FS3 = FS13 + FN13, FN3 = fill_rounds2[0] * 192 * 8 < NMOE - FS3 ? fill_rounds2[0] * 192 * 8 : NMOE - FS3, FS12 = FS3 + FN3, FN12 = fill_rounds2[1] * 192 * 8 < NMOE - FS12 ? fill_rounds2[1] * 192 * 8 : NMOE - FS12, FS17 = FS12 + FN12, FN17 = NMOE - FS17;
static_assert(FN13 >= 0 && FN17 >= 0, "fill schedule exceeds the MoE items");
template <int l>
__device__ __forceinline__ void layer_body(Ctx& C, const XcdBarrier& bar, const int lo, const int hi) {
        const int pb = l == 0 ? 1 : 10;
        const float* mod = WSP(float, WS_MODV) + (size_t)l * 5 * 12288;
        if (IN(pb + 0)) { if constexpr (l == 0) p_norm<0>(C, 0); else p_norm<1>(C, 1); } SEAM(pb + 0);
        if (IN(pb + 1)) {
            pg8::EpiStoreBf16 E{WSP(bf16, WS_P), NIN, WSP(float, WS_ABF)};
            pg8::Gemm g{WSP(bf16, WS_AN), WSP(bf16, WS_WIN) + (size_t)l * NINP * D, MT, NINP, D};
            const bool ded = STATIC_FILL && C.G == 256;
            if constexpr (l == 0) { if (!ded || C.bid < FB2) { pg8::StaticOrder S; S.init(MT, NINP, ded ? FB2 : C.G, C.bid); pg8::gemm_phase<pg8::EpiStoreBf16, pg8::StaticOrder, true, true>(C.lds, g, S, E); }
                fill_static(C, FS2, FN2, FB2); }
            else { if (!ded || C.bid < FB11) { pg8::InProjL1Order S; S.init(ded ? FB11 : C.G, C.bid); pg8::gemm_phase<pg8::EpiStoreBf16, pg8::InProjL1Order, true, true>(C.lds, g, S, E); }
                fill_static(C, FS11, FN11, FB11); }
        } SEAM(pb + 1);
        if (IN(pb + 2)) { p_mixers(C, l); if constexpr (l == 0) fill_static(C, FS3, FN3, 64); else fill_static(C, FS12, FN12, 64); } SEAM(pb + 2);
        if (IN(pb + 3)) { p_scan(C, l); if constexpr (l == 0) fill_static(C, FS4, FN4, FB4); else fill_static(C, FS13, FN13, FB13); } SEAM(pb + 3);
        if (IN(pb + 4)) { p_ghn(C, l); } SEAM(pb + 4);
        if (IN(pb + 5)) {
            pg8::EpiResid E{WSP(float, WS_XS), mod, 4096, WSP(float, WS_PART), D / 4};
            pg8::Gemm g{WSP(bf16, WS_Y), WSP(bf16, WS_WOUT) + (size_t)l * D * D, l == 0 ? MT : MX, D, D};
            if constexpr (l == 0) { pg8::ResidOrder S; S.init(D, C.G, C.bid); pg8::gemm_phase<pg8::EpiResid, pg8::ResidOrder, true, true>(C.lds, g, S, E); fill_static(C, FS6, FN6, FB6); }
            else { pg8::StaticOrder S; S.init(MX, D, C.G, C.bid); pg8::gemm_phase<pg8::EpiResid, pg8::StaticOrder, true, true>(C.lds, g, S, E); }
        } SEAM(pb + 5);
        if (IN(pb + 6)) { if constexpr (l == 0) p_norm<2>(C, 0); else p_norm<3>(C, 1); } SEAM(pb + 6);
        if constexpr (l == 0) {
            if (IN(8)) {
                pg8::EpiSwiglu E{WSP(bf16, WS_HM), DFF, 1 << 20};
                pg8::Gemm g{WSP(bf16, WS_AN), WSP(bf16, WS_W13), MT, 2 * DFF, D};
                const bool ded = STATIC_FILL && C.G == 256;
                if (!ded || C.bid < FB8) { pg8::StaticOrder S; S.init(MT, 2 * DFF, ded ? FB8 : C.G, C.bid); pg8::gemm_phase<pg8::EpiSwiglu, pg8::StaticOrder, true, true>(C.lds, g, S, E); }
                fill_static(C, FS8, FN8, FB8);
            } SEAM(8);
            if (IN(9)) {
                pg8::EpiResid E{WSP(float, WS_XS), mod, 10240, WSP(float, WS_PART), DFF / 4};
                pg8::Gemm g{WSP(bf16, WS_HM), WSP(bf16, WS_W2), MT, D, DFF};
                pg8::ResidOrder S; S.init(DFF, C.G, C.bid);
                pg8::gemm_phase<pg8::EpiResid, pg8::ResidOrder, true, true>(C.lds, g, S, E);
                fill_static(C, FS9, FN9, FB9);
            } SEAM(9);
        } else {
            if (IN(17)) { p_moe_gather(C); fill_static(C, FS17, FN17, 0); } SEAM(17);
            if (IN(18)) {
                const int* R = WSP(int, WS_ROUTE);
                pg8::MoeOrder S; S.init(R[R_NT], 56, R + R_TILEE, C.G, C.bid);
                if (MOE_FP8) { pg8::EpiSwiglu8 E{WSP(unsigned char, WS_HM), DFE, 56};
                    pg8::Gemm g{WSP(bf16, WS_AS), WSP(bf16, WS_MW13), MSORT, 2 * DFE * NE, D / 2};
                    pg8::gemm_phase<pg8::EpiSwiglu8, pg8::MoeOrder, true, true, true>(C.lds, g, S, E); }
                else { pg8::EpiSwiglu E{WSP(bf16, WS_HM), DFE, 56};
                    pg8::Gemm g{WSP(bf16, WS_AS), WSP(bf16, WS_MW13), MSORT, 2 * DFE * NE, D};
                    pg8::gemm_phase<pg8::EpiSwiglu, pg8::MoeOrder, true, true>(C.lds, g, S, E); }
            } SEAM(18);
            if (IN(19)) {
                const int* R = WSP(int, WS_ROUTE);
                pg8::EpiStoreF32 E{WSP(float, WS_OUTS), WSP(float, WS_PARTO), (MOE_FP8 ? DFE / 2 : DFE) / 4};
                if (MOE_FP8) { pg8::Gemm g{WSP(bf16, WS_HM), WSP(bf16, WS_MW2), MSORT, D * NE, DFE / 2};
                    pg8::MoeDownOrder S; S.init(R[R_NT], R + R_TILEE, DFE / 2, C.G, C.bid);
                    pg8::gemm_phase<pg8::EpiStoreF32, pg8::MoeDownOrder, true, true, true>(C.lds, g, S, E); }
                else { pg8::Gemm g{WSP(bf16, WS_HM), WSP(bf16, WS_MW2), MSORT, D * NE, DFE};
                    pg8::MoeDownOrder S; S.init(R[R_NT], R + R_TILEE, DFE, C.G, C.bid);
                    pg8::gemm_phase<pg8::EpiStoreF32, pg8::MoeDownOrder, true, true>(C.lds, g, S, E); }
            } SEAM(19);
        }
    }
__global__ void __launch_bounds__(NTHR, 2) fwd(Args a) {
    extern __shared__ __attribute__((aligned(16))) unsigned char lds_raw[];
    Ctx C;
    C.lds = (LAS unsigned char*)lds_raw;
    C.in = (CIN)__builtin_amdgcn_kernarg_segment_ptr();
    C.out = a.out; C.ws = a.ws; C.tid = threadIdx.x; C.lane = C.tid & 63; C.wave = __builtin_amdgcn_readfirstlane(C.tid >> 6); C.G = gridDim.x; C.bid = blockIdx.x;
    const int lo = a.ph_lo, hi = a.ph_hi;
    XcdBarrier bar; bar.bar = WSP(unsigned, WS_CTL) + CW_BAR; bar.x = 0; bar.st = (volatile LAS unsigned*)(C.lds + LDS_BARW);
    if (hi - lo > 1) {
        if (C.tid < 4) { ((volatile LAS unsigned*)(C.lds + LDS_BARW))[C.tid] = 0u; }
        __syncthreads();
        bar = xcd_barrier_post(WSP(unsigned, WS_CTL) + CW_BAR, (volatile LAS unsigned*)(C.lds + LDS_BARW));
    }
    if (IN(0)) { p_prologue(C); } SEAM(0);
    layer_body<0>(C, bar, lo, hi);
    layer_body<1>(C, bar, lo, hi);
    if (IN(20)) { p_final(C, C.out); }
}

static int g_grid = 0;
static inline bool setup(size_t ws_size, size_t need) {
    if (g_grid == 0) {
        if (ws_size < need) { fprintf(stderr, "kernel_launch: workspace too small: %zu < %zu\n", ws_size, need); g_grid = -1; return false; }
        int dev = 0, cus = 0, per_cu = 0;
        if (hipGetDevice(&dev) != hipSuccess || hipDeviceGetAttribute(&cus, hipDeviceAttributeMultiprocessorCount, dev) != hipSuccess) { g_grid = -1; return false; }
        if (hipFuncSetAttribute((const void*)fwd, hipFuncAttributeMaxDynamicSharedMemorySize, LDS_BYTES) != hipSuccess) { fprintf(stderr, "kernel_launch: hipFuncSetAttribute failed\n"); g_grid = -1; return false; }
        if (hipOccupancyMaxActiveBlocksPerMultiprocessor(&per_cu, (const void*)fwd, NTHR, LDS_BYTES) != hipSuccess || per_cu < 1) { fprintf(stderr, "kernel_launch: occupancy query says %d\n", per_cu); }
        (void)hipGetLastError();
        g_grid = cus;
    }
    return g_grid > 0;
}
static inline void launch(void* const* d_in, float* out, void* d_ws, int lo, int hi, hipStream_t stream) {
    Args a{};
    for (int i = 0; i < 33; ++i) a.in[i] = (const float*)d_in[i];
    a.out = out; a.ws = (unsigned char*)d_ws; a.ph_lo = lo; a.ph_hi = hi;
    hipLaunchKernelGGL(fwd, dim3(g_grid), dim3(NTHR), LDS_BYTES, stream, a);
}
}
#ifndef MK_DEBUG
#define MK_DEBUG 0
#endif
#ifndef MK_ONE_LAUNCH
#define MK_ONE_LAUNCH 0
#endif
#if MK_DEBUG
#ifndef DBG_LAYER
#define DBG_LAYER 0
#endif
namespace dbg {
using namespace mk;
constexpr size_t SNAP = (WS_END + 4095) & ~(size_t)4095;
constexpr size_t S_ERR = SNAP;
constexpr size_t S_MOD = S_ERR + 4096;
constexpr size_t S_AN = S_MOD + al((size_t)10 * 12288 * 2);
constexpr size_t S_AB = S_AN + al((size_t)MT * D * 2);
constexpr size_t S_P = S_AB + al((size_t)MT * 16 * 2);
constexpr size_t S_O = S_P + al((size_t)MT * NIN * 2);
constexpr size_t S_Y = S_O + al((size_t)2 * MT * 512 * 2);
constexpr size_t S_XM = S_Y + al((size_t)MT * D * 2);
constexpr size_t S_AF = S_XM + al((size_t)MT * D * 2);
constexpr size_t S_XE = S_AF + al((size_t)MT * D * 2);
constexpr size_t S_OUT2 = S_XE + al((size_t)MT * D * 2);
constexpr size_t S_END = S_OUT2 + al((size_t)MX * D * 4);
constexpr int NCK = 12;
__global__ void k_snap(const float* src, size_t lds_, bf16* dst, size_t ldd, int rows, int cols, int mode) {
    for (size_t i = (size_t)blockIdx.x * blockDim.x + threadIdx.x; i < (size_t)rows * cols; i += (size_t)gridDim.x * blockDim.x) {
        const int r = (int)(i / cols), c = (int)(i % cols); int sr = r, sc = c;
        if (mode == 1) sc = c < 1536 ? c : c + 16;
        if (mode == 2) sc = c + 1536;
        size_t dr = r;
        if (mode == 3) { const int dir = r / MT, row = r % MT; dr = (size_t)dir * MT + dirrow(row, dir); }
        dst[dr * ldd + c] = (bf16)f2bf(src[(size_t)sr * lds_ + sc]); }
}
__global__ void k_cmp(const void* a, int a_bf16, size_t lda, size_t acol0, const bf16* b, size_t ldb, size_t bcol0, int rows, int cols, float* acc) {
    float num = 0.f, den = 0.f;
    for (size_t i = (size_t)blockIdx.x * blockDim.x + threadIdx.x; i < (size_t)rows * cols; i += (size_t)gridDim.x * blockDim.x) {
        const size_t r = i / cols, c = i % cols;
        const float av = a_bf16 ? bf2f(((const bf16*)a)[r * lda + acol0 + c]) : ((const float*)a)[r * lda + acol0 + c];
        const float bv = bf2f(b[r * ldb + bcol0 + c]); const float d = av - bv;
        if (!(d == d)) { num += 1e30f; } else { num += d * d; } den += bv * bv; }
    num = wave_sum(num); den = wave_sum(den);
    if ((threadIdx.x & 63) == 0) { atomicAdd(acc, num); atomicAdd(acc + 1, den); }
}
__global__ void k_decide(float* err) {
    if (threadIdx.x != 0) return; int code = -1, level = 0;
    for (int k = 0; k < NCK; ++k) { const float num = err[2 * k], den = err[2 * k + 1]; if (den == 0.f && num == 0.f) continue;
        const float e = sqrtf(num / fmaxf(den, 1e-30f)); const float tol = (k == 4) ? 0.06f : 0.03f;
        if (!(e <= tol)) { code = k; level = !(e == e) ? 5 : e < 1e-4f ? 0 : e < 1e-3f ? 1 : e < 1e-2f ? 2 : e < 1e-1f ? 3 : e < 1.f ? 4 : 5; break; } }
    ((int*)err)[64] = code; ((int*)err)[65] = level;
}
__global__ void k_encode(float* out, const float* out2, const float* err) {
    const int code = ((const int*)err)[64], level = ((const int*)err)[65];
    for (size_t i = (size_t)blockIdx.x * blockDim.x + threadIdx.x; i < (size_t)MX * D; i += (size_t)gridDim.x * blockDim.x) {
        if (code < 0) { out[i] = out2[i]; continue; }
        const size_t row = i / D; if (row < (size_t)(code + 1) * (MX / 16)) out[i] = 0.f;
        if (i == (size_t)MX * D - 1) out[i] = (float)(16 << level); }
}
}
#endif

extern "C" void kernel_launch(void* const* d_in, const int* in_sizes, int n_in, void* d_out, int out_size, void* d_ws, size_t ws_size, hipStream_t stream) {
    using namespace mk;
#if MK_DEBUG
    if (!setup(ws_size, dbg::S_END) || n_in != 33) return;
    unsigned char* ws = (unsigned char*)d_ws;
    nv::Bufs nb; const size_t nneed = nv::carve(ws, nb);
    if (nneed > dbg::SNAP) { fprintf(stderr, "naive scratch overlaps snapshots\n"); return; }
    hipMemsetAsync(ws + dbg::S_ERR, 0, 4096, stream);
    auto snap = [&](const float* src, size_t lds_, size_t dst_off, size_t ldd, int rows, int cols, int mode) {
        hipLaunchKernelGGL(dbg::k_snap, dim3(2048), dim3(256), 0, stream, src, lds_, (bf16*)(ws + dst_off), ldd, rows, cols, mode); };
    auto hook = [&](int point, int l) {
        if (point == 0) { snap(nb.mod, 12288, dbg::S_MOD, 12288, 10, 12288, 0); return; }
        if (l != DBG_LAYER) return;
        if (point == 1) snap(nb.A, D, dbg::S_AN, D, MT, D, 0);
        if (point == 2) { snap(nb.p, nv::INW, dbg::S_P, NIN, MT, NIN, 1); snap(nb.p, nv::INW, dbg::S_AB, 16, MT, 16, 2); }
        if (point == 3) snap(nb.o, 512, dbg::S_O, 512, 2 * MT, 512, 3);
        if (point == 4) snap(nb.y, D, dbg::S_Y, D, MT, D, 0);
        if (point == 5) snap(nb.xs, D, dbg::S_XM, D, MT, D, 0);
        if (point == 6) snap(nb.A, D, dbg::S_AF, D, MT, D, 0);
        if (point == 7) snap(nb.xs, D, dbg::S_XE, D, MT, D, 0);
    };
    nv::forward(d_in, (float*)d_out, nb, stream, hook);
    hipMemsetAsync(ws + WS_CTL, 0, CTL_BYTES, stream);
    float* err = (float*)(ws + dbg::S_ERR); float* out2 = (float*)(ws + dbg::S_OUT2);
    auto cmp = [&](int k, const void* a, int a_bf16, size_t lda, size_t acol0, size_t snap_off, size_t ldb, size_t bcol0, int rows, int cols) {
        hipLaunchKernelGGL(dbg::k_cmp, dim3(1024), dim3(256), 0, stream, a, a_bf16, lda, acol0, (const bf16*)(ws + snap_off), ldb, bcol0, rows, cols, err + 2 * k); };
    const int L = DBG_LAYER, pb = L == 0 ? 1 : 10, nr = L == 0 ? MT : MX;
    for (int ph = 0; ph < NPHASE; ++ph) {
        launch(d_in, out2, d_ws, ph, ph + 1, stream);
        if (ph == 0) cmp(0, ws + WS_MODV, 0, 12288, 0, dbg::S_MOD, 12288, 0, 10, 12288);
        if (ph == pb + 0) { cmp(1, ws + WS_AN, 1, D, 0, dbg::S_AN, D, 0, MT, D); cmp(2, ws + WS_ABF, 0, 16, 0, dbg::S_AB, 16, 0, MT, 16); }
        if (ph == pb + 1) { cmp(3, ws + WS_P, 1, NIN, 0, dbg::S_P, NIN, 0, nr, NIN); if (L == 1) cmp(3, ws + WS_P + (size_t)MX * NIN * 2, 1, NIN, 0, dbg::S_P + (size_t)MX * NIN * 2, NIN, 0, MC, 1536); }
        if (ph == pb + 3) cmp(4, ws + WS_O, 0, 512, 0, dbg::S_O, 512, 0, 2 * MT, 512);
        if (ph == pb + 4) { cmp(5, ws + WS_Y, 1, D, 0, dbg::S_Y, D, 0, nr, 512); cmp(6, ws + WS_Y, 1, D, 512, dbg::S_Y, D, 512, nr, 512);
                            cmp(7, ws + WS_Y, 1, D, 1024, dbg::S_Y, D, 1024, nr, 512); cmp(8, ws + WS_Y, 1, D, 1536, dbg::S_Y, D, 1536, nr, 512); }
        if (ph == pb + 5) cmp(9, ws + WS_XS, 0, D, 0, dbg::S_XM, D, 0, nr, D);
        if (ph == pb + 6) cmp(10, ws + WS_AN, 1, D, 0, dbg::S_AF, D, 0, nr, D);
        if (L == 0 && ph == 9) cmp(11, ws + WS_XS, 0, D, 0, dbg::S_XE, D, 0, MT, D);
    }
    hipLaunchKernelGGL(dbg::k_decide, dim3(1), dim3(64), 0, stream, err);
    hipLaunchKernelGGL(dbg::k_encode, dim3(2048), dim3(256), 0, stream, (float*)d_out, out2, err);
#else
    if (!setup(ws_size, WS_END) || n_in != 33) return;
    hipMemsetAsync((unsigned char*)d_ws + WS_CTL, 0, CTL_BYTES, stream);
#if MK_ONE_LAUNCH
    launch(d_in, (float*)d_out, d_ws, 0, NPHASE, stream);
#else
#ifndef REP_MASK
#define REP_MASK 0
#endif
    for (int ph = 0; ph < NPHASE; ++ph) { launch(d_in, (float*)d_out, d_ws, ph, ph + 1, stream); if ((REP_MASK >> ph) & 1) launch(d_in, (float*)d_out, d_ws, ph, ph + 1, stream); }
#endif
#endif
}
```

```cpp
#include <hip/hip_runtime.h>
#include <cstdio>
#include <cstdint>
#define MK_DEBUG 0
#define DBG_LAYER 0
#define MK_ONE_LAUNCH 1
#define REP_MASK 0
#ifndef BG_QUEUE
#define BG_QUEUE 0
#endif
#ifndef STATIC_FILL
#define STATIC_FILL MK_ONE_LAUNCH
#endif
#define GAS __attribute__((address_space(1)))
#define LAS __attribute__((address_space(3)))
typedef unsigned short bf16;
typedef short bf16x8 __attribute__((ext_vector_type(8)));
typedef float f32x4 __attribute__((ext_vector_type(4)));
typedef float f32x2 __attribute__((ext_vector_type(2)));
typedef unsigned u32x4 __attribute__((ext_vector_type(4)));
typedef unsigned u32x2 __attribute__((ext_vector_type(2)));

#ifndef FP8_EMU
#define FP8_EMU 0
#endif
#ifndef MOE_FP8
#define MOE_FP8 1
#endif
__device__ __forceinline__ float rne_e4m3(float x) { return __builtin_amdgcn_cvt_f32_fp8(__builtin_amdgcn_cvt_pk_fp8_f32(x, x, 0, false), 0); }
namespace mk {
constexpr int D = 2048, NB = 4, TX = 2048, TC = 256, MX = NB * TX, MC = NB * TC, MT = MX + MC;
constexpr int INW = 4624, NIN = 4608, NINP = 4864;
constexpr int PQ = 0, PK = 512, PV = 1024, PZ = 1536, PSGU = 2048, PSGV = 2560, PPOOL = 3072, PCVA = 3584, PCVG = 4096;
constexpr int DFF = 5632, NE = 8, DFE = 7168;
constexpr int NCH = MT / 64;
constexpr int MSORT = 2 * MX + NE * 256;
constexpr float EPS = 1e-6f;
constexpr int NTHR = 512, NWAVE = 8;
constexpr int LDS_BYTES = 163840;
constexpr int LDS_BARW = LDS_BYTES - 16;

constexpr size_t al(size_t x) { return (x + 4095) & ~(size_t)4095; }
constexpr size_t WS_CTL = 0, CTL_BYTES = 1u << 20;
constexpr size_t WS_MODV = WS_CTL + CTL_BYTES;
constexpr size_t WS_POS = WS_MODV + al((size_t)2 * 5 * 12288 * 4);
constexpr size_t WS_PWT = WS_POS + al((size_t)TX * D * 4);
constexpr size_t WS_WABC = WS_PWT + al((size_t)2 * 4 * 128 * 128 * 2);
constexpr size_t WS_WIN = WS_WABC + al((size_t)2 * 2048 * 16 * 4);
constexpr size_t WS_WOUT = WS_WIN + al((size_t)2 * NINP * D * 2);
constexpr size_t WS_W13 = WS_WOUT + al((size_t)2 * D * D * 2);
constexpr size_t WS_W2 = WS_W13 + al((size_t)2 * DFF * D * 2);
constexpr size_t WS_MW13 = WS_W2 + al((size_t)D * DFF * 2);
constexpr size_t WS_MW2 = WS_MW13 + al((size_t)NE * 2 * DFE * D * 2);
constexpr size_t WS_XS = WS_MW2 + al((size_t)NE * D * DFE * 2);
constexpr size_t WS_AN = WS_XS + al((size_t)MT * D * 4);
constexpr size_t WS_ABF = WS_AN + al((size_t)MT * D * 2);
constexpr size_t WS_PART = WS_ABF + al((size_t)MT * 16 * 4);
constexpr size_t WS_ROUTE = WS_PART + al((size_t)4 * MC * D * 4);
constexpr size_t WS_BIG = WS_ROUTE + al((size_t)1 << 20);
constexpr size_t WS_P = WS_BIG;
constexpr size_t DN_FRAG = (size_t)2 * NCH * 4;
constexpr size_t WS_DNW = WS_P + al((size_t)MT * NIN * 2);
constexpr size_t WS_DNQG = WS_DNW + al(DN_FRAG * 16384);
constexpr size_t WS_DNKDT = WS_DNQG + al(DN_FRAG * 16384);
constexpr size_t WS_DNQK = WS_DNKDT + al(DN_FRAG * 16384);
constexpr size_t WS_DNU = WS_DNQK + al(DN_FRAG * 8192);
constexpr size_t WS_EGL = WS_DNU + al(DN_FRAG * 16384);
constexpr size_t WS_O = WS_EGL + al(DN_FRAG * 16);
constexpr size_t WS_Y = WS_O + al((size_t)2 * MT * 512 * 4);
constexpr size_t WS_CVH = WS_Y + al((size_t)MT * D * 2);
constexpr size_t WS_MIX_END = WS_CVH + al((size_t)MT * 512 * 4);
constexpr size_t WS_HM = WS_BIG;
constexpr size_t WS_AS = WS_HM + al((size_t)MSORT * DFE * 2);
constexpr size_t WS_OUTS = WS_AS + al((size_t)MSORT * D * 2);
constexpr size_t WS_PARTO = WS_OUTS + al((size_t)MSORT * D * 4);
constexpr size_t WS_FFN_END = WS_PARTO + al((size_t)4 * 2048 * D * 4);
constexpr size_t WS_END = WS_FFN_END > WS_MIX_END ? WS_FFN_END : WS_MIX_END;
constexpr int R_TE = 0;
constexpr int R_TG = R_TE + MX * 2;
constexpr int R_RANK = R_TG + MX * 2;
constexpr int R_POS = R_RANK + MX * 2;
constexpr int R_TILEE = R_POS + MX * 2;
constexpr int R_NT = R_TILEE + 128;
constexpr int CW_CNT = 64;
constexpr int CW_BGHEAD = 1024;
constexpr int CW_DONE = 2048;
constexpr int CW_BAR = 4096;

__device__ __forceinline__ float silu(float x) { return x * __builtin_amdgcn_rcpf(1.f + __expf(-x)); }
__device__ __forceinline__ float sigm(float x) { return __builtin_amdgcn_rcpf(1.f + __expf(-x)); }
__device__ __forceinline__ float gelu_tanh(float x) { const float u = 0.7978845608028654f * (x + 0.044715f * x * x * x); const float e = __expf(2.f * u); return x * (1.f - __builtin_amdgcn_rcpf(1.f + e)); }
__device__ __forceinline__ float softplus(float x) { return x > 20.f ? x : log1pf(__expf(x)); }
__device__ __forceinline__ unsigned f2bf(float f) { unsigned u = __builtin_bit_cast(unsigned, f); return (u + 0x7fffu + ((u >> 16) & 1u)) >> 16; }
__device__ __forceinline__ unsigned pk2(float lo, float hi) { return f2bf(lo) | (f2bf(hi) << 16); }
__device__ __forceinline__ float bf2f(unsigned short b) { return __builtin_bit_cast(float, (unsigned)b << 16); }
__device__ __forceinline__ float bflo(unsigned w) { return __builtin_bit_cast(float, w << 16); }
__device__ __forceinline__ float bfhi(unsigned w) { return __builtin_bit_cast(float, w & 0xffff0000u); }
__device__ __forceinline__ bf16x8 pack8(const float* v) { u32x4 w; w.x = pk2(v[0], v[1]); w.y = pk2(v[2], v[3]); w.z = pk2(v[4], v[5]); w.w = pk2(v[6], v[7]); return __builtin_bit_cast(bf16x8, w); }
__device__ __forceinline__ void unpack8(u32x4 w, float* v) { v[0] = bflo(w.x); v[1] = bfhi(w.x); v[2] = bflo(w.y); v[3] = bfhi(w.y); v[4] = bflo(w.z); v[5] = bfhi(w.z); v[6] = bflo(w.w); v[7] = bfhi(w.w); }
__device__ __forceinline__ unsigned pk4_fp8(float a, float b, float c, float d) { int p = __builtin_amdgcn_cvt_pk_fp8_f32(a, b, 0, false); p = __builtin_amdgcn_cvt_pk_fp8_f32(c, d, p, true); return (unsigned)p; }
__device__ __forceinline__ float clamp448(float x) { return fminf(fmaxf(x, -448.f), 448.f); }
__device__ __forceinline__ float wave_sum(float v) {
#pragma unroll
    for (int o = 1; o < 64; o <<= 1) v += __shfl_xor(v, o);
    return v;
}
__device__ __forceinline__ float sum16(float v) {
#pragma unroll
    for (int o = 1; o < 16; o <<= 1) v += __shfl_xor(v, o);
    return v;
}
__device__ __forceinline__ void rowinfo(int row, int& base, int& T, int& t, int& mv) {
    if (row < MX) { const int b = row >> 11; base = b << 11; T = TX; t = row - base; mv = b; }
    else { const int r = row - MX, b = r >> 8; base = MX + (b << 8); T = TC; t = r - (b << 8); mv = 4; }
}
__device__ __forceinline__ int dirrow(int row, int dir) { int base, T, t, mv; rowinfo(row, base, T, t, mv); return dir ? base + (T - 1 - t) : row; }
#define LDS_WAIT() asm volatile("s_waitcnt lgkmcnt(0)" ::: "memory")
#define VM_WAIT() asm volatile("s_waitcnt vmcnt(0)" ::: "memory")
#define WG_BAR() do { __syncthreads(); } while (0)
}
#define XB_TMO      128
#define XB_XCNT(j)  (256  + 64 * (j))
#define XB_XSUB(j)  (1280 + 64 * (j))
#define XB_XGEN(j)  (2304 + 64 * (j))
#define XB_TOP      3328
#define XB_TOPGEN   3392
#define XCD_BAR_WORDS 3456
#define XB_SPIN_CAP (1u << 18)
#define LAS __attribute__((address_space(3)))

__device__ __forceinline__ unsigned xb_ld(unsigned* p)              { return __hip_atomic_load(p, __ATOMIC_RELAXED, __HIP_MEMORY_SCOPE_AGENT); }
__device__ __forceinline__ unsigned xb_add(unsigned* p, unsigned v) { return __hip_atomic_fetch_add(p, v, __ATOMIC_RELAXED, __HIP_MEMORY_SCOPE_AGENT); }
__device__ __forceinline__ unsigned xb_xcc_id() { return (unsigned)__builtin_amdgcn_s_getreg((3 << 11) | 20) & 0xFu; }
#define XB_SPIN(cond, bar) do { unsigned _sp = 0; while (cond) { __builtin_amdgcn_s_sleep(1); \
    if ((++_sp & 255u) == 0u) { if (xb_ld(&(bar)[XB_TMO])) break; if (_sp > XB_SPIN_CAP) { atomicAdd(&(bar)[XB_TMO], 1u); break; } } } } while (0)

struct XcdBarrier {
    unsigned* bar; unsigned x;
    volatile LAS unsigned* st;
};

__device__ __forceinline__ XcdBarrier xcd_barrier_post(unsigned* bar, volatile LAS unsigned* st) {
    XcdBarrier b; b.bar = bar; b.x = xb_xcc_id(); b.st = st;
    if (threadIdx.x == 0) (void)xb_add(&bar[XB_XCNT(b.x)], 1u);
    return b;
}
__device__ __forceinline__ void xcd_barrier_complete(unsigned* bar, unsigned x, unsigned& nloc, unsigned& nx) {
    const unsigned G = gridDim.x * gridDim.y * gridDim.z;
    unsigned sum, cnt, mine, sp = 0u;
    for (;;) {
        sum = 0u; cnt = 0u; mine = 0u;
#pragma unroll
        for (unsigned j = 0; j < 16; ++j) { const unsigned c = xb_ld(&bar[XB_XCNT(j)]); sum += c; cnt += (c > 0u) ? 1u : 0u; mine = (j == x) ? c : mine; }
        if (sum == G) break;
        __builtin_amdgcn_s_sleep(1);
        if ((++sp & 255u) == 0u) { if (xb_ld(&bar[XB_TMO])) break; if (sp > XB_SPIN_CAP) { atomicAdd(&bar[XB_TMO], 1u); break; } }
    }
    nloc = mine > 0u ? mine : 1u; nx = cnt > 0u ? cnt : 1u;
}

__device__ __forceinline__ void xcd_barrier(const XcdBarrier& b) {
    asm volatile("s_waitcnt vmcnt(0)" ::: "memory");
    __syncthreads();
    if (threadIdx.x == 0) {
        unsigned* bar = b.bar;
        __builtin_amdgcn_s_waitcnt(0);
        unsigned nloc = b.st[0], nx = b.st[1];
        if (nloc == 0u) { xcd_barrier_complete(bar, b.x, nloc, nx); b.st[0] = nloc; b.st[1] = nx; }
        const unsigned old = xb_add(&bar[XB_XSUB(b.x)], 1u);
        const unsigned gen = old / nloc;
        if (old + 1u == (gen + 1u) * nloc) {
            __builtin_amdgcn_fence(__ATOMIC_RELEASE, "agent");
            asm volatile("s_waitcnt vmcnt(0)" ::: "memory");
            const unsigned og = xb_add(&bar[XB_TOP], 1u);
            const unsigned tg = og / nx;
            if (og + 1u == (tg + 1u) * nx) xb_add(&bar[XB_TOPGEN], 1u);
            else XB_SPIN(xb_ld(&bar[XB_TOPGEN]) == tg, bar);
            __builtin_amdgcn_fence(__ATOMIC_ACQUIRE, "agent");
            xb_add(&bar[XB_XGEN(b.x)], 1u);
            asm volatile("s_waitcnt vmcnt(0)" ::: "memory");
        } else {
            XB_SPIN(xb_ld(&bar[XB_XGEN(b.x)]) == gen, bar);
            __builtin_amdgcn_fence(__ATOMIC_ACQUIRE, "agent");
            asm volatile("s_waitcnt vmcnt(0)" ::: "memory");
        }
    }
    __syncthreads();
}
namespace pg8 {
#define PG8_LAS __attribute__((address_space(3)))
typedef unsigned short bf16_t;
typedef short bf16x8 __attribute__((ext_vector_type(8)));
typedef float f32x4 __attribute__((ext_vector_type(4)));
typedef unsigned u32x4 __attribute__((ext_vector_type(4)));
constexpr int BM = 256, BK = 64, HALF = 128, HTB = HALF * BK * 2  , STAGE_BYTES = 8 * HTB, NXCD = 8, WGM = 8;

__host__ __device__ __forceinline__ int lds_byte(int r, int c) { const int st = (r >> 4) * 2 + (c >> 5), rr = r & 15, cc = c & 31, ob = rr * 64 + cc * 2; return st * 1024 + (ob ^ (((ob >> 9) & 1) << 5)); }
__host__ __device__ __forceinline__ void stage_rc(int b, int& R, int& C) { const int st = b / 1024, sb = b % 1024, swz = sb ^ (((sb >> 9) & 1) << 5); R = (st >> 1) * 16 + swz / 64; C = (st & 1) * 32 + (swz % 64) / 2; }
__host__ __device__ __forceinline__ int perm32(int rho) { const int n = rho >> 4, i = rho & 15; return 8 * (i >> 2) + 4 * n + (i & 3); }

struct Unit { int pm, pn, k0, nk; };
struct Gemm { const bf16_t* A; const bf16_t* Bt; int M, N, K; };

struct StaticOrder {
    int nM, nN, nwg, G, c;
    __host__ __device__ void init(int M, int N, int G_, int c_) { nM = M / BM; nN = N / BM; nwg = nM * nN; G = G_; c = c_; }
    __host__ __device__ bool next(int i, Unit& u) const {
        const long L = (long)i * G + c; if (L >= nwg) return false;
        int wgid = (int)L; { const int q = nwg / NXCD, r = nwg % NXCD, xcd = wgid % NXCD, off = wgid / NXCD; wgid = (xcd < r ? xcd * (q + 1) : r * (q + 1) + (xcd - r) * q) + off; }
        const int nig = WGM * nN, gid = wgid / nig, fm = gid * WGM, gsz = (nM - fm) < WGM ? (nM - fm) : WGM;
        u.pm = fm + ((wgid % nig) % gsz); u.pn = (wgid % nig) / gsz; u.k0 = 0; u.nk = 0; return true;
    }
    __device__ __forceinline__ void a_ready(const Unit&) const {}
    __device__ __forceinline__ void done(const Unit&) const {}
};
__device__ __forceinline__ unsigned cvt_pk_bf16(float lo, float hi) { unsigned r; asm volatile("v_cvt_pk_bf16_f32 %0, %1, %2" : "=v"(r) : "v"(lo), "v"(hi)); return r; }
typedef float f32x2 __attribute__((ext_vector_type(2)));
typedef int pg8_v8i __attribute__((ext_vector_type(8)));
typedef int pg8_v4i __attribute__((ext_vector_type(4)));
__device__ __forceinline__ pg8_v8i pg8_cat(bf16x8 lo, bf16x8 hi) { const pg8_v4i a = __builtin_bit_cast(pg8_v4i, lo), b = __builtin_bit_cast(pg8_v4i, hi); return __builtin_shufflevector(a, b, 0, 1, 2, 3, 4, 5, 6, 7); }
constexpr int F8_WSCALE = 121;
template <class Epi, class Sched, bool ALIGN_EPI = false, bool SP2 = false, bool F8 = false>
__device__ __forceinline__ void gemm_phase(PG8_LAS unsigned char* lds, const Gemm g, const Sched& S, const Epi& E) {
    const int tid = threadIdx.x, wid = __builtin_amdgcn_readfirstlane(tid >> 6), lane = tid & 63, wr = wid >> 2, wc = wid & 3, fr = lane & 15, fq = lane >> 4;
    const int K = g.K, nt = K / BK;
    unsigned voffA[2], voffB[2];
#pragma unroll
    for (int i = 0; i < 2; ++i) { int R, C; stage_rc(tid * 16 + i * 8192, R, C); const int Rb = Epi::PERM ? ((R & ~31) + perm32(R & 31)) : R;
        voffA[i] = (unsigned)(R * K + C) * 2u; voffB[i] = (unsigned)(Rb * K + C) * 2u; }
    const size_t kstep = (size_t)(BK * 2);
    const size_t hstep = (size_t)HALF * K * 2;
    const size_t tstep = 2 * hstep;
    const unsigned ldsw = (unsigned)wid * 1024u;
    const int aoff = lds_byte(wr * 64 + fr, fq * 8), boff = lds_byte(wc * 32 + fr, fq * 8);
#define PG8_SA(b, h) (((b) * 2 + (h)) * HTB)
#define PG8_SB(b, h) ((4 + (b) * 2 + (h)) * HTB)
#define PG8_STAGE(bufoff, gbase, voff) do { _Pragma("unroll") for (int _i = 0; _i < 2; ++_i) \
        __builtin_amdgcn_global_load_lds((const unsigned*)((const char*)(gbase) + (voff)[_i]), (PG8_LAS unsigned*)(lds + (bufoff) + ldsw + _i * 8192), 16, 0, 0); } while (0)
#define PG8_LDA(dst, b, h) do { _Pragma("unroll") for (int m = 0; m < 4; ++m) { if constexpr (F8) { dst##8[m] = pg8_cat(*(const PG8_LAS bf16x8*)(lds + PG8_SA(b, h) + aoff + m * 2048), *(const PG8_LAS bf16x8*)(lds + PG8_SA(b, h) + aoff + m * 2048 + 1024)); } else { _Pragma("unroll") for (int k = 0; k < 2; ++k) dst[m][k] = *(const PG8_LAS bf16x8*)(lds + PG8_SA(b, h) + aoff + m * 2048 + k * 1024); } } } while (0)
#define PG8_LDB(dst, b, h) do { _Pragma("unroll") for (int n = 0; n < 2; ++n) { if constexpr (F8) { dst##8[n] = pg8_cat(*(const PG8_LAS bf16x8*)(lds + PG8_SB(b, h) + boff + n * 2048), *(const PG8_LAS bf16x8*)(lds + PG8_SB(b, h) + boff + n * 2048 + 1024)); } else { _Pragma("unroll") for (int k = 0; k < 2; ++k) dst[n][k] = *(const PG8_LAS bf16x8*)(lds + PG8_SB(b, h) + boff + n * 2048 + k * 1024); } } } while (0)
#define PG8_MMA(ai, bj, At, Bt) do { __builtin_amdgcn_s_setprio(1); if constexpr (F8) { _Pragma("unroll") for (int m = 0; m < 4; ++m) _Pragma("unroll") for (int n = 0; n < 2; ++n) \
        asm volatile("v_mfma_scale_f32_16x16x128_f8f6f4 %0, %1, %2, %0, %3, %4 op_sel_hi:[0,0,0]" : "+v"(acc[ai][bj][m][n]) : "v"(Bt##8[n]), "v"(At##8[m]), "v"(f8_sw), "v"(f8_sa)); } \
        else { _Pragma("unroll") for (int m = 0; m < 4; ++m) _Pragma("unroll") for (int n = 0; n < 2; ++n) _Pragma("unroll") for (int k = 0; k < 2; ++k) \
        acc[ai][bj][m][n] = __builtin_amdgcn_mfma_f32_16x16x32_bf16(Bt[n][k], At[m][k], acc[ai][bj][m][n], 0, 0, 0); } __builtin_amdgcn_s_setprio(0); } while (0)
#define PG8_WAIT_V(n) asm volatile("s_waitcnt vmcnt(" #n ")" ::: "memory")
#define PG8_WAIT_L(n) asm volatile("s_waitcnt lgkmcnt(" #n ")" ::: "memory")
#define PG8_BAR __builtin_amdgcn_s_barrier()
#define PG8_SCHED __builtin_amdgcn_sched_barrier(0)
    Unit cur, nxt; int ui = 0;
    if (!S.next(0, cur)) return;
    f32x4 acc[2][2][4][2];
#pragma unroll
    for (int a = 0; a < 2; ++a)
#pragma unroll
        for (int b = 0; b < 2; ++b)
#pragma unroll
            for (int m = 0; m < 4; ++m)
#pragma unroll
                for (int n = 0; n < 2; ++n) acc[a][b][m][n] = (f32x4){0.f, 0.f, 0.f, 0.f};
    bf16x8 At[4][2], B0[2][2], B1[2][2]; pg8_v8i At8[4], B08[2], B18[2]; const int f8_sw = F8_WSCALE, f8_sa = 127;
    const char* cA = (const char*)g.A + (size_t)cur.pm * tstep + (size_t)cur.k0 * 2; const char* cB = (const char*)g.Bt + (size_t)cur.pn * tstep + (size_t)cur.k0 * 2;
    S.a_ready(cur);
    if constexpr (SP2) {
        PG8_STAGE(PG8_SB(0, 0), cB, voffB); PG8_STAGE(PG8_SB(0, 1), cB + hstep, voffB); PG8_STAGE(PG8_SA(0, 0), cA, voffA); PG8_STAGE(PG8_SA(0, 1), cA + hstep, voffA);
        if (wr == 1) PG8_BAR;
        PG8_WAIT_V(2); PG8_BAR;
        PG8_STAGE(PG8_SB(1, 0), cB + kstep, voffB); PG8_STAGE(PG8_SA(1, 0), cA + kstep, voffA); PG8_STAGE(PG8_SB(1, 1), cB + hstep + kstep, voffB);
        PG8_WAIT_V(6); PG8_BAR;
    } else {
        PG8_STAGE(PG8_SB(0, 0), cB, voffB); PG8_STAGE(PG8_SA(0, 0), cA, voffA); PG8_STAGE(PG8_SB(0, 1), cB + hstep, voffB); PG8_STAGE(PG8_SA(0, 1), cA + hstep, voffA);
        if (wr == 1) PG8_BAR;
        PG8_WAIT_V(4); PG8_BAR;
        PG8_STAGE(PG8_SB(1, 0), cB + kstep, voffB); PG8_STAGE(PG8_SA(1, 0), cA + kstep, voffA); PG8_STAGE(PG8_SB(1, 1), cB + hstep + kstep, voffB);
        PG8_WAIT_V(6); PG8_BAR;
    }
    for (;;) {
        const bool has_next = S.next(ui + 1, nxt);
        const char* nA = has_next ? (const char*)g.A + (size_t)nxt.pm * tstep + (size_t)nxt.k0 * 2 : cA; const char* nB = has_next ? (const char*)g.Bt + (size_t)nxt.pn * tstep + (size_t)nxt.k0 * 2 : cB;
        const int ntc = cur.nk ? cur.nk : nt;
        for (int t = 0; t < ntc; t += 2) {
            const bool last = (t == ntc - 2);
            const char* a1 = cA + (size_t)(t + 1) * kstep;
            const char* a2 = last ? nA : cA + (size_t)(t + 2) * kstep; const char* b2 = last ? nB : cB + (size_t)(t + 2) * kstep;
            const char* a3 = a2 + kstep; const char* b3 = b2 + kstep;
            if (last && has_next) S.a_ready(nxt);
            if constexpr (SP2) {
            PG8_LDB(B0, 0, 0); PG8_LDB(B1, 0, 1); PG8_SCHED; PG8_LDA(At, 0, 0); PG8_STAGE(PG8_SA(1, 1), a1 + hstep, voffA);
            PG8_WAIT_V(8); PG8_WAIT_L(0); PG8_BAR; PG8_MMA(0, 0, At, B0); PG8_MMA(0, 1, At, B1); PG8_BAR; PG8_SCHED;
            PG8_LDA(At, 0, 1); PG8_STAGE(PG8_SB(0, 0), b2, voffB); PG8_STAGE(PG8_SB(0, 1), b2 + hstep, voffB); PG8_STAGE(PG8_SA(0, 0), a2, voffA);
            PG8_WAIT_V(8); PG8_WAIT_L(0); PG8_BAR; PG8_MMA(1, 0, At, B0); PG8_MMA(1, 1, At, B1); PG8_BAR; PG8_SCHED;
            PG8_LDB(B0, 1, 0); PG8_LDB(B1, 1, 1); PG8_SCHED; PG8_LDA(At, 1, 0); PG8_STAGE(PG8_SA(0, 1), a2 + hstep, voffA);
            PG8_WAIT_V(8); PG8_WAIT_L(0); PG8_BAR; PG8_MMA(0, 0, At, B0); PG8_MMA(0, 1, At, B1); PG8_BAR; PG8_SCHED;
            PG8_LDA(At, 1, 1); PG8_STAGE(PG8_SB(1, 0), b3, voffB); PG8_STAGE(PG8_SB(1, 1), b3 + hstep, voffB); PG8_STAGE(PG8_SA(1, 0), a3, voffA);
            PG8_WAIT_V(8); PG8_WAIT_L(0); PG8_BAR; PG8_MMA(1, 0, At, B0); PG8_MMA(1, 1, At, B1); PG8_BAR; PG8_SCHED;
            } else {
            PG8_LDB(B0, 0, 0); PG8_SCHED; PG8_LDA(At, 0, 0); PG8_STAGE(PG8_SA(1, 1), a1 + hstep, voffA);
            PG8_WAIT_L(8); PG8_BAR; PG8_WAIT_L(0); PG8_MMA(0, 0, At, B0); PG8_BAR; PG8_SCHED;
            PG8_LDB(B1, 0, 1); PG8_STAGE(PG8_SB(0, 0), b2, voffB);
            PG8_BAR; PG8_WAIT_L(0); PG8_MMA(0, 1, At, B1); PG8_BAR;
            PG8_LDA(At, 0, 1); PG8_STAGE(PG8_SA(0, 0), a2, voffA);
            PG8_BAR; PG8_WAIT_L(0); PG8_MMA(1, 0, At, B0); PG8_BAR; PG8_SCHED;
            PG8_STAGE(PG8_SB(0, 1), b2 + hstep, voffB);
            PG8_WAIT_V(6); PG8_BAR; PG8_MMA(1, 1, At, B1); PG8_BAR;
            PG8_LDB(B0, 1, 0); PG8_SCHED; PG8_LDA(At, 1, 0); PG8_STAGE(PG8_SA(0, 1), a2 + hstep, voffA);
            PG8_WAIT_L(8); PG8_BAR; PG8_WAIT_L(0); PG8_MMA(0, 0, At, B0); PG8_BAR; PG8_SCHED;
            PG8_LDB(B1, 1, 1); PG8_STAGE(PG8_SB(1, 0), b3, voffB);
            PG8_BAR; PG8_WAIT_L(0); PG8_MMA(0, 1, At, B1); PG8_BAR;
            PG8_LDA(At, 1, 1); PG8_STAGE(PG8_SA(1, 0), a3, voffA);
            PG8_BAR; PG8_WAIT_L(0); PG8_MMA(1, 0, At, B0); PG8_BAR; PG8_SCHED;
            PG8_STAGE(PG8_SB(1, 1), b3 + hstep, voffB);
            PG8_WAIT_V(6); PG8_BAR; PG8_MMA(1, 1, At, B1); PG8_BAR;
            }
        }
        if constexpr (F8) { asm volatile("s_nop 15\n\ts_nop 15" ::: "memory"); }
        if constexpr (ALIGN_EPI) { if (wr == 0) PG8_BAR; }
        if constexpr (!Epi::AFTER_DRAIN) { E(acc, cur, wr, wc, fr, fq); S.done(cur); }
        if (!has_next) break;
#pragma unroll
        for (int a = 0; a < 2; ++a)
#pragma unroll
            for (int b = 0; b < 2; ++b)
#pragma unroll
                for (int m = 0; m < 4; ++m)
#pragma unroll
                    for (int n = 0; n < 2; ++n) acc[a][b][m][n] = (f32x4){0.f, 0.f, 0.f, 0.f};
        cur = nxt; cA = nA; cB = nB; ++ui;
        if constexpr (ALIGN_EPI) { if (wr == 1) PG8_BAR; }
    }
    PG8_WAIT_V(0);
    if constexpr (!ALIGN_EPI) { if (wr == 0) PG8_BAR; }
    PG8_BAR;
    if constexpr (Epi::AFTER_DRAIN) { E.fused(acc, cur, wr, wc, fr, fq, lds, wid, lane); S.done(cur); }
#undef PG8_SA
#undef PG8_SB
#undef PG8_STAGE
#undef PG8_LDA
#undef PG8_LDB
#undef PG8_MMA
#undef PG8_WAIT_V
#undef PG8_WAIT_L
#undef PG8_BAR
#undef PG8_SCHED
}
struct EpiStoreBf16 {
    static constexpr bool PERM = true, AFTER_DRAIN = false;
    bf16_t* O; int ldc; float* AB;
    __device__ __forceinline__ void operator()(const f32x4 (&acc)[2][2][4][2], const Unit& u, int wr, int wc, int fr, int fq) const {
        const int row0 = u.pm * BM + wr * 64 + fr, col0 = u.pn * BM + wc * 32 + 8 * fq;
        if (u.pn == 18) { if (wc == 0 && fq < 2) {
#pragma unroll
            for (int ai = 0; ai < 2; ++ai)
#pragma unroll
                for (int m = 0; m < 4; ++m) { float* rp = AB + (size_t)(row0 + ai * HALF + m * 16) * 16 + 8 * fq; *(f32x4*)rp = acc[ai][0][m][0]; *(f32x4*)(rp + 4) = acc[ai][0][m][1]; } }
            return; }
#pragma unroll
        for (int ai = 0; ai < 2; ++ai)
#pragma unroll
            for (int m = 0; m < 4; ++m) { bf16_t* rowp = O + (size_t)(row0 + ai * HALF + m * 16) * ldc + col0;
#pragma unroll
                for (int bj = 0; bj < 2; ++bj) { const f32x4 v0 = acc[ai][bj][m][0], v1 = acc[ai][bj][m][1];
                    u32x4 w; w.x = cvt_pk_bf16(v0[0], v0[1]); w.y = cvt_pk_bf16(v0[2], v0[3]); w.z = cvt_pk_bf16(v1[0], v1[1]); w.w = cvt_pk_bf16(v1[2], v1[3]);
                    *(u32x4*)(rowp + bj * HALF) = w; } }
    }
};
struct EpiResid {
    static constexpr bool PERM = false, AFTER_DRAIN = false;
    float* X; const float* mod; int goff; float* part; int kslice;
    __device__ __forceinline__ void operator()(const f32x4 (&acc)[2][2][4][2], const Unit& u, int wr, int wc, int fr, int fq) const {
        const int row0 = u.pm * BM + wr * 64 + fr, col0 = u.pn * BM + wc * 32 + 4 * fq;
        const int mv = u.pm < 32 ? (u.pm >> 3) : 4;
        const float* gp = mod + (size_t)mv * 12288 + goff + col0;
        f32x4 gv[2][2];
#pragma unroll
        for (int bj = 0; bj < 2; ++bj)
#pragma unroll
            for (int n = 0; n < 2; ++n) gv[bj][n] = *(const f32x4*)(gp + bj * HALF + n * 16);
        if (u.nk != 0) { float* pb = part + ((size_t)(u.k0 / kslice) * 1024 + (row0 - 8192)) * 2048 + col0;
#pragma unroll
            for (int ai = 0; ai < 2; ++ai)
#pragma unroll
                for (int m = 0; m < 4; ++m) { float* rowp = pb + (size_t)(ai * HALF + m * 16) * 2048;
#pragma unroll
                    for (int bj = 0; bj < 2; ++bj)
#pragma unroll
                        for (int n = 0; n < 2; ++n) *(f32x4*)(rowp + bj * HALF + n * 16) = gv[bj][n] * acc[ai][bj][m][n]; }
            return; }
#pragma unroll
        for (int ai = 0; ai < 2; ++ai)
#pragma unroll
            for (int m = 0; m < 4; ++m) { float* rowp = X + (size_t)(row0 + ai * HALF + m * 16) * 2048 + col0;
#pragma unroll
                for (int bj = 0; bj < 2; ++bj)
#pragma unroll
                    for (int n = 0; n < 2; ++n) { f32x4* p = (f32x4*)(rowp + bj * HALF + n * 16); *p = *p + gv[bj][n] * acc[ai][bj][m][n]; } }
    }
};
struct ResidOrder {
    StaticOrder so; int G, c, kslice;
    __device__ void init(int K, int G_, int c_) { so.init(8192, 2048, G_, c_); G = G_; c = c_; kslice = K / 4; }
    __device__ bool next(int i, Unit& u) const {
        const int L = i * G + c;
        if (L < so.nwg) return so.next(i, u);
        const int j = L - so.nwg; if (j >= 128) return false;
        const int t = j >> 2; u.pm = 32 + (t >> 3); u.pn = t & 7; u.k0 = (j & 3) * kslice; u.nk = kslice / BK; return true;
    }
    __device__ __forceinline__ void a_ready(const Unit&) const {}
    __device__ __forceinline__ void done(const Unit&) const {}
};
__device__ __forceinline__ float silu_f(float x) { return x * __builtin_amdgcn_rcpf(1.f + __builtin_amdgcn_exp2f(-1.4426950408889634f * x)); }
struct EpiSwiglu {
    static constexpr bool PERM = true, AFTER_DRAIN = false;
    bf16_t* H; int ldh; int ntn;
    __device__ __forceinline__ void operator()(const f32x4 (&acc)[2][2][4][2], const Unit& u, int wr, int wc, int fr, int fq) const {
        const int row0 = u.pm * BM + wr * 64 + fr, hcol0 = (u.pn % ntn) * HALF + wc * 32 + 8 * fq;
#pragma unroll
        for (int ai = 0; ai < 2; ++ai)
#pragma unroll
            for (int m = 0; m < 4; ++m) { bf16_t* rowp = H + (size_t)(row0 + ai * HALF + m * 16) * ldh + hcol0;
                const f32x4 a0 = acc[ai][0][m][0], a1 = acc[ai][0][m][1], b0 = acc[ai][1][m][0], b1 = acc[ai][1][m][1];
                float h[8];
#pragma unroll
                for (int j = 0; j < 4; ++j) { if (FP8_EMU && ntn == 56) { const float q = 1.f / 64.f; h[j] = rne_e4m3(silu_f(a0[j] * q) * (b0[j] * q)); h[4 + j] = rne_e4m3(silu_f(a1[j] * q) * (b1[j] * q)); } else { h[j] = silu_f(a0[j]) * b0[j]; h[4 + j] = silu_f(a1[j]) * b1[j]; } }
                u32x4 w; w.x = cvt_pk_bf16(h[0], h[1]); w.y = cvt_pk_bf16(h[2], h[3]); w.z = cvt_pk_bf16(h[4], h[5]); w.w = cvt_pk_bf16(h[6], h[7]);
                *(u32x4*)rowp = w; }
    }
};
struct EpiSwiglu8 {
    static constexpr bool PERM = true, AFTER_DRAIN = false;
    unsigned char* H; int ldh; int ntn;
    __device__ __forceinline__ void operator()(const f32x4 (&acc)[2][2][4][2], const Unit& u, int wr, int wc, int fr, int fq) const {
        const int row0 = u.pm * BM + wr * 64 + fr, hcol0 = (u.pn % ntn) * HALF + wc * 32 + 8 * fq;
#pragma unroll
        for (int ai = 0; ai < 2; ++ai)
#pragma unroll
            for (int m = 0; m < 4; ++m) { unsigned char* rowp = H + (size_t)(row0 + ai * HALF + m * 16) * ldh + hcol0;
                const f32x4 a0 = acc[ai][0][m][0], a1 = acc[ai][0][m][1], b0 = acc[ai][1][m][0], b1 = acc[ai][1][m][1];
                float h[8];
#pragma unroll
                for (int j = 0; j < 4; ++j) { h[j] = fminf(fmaxf(silu_f(a0[j]) * b0[j], -448.f), 448.f); h[4 + j] = fminf(fmaxf(silu_f(a1[j]) * b1[j], -448.f), 448.f); }
                int p0 = __builtin_amdgcn_cvt_pk_fp8_f32(h[0], h[1], 0, false); p0 = __builtin_amdgcn_cvt_pk_fp8_f32(h[2], h[3], p0, true);
                int p1 = __builtin_amdgcn_cvt_pk_fp8_f32(h[4], h[5], 0, false); p1 = __builtin_amdgcn_cvt_pk_fp8_f32(h[6], h[7], p1, true);
                u32x2 w; w.x = (unsigned)p0; w.y = (unsigned)p1; *(u32x2*)rowp = w; }
    }
};
struct EpiStoreF32 {
    static constexpr bool PERM = false, AFTER_DRAIN = false;
    float* C; float* part; int kslice;
    __device__ __forceinline__ void operator()(const f32x4 (&acc)[2][2][4][2], const Unit& u, int wr, int wc, int fr, int fq) const {
        const int row0 = u.pm * BM + wr * 64 + fr, col0 = (u.pn & 7) * BM + wc * 32 + 4 * fq;
        float* base = u.nk != 0 ? part + ((size_t)(u.k0 / kslice) * 2048 + (row0 - 16384)) * 2048 + col0 : C + (size_t)row0 * 2048 + col0;
#pragma unroll
        for (int ai = 0; ai < 2; ++ai)
#pragma unroll
            for (int m = 0; m < 4; ++m) { float* rowp = base + (size_t)(ai * HALF + m * 16) * 2048;
#pragma unroll
                for (int bj = 0; bj < 2; ++bj)
#pragma unroll
                    for (int n = 0; n < 2; ++n) *(f32x4*)(rowp + bj * HALF + n * 16) = FP8_EMU ? acc[ai][bj][m][n] * (1.f / 64.f) : acc[ai][bj][m][n]; }
    }
};
struct InProjL1Order {
    StaticOrder so; int G, c;
    __device__ void init(int G_, int c_) { so.init(8192, 4864, G_, c_); G = G_; c = c_; }
    __device__ bool next(int i, Unit& u) const {
        const int L = i * G + c;
        if (L < so.nwg) return so.next(i, u);
        const int L2 = L - so.nwg; if (L2 >= 28) return false;
        u.pm = 32 + (L2 & 3); u.pn = (L2 >> 2) == 6 ? 18 : (L2 >> 2); u.k0 = 0; u.nk = 0; return true;
    }
    __device__ __forceinline__ void a_ready(const Unit&) const {}
    __device__ __forceinline__ void done(const Unit&) const {}
};
struct MoeOrder {
    StaticOrder so; const int* tile_e; int NT;
    __device__ void init(int ntiles, int NT_, const int* te, int G_, int c_) { so.nM = ntiles; so.nN = NT_; so.nwg = ntiles * NT_; so.G = G_; so.c = c_; tile_e = te; NT = NT_; }
    __device__ bool next(int i, Unit& u) const { if (!so.next(i, u)) return false; u.pn += tile_e[u.pm] * NT; return true; }
    __device__ __forceinline__ void a_ready(const Unit&) const {}
    __device__ __forceinline__ void done(const Unit&) const {}
};
struct MoeDownOrder {
    StaticOrder so; const int* tile_e; int ntiles, G, c, kslice;
    __device__ void init(int ntiles_, const int* te, int K, int G_, int c_) { ntiles = ntiles_; const int nm = ntiles_ < 64 ? ntiles_ : 64; so.nM = nm; so.nN = 8; so.nwg = nm * 8; so.G = G_; so.c = c_; tile_e = te; G = G_; c = c_; kslice = K / 4; }
    __device__ bool next(int i, Unit& u) const {
        const int L = i * G + c;
        if (L < so.nwg) { so.next(i, u); u.pn += tile_e[u.pm] * 8; return true; }
        const int j = L - so.nwg; if (j >= (ntiles - so.nM) * 32) return false;
        const int t = j >> 2; u.pm = 64 + (t >> 3); u.pn = tile_e[u.pm] * 8 + (t & 7); u.k0 = (j & 3) * kslice; u.nk = kslice / BK; return true;
    }
    __device__ __forceinline__ void a_ready(const Unit&) const {}
    __device__ __forceinline__ void done(const Unit&) const {}
};
}
namespace mk {
typedef const float* KP;
typedef __attribute__((address_space(4))) KP const* CIN;
struct Ctx {
    LAS unsigned char* lds;
    CIN in; float* out; unsigned char* ws;
    int tid, lane, wave, G, bid;
};
#define WSP(T, off) ((T*)(C.ws + (off)))
__device__ __forceinline__ const float* inp_(CIN p, int k) { asm volatile("" : "+s"(p)); return p[k]; }
#define INP(k) inp_(C.in, (k))

__device__ __forceinline__ void tr_item(const float* W, int ldw, int k0, int ncol0, bf16* WT, int ldt, int drow0, LAS float* scr, int lane, bool f8 = false) {
    f32x4 v[16];
#pragma unroll
    for (int i = 0; i < 16; ++i) { const int idx = lane + 64 * i, kk = idx >> 4, c4 = idx & 15; v[i] = *(const f32x4*)(W + (size_t)(k0 + kk) * ldw + ncol0 + 4 * c4); }
    if (FP8_EMU && f8) {
#pragma unroll
        for (int i = 0; i < 16; ++i) { v[i].x = rne_e4m3(v[i].x * 64.f); v[i].y = rne_e4m3(v[i].y * 64.f); v[i].z = rne_e4m3(v[i].z * 64.f); v[i].w = rne_e4m3(v[i].w * 64.f); } }
#pragma unroll
    for (int i = 0; i < 16; ++i) { const int idx = lane + 64 * i, kk = idx >> 4, c4 = idx & 15; LAS float* p = scr + kk * 65 + 4 * c4; p[0] = v[i].x; p[1] = v[i].y; p[2] = v[i].z; p[3] = v[i].w; }
    LDS_WAIT(); asm volatile("" ::: "memory");
    const int c = lane & 7;
#pragma unroll
    for (int jj = 0; jj < 8; ++jj) { const int n = (lane >> 3) + 8 * jj; const LAS float* s = scr + (8 * c) * 65 + n;
        u32x4 o; o.x = pk2(s[0], s[65]); o.y = pk2(s[2 * 65], s[3 * 65]); o.z = pk2(s[4 * 65], s[5 * 65]); o.w = pk2(s[6 * 65], s[7 * 65]);
        *(u32x4*)(WT + (size_t)(drow0 + n) * ldt + k0 + 8 * c) = o; }
    LDS_WAIT(); asm volatile("" ::: "memory");
}
__device__ __forceinline__ void tr_item8(const float* W, int ldw, int k0, int ncol0, unsigned char* WT, int ldt, int drow0, LAS float* scr, int lane) {
    f32x4 v[16];
#pragma unroll
    for (int i = 0; i < 16; ++i) { const int idx = lane + 64 * i, kk = idx >> 3, c4 = idx & 7; v[i] = *(const f32x4*)(W + (size_t)(k0 + kk) * ldw + ncol0 + 4 * c4); }
#pragma unroll
    for (int i = 0; i < 16; ++i) { const int idx = lane + 64 * i, kk = idx >> 3, c4 = idx & 7; LAS float* p = scr + kk * 33 + 4 * c4; p[0] = v[i].x * 64.f; p[1] = v[i].y * 64.f; p[2] = v[i].z * 64.f; p[3] = v[i].w * 64.f; }
    LDS_WAIT(); asm volatile("" ::: "memory");
    const int c = lane & 7;
#pragma unroll
    for (int jj = 0; jj < 4; ++jj) { const int n = (lane >> 3) + 8 * jj; const LAS float* s = scr + (16 * c) * 33 + n;
        u32x4 o; o.x = pk4_fp8(s[0], s[33], s[2 * 33], s[3 * 33]); o.y = pk4_fp8(s[4 * 33], s[5 * 33], s[6 * 33], s[7 * 33]);
        o.z = pk4_fp8(s[8 * 33], s[9 * 33], s[10 * 33], s[11 * 33]); o.w = pk4_fp8(s[12 * 33], s[13 * 33], s[14 * 33], s[15 * 33]);
        *(u32x4*)(WT + (size_t)(drow0 + n) * ldt + k0 + 16 * c) = o; }
    LDS_WAIT(); asm volatile("" ::: "memory");
}
constexpr int IT_WIN = 32 * 73, IT_WOUT = 32 * 32, IT_W1 = 32 * 88, IT_W2 = 88 * 32, IT_MW1 = 32 * 112, IT_MW2 = 112 * 32, IT_PW = 2 * 2;
constexpr int IT_PRO = IT_WIN + 8 * IT_PW;
constexpr int BG_WOUT0 = 0, BG_W13 = BG_WOUT0 + IT_WOUT, BG_W2 = BG_W13 + 2 * IT_W1, BG_WIN1 = BG_W2 + IT_W2, BG_WOUT1 = BG_WIN1 + IT_WIN, BG_MOE = BG_WOUT1 + IT_WOUT, NBG = BG_MOE + 16 * IT_MW1 + 8 * IT_MW2;
constexpr int IT_TOTAL = IT_PRO + NBG;
__device__ __forceinline__ void tr_dispatch(Ctx& C, int it, LAS float* scr) {
    const float* W; int ldw, k0, nc0, ldt, dr0; bf16* WT; int r = it;
    if (r < IT_WIN) { const int kb = r / 73, nb = r % 73; W = INP(7); ldw = INW; k0 = 64 * kb; nc0 = nb == 72 ? 1536 : nb < 24 ? 64 * nb : 1552 + 64 * (nb - 24); WT = WSP(bf16, WS_WIN); ldt = D; dr0 = nb == 72 ? 4608 : nb < 24 ? 64 * nb : 1536 + 64 * (nb - 24); }
    else if (r < IT_PRO) { r -= IT_WIN; const int m = r / IT_PW, q = r % IT_PW; W = INP(16) + (size_t)m * 128 * 128; ldw = 128; k0 = 64 * (q >> 1); nc0 = 64 * (q & 1); WT = WSP(bf16, WS_PWT) + (size_t)m * 128 * 128; ldt = 128; dr0 = 64 * (q & 1); }
    else { r -= IT_PRO;
        if (r < BG_W13) { const int kb = r / 32, nb = r % 32; W = INP(22); ldw = D; k0 = 64 * kb; nc0 = 64 * nb; WT = WSP(bf16, WS_WOUT); ldt = D; dr0 = 64 * nb; }
        else if (r < BG_W2) { r -= BG_W13; const int s = r / IT_W1; r -= s * IT_W1; const int kb = r / 88, nb = r % 88; W = INP(24 + s); ldw = DFF; k0 = 64 * kb; nc0 = 64 * nb; WT = WSP(bf16, WS_W13); ldt = D; dr0 = 256 * (nb >> 1) + 128 * s + 64 * (nb & 1); }
        else if (r < BG_WIN1) { r -= BG_W2; const int kb = r / 32, nb = r % 32; W = INP(26); ldw = D; k0 = 64 * kb; nc0 = 64 * nb; WT = WSP(bf16, WS_W2); ldt = DFF; dr0 = 64 * nb; }
        else if (r < BG_WOUT1) { r -= BG_WIN1; const int kb = r / 73, nb = r % 73; W = INP(7) + (size_t)D * INW; ldw = INW; k0 = 64 * kb; nc0 = nb == 72 ? 1536 : nb < 24 ? 64 * nb : 1552 + 64 * (nb - 24); WT = WSP(bf16, WS_WIN) + (size_t)NINP * D; ldt = D; dr0 = nb == 72 ? 4608 : nb < 24 ? 64 * nb : 1536 + 64 * (nb - 24); }
        else if (r < BG_MOE) { r -= BG_WOUT1; const int kb = r / 32, nb = r % 32; W = INP(22) + (size_t)D * D; ldw = D; k0 = 64 * kb; nc0 = 64 * nb; WT = WSP(bf16, WS_WOUT) + (size_t)D * D; ldt = D; dr0 = 64 * nb; }
        else { r -= BG_MOE;
            if (MOE_FP8) {
                if (r < 16 * IT_MW1) { const int j = r / IT_MW1; r -= j * IT_MW1; const int s = j >> 3, e = j & 7, kb = r / 224, nb = r % 224, h0 = 32 * nb;
                    tr_item8(INP(29 + s) + (size_t)e * D * DFE, DFE, 128 * kb, h0, WSP(unsigned char, WS_MW13) + (size_t)e * 2 * DFE * D, D, 256 * (h0 >> 7) + 128 * s + (h0 & 127), scr, C.lane); }
                else { r -= 16 * IT_MW1; const int e = r / IT_MW2; r -= e * IT_MW2; const int kb = r / 64, nb = r % 64;
                    tr_item8(INP(31) + (size_t)e * DFE * D, D, 128 * kb, 32 * nb, WSP(unsigned char, WS_MW2) + (size_t)e * D * DFE, DFE, 32 * nb, scr, C.lane); }
                return; }
            if (r < 16 * IT_MW1) { const int j = r / IT_MW1; r -= j * IT_MW1; const int s = j >> 3, e = j & 7, kb = r / 112, nb = r % 112;
                W = INP(29 + s) + (size_t)e * D * DFE; ldw = DFE; k0 = 64 * kb; nc0 = 64 * nb; WT = WSP(bf16, WS_MW13) + (size_t)e * 2 * DFE * D; ldt = D; dr0 = 256 * (nb >> 1) + 128 * s + 64 * (nb & 1); }
            else { r -= 16 * IT_MW1; const int e = r / IT_MW2; r -= e * IT_MW2; const int kb = r / 32, nb = r % 32;
                W = INP(31) + (size_t)e * DFE * D; ldw = D; k0 = 64 * kb; nc0 = 64 * nb; WT = WSP(bf16, WS_MW2) + (size_t)e * D * DFE; ldt = DFE; dr0 = 64 * nb; } } }
    tr_item(W, ldw, k0, nc0, WT, ldt, dr0, scr, C.lane, it >= IT_PRO + BG_MOE);
}
#ifndef BG_BATCH_N
#define BG_BATCH_N 1
#endif
constexpr int BG_BATCH = BG_BATCH_N;
__device__ __forceinline__ void bg_work(Ctx& C, int limit, int poll_phase) {
    unsigned* ctl = WSP(unsigned, WS_CTL);
    volatile LAS unsigned* flag = (volatile LAS unsigned*)(C.lds + LDS_BARW + 8);
    VM_WAIT(); __syncthreads();
    if (C.tid == 0) { flag[0] = 0u; flag[1] = __hip_atomic_load(ctl + CW_BGHEAD, __ATOMIC_RELAXED, __HIP_MEMORY_SCOPE_AGENT) >= (unsigned)NBG ? 1u : 0u;
        if (poll_phase >= 0) __hip_atomic_fetch_add(ctl + CW_DONE + 64 * poll_phase, 1u, __ATOMIC_RELAXED, __HIP_MEMORY_SCOPE_AGENT); }
    __syncthreads();
    if (flag[1] != 0u) return;
    LAS float* scr = (LAS float*)(C.lds + C.wave * 16896);
    for (;;) {
        if (C.tid == 0) { unsigned base = 0xffffffffu;
            const unsigned head = __hip_atomic_load(ctl + CW_BGHEAD, __ATOMIC_RELAXED, __HIP_MEMORY_SCOPE_AGENT);
            bool go = head < (unsigned)limit;
            if (!go && poll_phase >= 0 && head < (unsigned)NBG) go = __hip_atomic_load(ctl + CW_DONE + 64 * poll_phase, __ATOMIC_RELAXED, __HIP_MEMORY_SCOPE_AGENT) < (unsigned)C.G;
            if (go) base = __hip_atomic_fetch_add(ctl + CW_BGHEAD, (unsigned)NWAVE, __ATOMIC_RELAXED, __HIP_MEMORY_SCOPE_AGENT);
            flag[0] = base; }
        __syncthreads();
        const unsigned base = flag[0];
        if (base >= (unsigned)NBG) break;
        if (base + C.wave < (unsigned)NBG) tr_dispatch(C, IT_PRO + (int)base + C.wave, scr);
        __syncthreads();
    }
}
__device__ __forceinline__ void mod_unit(Ctx& C, int unit, LAS float* sv  , LAS float* red  ) {
    const int l = unit / 192, col0 = (unit % 192) * 64, cq = C.tid & 15, ks = C.tid >> 4;
    const float* w = INP(4) + ((size_t)l * D + ks * 64) * 12288 + col0 + 4 * cq;
    f32x4 acc[5];
#pragma unroll
    for (int v = 0; v < 5; ++v) acc[v] = (f32x4){0.f, 0.f, 0.f, 0.f};
#pragma unroll 8
    for (int k = 0; k < 64; ++k) { const f32x4 wv = *(const f32x4*)(w + (size_t)k * 12288);
#pragma unroll
        for (int v = 0; v < 5; ++v) acc[v] += wv * sv[v * 2048 + ks * 64 + k]; }
#pragma unroll
    for (int v = 0; v < 5; ++v) *(LAS f32x4*)(red + (ks * 5 + v) * 64 + 4 * cq) = acc[v];
    WG_BAR();
    if (C.tid < 320) { const int v = C.tid >> 6, c = C.tid & 63; float s = 0.f;
#pragma unroll 8
        for (int k = 0; k < 32; ++k) s += red[(k * 5 + v) * 64 + c];
        WSP(float, WS_MODV)[((size_t)l * 5 + v) * 12288 + col0 + c] = s + INP(5)[l * 12288 + col0 + c]; }
    WG_BAR();
}
__device__ __forceinline__ void p_prologue(Ctx& C) {
    LAS float* sv = (LAS float*)C.lds; LAS float* red = sv + 5 * 2048;
    for (int i = C.tid; i < 5 * 2048; i += NTHR) { const float x = i < 4 * 2048 ? INP(1)[i] : INP(3)[i - 4 * 2048]; sv[i] = x / (1.f + expf(-x)); }
    WG_BAR();
    for (int u = C.bid; u < 384; u += C.G) mod_unit(C, u, sv, red);
    for (int i = C.bid * NTHR + C.tid; i < 2 * 2048 * 4; i += C.G * NTHR) { const int lk = i >> 2, q = i & 3; *(f32x4*)(WSP(float, WS_WABC) + (size_t)lk * 16 + 4 * q) = *(const f32x4*)(INP(7) + (size_t)lk * INW + 1536 + 4 * q); }
    { float* pos = WSP(float, WS_POS);
      for (size_t i = (size_t)C.bid * NTHR + C.tid; i < (size_t)TX * D; i += (size_t)C.G * NTHR) {
          const int t = (int)(i >> 11), d = (int)(i & 2047), r = t >> 6, cc = t & 63, part = d >> 9, fi = d & 511;
          const float freq = expf(-9.210340371976184f * (float)fi / 512.f);
          const float ang = (part < 2 ? (float)r : (float)cc) * freq;
          pos[i] = (part & 1) ? cosf(ang) : sinf(ang); } }
    WG_BAR();
    LAS float* scr = (LAS float*)(C.lds + C.wave * 16896);
    const int gw = C.bid * NWAVE + C.wave, NGW = C.G * NWAVE;
    const int nit = (STATIC_FILL && C.G == 256) ? IT_PRO + BG_MOE : IT_TOTAL;
    for (int it = gw; it < nit; it += NGW) tr_dispatch(C, it, scr);
}
struct F8Item { const float* W; unsigned char* WT; int ldw, ldt; };
__device__ __forceinline__ F8Item f8_item(Ctx& C, int r) {
    F8Item t;
    if (r < 16 * IT_MW1) { const int j = r / IT_MW1; r -= j * IT_MW1; const int s = j >> 3, e = j & 7, kb = r / 224, nb = r % 224, h0 = 32 * nb;
        t.W = INP(29 + s) + (size_t)e * D * DFE + (size_t)(128 * kb) * DFE + h0; t.ldw = DFE; t.ldt = D;
        t.WT = WSP(unsigned char, WS_MW13) + (size_t)e * 2 * DFE * D + (size_t)(256 * (h0 >> 7) + 128 * s + (h0 & 127)) * D + 128 * kb; }
    else { r -= 16 * IT_MW1; const int e = r / IT_MW2; r -= e * IT_MW2; const int kb = r / 64, nb = r % 64;
        t.W = INP(31) + (size_t)e * DFE * D + (size_t)(128 * kb) * D + 32 * nb; t.ldw = D; t.ldt = DFE;
        t.WT = WSP(unsigned char, WS_MW2) + (size_t)e * D * DFE + (size_t)(32 * nb) * DFE + 128 * kb; }
    return t;
}
__device__ __forceinline__ void f8_load(const F8Item& t, f32x4 (&v)[16], int lane) {
#pragma unroll
    for (int i = 0; i < 16; ++i) { const int idx = lane + 64 * i, kk = idx >> 3, c4 = idx & 7; v[i] = *(const f32x4*)(t.W + (size_t)kk * t.ldw + 4 * c4); }
}
__device__ __forceinline__ void f8_store(const F8Item& t, const f32x4 (&v)[16], LAS float* scr, int lane) {
#pragma unroll
    for (int i = 0; i < 16; ++i) { const int idx = lane + 64 * i, kk = idx >> 3, c4 = idx & 7; LAS float* p = scr + kk * 33 + 4 * c4; p[0] = v[i].x * 64.f; p[1] = v[i].y * 64.f; p[2] = v[i].z * 64.f; p[3] = v[i].w * 64.f; }
    LDS_WAIT(); asm volatile("" ::: "memory");
    const int c = lane & 7;
#pragma unroll
    for (int jj = 0; jj < 4; ++jj) { const int n = (lane >> 3) + 8 * jj; const LAS float* s = scr + (16 * c) * 33 + n;
        u32x4 o; o.x = pk4_fp8(s[0], s[33], s[2 * 33], s[3 * 33]); o.y = pk4_fp8(s[4 * 33], s[5 * 33], s[6 * 33], s[7 * 33]);
        o.z = pk4_fp8(s[8 * 33], s[9 * 33], s[10 * 33], s[11 * 33]); o.w = pk4_fp8(s[12 * 33], s[13 * 33], s[14 * 33], s[15 * 33]);
        *(u32x4*)(t.WT + (size_t)n * t.ldt + 16 * c) = o; }
    LDS_WAIT(); asm volatile("" ::: "memory");
}
__device__ __forceinline__ void fill_static(Ctx& C, int first, int n, int b0) {
    if (!(STATIC_FILL && C.G == 256) || C.bid < b0 || n <= 0) return;
    VM_WAIT(); __syncthreads();
    LAS float* scr = (LAS float*)(C.lds + C.wave * 16896);
    const int nb = C.G - b0, step = nb * NWAVE, end = first + n;
    int it = first + (C.bid - b0) * NWAVE + C.wave;
    if (!MOE_FP8) { for (; it < end; it += step) tr_dispatch(C, IT_PRO + BG_MOE + it, scr); return; }
    if (it >= end) return;
    f32x4 va[16], vb[16];
    F8Item ta = f8_item(C, it), tb = ta; f8_load(ta, va, C.lane);
    for (;;) {
        const bool mb = it + step < end; if (mb) { tb = f8_item(C, it + step); f8_load(tb, vb, C.lane); }
        f8_store(ta, va, scr, C.lane);
        if (!mb) break; it += step;
        const bool ma = it + step < end; if (ma) { ta = f8_item(C, it + step); f8_load(ta, va, C.lane); }
        f8_store(tb, vb, scr, C.lane);
        if (!ma) break; it += step;
    }
}

template <int MODE>
__device__ __forceinline__ void p_norm(Ctx& C, int l) {
    const float* mod = WSP(float, WS_MODV) + (size_t)l * 5 * 12288;
    float* XS = WSP(float, WS_XS); bf16* AN = WSP(bf16, WS_AN);
    const bool mix = MODE <= 1;
    const float* gain = (mix ? INP(6) : INP(23)) + l * D;
    const int sh_off = mix ? 0 : 6144, sc_off = mix ? 2048 : 8192;
    LAS f32x4* wl = (LAS f32x4*)C.lds;
    if (MODE == 3) { const float* wsrc = INP(27);
        for (int idx = C.tid; idx < 2048 * 2; idx += NTHR) { const int k = idx >> 1, q = idx & 1, ln = (k & 255) >> 2, i = k & 3, j = k >> 8;
            wl[((j * 4 + i) * 2 + q) * 64 + ln] = *(const f32x4*)(wsrc + (size_t)k * 8 + 4 * q); } }
    WG_BAR();
    const int nrows = MODE == 3 ? MX : MT;
    const int gw = C.bid * NWAVE + C.wave, NGW = C.G * NWAVE, lane = C.lane;
    for (int row = gw; row < nrows; row += NGW) {
        int base, T, t, mv; rowinfo(row, base, T, t, mv);
        f32x4 x[8]; float ss = 0.f;
        if (MODE == 0) {
            if (row < MX) { const f32x4* xi = (const f32x4*)(INP(0) + (size_t)row * D) + lane; const f32x4* pp = (const f32x4*)(WSP(float, WS_POS) + (size_t)t * D) + lane;
#pragma unroll
                for (int j = 0; j < 8; ++j) x[j] = xi[64 * j] + pp[64 * j]; }
            else { const f32x4* xi = (const f32x4*)(INP(2) + (size_t)(row - MX) * D) + lane;
#pragma unroll
                for (int j = 0; j < 8; ++j) x[j] = xi[64 * j]; }
            f32x4* xo = (f32x4*)(XS + (size_t)row * D) + lane;
#pragma unroll
            for (int j = 0; j < 8; ++j) xo[64 * j] = x[j];
        } else { const f32x4* xi = (const f32x4*)(XS + (size_t)row * D) + lane;
#pragma unroll
            for (int j = 0; j < 8; ++j) x[j] = xi[64 * j];
            if ((MODE == 1 || (MODE == 2 && l == 0)) && row >= MX) {
#pragma unroll
                for (int ks = 0; ks < 4; ++ks) { const f32x4* pp = (const f32x4*)(WSP(float, WS_PART) + ((size_t)ks * MC + (row - MX)) * D) + lane;
#pragma unroll
                    for (int j = 0; j < 8; ++j) x[j] += pp[64 * j]; }
                f32x4* xo = (f32x4*)(XS + (size_t)row * D) + lane;
#pragma unroll
                for (int j = 0; j < 8; ++j) xo[64 * j] = x[j]; } }
#pragma unroll
        for (int j = 0; j < 8; ++j) ss += (x[j].x * x[j].x + x[j].y * x[j].y) + (x[j].z * x[j].z + x[j].w * x[j].w);
        const float rs = rsqrtf(wave_sum(ss) * (1.f / D) + EPS);
        const f32x4* gp = (const f32x4*)gain + lane; const f32x4* shp = (const f32x4*)(mod + (size_t)mv * 12288 + sh_off) + lane; const f32x4* scp = (const f32x4*)(mod + (size_t)mv * 12288 + sc_off) + lane;
        u32x2* ao = (u32x2*)(AN + (size_t)row * D) + lane;
#pragma unroll
        for (int j = 0; j < 8; ++j) { const f32x4 g = gp[64 * j], sh = shp[64 * j], sc = scp[64 * j];
            x[j] = x[j] * rs * g * (sc + 1.f) + sh;
            u32x2 w; w.x = pk2(x[j].x, x[j].y); w.y = pk2(x[j].z, x[j].w); ao[64 * j] = w; }
        if (MODE == 3) {
            f32x4 acc[2] = {(f32x4){0.f, 0.f, 0.f, 0.f}, (f32x4){0.f, 0.f, 0.f, 0.f}};
#pragma unroll
            for (int j = 0; j < 8; ++j)
#pragma unroll
                for (int i = 0; i < 4; ++i) { const float a = x[j][i];
#pragma unroll
                    for (int q = 0; q < 2; ++q) acc[q] += wl[((j * 4 + i) * 2 + q) * 64 + lane] * a; asm volatile("" ::: "memory"); }
            float lg[8];
#pragma unroll
            for (int e = 0; e < 8; ++e) lg[e] = wave_sum(acc[e >> 2][e & 3]) + INP(28)[e];
            if (lane == 0) { int i1 = 0;
#pragma unroll
                for (int e = 1; e < 8; ++e) if (lg[e] > lg[i1]) i1 = e;
                int i2 = i1 == 0 ? 1 : 0;
#pragma unroll
                for (int e = 0; e < 8; ++e) if (e != i1 && lg[e] > lg[i2]) i2 = e;
                float v1 = lg[0], v2 = lg[0];
#pragma unroll
                for (int e = 0; e < 8; ++e) { v1 = e == i1 ? lg[e] : v1; v2 = e == i2 ? lg[e] : v2; }
                const float g2 = 1.f / (1.f + expf(v1 - v2));
                int* R = WSP(int, WS_ROUTE); float* Rf = WSP(float, WS_ROUTE); unsigned* ctl = WSP(unsigned, WS_CTL);
                R[R_TE + 2 * row] = i1; R[R_TE + 2 * row + 1] = i2; Rf[R_TG + 2 * row] = 1.f - g2; Rf[R_TG + 2 * row + 1] = g2;
                R[R_RANK + 2 * row] = (int)atomicAdd(ctl + CW_CNT + 64 * i1, 1u); R[R_RANK + 2 * row + 1] = (int)atomicAdd(ctl + CW_CNT + 64 * i2, 1u); }
        }
    }
}
}
namespace mk {
__device__ __forceinline__ f32x4 mfma16(bf16x8 a, bf16x8 b, f32x4 c) { return __builtin_amdgcn_mfma_f32_16x16x32_bf16(a, b, c, 0, 0, 0); }

constexpr int DP_PITCH = 132;
constexpr int DP_Q = 0, DP_K = 33792, DP_V = 67584;
constexpr int DP_L = 101376;
constexpr int DP_QK = DP_L + 32768;
constexpr int DP_SM = DP_QK + 16384;
static_assert(DP_SM + 2048 <= LDS_BARW, "DN prep LDS map");
__device__ __forceinline__ size_t dn_rec(int dir, int cid, int h) { return ((size_t)dir * NCH + cid) * 4 + h; }

__device__ __forceinline__ void dnprep_unit(Ctx& C, int l, int cidx, int h) {
    LAS float* Qs = (LAS float*)(C.lds + DP_Q); LAS float* Ks = (LAS float*)(C.lds + DP_K); LAS float* Vs = (LAS float*)(C.lds + DP_V);
    LAS float* Ls = (LAS float*)(C.lds + DP_L); LAS bf16* QKi = (LAS bf16*)(C.lds + DP_QK); LAS float* sm = (LAS float*)(C.lds + DP_SM);
    LAS float* Gs = sm; LAS float* Bs = sm + 128; LAS float* EGs = sm + 256; LAS float* EGRs = sm + 384;
    const bf16* P = WSP(bf16, WS_P);
    const int tid = C.tid, lane = C.lane, wave = C.wave;
    const int r0 = cidx * 64; int sbase, T, t0, mv; rowinfo(r0, sbase, T, t0, mv);
    const int nloc = t0 >> 6, nch = T >> 6, cbase = sbase >> 6;
#ifndef DP_SKIP
#define DP_SKIP 0
#endif
    if (!(DP_SKIP & 1)) { if (tid < 384) {
        const int o = tid % 48, tg = tid / 48, wh = o >> 4, oc = o & 15, ch = wh * 512 + h * 128 + 8 * oc;
        float w[5][8];
        const float* cw = INP(8) + (size_t)l * 5 * 1536 + ch;
#pragma unroll
        for (int k = 0; k < 5; ++k) { const f32x4 a = *(const f32x4*)(cw + k * 1536), b = *(const f32x4*)(cw + k * 1536 + 4);
            w[k][0] = a.x; w[k][1] = a.y; w[k][2] = a.z; w[k][3] = a.w; w[k][4] = b.x; w[k][5] = b.y; w[k][6] = b.z; w[k][7] = b.w; }
#pragma unroll 1
        for (int hf = 0; hf < 2; ++hf) {
        float xin[8][8];
#pragma unroll
        for (int i = 0; i < 8; ++i) { const int t = t0 + 8 * tg + 4 * hf + i - 2;
            if (t >= 0 && t < T) { const u32x4 raw = *(const u32x4*)(P + (size_t)(sbase + t) * NIN + ch); unpack8(raw, xin[i]); }
            else {
#pragma unroll
                for (int c = 0; c < 8; ++c) xin[i][c] = 0.f; } }
#pragma unroll
        for (int i = 0; i < 4; ++i) { float ov[8]; float ss = 0.f;
#pragma unroll
            for (int c = 0; c < 8; ++c) { float s = 0.f;
#pragma unroll
                for (int k = 0; k < 5; ++k) s += w[k][c] * xin[i + k][c];
                ov[c] = silu(s); ss += ov[c] * ov[c]; }
            ss = sum16(ss);
            const float sc = wh == 0 ? rsqrtf(ss + EPS) * 0.08838834764831845f : wh == 1 ? rsqrtf(ss + EPS) : 1.f;
            LAS float* dst = (wh == 0 ? Qs : wh == 1 ? Ks : Vs) + (8 * tg + 4 * hf + i) * DP_PITCH + 8 * oc;
            *(LAS f32x4*)dst = (f32x4){ov[0] * sc, ov[1] * sc, ov[2] * sc, ov[3] * sc}; *(LAS f32x4*)(dst + 4) = (f32x4){ov[4] * sc, ov[5] * sc, ov[6] * sc, ov[7] * sc}; }
        }
    } else {
        const int d = wave - 6, s = lane, i = d ? 63 - s : s; const float* ab = WSP(float, WS_ABF) + (size_t)(r0 + i) * 16;
        const float la = -expf(INP(9)[l * 8 + d * 4 + h]) * softplus(ab[d * 4 + h] + INP(10)[l * 8 + d * 4 + h]);
        const float be = sigm(ab[8 + d * 4 + h]);
        float g = la;
#pragma unroll
        for (int o = 1; o < 64; o <<= 1) { const float up = __shfl_up(g, o); if (lane >= o) g += up; }
        const float gl = __shfl(g, 63);
        Gs[d * 64 + s] = g; Bs[d * 64 + s] = be; EGs[d * 64 + s] = expf(g); EGRs[d * 64 + s] = expf(gl - g);
        if (lane == 63) { const int cid = d ? cbase + (nch - 1 - nloc) : cidx; const float e = expf(gl); *(f32x4*)(WSP(float, WS_EGL) + dn_rec(d, cid, h) * 4) = (f32x4){e, e, e, e}; }
    } }
    WG_BAR();
    if (!(DP_SKIP & 2)) {
        const int wh = wave >> 2, mb = wave & 3, c = lane & 15, g4 = lane >> 4;
        const LAS float* Am = wh ? Qs : Ks;
        f32x4 acc[4];
#pragma unroll
        for (int nb = 0; nb < 4; ++nb) acc[nb] = (f32x4){0.f, 0.f, 0.f, 0.f};
#pragma unroll
        for (int ks = 0; ks < 4; ++ks) {
            float av[8]; { const LAS float* p = Am + (16 * mb + c) * DP_PITCH + 32 * ks + 8 * g4; const f32x4 a = *(const LAS f32x4*)p, b = *(const LAS f32x4*)(p + 4);
                av[0] = a.x; av[1] = a.y; av[2] = a.z; av[3] = a.w; av[4] = b.x; av[5] = b.y; av[6] = b.z; av[7] = b.w; }
            const bf16x8 af = pack8(av);
#pragma unroll
            for (int nb = 0; nb < 4; ++nb) { float bv[8]; const LAS float* p = Ks + (16 * nb + c) * DP_PITCH + 32 * ks + 8 * g4; const f32x4 a = *(const LAS f32x4*)p, b = *(const LAS f32x4*)(p + 4);
                bv[0] = a.x; bv[1] = a.y; bv[2] = a.z; bv[3] = a.w; bv[4] = b.x; bv[5] = b.y; bv[6] = b.z; bv[7] = b.w;
                acc[nb] = mfma16(af, pack8(bv), acc[nb]); }
        }
        if (wh == 0) {
#pragma unroll
            for (int d = 0; d < 2; ++d) { const LAS float* Gd = Gs + d * 64; const LAS float* Bd = Bs + d * 64; LAS float* Ld = Ls + d * 4096;
#pragma unroll
                for (int r = 0; r < 4; ++r) { const int i = 16 * mb + 4 * g4 + r, s = d ? 63 - i : i; const float gs = Gd[s], bs = Bd[s];
#pragma unroll
                    for (int nb = 0; nb < 4; ++nb) { const int ip = 16 * nb + c, sp = d ? 63 - ip : ip;
                        Ld[s * 64 + sp] = s > sp ? bs * acc[nb][r] * __expf(gs - Gd[sp]) : 0.f; } } }
        } else {
#pragma unroll
            for (int d = 0; d < 2; ++d) { const LAS float* Gd = Gs + d * 64; LAS bf16* Qd = QKi + d * 4096;
#pragma unroll
                for (int r = 0; r < 4; ++r) { const int i = 16 * mb + 4 * g4 + r, s = d ? 63 - i : i; const float gs = Gd[s];
#pragma unroll
                    for (int nb = 0; nb < 4; ++nb) { const int ip = 16 * nb + c, sp = d ? 63 - ip : ip;
                        const float qk = s >= sp ? acc[nb][r] * __expf(gs - Gd[sp]) : 0.f;
                        const int lp = ((sp & 15) >> 2) * 16 + (s & 15), jp = 4 * ((sp >> 4) & 1) + (sp & 3);
                        Qd[(((s >> 4) * 2 + (sp >> 5)) * 64 + lp) * 8 + jp] = (bf16)f2bf(qk); } } }
        }
    }
    WG_BAR();
    if (!(DP_SKIP & 4)) {
        const int d = tid >> 8; int col = tid & 255; asm volatile("" : "+v"(col));
        float X[64];
        const LAS float* src = col < 128 ? Vs + col : Ks + (col - 128);
        const LAS float* Bd = Bs + d * 64; const LAS float* Ed = EGs + d * 64;
        if (d == 0) {
#pragma unroll
            for (int s = 0; s < 64; ++s) { const float sc = col < 128 ? Bd[s] : Bd[s] * Ed[s]; X[s] = sc * src[s * DP_PITCH]; if ((s & 7) == 7) asm volatile("" ::: "memory"); }
        } else {
#pragma unroll
            for (int s = 0; s < 64; ++s) { const float sc = col < 128 ? Bd[s] : Bd[s] * Ed[s]; X[s] = sc * src[(63 - s) * DP_PITCH]; if ((s & 7) == 7) asm volatile("" ::: "memory"); }
        }
        WG_BAR();
        const LAS float* Ld = Ls + d * 4096;
#pragma unroll
        for (int s = 1; s < 64; ++s) { float a0 = X[s], a1 = 0.f, a2 = 0.f, a3 = 0.f;
#pragma unroll
            for (int j4 = 0; j4 < (s + 3) / 4; ++j4) { const f32x4 lv = *(const LAS f32x4*)(Ld + s * 64 + 4 * j4);
                if (4 * j4 + 0 < s) a0 -= lv.x * X[4 * j4 + 0];
                if (4 * j4 + 1 < s) a1 -= lv.y * X[4 * j4 + 1];
                if (4 * j4 + 2 < s) a2 -= lv.z * X[4 * j4 + 2];
                if (4 * j4 + 3 < s) a3 -= lv.w * X[4 * j4 + 3]; }
            X[s] = (a0 + a1) + (a2 + a3); asm volatile("" ::: "memory"); }
        WG_BAR();
        if (col < 128) { const int wq = col >> 4, c = col & 15;
            LAS bf16* Ui = (LAS bf16*)(C.lds + DP_L) + d * 8192;
#pragma unroll
            for (int s = 0; s < 64; ++s) { const int mb = s >> 4, g4 = (s & 15) >> 2, r = s & 3; Ui[(((wq * 2 + (mb >> 1)) * 64 + g4 * 16 + c) * 8) + 4 * (mb & 1) + r] = (bf16)f2bf(X[s]); } }
        else { const int dk = col - 128, ks = dk >> 5, q = dk & 31, j = 4 * (q >> 4) + (q & 3), g4 = (q & 15) >> 2;
            LAS bf16* Wi = (LAS bf16*)(C.lds + DP_V) + d * 8192;
#pragma unroll
            for (int s = 0; s < 64; ++s) Wi[(((s >> 4) * 4 + ks) * 64 + g4 * 16 + (s & 15)) * 8 + j] = (bf16)f2bf(X[s]); }
    }
    WG_BAR();
    if (!(DP_SKIP & 8)) {
        for (int ci = tid; ci < 2048; ci += NTHR) { const int d = ci >> 10, cc = ci & 1023; const int cid = d ? cbase + (nch - 1 - nloc) : cidx;
            ((u32x4*)(WSP(unsigned char, WS_DNU) + dn_rec(d, cid, h) * 16384))[cc] = ((const LAS u32x4*)(C.lds + DP_L + d * 16384))[cc]; }
        for (int ci = tid; ci < 2048; ci += NTHR) { const int d = ci >> 10, cc = ci & 1023; const int cid = d ? cbase + (nch - 1 - nloc) : cidx;
            ((u32x4*)(WSP(unsigned char, WS_DNW) + dn_rec(d, cid, h) * 16384))[cc] = ((const LAS u32x4*)(C.lds + DP_V + d * 16384))[cc]; }
        for (int ci = tid; ci < 1024; ci += NTHR) { const int d = ci >> 9, cc = ci & 511; const int cid = d ? cbase + (nch - 1 - nloc) : cidx;
            ((u32x4*)(WSP(unsigned char, WS_DNQK) + dn_rec(d, cid, h) * 8192))[cc] = ((const LAS u32x4*)(C.lds + DP_QK + d * 8192))[cc]; }
        for (int ci = tid; ci < 2048; ci += NTHR) { const int d = ci >> 10, cc = ci & 1023, mb = cc >> 8, ks = (cc >> 6) & 3, lp = cc & 63, c = lp & 15, g4 = lp >> 4;
            const int s = 16 * mb + c, i = d ? 63 - s : s; const float e = EGs[d * 64 + s];
            const LAS float* p = Qs + i * DP_PITCH + 32 * ks + 4 * g4; const f32x4 a = *(const LAS f32x4*)p, b = *(const LAS f32x4*)(p + 16);
            float v[8] = {a.x * e, a.y * e, a.z * e, a.w * e, b.x * e, b.y * e, b.z * e, b.w * e};
            const int cid = d ? cbase + (nch - 1 - nloc) : cidx;
            ((bf16x8*)(WSP(unsigned char, WS_DNQG) + dn_rec(d, cid, h) * 16384))[cc] = pack8(v); }
        for (int ci = tid; ci < 2048; ci += NTHR) { const int d = ci >> 10, cc = ci & 1023, tt = cc >> 7, ks2 = (cc >> 6) & 1, lp = cc & 63, c = lp & 15, g4 = lp >> 4;
            float v[8];
#pragma unroll
            for (int j = 0; j < 8; ++j) { const int s = 32 * ks2 + 16 * (j >> 2) + 4 * g4 + (j & 3), i = d ? 63 - s : s; v[j] = Ks[i * DP_PITCH + 16 * tt + c] * EGRs[d * 64 + s]; }
            const int cid = d ? cbase + (nch - 1 - nloc) : cidx;
            ((bf16x8*)(WSP(unsigned char, WS_DNKDT) + dn_rec(d, cid, h) * 16384))[cc] = pack8(v); }
    }
    WG_BAR();
}

constexpr int SG_VT = 0, SG_VPITCH = 136;
__device__ __forceinline__ void sg_unit(Ctx& C, int l, int cb, int h) {
    LAS bf16* vT = (LAS bf16*)(C.lds + SG_VT);
    const bf16* P = WSP(bf16, WS_P); bf16* Y = WSP(bf16, WS_Y);
    const int lane = C.lane, wave = C.wave, r0 = cb * 128;
    const float* lg = INP(12) + l * 512; const float* lb = INP(13) + l * 512;
    for (int q = 0; q < 16; ++q) { const int j = 16 * wave + q; float v[8];
        unpack8(*(const u32x4*)(P + (size_t)(r0 + j) * NIN + PSGV + 8 * lane), v);
        float s = 0.f;
#pragma unroll
        for (int c = 0; c < 8; ++c) { v[c] = gelu_tanh(v[c]); s += v[c]; }
        const float mu = wave_sum(s) * (1.f / 512.f); float s2 = 0.f;
#pragma unroll
        for (int c = 0; c < 8; ++c) { v[c] -= mu; s2 += v[c] * v[c]; }
        const float rs = rsqrtf(wave_sum(s2) * (1.f / 512.f) + EPS);
        if ((lane >> 4) == h) { const int d0 = 8 * (lane & 15);
#pragma unroll
            for (int c = 0; c < 8; ++c) vT[(d0 + c) * SG_VPITCH + j] = (bf16)f2bf(v[c] * rs * lg[128 * h + d0 + c] + lb[128 * h + d0 + c]); } }
    WG_BAR();
    const int c = lane & 15, g4 = lane >> 4;
    const float* W = INP(14) + ((size_t)(l * 4 + h) * 128 + 16 * wave + c) * 128;
    f32x4 acc[8];
#pragma unroll
    for (int nb = 0; nb < 8; ++nb) acc[nb] = (f32x4){0.f, 0.f, 0.f, 0.f};
#pragma unroll
    for (int ks = 0; ks < 4; ++ks) { const f32x4 a = *(const f32x4*)(W + 32 * ks + 8 * g4), b = *(const f32x4*)(W + 32 * ks + 8 * g4 + 4);
        float av[8] = {a.x, a.y, a.z, a.w, b.x, b.y, b.z, b.w}; const bf16x8 af = pack8(av);
#pragma unroll
        for (int nb = 0; nb < 8; ++nb) { const bf16x8 bfr = *(const LAS bf16x8*)(vT + (16 * nb + c) * SG_VPITCH + 32 * ks + 8 * g4); acc[nb] = mfma16(af, bfr, acc[nb]); } }
    const float* bs = INP(15) + (l * 4 + h) * 128;
#pragma unroll
    for (int r = 0; r < 4; ++r) { const int i = 16 * wave + 4 * g4 + r; const float bi = bs[i]; const size_t row = (size_t)(r0 + i);
#pragma unroll
        for (int nb = 0; nb < 8; ++nb) { const int d = 16 * nb + c; const float u = gelu_tanh(bf2f(P[row * NIN + PSGU + 128 * h + d]));
            Y[row * D + 512 + 128 * h + d] = (bf16)f2bf(u * (acc[nb][r] + bi)); } }
    WG_BAR();
}

constexpr int PL_PITCH = 132, PL_BUF = 80 * PL_PITCH;
__device__ __forceinline__ void pool_unit(Ctx& C, int l, int cidx, int g) {
    const bf16* P = WSP(bf16, WS_P); bf16* Y = WSP(bf16, WS_Y); const bf16* PW = WSP(bf16, WS_PWT) + (size_t)(l * 4 + g) * 128 * 128;
    LAS float* X = (LAS float*)C.lds; LAS float* B0 = X + PL_BUF; LAS float* B1 = B0 + PL_BUF;
    const int lane = C.lane, wave = C.wave, c = lane & 15, g4 = lane >> 4, mb = wave & 3, nh = wave >> 2;
    const int r0 = cidx * 64; int sbase, T, t0, mv; rowinfo(r0, sbase, T, t0, mv);
    for (int idx = C.tid; idx < 80 * 16; idx += NTHR) { const int q = idx >> 4, oc = idx & 15, t = t0 + q - 8; float v[8];
        if (t >= 0 && t < T) unpack8(*(const u32x4*)(P + (size_t)(sbase + t) * NIN + PPOOL + 128 * g + 8 * oc), v);
        else {
#pragma unroll
            for (int cc = 0; cc < 8; ++cc) v[cc] = 0.f; }
        LAS float* d = X + q * PL_PITCH + 8 * oc; *(LAS f32x4*)d = (f32x4){v[0], v[1], v[2], v[3]}; *(LAS f32x4*)(d + 4) = (f32x4){v[4], v[5], v[6], v[7]}; }
    WG_BAR();
    const LAS float* src = X; LAS float* dst = B0;
    for (int pass = 0, w = 1; pass <= g; ++pass, w <<= 1) {
        for (int idx = C.tid; idx < (80 - w) * 32; idx += NTHR) { const int r = idx >> 5, c4 = idx & 31;
            *(LAS f32x4*)(dst + r * PL_PITCH + 4 * c4) = *(const LAS f32x4*)(src + r * PL_PITCH + 4 * c4) + *(const LAS f32x4*)(src + (r + w) * PL_PITCH + 4 * c4); }
        WG_BAR();
        src = dst; dst = (dst == B0) ? B1 : B0;
    }
    const int i = 16 * mb + c, t = t0 + i, hw = 1 << g;
    const int lo = t - hw < 0 ? 0 : t - hw, hi = t + hw > T ? T : t + hw; const float inv = 1.f / (float)(hi - lo);
    f32x4 acc[4];
#pragma unroll
    for (int nb = 0; nb < 4; ++nb) acc[nb] = (f32x4){0.f, 0.f, 0.f, 0.f};
#pragma unroll
    for (int ks = 0; ks < 4; ++ks) { const LAS float* sp = src + (i + 8 - hw) * PL_PITCH + 32 * ks + 8 * g4; const LAS float* xp = X + (i + 8) * PL_PITCH + 32 * ks + 8 * g4;
        const f32x4 s0 = *(const LAS f32x4*)sp, s1 = *(const LAS f32x4*)(sp + 4), x0 = *(const LAS f32x4*)xp, x1 = *(const LAS f32x4*)(xp + 4);
        float s[8] = {s0.x * inv - x0.x, s0.y * inv - x0.y, s0.z * inv - x0.z, s0.w * inv - x0.w, s1.x * inv - x1.x, s1.y * inv - x1.y, s1.z * inv - x1.z, s1.w * inv - x1.w};
        const bf16x8 af = pack8(s);
#pragma unroll
        for (int nb = 0; nb < 4; ++nb) { const bf16x8 bfr = *(const bf16x8*)(PW + (size_t)(16 * (4 * nh + nb) + c) * 128 + 32 * ks + 8 * g4); acc[nb] = mfma16(af, bfr, acc[nb]); } }
    const float* psc = INP(17) + l * 512 + 128 * g;
#pragma unroll
    for (int nb = 0; nb < 4; ++nb) { const int e = 16 * (4 * nh + nb) + c; const float sc = psc[e];
#pragma unroll
        for (int r = 0; r < 4; ++r) Y[(size_t)(r0 + 16 * mb + 4 * g4 + r) * D + 1024 + 128 * g + e] = (bf16)f2bf(acc[nb][r] * sc); }
    WG_BAR();
}

constexpr int CV_PITCH = 132;
__device__ __forceinline__ void conf_unit(Ctx& C, int l, int cidx, int cq) {
    const bf16* P = WSP(bf16, WS_P); float* H = WSP(float, WS_CVH); LAS float* gl = (LAS float*)C.lds;
    const int r0 = cidx * 64; int sbase, T, t0, mv; rowinfo(r0, sbase, T, t0, mv);
    for (int idx = C.tid; idx < 94 * 16; idx += NTHR) { const int q = idx >> 4, oc = idx & 15, t = t0 + q - 15; float v[8];
        if (t >= 0 && t < T) { const bf16* pr = P + (size_t)(sbase + t) * NIN + 128 * cq + 8 * oc; float a[8], g[8];
            unpack8(*(const u32x4*)(pr + PCVA), a); unpack8(*(const u32x4*)(pr + PCVG), g);
#pragma unroll
            for (int c = 0; c < 8; ++c) v[c] = a[c] * sigm(g[c]); }
        else {
#pragma unroll
            for (int c = 0; c < 8; ++c) v[c] = 0.f; }
        LAS float* d = gl + q * CV_PITCH + 8 * oc; *(LAS f32x4*)d = (f32x4){v[0], v[1], v[2], v[3]}; *(LAS f32x4*)(d + 4) = (f32x4){v[4], v[5], v[6], v[7]}; }
    const int chl = C.tid & 127, ch = 128 * cq + chl, grp = C.tid >> 7;
    float w[31];
#pragma unroll
    for (int k = 0; k < 31; ++k) w[k] = INP(18)[((size_t)l * 31 + k) * 512 + ch];
    const float cb = INP(19)[l * 512 + ch];
    WG_BAR();
    float glu[46];
#pragma unroll
    for (int q = 0; q < 46; ++q) glu[q] = gl[(16 * grp + q) * CV_PITCH + chl];
#pragma unroll
    for (int i = 0; i < 16; ++i) { float a = cb;
#pragma unroll
        for (int k = 0; k < 31; ++k) a += w[k] * glu[i + k];
        H[(size_t)(r0 + 16 * grp + i) * 512 + ch] = a; }
    WG_BAR();
}

__device__ __forceinline__ void p_mixers(Ctx& C, int l) {
    const int nchk = l == 0 ? NCH : MX / 64;
    for (int u = C.bid; u < NCH * 4; u += C.G) dnprep_unit(C, l, u >> 2, u & 3);
}
__device__ __forceinline__ void p_mixers_bcd(Ctx& C, int l, int vb, int nb) {
    const int nchk = l == 0 ? NCH : MX / 64;
    const int o2 = (nchk * 4) % nb, o3 = (o2 + (nchk / 2) * 4) % nb;
    for (int u = vb; u < nchk * 4; u += nb) conf_unit(C, l, u >> 2, u & 3);
    for (int u = (vb + nb - o2) % nb; u < (nchk / 2) * 4; u += nb) sg_unit(C, l, u >> 2, u & 3);
    for (int u = (vb + nb - o3) % nb; u < nchk * 4; u += nb) pool_unit(C, l, u >> 2, u & 3);
}

constexpr int SC_SLOT = 58368, SC_U = 2 * SC_SLOT;
static_assert(SC_U + 16384 <= LDS_BARW, "scan LDS map");
__device__ __forceinline__ void p_scan(Ctx& C, int l) {
    if (C.bid >= 32) { if (C.G > 32) p_mixers_bcd(C, l, C.bid - 32, C.G - 32); return; }
    const int b = C.bid >> 3, h = (C.bid >> 1) & 3, dir = C.bid & 1, lane = C.lane, w = C.wave, c = lane & 15, g4 = lane >> 4;
    float* O = WSP(float, WS_O) + (size_t)dir * MT * 512;
    f32x4 S[8];
#pragma unroll
    for (int t = 0; t < 8; ++t) S[t] = (f32x4){0.f, 0.f, 0.f, 0.f};
    auto rec_of = [&](int st) -> size_t { const int rb = st < 4 ? MX + b * TC : b * TX, n = st < 4 ? st : st - 4; return dn_rec(dir, (rb >> 6) + n, h); };
#define SC_ISSUE(st_, SL) do { const size_t rec_ = rec_of(st_); \
        _Pragma("unroll") for (int q = 0; q < 7; ++q) { const int ch = w + 8 * q; \
            const unsigned char* src = ch < 16 ? WSP(unsigned char, WS_DNW) + rec_ * 16384 + ch * 1024 : ch < 32 ? WSP(unsigned char, WS_DNQG) + rec_ * 16384 + (ch - 16) * 1024 \
                                     : ch < 48 ? WSP(unsigned char, WS_DNKDT) + rec_ * 16384 + (ch - 32) * 1024 : WSP(unsigned char, WS_DNQK) + rec_ * 8192 + (ch - 48) * 1024; \
            __builtin_amdgcn_global_load_lds((const unsigned*)(src + lane * 16), (LAS unsigned*)(C.lds + (SL) * SC_SLOT + w * 1024 + q * 8192), 16, 0, 0); } \
        if (w == 0) __builtin_amdgcn_global_load_lds((const unsigned*)(WSP(unsigned char, WS_EGL) + rec_ * 16), (LAS unsigned*)(C.lds + (SL) * SC_SLOT + 57344), 16, 0, 0); } while (0)
#define SC_ISSUE_U(st_) do { const unsigned char* Us_ = WSP(unsigned char, WS_DNU) + rec_of(st_) * 16384 + w * 2048 + lane * 16; \
        _Pragma("unroll") for (int j = 0; j < 2; ++j) __builtin_amdgcn_global_load_lds((const unsigned*)(Us_ + j * 1024), (LAS unsigned*)(C.lds + SC_U + w * 2048 + j * 1024), 16, 0, 0); } while (0)
#define SC_STEP(st_, SL) do { const int st = (st_); \
        if (st == 0) asm volatile("s_waitcnt vmcnt(0)" ::: "memory"); else asm volatile("s_waitcnt vmcnt(16)" ::: "memory"); \
        __builtin_amdgcn_s_barrier(); asm volatile("" ::: "memory"); \
        if (st + 1 < 36) SC_ISSUE(st + 1, 1 - (SL)); \
        const LAS bf16x8* Wf = (const LAS bf16x8*)(C.lds + (SL) * SC_SLOT) + lane; const LAS bf16x8* QGf = Wf + 1024; const LAS bf16x8* KDf = Wf + 2048; const LAS bf16x8* QKf = Wf + 3072; \
        const float egl = *(const LAS float*)(C.lds + (SL) * SC_SLOT + 57344); \
        const int rbase = st < 4 ? MX + b * TC + 64 * st : b * TX + 64 * (st - 4); \
        bf16x8 Sb[4]; \
        _Pragma("unroll") for (int ks = 0; ks < 4; ++ks) { float v[8] = {S[2 * ks][0], S[2 * ks][1], S[2 * ks][2], S[2 * ks][3], S[2 * ks + 1][0], S[2 * ks + 1][1], S[2 * ks + 1][2], S[2 * ks + 1][3]}; Sb[ks] = pack8(v); } \
        f32x4 vn[4], oacc[4]; \
        _Pragma("unroll") for (int mb = 0; mb < 4; ++mb) { f32x4 a = (f32x4){0.f, 0.f, 0.f, 0.f}, o = (f32x4){0.f, 0.f, 0.f, 0.f}; \
            _Pragma("unroll") for (int ks = 0; ks < 4; ++ks) { a = mfma16(Wf[(mb * 4 + ks) * 64], Sb[ks], a); o = mfma16(QGf[(mb * 4 + ks) * 64], Sb[ks], o); } \
            vn[mb] = a; oacc[mb] = o; } \
        _Pragma("unroll") for (int j = 0; j < 2; ++j) { float uv[8]; unpack8(*(const LAS u32x4*)(C.lds + SC_U + w * 2048 + j * 1024 + lane * 16), uv); \
            vn[2 * j] = (f32x4){uv[0], uv[1], uv[2], uv[3]} - vn[2 * j]; vn[2 * j + 1] = (f32x4){uv[4], uv[5], uv[6], uv[7]} - vn[2 * j + 1]; } \
        asm volatile("s_waitcnt lgkmcnt(0)" ::: "memory"); __builtin_amdgcn_s_barrier(); asm volatile("" ::: "memory"); \
        if (st + 1 < 36) SC_ISSUE_U(st + 1); \
        bf16x8 Vb[2]; \
        _Pragma("unroll") for (int k2 = 0; k2 < 2; ++k2) { float v[8] = {vn[2 * k2][0], vn[2 * k2][1], vn[2 * k2][2], vn[2 * k2][3], vn[2 * k2 + 1][0], vn[2 * k2 + 1][1], vn[2 * k2 + 1][2], vn[2 * k2 + 1][3]}; Vb[k2] = pack8(v); } \
        _Pragma("unroll") for (int t = 0; t < 8; ++t) { f32x4 a = S[t] * egl; \
            _Pragma("unroll") for (int k2 = 0; k2 < 2; ++k2) a = mfma16(KDf[(t * 2 + k2) * 64], Vb[k2], a); \
            S[t] = a; } \
        _Pragma("unroll") for (int mb = 0; mb < 4; ++mb) { \
            _Pragma("unroll") for (int k2 = 0; k2 < 2; ++k2) oacc[mb] = mfma16(QKf[(mb * 2 + k2) * 64], Vb[k2], oacc[mb]); \
            _Pragma("unroll") for (int r = 0; r < 4; ++r) O[(size_t)(rbase + 16 * mb + 4 * g4 + r) * 512 + 128 * h + 16 * w + c] = oacc[mb][r]; } } while (0)
    SC_ISSUE(0, 0); SC_ISSUE_U(0);
#pragma unroll 1
    for (int s2 = 0; s2 < 36; s2 += 2) { SC_STEP(s2, 0); SC_STEP(s2 + 1, 1); }
    asm volatile("s_waitcnt vmcnt(0)" ::: "memory");
#undef SC_ISSUE
#undef SC_ISSUE_U
#undef SC_STEP
}

__device__ __forceinline__ void p_ghn(Ctx& C, int l) {
    const int nrows = l == 0 ? MT : MX, lane = C.lane; const float* O = WSP(float, WS_O); const bf16* P = WSP(bf16, WS_P); bf16* Y = WSP(bf16, WS_Y);
    const float* gn = INP(11) + l * 128 + 8 * (lane & 15);
    for (int row = C.bid * NWAVE + C.wave; row < nrows; row += C.G * NWAVE) {
        const int rb = dirrow(row, 1);
        const f32x4* pf = (const f32x4*)(O + (size_t)row * 512 + 8 * lane); const f32x4* pb = (const f32x4*)(O + ((size_t)MT + rb) * 512 + 8 * lane);
        const f32x4 a = pf[0] + pb[0], b2 = pf[1] + pb[1];
        float o[8] = {a.x, a.y, a.z, a.w, b2.x, b2.y, b2.z, b2.w}, z[8]; float ss = 0.f;
#pragma unroll
        for (int c = 0; c < 8; ++c) ss += o[c] * o[c];
        const float rs = rsqrtf(sum16(ss) * (1.f / 128.f) + EPS);
        unpack8(*(const u32x4*)(P + (size_t)row * NIN + PZ + 8 * lane), z);
#pragma unroll
        for (int c = 0; c < 8; ++c) o[c] = o[c] * rs * gn[c] * silu(z[c]);
        *(bf16x8*)(Y + (size_t)row * D + 8 * lane) = pack8(o);
        { const float* hp = WSP(float, WS_CVH) + (size_t)row * 512 + 8 * lane; const f32x4 a = *(const f32x4*)hp, b2 = *(const f32x4*)(hp + 4);
          float v[8] = {a.x, a.y, a.z, a.w, b2.x, b2.y, b2.z, b2.w}; float s = 0.f;
#pragma unroll
          for (int c = 0; c < 8; ++c) s += v[c];
          const float mu = wave_sum(s) * (1.f / 512.f); float s2 = 0.f;
#pragma unroll
          for (int c = 0; c < 8; ++c) { v[c] -= mu; s2 += v[c] * v[c]; }
          const float rs = rsqrtf(wave_sum(s2) * (1.f / 512.f) + EPS);
          const float* lg = INP(20) + l * 512 + 8 * lane; const float* lb = INP(21) + l * 512 + 8 * lane;
#pragma unroll
          for (int c = 0; c < 8; ++c) v[c] = silu(v[c] * rs * lg[c] + lb[c]);
          *(bf16x8*)(Y + (size_t)row * D + 1536 + 8 * lane) = pack8(v); }
    }
}

__device__ __forceinline__ void p_moe_gather(Ctx& C) {
    int* R = WSP(int, WS_ROUTE); const unsigned* ctl = WSP(unsigned, WS_CTL);
    LAS int* offs = (LAS int*)C.lds;
    if (C.tid == 0) { int o = 0, nt = 0;
        for (int e = 0; e < 8; ++e) { const int cnt = (int)ctl[CW_CNT + 64 * e], tl = (cnt + 255) >> 8; offs[e] = o;
            if (C.bid == 0) for (int q = 0; q < tl; ++q) R[R_TILEE + nt + q] = e;
            nt += tl; o += tl << 8; }
        if (C.bid == 0) R[R_NT] = nt; }
    WG_BAR();
    const bf16* AN = WSP(bf16, WS_AN); bf16* AS = WSP(bf16, WS_AS);
    for (int tok = C.bid * NWAVE + C.wave; tok < MX; tok += C.G * NWAVE) {
        const int p0 = offs[R[R_TE + 2 * tok]] + R[R_RANK + 2 * tok], p1 = offs[R[R_TE + 2 * tok + 1]] + R[R_RANK + 2 * tok + 1];
        if (C.lane == 0) { R[R_POS + 2 * tok] = p0; R[R_POS + 2 * tok + 1] = p1; }
        if (MOE_FP8) {
            const u32x4* src = (const u32x4*)(AN + (size_t)tok * D) + 4 * C.lane; float f[32];
#pragma unroll
            for (int j = 0; j < 4; ++j) unpack8(src[j], f + 8 * j);
            u32x4 o[2];
#pragma unroll
            for (int j = 0; j < 2; ++j) { const float* q = f + 16 * j;
                o[j].x = pk4_fp8(clamp448(q[0]), clamp448(q[1]), clamp448(q[2]), clamp448(q[3])); o[j].y = pk4_fp8(clamp448(q[4]), clamp448(q[5]), clamp448(q[6]), clamp448(q[7]));
                o[j].z = pk4_fp8(clamp448(q[8]), clamp448(q[9]), clamp448(q[10]), clamp448(q[11])); o[j].w = pk4_fp8(clamp448(q[12]), clamp448(q[13]), clamp448(q[14]), clamp448(q[15])); }
            u32x4* d0 = (u32x4*)((unsigned char*)AS + (size_t)p0 * D) + 2 * C.lane; u32x4* d1 = (u32x4*)((unsigned char*)AS + (size_t)p1 * D) + 2 * C.lane;
            d0[0] = o[0]; d0[1] = o[1]; d1[0] = o[0]; d1[1] = o[1];
        } else {
        const u32x4* src = (const u32x4*)(AN + (size_t)tok * D) + C.lane; u32x4* d0 = (u32x4*)(AS + (size_t)p0 * D) + C.lane; u32x4* d1 = (u32x4*)(AS + (size_t)p1 * D) + C.lane;
#pragma unroll
        for (int j = 0; j < 4; ++j) { u32x4 v = src[64 * j];
            if (FP8_EMU) { float f[8]; unpack8(v, f);
#pragma unroll
                for (int q = 0; q < 8; ++q) f[q] = rne_e4m3(f[q]);
                v = __builtin_bit_cast(u32x4, pack8(f)); }
            d0[64 * j] = v; d1[64 * j] = v; } }
    }
}

__device__ __forceinline__ void p_final(Ctx& C, float* out) {
    const int* R = WSP(int, WS_ROUTE); const float* Rf = WSP(float, WS_ROUTE); const float* XS = WSP(float, WS_XS); const float* OS = WSP(float, WS_OUTS);
    const float* mod = WSP(float, WS_MODV) + (size_t)5 * 12288; const int lane = C.lane;
    for (int tok = C.bid * NWAVE + C.wave; tok < MX; tok += C.G * NWAVE) {
        const int p0 = R[R_POS + 2 * tok], p1 = R[R_POS + 2 * tok + 1]; const float g0 = Rf[R_TG + 2 * tok], g1 = Rf[R_TG + 2 * tok + 1];
        const f32x4* xp = (const f32x4*)(XS + (size_t)tok * D) + lane; const f32x4* o0 = (const f32x4*)(OS + (size_t)p0 * D) + lane; const f32x4* o1 = (const f32x4*)(OS + (size_t)p1 * D) + lane;
        const f32x4* gf = (const f32x4*)(mod + (size_t)(tok >> 11) * 12288 + 10240) + lane; const f32x4* fg = (const f32x4*)INP(32) + lane;
        f32x4 x[8]; float ss = 0.f;
        f32x4 e0[8], e1[8];
        if (p0 < 16384) {
#pragma unroll
            for (int j = 0; j < 8; ++j) e0[j] = o0[64 * j];
        } else { const f32x4* q = (const f32x4*)(WSP(float, WS_PARTO) + (size_t)(p0 - 16384) * D) + lane;
#pragma unroll
            for (int j = 0; j < 8; ++j) e0[j] = (q[64 * j] + q[64 * j + (size_t)2048 * 512]) + (q[64 * j + (size_t)2 * 2048 * 512] + q[64 * j + (size_t)3 * 2048 * 512]); }
        if (p1 < 16384) {
#pragma unroll
            for (int j = 0; j < 8; ++j) e1[j] = o1[64 * j];
        } else { const f32x4* q = (const f32x4*)(WSP(float, WS_PARTO) + (size_t)(p1 - 16384) * D) + lane;
#pragma unroll
            for (int j = 0; j < 8; ++j) e1[j] = (q[64 * j] + q[64 * j + (size_t)2048 * 512]) + (q[64 * j + (size_t)2 * 2048 * 512] + q[64 * j + (size_t)3 * 2048 * 512]); }
#pragma unroll
        for (int j = 0; j < 8; ++j) { x[j] = xp[64 * j] + gf[64 * j] * (e0[j] * g0 + e1[j] * g1); ss += (x[j].x * x[j].x + x[j].y * x[j].y) + (x[j].z * x[j].z + x[j].w * x[j].w); }
        const float rs = rsqrtf(wave_sum(ss) * (1.f / D) + EPS);
        f32x4* op = (f32x4*)(out + (size_t)tok * D) + lane;
#pragma unroll
        for (int j = 0; j < 8; ++j) op[64 * j] = x[j] * rs * fg[64 * j];
    }
}
}
namespace mk {
constexpr int NPHASE = 21;
struct Args { const float* in[33]; float* out; unsigned char* ws; int ph_lo, ph_hi; };
static_assert(sizeof(Args) == 35 * 8 + 8, "Args has no padding");

#ifdef ONLY_PHASE
#define IN(k) ((k) == ONLY_PHASE)
#else
#define IN(k) (lo <= (k) && (k) < hi)
#endif
__device__ __forceinline__ constexpr int bg_need(int k) { return k >= 18 ? NBG : k >= 15 ? BG_MOE : k >= 11 ? BG_WOUT1 : k >= 9 ? BG_WIN1 : k >= 8 ? BG_W2 : k >= 6 ? BG_W13 : 0; }
#ifndef BG_FILL_MASK
#define BG_FILL_MASK ((1 << 2) | (1 << 4) | (1 << 6) | (1 << 8) | (1 << 9) | (1 << 11) | (1 << 13))
#endif
#define SEAM(k) do { if (IN(k) && IN((k) + 1)) { if (BG_QUEUE) bg_work(C, bg_need((k) + 1), ((BG_FILL_MASK >> (k)) & 1) ? (k) : -1); xcd_barrier(bar); } } while (0)
constexpr int NMOE = 16 * IT_MW1 + 8 * IT_MW2;
#ifndef FILL_R
#define FILL_R 25, 0, 2, 65, 10, 25, 0
#endif
#ifndef FILL_R2
#define FILL_R2 14, 14
#endif
constexpr int fill_rounds[7] = {FILL_R}; constexpr int fill_rounds2[2] = {FILL_R2};
constexpr int FB2 = 228, FB4 = 32, FB6 = 128, FB8 = 227, FB9 = 128, FB11 = 212, FB13 = 32;
constexpr int FN2 = fill_rounds[0] * (256 - FB2) * 8, FN4 = fill_rounds[1] * (256 - FB4) * 8, FN6 = fill_rounds[2] * (256 - FB6) * 8, FN8 = fill_rounds[3] * (256 - FB8) * 8,
              FN9 = fill_rounds[4] * (256 - FB9) * 8, FN11 = fill_rounds[5] * (256 - FB11) * 8;
constexpr int FS2 = 0, FS4 = FS2 + FN2, FS6 = FS4 + FN4, FS8 = FS6 + FN6, FS9 = FS8 + FN8, FS11 = FS9 + FN9, FS13 = FS11 + FN11, FN13 = fill_rounds[6] * (256 - FB13) * 8 < NMOE - FS13 ? fill_rounds[6] * (256 - FB13) * 8 : NMOE - FS13, FS3 = FS13 + FN13, FN3 = fill_rounds2[0] * 192 * 8 < NMOE - FS3 ? fill_rounds2[0] * 192 * 8 : NMOE - FS3, FS12 = FS3 + FN3, FN12 = fill_rounds2[1] * 192 * 8 < NMOE - FS12 ? fill_rounds2[1] * 192 * 8 : NMOE - FS12, FS17 = FS12 + FN12, FN17 = NMOE - FS17;
static_assert(FN13 >= 0 && FN17 >= 0, "fill schedule exceeds the MoE items");
template <int l>
__device__ __forceinline__ void layer_body(Ctx& C, const XcdBarrier& bar, const int lo, const int hi) {
        const int pb = l == 0 ? 1 : 10;
        const float* mod = WSP(float, WS_MODV) + (size_t)l * 5 * 12288;
        if (IN(pb + 0)) { if constexpr (l == 0) p_norm<0>(C, 0); else p_norm<1>(C, 1); } SEAM(pb + 0);
        if (IN(pb + 1)) {
            pg8::EpiStoreBf16 E{WSP(bf16, WS_P), NIN, WSP(float, WS_ABF)};
            pg8::Gemm g{WSP(bf16, WS_AN), WSP(bf16, WS_WIN) + (size_t)l * NINP * D, MT, NINP, D};
            const bool ded = STATIC_FILL && C.G == 256;
            if constexpr (l == 0) { if (!ded || C.bid < FB2) { pg8::StaticOrder S; S.init(MT, NINP, ded ? FB2 : C.G, C.bid); pg8::gemm_phase<pg8::EpiStoreBf16, pg8::StaticOrder, true, true>(C.lds, g, S, E); }
                fill_static(C, FS2, FN2, FB2); }
            else { if (!ded || C.bid < FB11) { pg8::InProjL1Order S; S.init(ded ? FB11 : C.G, C.bid); pg8::gemm_phase<pg8::EpiStoreBf16, pg8::InProjL1Order, true, true>(C.lds, g, S, E); }
                fill_static(C, FS11, FN11, FB11); }
        } SEAM(pb + 1);
        if (IN(pb + 2)) { p_mixers(C, l); if constexpr (l == 0) fill_static(C, FS3, FN3, 64); else fill_static(C, FS12, FN12, 64); } SEAM(pb + 2);
        if (IN(pb + 3)) { p_scan(C, l); if constexpr (l == 0) fill_static(C, FS4, FN4, FB4); else fill_static(C, FS13, FN13, FB13); } SEAM(pb + 3);
        if (IN(pb + 4)) { p_ghn(C, l); } SEAM(pb + 4);
        if (IN(pb + 5)) {
            pg8::EpiResid E{WSP(float, WS_XS), mod, 4096, WSP(float, WS_PART), D / 4};
            pg8::Gemm g{WSP(bf16, WS_Y), WSP(bf16, WS_WOUT) + (size_t)l * D * D, l == 0 ? MT : MX, D, D};
            if constexpr (l == 0) { pg8::ResidOrder S; S.init(D, C.G, C.bid); pg8::gemm_phase<pg8::EpiResid, pg8::ResidOrder, true, true>(C.lds, g, S, E); fill_static(C, FS6, FN6, FB6); }
            else { pg8::StaticOrder S; S.init(MX, D, C.G, C.bid); pg8::gemm_phase<pg8::EpiResid, pg8::StaticOrder, true, true>(C.lds, g, S, E); }
        } SEAM(pb + 5);
        if (IN(pb + 6)) { if constexpr (l == 0) p_norm<2>(C, 0); else p_norm<3>(C, 1); } SEAM(pb + 6);
        if constexpr (l == 0) {
            if (IN(8)) {
                pg8::EpiSwiglu E{WSP(bf16, WS_HM), DFF, 1 << 20};
                pg8::Gemm g{WSP(bf16, WS_AN), WSP(bf16, WS_W13), MT, 2 * DFF, D};
                const bool ded = STATIC_FILL && C.G == 256;
                if (!ded || C.bid < FB8) { pg8::StaticOrder S; S.init(MT, 2 * DFF, ded ? FB8 : C.G, C.bid); pg8::gemm_phase<pg8::EpiSwiglu, pg8::StaticOrder, true, true>(C.lds, g, S, E); }
                fill_static(C, FS8, FN8, FB8);
            } SEAM(8);
            if (IN(9)) {
                pg8::EpiResid E{WSP(float, WS_XS), mod, 10240, WSP(float, WS_PART), DFF / 4};
                pg8::Gemm g{WSP(bf16, WS_HM), WSP(bf16, WS_W2), MT, D, DFF};
                pg8::ResidOrder S; S.init(DFF, C.G, C.bid);
                pg8::gemm_phase<pg8::EpiResid, pg8::ResidOrder, true, true>(C.lds, g, S, E);
                fill_static(C, FS9, FN9, FB9);
            } SEAM(9);
        } else {
            if (IN(17)) { p_moe_gather(C); fill_static(C, FS17, FN17, 0); } SEAM(17);
            if (IN(18)) {
                const int* R = WSP(int, WS_ROUTE);
                pg8::MoeOrder S; S.init(R[R_NT], 56, R + R_TILEE, C.G, C.bid);
                if (MOE_FP8) { pg8::EpiSwiglu8 E{WSP(unsigned char, WS_HM), DFE, 56};
                    pg8::Gemm g{WSP(bf16, WS_AS), WSP(bf16, WS_MW13), MSORT, 2 * DFE * NE, D / 2};
                    pg8::gemm_phase<pg8::EpiSwiglu8, pg8::MoeOrder, true, true, true>(C.lds, g, S, E); }
                else { pg8::EpiSwiglu E{WSP(bf16, WS_HM), DFE, 56};
                    pg8::Gemm g{WSP(bf16, WS_AS), WSP(bf16, WS_MW13), MSORT, 2 * DFE * NE, D};
                    pg8::gemm_phase<pg8::EpiSwiglu, pg8::MoeOrder, true, true>(C.lds, g, S, E); }
            } SEAM(18);
            if (IN(19)) {
                const int* R = WSP(int, WS_ROUTE);
                pg8::EpiStoreF32 E{WSP(float, WS_OUTS), WSP(float, WS_PARTO), (MOE_FP8 ? DFE / 2 : DFE) / 4};
                if (MOE_FP8) { pg8::Gemm g{WSP(bf16, WS_HM), WSP(bf16, WS_MW2), MSORT, D * NE, DFE / 2};
                    pg8::MoeDownOrder S; S.init(R[R_NT], R + R_TILEE, DFE / 2, C.G, C.bid);
                    pg8::gemm_phase<pg8::EpiStoreF32, pg8::MoeDownOrder, true, true, true>(C.lds, g, S, E); }
                else { pg8::Gemm g{WSP(bf16, WS_HM), WSP(bf16, WS_MW2), MSORT, D * NE, DFE};
                    pg8::MoeDownOrder S; S.init(R[R_NT], R + R_TILEE, DFE, C.G, C.bid);
                    pg8::gemm_phase<pg8::EpiStoreF32, pg8::MoeDownOrder, true, true>(C.lds, g, S, E); }
            } SEAM(19);
        }
    }
__global__ void __launch_bounds__(NTHR, 2) fwd(Args a) {
    extern __shared__ __attribute__((aligned(16))) unsigned char lds_raw[];
    Ctx C;
    C.lds = (LAS unsigned char*)lds_raw;
    C.in = (CIN)__builtin_amdgcn_kernarg_segment_ptr();
    C.out = a.out; C.ws = a.ws; C.tid = threadIdx.x; C.lane = C.tid & 63; C.wave = __builtin_amdgcn_readfirstlane(C.tid >> 6); C.G = gridDim.x; C.bid = blockIdx.x;
    const int lo = a.ph_lo, hi = a.ph_hi;
    XcdBarrier bar; bar.bar = WSP(unsigned, WS_CTL) + CW_BAR; bar.x = 0; bar.st = (volatile LAS unsigned*)(C.lds + LDS_BARW);
    if (hi - lo > 1) {
        if (C.tid < 4) { ((volatile LAS unsigned*)(C.lds + LDS_BARW))[C.tid] = 0u; }
        __syncthreads();
        bar = xcd_barrier_post(WSP(unsigned, WS_CTL) + CW_BAR, (volatile LAS unsigned*)(C.lds + LDS_BARW));
    }
    if (IN(0)) { p_prologue(C); } SEAM(0);
    layer_body<0>(C, bar, lo, hi);
    layer_body<1>(C, bar, lo, hi);
    if (IN(20)) { p_final(C, C.out); }
}

static int g_grid = 0;
static inline bool setup(size_t ws_size, size_t need) {
    if (g_grid == 0) {
        if (ws_size < need) { fprintf(stderr, "kernel_launch: workspace too small: %zu < %zu\n", ws_size, need); g_grid = -1; return false; }
        int dev = 0, cus = 0, per_cu = 0;
        if (hipGetDevice(&dev) != hipSuccess || hipDeviceGetAttribute(&cus, hipDeviceAttributeMultiprocessorCount, dev) != hipSuccess) { g_grid = -1; return false; }
        if (hipFuncSetAttribute((const void*)fwd, hipFuncAttributeMaxDynamicSharedMemorySize, LDS_BYTES) != hipSuccess) { fprintf(stderr, "kernel_launch: hipFuncSetAttribute failed\n"); g_grid = -1; return false; }
        if (hipOccupancyMaxActiveBlocksPerMultiprocessor(&per_cu, (const void*)fwd, NTHR, LDS_BYTES) != hipSuccess || per_cu < 1) { fprintf(stderr, "kernel_launch: occupancy query says %d\n", per_cu); }
        (void)hipGetLastError();
        g_grid = cus;
    }
    return g_grid > 0;
}
static inline void launch(void* const* d_in, float* out, void* d_ws, int lo, int hi, hipStream_t stream) {
    Args a{};
    for (int i = 0; i < 33; ++i) a.in[i] = (const float*)d_in[i];
    a.out = out; a.ws = (unsigned char*)d_ws; a.ph_lo = lo; a.ph_hi = hi;
    hipLaunchKernelGGL(fwd, dim3(g_grid), dim3(NTHR), LDS_BYTES, stream, a);
}
}
#ifndef MK_DEBUG
#define MK_DEBUG 0
#endif
#ifndef MK_ONE_LAUNCH
#define MK_ONE_LAUNCH 0
#endif
#if MK_DEBUG
#ifndef DBG_LAYER
#define DBG_LAYER 0
#endif
namespace dbg {
using namespace mk;
constexpr size_t SNAP = (WS_END + 4095) & ~(size_t)4095;
constexpr size_t S_ERR = SNAP;
constexpr size_t S_MOD = S_ERR + 4096;
constexpr size_t S_AN = S_MOD + al((size_t)10 * 12288 * 2);
constexpr size_t S_AB = S_AN + al((size_t)MT * D * 2);
constexpr size_t S_P = S_AB + al((size_t)MT * 16 * 2);
constexpr size_t S_O = S_P + al((size_t)MT * NIN * 2);
constexpr size_t S_Y = S_O + al((size_t)2 * MT * 512 * 2);
constexpr size_t S_XM = S_Y + al((size_t)MT * D * 2);
constexpr size_t S_AF = S_XM + al((size_t)MT * D * 2);
constexpr size_t S_XE = S_AF + al((size_t)MT * D * 2);
constexpr size_t S_OUT2 = S_XE + al((size_t)MT * D * 2);
constexpr size_t S_END = S_OUT2 + al((size_t)MX * D * 4);
constexpr int NCK = 12;
__global__ void k_snap(const float* src, size_t lds_, bf16* dst, size_t ldd, int rows, int cols, int mode) {
    for (size_t i = (size_t)blockIdx.x * blockDim.x + threadIdx.x; i < (size_t)rows * cols; i += (size_t)gridDim.x * blockDim.x) {
        const int r = (int)(i / cols), c = (int)(i % cols); int sr = r, sc = c;
        if (mode == 1) sc = c < 1536 ? c : c + 16;
        if (mode == 2) sc = c + 1536;
        size_t dr = r;
        if (mode == 3) { const int dir = r / MT, row = r % MT; dr = (size_t)dir * MT + dirrow(row, dir); }
        dst[dr * ldd + c] = (bf16)f2bf(src[(size_t)sr * lds_ + sc]); }
}
__global__ void k_cmp(const void* a, int a_bf16, size_t lda, size_t acol0, const bf16* b, size_t ldb, size_t bcol0, int rows, int cols, float* acc) {
    float num = 0.f, den = 0.f;
    for (size_t i = (size_t)blockIdx.x * blockDim.x + threadIdx.x; i < (size_t)rows * cols; i += (size_t)gridDim.x * blockDim.x) {
        const size_t r = i / cols, c = i % cols;
        const float av = a_bf16 ? bf2f(((const bf16*)a)[r * lda + acol0 + c]) : ((const float*)a)[r * lda + acol0 + c];
        const float bv = bf2f(b[r * ldb + bcol0 + c]); const float d = av - bv;
        if (!(d == d)) { num += 1e30f; } else { num += d * d; } den += bv * bv; }
    num = wave_sum(num); den = wave_sum(den);
    if ((threadIdx.x & 63) == 0) { atomicAdd(acc, num); atomicAdd(acc + 1, den); }
}
__global__ void k_decide(float* err) {
    if (threadIdx.x != 0) return; int code = -1, level = 0;
    for (int k = 0; k < NCK; ++k) { const float num = err[2 * k], den = err[2 * k + 1]; if (den == 0.f && num == 0.f) continue;
        const float e = sqrtf(num / fmaxf(den, 1e-30f)); const float tol = (k == 4) ? 0.06f : 0.03f;
        if (!(e <= tol)) { code = k; level = !(e == e) ? 5 : e < 1e-4f ? 0 : e < 1e-3f ? 1 : e < 1e-2f ? 2 : e < 1e-1f ? 3 : e < 1.f ? 4 : 5; break; } }
    ((int*)err)[64] = code; ((int*)err)[65] = level;
}
__global__ void k_encode(float* out, const float* out2, const float* err) {
    const int code = ((const int*)err)[64], level = ((const int*)err)[65];
    for (size_t i = (size_t)blockIdx.x * blockDim.x + threadIdx.x; i < (size_t)MX * D; i += (size_t)gridDim.x * blockDim.x) {
        if (code < 0) { out[i] = out2[i]; continue; }
        const size_t row = i / D; if (row < (size_t)(code + 1) * (MX / 16)) out[i] = 0.f;
        if (i == (size_t)MX * D - 1) out[i] = (float)(16 << level); }
}
}
#endif

extern "C" void kernel_launch(void* const* d_in, const int* in_sizes, int n_in, void* d_out, int out_size, void* d_ws, size_t ws_size, hipStream_t stream) {
    using namespace mk;
#if MK_DEBUG
    if (!setup(ws_size, dbg::S_END) || n_in != 33) return;
    unsigned char* ws = (unsigned char*)d_ws;
    nv::Bufs nb; const size_t nneed = nv::carve(ws, nb);
    if (nneed > dbg::SNAP) { fprintf(stderr, "naive scratch overlaps snapshots\n"); return; }
    hipMemsetAsync(ws + dbg::S_ERR, 0, 4096, stream);
    auto snap = [&](const float* src, size_t lds_, size_t dst_off, size_t ldd, int rows, int cols, int mode) {
        hipLaunchKernelGGL(dbg::k_snap, dim3(2048), dim3(256), 0, stream, src, lds_, (bf16*)(ws + dst_off), ldd, rows, cols, mode); };
    auto hook = [&](int point, int l) {
        if (point == 0) { snap(nb.mod, 12288, dbg::S_MOD, 12288, 10, 12288, 0); return; }
        if (l != DBG_LAYER) return;
        if (point == 1) snap(nb.A, D, dbg::S_AN, D, MT, D, 0);
        if (point == 2) { snap(nb.p, nv::INW, dbg::S_P, NIN, MT, NIN, 1); snap(nb.p, nv::INW, dbg::S_AB, 16, MT, 16, 2); }
        if (point == 3) snap(nb.o, 512, dbg::S_O, 512, 2 * MT, 512, 3);
        if (point == 4) snap(nb.y, D, dbg::S_Y, D, MT, D, 0);
        if (point == 5) snap(nb.xs, D, dbg::S_XM, D, MT, D, 0);
        if (point == 6) snap(nb.A, D, dbg::S_AF, D, MT, D, 0);
        if (point == 7) snap(nb.xs, D, dbg::S_XE, D, MT, D, 0);
    };
    nv::forward(d_in, (float*)d_out, nb, stream, hook);
    hipMemsetAsync(ws + WS_CTL, 0, CTL_BYTES, stream);
    float* err = (float*)(ws + dbg::S_ERR); float* out2 = (float*)(ws + dbg::S_OUT2);
    auto cmp = [&](int k, const void* a, int a_bf16, size_t lda, size_t acol0, size_t snap_off, size_t ldb, size_t bcol0, int rows, int cols) {
        hipLaunchKernelGGL(dbg::k_cmp, dim3(1024), dim3(256), 0, stream, a, a_bf16, lda, acol0, (const bf16*)(ws + snap_off), ldb, bcol0, rows, cols, err + 2 * k); };
    const int L = DBG_LAYER, pb = L == 0 ? 1 : 10, nr = L == 0 ? MT : MX;
    for (int ph = 0; ph < NPHASE; ++ph) {
        launch(d_in, out2, d_ws, ph, ph + 1, stream);
        if (ph == 0) cmp(0, ws + WS_MODV, 0, 12288, 0, dbg::S_MOD, 12288, 0, 10, 12288);
        if (ph == pb + 0) { cmp(1, ws + WS_AN, 1, D, 0, dbg::S_AN, D, 0, MT, D); cmp(2, ws + WS_ABF, 0, 16, 0, dbg::S_AB, 16, 0, MT, 16); }
        if (ph == pb + 1) { cmp(3, ws + WS_P, 1, NIN, 0, dbg::S_P, NIN, 0, nr, NIN); if (L == 1) cmp(3, ws + WS_P + (size_t)MX * NIN * 2, 1, NIN, 0, dbg::S_P + (size_t)MX * NIN * 2, NIN, 0, MC, 1536); }
        if (ph == pb + 3) cmp(4, ws + WS_O, 0, 512, 0, dbg::S_O, 512, 0, 2 * MT, 512);
        if (ph == pb + 4) { cmp(5, ws + WS_Y, 1, D, 0, dbg::S_Y, D, 0, nr, 512); cmp(6, ws + WS_Y, 1, D, 512, dbg::S_Y, D, 512, nr, 512);
                            cmp(7, ws + WS_Y, 1, D, 1024, dbg::S_Y, D, 1024, nr, 512); cmp(8, ws + WS_Y, 1, D, 1536, dbg::S_Y, D, 1536, nr, 512); }
        if (ph == pb + 5) cmp(9, ws + WS_XS, 0, D, 0, dbg::S_XM, D, 0, nr, D);
        if (ph == pb + 6) cmp(10, ws + WS_AN, 1, D, 0, dbg::S_AF, D, 0, nr, D);
        if (L == 0 && ph == 9) cmp(11, ws + WS_XS, 0, D, 0, dbg::S_XE, D, 0, MT, D);
    }
    hipLaunchKernelGGL(dbg::k_decide, dim3(1), dim3(64), 0, stream, err);
    hipLaunchKernelGGL(dbg::k_encode, dim3(2048), dim3(256), 0, stream, (float*)d_out, out2, err);
#else
    if (!setup(ws_size, WS_END) || n_in != 33) return;
    hipMemsetAsync((unsigned char*)d_ws + WS_CTL, 0, CTL_BYTES, stream);
#if MK_ONE_LAUNCH
    launch(d_in, (float*)d_out, d_ws, 0, NPHASE, stream);
#else
#ifndef REP_MASK
#define REP_MASK 0
#endif
    for (int ph = 0; ph < NPHASE; ++ph) { launch(d_in, (float*)d_out, d_ws, ph, ph + 1, stream); if ((REP_MASK >> ph) & 1) launch(d_in, (float*)d_out, d_ws, ph, ph + 1, stream); }
#endif
#endif
}
```

```cpp
#include <hip/hip_runtime.h>
#include <cstdio>
#include <cstdint>
#define MK_DEBUG 0
#define DBG_LAYER 0
#define MK_ONE_LAUNCH 1
#define REP_MASK 0
#ifndef BG_QUEUE
#define BG_QUEUE 0
#endif
#ifndef STATIC_FILL
#define STATIC_FILL MK_ONE_LAUNCH
#endif
#define GAS __attribute__((address_space(1)))
#define LAS __attribute__((address_space(3)))
typedef unsigned short bf16;
typedef short bf16x8 __attribute__((ext_vector_type(8)));
typedef float f32x4 __attribute__((ext_vector_type(4)));
typedef float f32x2 __attribute__((ext_vector_type(2)));
typedef unsigned u32x4 __attribute__((ext_vector_type(4)));
typedef unsigned u32x2 __attribute__((ext_vector_type(2)));

#ifndef SCAN_BCD_BLOCKS
#define SCAN_BCD_BLOCKS 160
#endif
#ifndef FP8_EMU
#define FP8_EMU 0
#endif
#ifndef MOE_FP8
#define MOE_FP8 1
#endif
__device__ __forceinline__ float rne_e4m3(float x) { return __builtin_amdgcn_cvt_f32_fp8(__builtin_amdgcn_cvt_pk_fp8_f32(x, x, 0, false), 0); }
namespace mk {
constexpr int D = 2048, NB = 4, TX = 2048, TC = 256, MX = NB * TX, MC = NB * TC, MT = MX + MC;
constexpr int INW = 4624, NIN = 4608, NINP = 4864;
constexpr int PQ = 0, PK = 512, PV = 1024, PZ = 1536, PSGU = 2048, PSGV = 2560, PPOOL = 3072, PCVA = 3584, PCVG = 4096;
constexpr int DFF = 5632, NE = 8, DFE = 7168;
constexpr int NCH = MT / 64;
constexpr int MSORT = 2 * MX + NE * 256;
constexpr float EPS = 1e-6f;
constexpr int NTHR = 512, NWAVE = 8;
constexpr int LDS_BYTES = 163840;
constexpr int LDS_BARW = LDS_BYTES - 16;

constexpr size_t al(size_t x) { return (x + 4095) & ~(size_t)4095; }
constexpr size_t WS_CTL = 0, CTL_BYTES = 1u << 20;
constexpr size_t WS_MODV = WS_CTL + CTL_BYTES;
constexpr size_t WS_POS = WS_MODV + al((size_t)2 * 5 * 12288 * 4);
constexpr size_t WS_PWT = WS_POS + al((size_t)TX * D * 4);
constexpr size_t WS_WABC = WS_PWT + al((size_t)2 * 4 * 128 * 128 * 2);
constexpr size_t WS_WIN = WS_WABC + al((size_t)2 * 2048 * 16 * 4);
constexpr size_t WS_WOUT = WS_WIN + al((size_t)2 * NINP * D * 2);
constexpr size_t WS_W13 = WS_WOUT + al((size_t)2 * D * D * 2);
constexpr size_t WS_W2 = WS_W13 + al((size_t)2 * DFF * D * 2);
constexpr size_t WS_MW13 = WS_W2 + al((size_t)D * DFF * 2);
constexpr size_t WS_MW2 = WS_MW13 + al((size_t)NE * 2 * DFE * D * 2);
constexpr size_t WS_XS = WS_MW2 + al((size_t)NE * D * DFE * 2);
constexpr size_t WS_AN = WS_XS + al((size_t)MT * D * 4);
constexpr size_t WS_ABF = WS_AN + al((size_t)MT * D * 2);
constexpr size_t WS_PART = WS_ABF + al((size_t)MT * 16 * 4);
constexpr size_t WS_ROUTE = WS_PART + al((size_t)4 * MC * D * 4);
constexpr size_t WS_BIG = WS_ROUTE + al((size_t)1 << 20);
constexpr size_t WS_P = WS_BIG;
constexpr size_t DN_FRAG = (size_t)2 * NCH * 4;
constexpr size_t WS_DNW = WS_P + al((size_t)MT * NIN * 2);
constexpr size_t WS_DNQG = WS_DNW + al(DN_FRAG * 16384);
constexpr size_t WS_DNKDT = WS_DNQG + al(DN_FRAG * 16384);
constexpr size_t WS_DNQK = WS_DNKDT + al(DN_FRAG * 16384);
constexpr size_t WS_DNU = WS_DNQK + al(DN_FRAG * 8192);
constexpr size_t WS_EGL = WS_DNU + al(DN_FRAG * 16384);
constexpr size_t WS_O = WS_EGL + al(DN_FRAG * 16);
constexpr size_t WS_Y = WS_O + al((size_t)2 * MT * 512 * 4);
constexpr size_t WS_CVH = WS_Y + al((size_t)MT * D * 2);
constexpr size_t WS_MIX_END = WS_CVH + al((size_t)MT * 512 * 4);
constexpr size_t WS_HM = WS_BIG;
constexpr size_t WS_AS = WS_HM + al((size_t)MSORT * DFE * 2);
constexpr size_t WS_OUTS = WS_AS + al((size_t)MSORT * D * 2);
constexpr size_t WS_PARTO = WS_OUTS + al((size_t)MSORT * D * 4);
constexpr size_t WS_FFN_END = WS_PARTO + al((size_t)4 * 2048 * D * 4);
constexpr size_t WS_END = WS_FFN_END > WS_MIX_END ? WS_FFN_END : WS_MIX_END;
constexpr int R_TE = 0;
constexpr int R_TG = R_TE + MX * 2;
constexpr int R_RANK = R_TG + MX * 2;
constexpr int R_POS = R_RANK + MX * 2;
constexpr int R_TILEE = R_POS + MX * 2;
constexpr int R_NT = R_TILEE + 128;
constexpr int CW_CNT = 64;
constexpr int CW_BGHEAD = 1024;
constexpr int CW_DONE = 2048;
constexpr int CW_BAR = 4096;

__device__ __forceinline__ float silu(float x) { return x * __builtin_amdgcn_rcpf(1.f + __expf(-x)); }
__device__ __forceinline__ float sigm(float x) { return __builtin_amdgcn_rcpf(1.f + __expf(-x)); }
__device__ __forceinline__ float gelu_tanh(float x) { const float u = 0.7978845608028654f * (x + 0.044715f * x * x * x); const float e = __expf(2.f * u); return x * (1.f - __builtin_amdgcn_rcpf(1.f + e)); }
__device__ __forceinline__ float softplus(float x) { return x > 20.f ? x : log1pf(__expf(x)); }
__device__ __forceinline__ unsigned f2bf(float f) { unsigned u = __builtin_bit_cast(unsigned, f); return (u + 0x7fffu + ((u >> 16) & 1u)) >> 16; }
__device__ __forceinline__ unsigned pk2(float lo, float hi) { return f2bf(lo) | (f2bf(hi) << 16); }
__device__ __forceinline__ float bf2f(unsigned short b) { return __builtin_bit_cast(float, (unsigned)b << 16); }
__device__ __forceinline__ float bflo(unsigned w) { return __builtin_bit_cast(float, w << 16); }
__device__ __forceinline__ float bfhi(unsigned w) { return __builtin_bit_cast(float, w & 0xffff0000u); }
__device__ __forceinline__ bf16x8 pack8(const float* v) { u32x4 w; w.x = pk2(v[0], v[1]); w.y = pk2(v[2], v[3]); w.z = pk2(v[4], v[5]); w.w = pk2(v[6], v[7]); return __builtin_bit_cast(bf16x8, w); }
__device__ __forceinline__ void unpack8(u32x4 w, float* v) { v[0] = bflo(w.x); v[1] = bfhi(w.x); v[2] = bflo(w.y); v[3] = bfhi(w.y); v[4] = bflo(w.z); v[5] = bfhi(w.z); v[6] = bflo(w.w); v[7] = bfhi(w.w); }
__device__ __forceinline__ unsigned pk4_fp8(float a, float b, float c, float d) { int p = __builtin_amdgcn_cvt_pk_fp8_f32(a, b, 0, false); p = __builtin_amdgcn_cvt_pk_fp8_f32(c, d, p, true); return (unsigned)p; }
__device__ __forceinline__ float clamp448(float x) { return fminf(fmaxf(x, -448.f), 448.f); }
__device__ __forceinline__ float wave_sum(float v) {
#pragma unroll
    for (int o = 1; o < 64; o <<= 1) v += __shfl_xor(v, o);
    return v;
}
__device__ __forceinline__ float sum16(float v) {
#pragma unroll
    for (int o = 1; o < 16; o <<= 1) v += __shfl_xor(v, o);
    return v;
}
__device__ __forceinline__ void rowinfo(int row, int& base, int& T, int& t, int& mv) {
    if (row < MX) { const int b = row >> 11; base = b << 11; T = TX; t = row - base; mv = b; }
    else { const int r = row - MX, b = r >> 8; base = MX + (b << 8); T = TC; t = r - (b << 8); mv = 4; }
}
__device__ __forceinline__ int dirrow(int row, int dir) { int base, T, t, mv; rowinfo(row, base, T, t, mv); return dir ? base + (T - 1 - t) : row; }
#define LDS_WAIT() asm volatile("s_waitcnt lgkmcnt(0)" ::: "memory")
#define VM_WAIT() asm volatile("s_waitcnt vmcnt(0)" ::: "memory")
#define WG_BAR() do { __syncthreads(); } while (0)
}
#define XB_TMO      128
#define XB_XCNT(j)  (256  + 64 * (j))
#define XB_XSUB(j)  (1280 + 64 * (j))
#define XB_XGEN(j)  (2304 + 64 * (j))
#define XB_TOP      3328
#define XB_TOPGEN   3392
#define XCD_BAR_WORDS 3456
#define XB_SPIN_CAP (1u << 18)
#define LAS __attribute__((address_space(3)))

__device__ __forceinline__ unsigned xb_ld(unsigned* p)              { return __hip_atomic_load(p, __ATOMIC_RELAXED, __HIP_MEMORY_SCOPE_AGENT); }
__device__ __forceinline__ unsigned xb_add(unsigned* p, unsigned v) { return __hip_atomic_fetch_add(p, v, __ATOMIC_RELAXED, __HIP_MEMORY_SCOPE_AGENT); }
__device__ __forceinline__ unsigned xb_xcc_id() { return (unsigned)__builtin_amdgcn_s_getreg((3 << 11) | 20) & 0xFu; }
#define XB_SPIN(cond, bar) do { unsigned _sp = 0; while (cond) { __builtin_amdgcn_s_sleep(1); \
    if ((++_sp & 255u) == 0u) { if (xb_ld(&(bar)[XB_TMO])) break; if (_sp > XB_SPIN_CAP) { atomicAdd(&(bar)[XB_TMO], 1u); break; } } } } while (0)

struct XcdBarrier {
    unsigned* bar; unsigned x;
    volatile LAS unsigned* st;
};

__device__ __forceinline__ XcdBarrier xcd_barrier_post(unsigned* bar, volatile LAS unsigned* st) {
    XcdBarrier b; b.bar = bar; b.x = xb_xcc_id(); b.st = st;
    if (threadIdx.x == 0) (void)xb_add(&bar[XB_XCNT(b.x)], 1u);
    return b;
}
__device__ __forceinline__ void xcd_barrier_complete(unsigned* bar, unsigned x, unsigned& nloc, unsigned& nx) {
    const unsigned G = gridDim.x * gridDim.y * gridDim.z;
    unsigned sum, cnt, mine, sp = 0u;
    for (;;) {
        sum = 0u; cnt = 0u; mine = 0u;
#pragma unroll
        for (unsigned j = 0; j < 16; ++j) { const unsigned c = xb_ld(&bar[XB_XCNT(j)]); sum += c; cnt += (c > 0u) ? 1u : 0u; mine = (j == x) ? c : mine; }
        if (sum == G) break;
        __builtin_amdgcn_s_sleep(1);
        if ((++sp & 255u) == 0u) { if (xb_ld(&bar[XB_TMO])) break; if (sp > XB_SPIN_CAP) { atomicAdd(&bar[XB_TMO], 1u); break; } }
    }
    nloc = mine > 0u ? mine : 1u; nx = cnt > 0u ? cnt : 1u;
}

__device__ __forceinline__ void xcd_barrier(const XcdBarrier& b) {
    asm volatile("s_waitcnt vmcnt(0)" ::: "memory");
    __syncthreads();
    if (threadIdx.x == 0) {
        unsigned* bar = b.bar;
        __builtin_amdgcn_s_waitcnt(0);
        unsigned nloc = b.st[0], nx = b.st[1];
        if (nloc == 0u) { xcd_barrier_complete(bar, b.x, nloc, nx); b.st[0] = nloc; b.st[1] = nx; }
        const unsigned old = xb_add(&bar[XB_XSUB(b.x)], 1u);
        const unsigned gen = old / nloc;
        if (old + 1u == (gen + 1u) * nloc) {
            __builtin_amdgcn_fence(__ATOMIC_RELEASE, "agent");
            asm volatile("s_waitcnt vmcnt(0)" ::: "memory");
            const unsigned og = xb_add(&bar[XB_TOP], 1u);
            const unsigned tg = og / nx;
            if (og + 1u == (tg + 1u) * nx) xb_add(&bar[XB_TOPGEN], 1u);
            else XB_SPIN(xb_ld(&bar[XB_TOPGEN]) == tg, bar);
            __builtin_amdgcn_fence(__ATOMIC_ACQUIRE, "agent");
            xb_add(&bar[XB_XGEN(b.x)], 1u);
            asm volatile("s_waitcnt vmcnt(0)" ::: "memory");
        } else {
            XB_SPIN(xb_ld(&bar[XB_XGEN(b.x)]) == gen, bar);
            __builtin_amdgcn_fence(__ATOMIC_ACQUIRE, "agent");
            asm volatile("s_waitcnt vmcnt(0)" ::: "memory");
        }
    }
    __syncthreads();
}
namespace pg8 {
#define PG8_LAS __attribute__((address_space(3)))
typedef unsigned short bf16_t;
typedef short bf16x8 __attribute__((ext_vector_type(8)));
typedef float f32x4 __attribute__((ext_vector_type(4)));
typedef unsigned u32x4 __attribute__((ext_vector_type(4)));
constexpr int BM = 256, BK = 64, HALF = 128, HTB = HALF * BK * 2  , STAGE_BYTES = 8 * HTB, NXCD = 8, WGM = 8;

__host__ __device__ __forceinline__ int lds_byte(int r, int c) { const int st = (r >> 4) * 2 + (c >> 5), rr = r & 15, cc = c & 31, ob = rr * 64 + cc * 2; return st * 1024 + (ob ^ (((ob >> 9) & 1) << 5)); }
__host__ __device__ __forceinline__ void stage_rc(int b, int& R, int& C) { const int st = b / 1024, sb = b % 1024, swz = sb ^ (((sb >> 9) & 1) << 5); R = (st >> 1) * 16 + swz / 64; C = (st & 1) * 32 + (swz % 64) / 2; }
__host__ __device__ __forceinline__ int perm32(int rho) { const int n = rho >> 4, i = rho & 15; return 8 * (i >> 2) + 4 * n + (i & 3); }

struct Unit { int pm, pn, k0, nk; };
struct Gemm { const bf16_t* A; const bf16_t* Bt; int M, N, K; };

struct StaticOrder {
    int nM, nN, nwg, G, c;
    __host__ __device__ void init(int M, int N, int G_, int c_) { nM = M / BM; nN = N / BM; nwg = nM * nN; G = G_; c = c_; }
    __host__ __device__ bool next(int i, Unit& u) const {
        const long L = (long)i * G + c; if (L >= nwg) return false;
        int wgid = (int)L; { const int q = nwg / NXCD, r = nwg % NXCD, xcd = wgid % NXCD, off = wgid / NXCD; wgid = (xcd < r ? xcd * (q + 1) : r * (q + 1) + (xcd - r) * q) + off; }
        const int nig = WGM * nN, gid = wgid / nig, fm = gid * WGM, gsz = (nM - fm) < WGM ? (nM - fm) : WGM;
        u.pm = fm + ((wgid % nig) % gsz); u.pn = (wgid % nig) / gsz; u.k0 = 0; u.nk = 0; return true;
    }
    __device__ __forceinline__ void a_ready(const Unit&) const {}
    __device__ __forceinline__ void done(const Unit&) const {}
};
__device__ __forceinline__ unsigned cvt_pk_bf16(float lo, float hi) { unsigned r; asm volatile("v_cvt_pk_bf16_f32 %0, %1, %2" : "=v"(r) : "v"(lo), "v"(hi)); return r; }
typedef float f32x2 __attribute__((ext_vector_type(2)));
typedef int pg8_v8i __attribute__((ext_vector_type(8)));
typedef int pg8_v4i __attribute__((ext_vector_type(4)));
__device__ __forceinline__ pg8_v8i pg8_cat(bf16x8 lo, bf16x8 hi) { const pg8_v4i a = __builtin_bit_cast(pg8_v4i, lo), b = __builtin_bit_cast(pg8_v4i, hi); return __builtin_shufflevector(a, b, 0, 1, 2, 3, 4, 5, 6, 7); }
constexpr int F8_WSCALE = 121;
template <class Epi, class Sched, bool ALIGN_EPI = false, bool SP2 = false, bool F8 = false>
__device__ __forceinline__ void gemm_phase(PG8_LAS unsigned char* lds, const Gemm g, const Sched& S, const Epi& E) {
    const int tid = threadIdx.x, wid = __builtin_amdgcn_readfirstlane(tid >> 6), lane = tid & 63, wr = wid >> 2, wc = wid & 3, fr = lane & 15, fq = lane >> 4;
    const int K = g.K, nt = K / BK;
    unsigned voffA[2], voffB[2];
#pragma unroll
    for (int i = 0; i < 2; ++i) { int R, C; stage_rc(tid * 16 + i * 8192, R, C); const int Rb = Epi::PERM ? ((R & ~31) + perm32(R & 31)) : R;
        voffA[i] = (unsigned)(R * K + C) * 2u; voffB[i] = (unsigned)(Rb * K + C) * 2u; }
    const size_t kstep = (size_t)(BK * 2);
    const size_t hstep = (size_t)HALF * K * 2;
    const size_t tstep = 2 * hstep;
    const unsigned ldsw = (unsigned)wid * 1024u;
    const int aoff = lds_byte(wr * 64 + fr, fq * 8), boff = lds_byte(wc * 32 + fr, fq * 8);
#define PG8_SA(b, h) (((b) * 2 + (h)) * HTB)
#define PG8_SB(b, h) ((4 + (b) * 2 + (h)) * HTB)
#define PG8_STAGE(bufoff, gbase, voff) do { _Pragma("unroll") for (int _i = 0; _i < 2; ++_i) \
        __builtin_amdgcn_global_load_lds((const unsigned*)((const char*)(gbase) + (voff)[_i]), (PG8_LAS unsigned*)(lds + (bufoff) + ldsw + _i * 8192), 16, 0, 0); } while (0)
#define PG8_LDA(dst, b, h) do { _Pragma("unroll") for (int m = 0; m < 4; ++m) { if constexpr (F8) { dst##8[m] = pg8_cat(*(const PG8_LAS bf16x8*)(lds + PG8_SA(b, h) + aoff + m * 2048), *(const PG8_LAS bf16x8*)(lds + PG8_SA(b, h) + aoff + m * 2048 + 1024)); } else { _Pragma("unroll") for (int k = 0; k < 2; ++k) dst[m][k] = *(const PG8_LAS bf16x8*)(lds + PG8_SA(b, h) + aoff + m * 2048 + k * 1024); } } } while (0)
#define PG8_LDB(dst, b, h) do { _Pragma("unroll") for (int n = 0; n < 2; ++n) { if constexpr (F8) { dst##8[n] = pg8_cat(*(const PG8_LAS bf16x8*)(lds + PG8_SB(b, h) + boff + n * 2048), *(const PG8_LAS bf16x8*)(lds + PG8_SB(b, h) + boff + n * 2048 + 1024)); } else { _Pragma("unroll") for (int k = 0; k < 2; ++k) dst[n][k] = *(const PG8_LAS bf16x8*)(lds + PG8_SB(b, h) + boff + n * 2048 + k * 1024); } } } while (0)
#define PG8_MMA(ai, bj, At, Bt) do { __builtin_amdgcn_s_setprio(1); if constexpr (F8) { _Pragma("unroll") for (int m = 0; m < 4; ++m) _Pragma("unroll") for (int n = 0; n < 2; ++n) \
        asm volatile("v_mfma_scale_f32_16x16x128_f8f6f4 %0, %1, %2, %0, %3, %4 op_sel_hi:[0,0,0]" : "+v"(acc[ai][bj][m][n]) : "v"(Bt##8[n]), "v"(At##8[m]), "v"(f8_sw), "v"(f8_sa)); } \
        else { _Pragma("unroll") for (int m = 0; m < 4; ++m) _Pragma("unroll") for (int n = 0; n < 2; ++n) _Pragma("unroll") for (int k = 0; k < 2; ++k) \
        acc[ai][bj][m][n] = __builtin_amdgcn_mfma_f32_16x16x32_bf16(Bt[n][k], At[m][k], acc[ai][bj][m][n], 0, 0, 0); } __builtin_amdgcn_s_setprio(0); } while (0)
#define PG8_WAIT_V(n) asm volatile("s_waitcnt vmcnt(" #n ")" ::: "memory")
#define PG8_WAIT_L(n) asm volatile("s_waitcnt lgkmcnt(" #n ")" ::: "memory")
#define PG8_BAR __builtin_amdgcn_s_barrier()
#define PG8_SCHED __builtin_amdgcn_sched_barrier(0)
    Unit cur, nxt; int ui = 0;
    if (!S.next(0, cur)) return;
    f32x4 acc[2][2][4][2];
#pragma unroll
    for (int a = 0; a < 2; ++a)
#pragma unroll
        for (int b = 0; b < 2; ++b)
#pragma unroll
            for (int m = 0; m < 4; ++m)
#pragma unroll
                for (int n = 0; n < 2; ++n) acc[a][b][m][n] = (f32x4){0.f, 0.f, 0.f, 0.f};
    bf16x8 At[4][2], B0[2][2], B1[2][2]; pg8_v8i At8[4], B08[2], B18[2]; const int f8_sw = F8_WSCALE, f8_sa = 127;
    const char* cA = (const char*)g.A + (size_t)cur.pm * tstep + (size_t)cur.k0 * 2; const char* cB = (const char*)g.Bt + (size_t)cur.pn * tstep + (size_t)cur.k0 * 2;
    S.a_ready(cur);
    if constexpr (SP2) {
        PG8_STAGE(PG8_SB(0, 0), cB, voffB); PG8_STAGE(PG8_SB(0, 1), cB + hstep, voffB); PG8_STAGE(PG8_SA(0, 0), cA, voffA); PG8_STAGE(PG8_SA(0, 1), cA + hstep, voffA);
        if (wr == 1) PG8_BAR;
        PG8_WAIT_V(2); PG8_BAR;
        PG8_STAGE(PG8_SB(1, 0), cB + kstep, voffB); PG8_STAGE(PG8_SA(1, 0), cA + kstep, voffA); PG8_STAGE(PG8_SB(1, 1), cB + hstep + kstep, voffB);
        PG8_WAIT_V(6); PG8_BAR;
    } else {
        PG8_STAGE(PG8_SB(0, 0), cB, voffB); PG8_STAGE(PG8_SA(0, 0), cA, voffA); PG8_STAGE(PG8_SB(0, 1), cB + hstep, voffB); PG8_STAGE(PG8_SA(0, 1), cA + hstep, voffA);
        if (wr == 1) PG8_BAR;
        PG8_WAIT_V(4); PG8_BAR;
        PG8_STAGE(PG8_SB(1, 0), cB + kstep, voffB); PG8_STAGE(PG8_SA(1, 0), cA + kstep, voffA); PG8_STAGE(PG8_SB(1, 1), cB + hstep + kstep, voffB);
        PG8_WAIT_V(6); PG8_BAR;
    }
    for (;;) {
        const bool has_next = S.next(ui + 1, nxt);
        const char* nA = has_next ? (const char*)g.A + (size_t)nxt.pm * tstep + (size_t)nxt.k0 * 2 : cA; const char* nB = has_next ? (const char*)g.Bt + (size_t)nxt.pn * tstep + (size_t)nxt.k0 * 2 : cB;
        const int ntc = cur.nk ? cur.nk : nt;
        for (int t = 0; t < ntc; t += 2) {
            const bool last = (t == ntc - 2);
            const char* a1 = cA + (size_t)(t + 1) * kstep;
            const char* a2 = last ? nA : cA + (size_t)(t + 2) * kstep; const char* b2 = last ? nB : cB + (size_t)(t + 2) * kstep;
            const char* a3 = a2 + kstep; const char* b3 = b2 + kstep;
            if (last && has_next) S.a_ready(nxt);
            if constexpr (SP2) {
            PG8_LDB(B0, 0, 0); PG8_LDB(B1, 0, 1); PG8_SCHED; PG8_LDA(At, 0, 0); PG8_STAGE(PG8_SA(1, 1), a1 + hstep, voffA);
            PG8_WAIT_V(8); PG8_WAIT_L(0); PG8_BAR; PG8_MMA(0, 0, At, B0); PG8_MMA(0, 1, At, B1); PG8_BAR; PG8_SCHED;
            PG8_LDA(At, 0, 1); PG8_STAGE(PG8_SB(0, 0), b2, voffB); PG8_STAGE(PG8_SB(0, 1), b2 + hstep, voffB); PG8_STAGE(PG8_SA(0, 0), a2, voffA);
            PG8_WAIT_V(8); PG8_WAIT_L(0); PG8_BAR; PG8_MMA(1, 0, At, B0); PG8_MMA(1, 1, At, B1); PG8_BAR; PG8_SCHED;
            PG8_LDB(B0, 1, 0); PG8_LDB(B1, 1, 1); PG8_SCHED; PG8_LDA(At, 1, 0); PG8_STAGE(PG8_SA(0, 1), a2 + hstep, voffA);
            PG8_WAIT_V(8); PG8_WAIT_L(0); PG8_BAR; PG8_MMA(0, 0, At, B0); PG8_MMA(0, 1, At, B1); PG8_BAR; PG8_SCHED;
            PG8_LDA(At, 1, 1); PG8_STAGE(PG8_SB(1, 0), b3, voffB); PG8_STAGE(PG8_SB(1, 1), b3 + hstep, voffB); PG8_STAGE(PG8_SA(1, 0), a3, voffA);
            PG8_WAIT_V(8); PG8_WAIT_L(0); PG8_BAR; PG8_MMA(1, 0, At, B0); PG8_MMA(1, 1, At, B1); PG8_BAR; PG8_SCHED;
            } else {
            PG8_LDB(B0, 0, 0); PG8_SCHED; PG8_LDA(At, 0, 0); PG8_STAGE(PG8_SA(1, 1), a1 + hstep, voffA);
            PG8_WAIT_L(8); PG8_BAR; PG8_WAIT_L(0); PG8_MMA(0, 0, At, B0); PG8_BAR; PG8_SCHED;
            PG8_LDB(B1, 0, 1); PG8_STAGE(PG8_SB(0, 0), b2, voffB);
            PG8_BAR; PG8_WAIT_L(0); PG8_MMA(0, 1, At, B1); PG8_BAR;
            PG8_LDA(At, 0, 1); PG8_STAGE(PG8_SA(0, 0), a2, voffA);
            PG8_BAR; PG8_WAIT_L(0); PG8_MMA(1, 0, At, B0); PG8_BAR; PG8_SCHED;
            PG8_STAGE(PG8_SB(0, 1), b2 + hstep, voffB);
            PG8_WAIT_V(6); PG8_BAR; PG8_MMA(1, 1, At, B1); PG8_BAR;
            PG8_LDB(B0, 1, 0); PG8_SCHED; PG8_LDA(At, 1, 0); PG8_STAGE(PG8_SA(0, 1), a2 + hstep, voffA);
            PG8_WAIT_L(8); PG8_BAR; PG8_WAIT_L(0); PG8_MMA(0, 0, At, B0); PG8_BAR; PG8_SCHED;
            PG8_LDB(B1, 1, 1); PG8_STAGE(PG8_SB(1, 0), b3, voffB);
            PG8_BAR; PG8_WAIT_L(0); PG8_MMA(0, 1, At, B1); PG8_BAR;
            PG8_LDA(At, 1, 1); PG8_STAGE(PG8_SA(1, 0), a3, voffA);
            PG8_BAR; PG8_WAIT_L(0); PG8_MMA(1, 0, At, B0); PG8_BAR; PG8_SCHED;
            PG8_STAGE(PG8_SB(1, 1), b3 + hstep, voffB);
            PG8_WAIT_V(6); PG8_BAR; PG8_MMA(1, 1, At, B1); PG8_BAR;
            }
        }
        if constexpr (F8) { asm volatile("s_nop 15\n\ts_nop 15" ::: "memory"); }
        if constexpr (ALIGN_EPI) { if (wr == 0) PG8_BAR; }
        if constexpr (!Epi::AFTER_DRAIN) { E(acc, cur, wr, wc, fr, fq); S.done(cur); }
        if (!has_next) break;
#pragma unroll
        for (int a = 0; a < 2; ++a)
#pragma unroll
            for (int b = 0; b < 2; ++b)
#pragma unroll
                for (int m = 0; m < 4; ++m)
#pragma unroll
                    for (int n = 0; n < 2; ++n) acc[a][b][m][n] = (f32x4){0.f, 0.f, 0.f, 0.f};
        cur = nxt; cA = nA; cB = nB; ++ui;
        if constexpr (ALIGN_EPI) { if (wr == 1) PG8_BAR; }
    }
    PG8_WAIT_V(0);
    if constexpr (!ALIGN_EPI) { if (wr == 0) PG8_BAR; }
    PG8_BAR;
    if constexpr (Epi::AFTER_DRAIN) { E.fused(acc, cur, wr, wc, fr, fq, lds, wid, lane); S.done(cur); }
#undef PG8_SA
#undef PG8_SB
#undef PG8_STAGE
#undef PG8_LDA
#undef PG8_LDB
#undef PG8_MMA
#undef PG8_WAIT_V
#undef PG8_WAIT_L
#undef PG8_BAR
#undef PG8_SCHED
}
struct EpiStoreBf16 {
    static constexpr bool PERM = true, AFTER_DRAIN = false;
    bf16_t* O; int ldc; float* AB;
    __device__ __forceinline__ void operator()(const f32x4 (&acc)[2][2][4][2], const Unit& u, int wr, int wc, int fr, int fq) const {
        const int row0 = u.pm * BM + wr * 64 + fr, col0 = u.pn * BM + wc * 32 + 8 * fq;
        if (u.pn == 18) { if (wc == 0 && fq < 2) {
#pragma unroll
            for (int ai = 0; ai < 2; ++ai)
#pragma unroll
                for (int m = 0; m < 4; ++m) { float* rp = AB + (size_t)(row0 + ai * HALF + m * 16) * 16 + 8 * fq; *(f32x4*)rp = acc[ai][0][m][0]; *(f32x4*)(rp + 4) = acc[ai][0][m][1]; } }
            return; }
#pragma unroll
        for (int ai = 0; ai < 2; ++ai)
#pragma unroll
            for (int m = 0; m < 4; ++m) { bf16_t* rowp = O + (size_t)(row0 + ai * HALF + m * 16) * ldc + col0;
#pragma unroll
                for (int bj = 0; bj < 2; ++bj) { const f32x4 v0 = acc[ai][bj][m][0], v1 = acc[ai][bj][m][1];
                    u32x4 w; w.x = cvt_pk_bf16(v0[0], v0[1]); w.y = cvt_pk_bf16(v0[2], v0[3]); w.z = cvt_pk_bf16(v1[0], v1[1]); w.w = cvt_pk_bf16(v1[2], v1[3]);
                    *(u32x4*)(rowp + bj * HALF) = w; } }
    }
};
struct EpiResid {
    static constexpr bool PERM = false, AFTER_DRAIN = false;
    float* X; const float* mod; int goff; float* part; int kslice;
    __device__ __forceinline__ void operator()(const f32x4 (&acc)[2][2][4][2], const Unit& u, int wr, int wc, int fr, int fq) const {
        const int row0 = u.pm * BM + wr * 64 + fr, col0 = u.pn * BM + wc * 32 + 4 * fq;
        const int mv = u.pm < 32 ? (u.pm >> 3) : 4;
        const float* gp = mod + (size_t)mv * 12288 + goff + col0;
        f32x4 gv[2][2];
#pragma unroll
        for (int bj = 0; bj < 2; ++bj)
#pragma unroll
            for (int n = 0; n < 2; ++n) gv[bj][n] = *(const f32x4*)(gp + bj * HALF + n * 16);
        if (u.nk != 0) { float* pb = part + ((size_t)(u.k0 / kslice) * 1024 + (row0 - 8192)) * 2048 + col0;
#pragma unroll
            for (int ai = 0; ai < 2; ++ai)
#pragma unroll
                for (int m = 0; m < 4; ++m) { float* rowp = pb + (size_t)(ai * HALF + m * 16) * 2048;
#pragma unroll
                    for (int bj = 0; bj < 2; ++bj)
#pragma unroll
                        for (int n = 0; n < 2; ++n) *(f32x4*)(rowp + bj * HALF + n * 16) = gv[bj][n] * acc[ai][bj][m][n]; }
            return; }
#pragma unroll
        for (int ai = 0; ai < 2; ++ai)
#pragma unroll
            for (int m = 0; m < 4; ++m) { float* rowp = X + (size_t)(row0 + ai * HALF + m * 16) * 2048 + col0;
#pragma unroll
                for (int bj = 0; bj < 2; ++bj)
#pragma unroll
                    for (int n = 0; n < 2; ++n) { f32x4* p = (f32x4*)(rowp + bj * HALF + n * 16); *p = *p + gv[bj][n] * acc[ai][bj][m][n]; } }
    }
};
struct ResidOrder {
    StaticOrder so; int G, c, kslice;
    __device__ void init(int K, int G_, int c_) { so.init(8192, 2048, G_, c_); G = G_; c = c_; kslice = K / 4; }
    __device__ bool next(int i, Unit& u) const {
        const int L = i * G + c;
        if (L < so.nwg) return so.next(i, u);
        const int j = L - so.nwg; if (j >= 128) return false;
        const int t = j >> 2; u.pm = 32 + (t >> 3); u.pn = t & 7; u.k0 = (j & 3) * kslice; u.nk = kslice / BK; return true;
    }
    __device__ __forceinline__ void a_ready(const Unit&) const {}
    __device__ __forceinline__ void done(const Unit&) const {}
};
__device__ __forceinline__ float silu_f(float x) { return x * __builtin_amdgcn_rcpf(1.f + __builtin_amdgcn_exp2f(-1.4426950408889634f * x)); }
struct EpiSwiglu {
    static constexpr bool PERM = true, AFTER_DRAIN = false;
    bf16_t* H; int ldh; int ntn;
    __device__ __forceinline__ void operator()(const f32x4 (&acc)[2][2][4][2], const Unit& u, int wr, int wc, int fr, int fq) const {
        const int row0 = u.pm * BM + wr * 64 + fr, hcol0 = (u.pn % ntn) * HALF + wc * 32 + 8 * fq;
#pragma unroll
        for (int ai = 0; ai < 2; ++ai)
#pragma unroll
            for (int m = 0; m < 4; ++m) { bf16_t* rowp = H + (size_t)(row0 + ai * HALF + m * 16) * ldh + hcol0;
                const f32x4 a0 = acc[ai][0][m][0], a1 = acc[ai][0][m][1], b0 = acc[ai][1][m][0], b1 = acc[ai][1][m][1];
                float h[8];
#pragma unroll
                for (int j = 0; j < 4; ++j) { if (FP8_EMU && ntn == 56) { const float q = 1.f / 64.f; h[j] = rne_e4m3(silu_f(a0[j] * q) * (b0[j] * q)); h[4 + j] = rne_e4m3(silu_f(a1[j] * q) * (b1[j] * q)); } else { h[j] = silu_f(a0[j]) * b0[j]; h[4 + j] = silu_f(a1[j]) * b1[j]; } }
                u32x4 w; w.x = cvt_pk_bf16(h[0], h[1]); w.y = cvt_pk_bf16(h[2], h[3]); w.z = cvt_pk_bf16(h[4], h[5]); w.w = cvt_pk_bf16(h[6], h[7]);
                *(u32x4*)rowp = w; }
    }
};
struct EpiSwiglu8 {
    static constexpr bool PERM = true, AFTER_DRAIN = false;
    unsigned char* H; int ldh; int ntn;
    __device__ __forceinline__ void operator()(const f32x4 (&acc)[2][2][4][2], const Unit& u, int wr, int wc, int fr, int fq) const {
        const int row0 = u.pm * BM + wr * 64 + fr, hcol0 = (u.pn % ntn) * HALF + wc * 32 + 8 * fq;
#pragma unroll
        for (int ai = 0; ai < 2; ++ai)
#pragma unroll
            for (int m = 0; m < 4; ++m) { unsigned char* rowp = H + (size_t)(row0 + ai * HALF + m * 16) * ldh + hcol0;
                const f32x4 a0 = acc[ai][0][m][0], a1 = acc[ai][0][m][1], b0 = acc[ai][1][m][0], b1 = acc[ai][1][m][1];
                float h[8];
#pragma unroll
                for (int j = 0; j < 4; ++j) { h[j] = __builtin_amdgcn_fmed3f(silu_f(a0[j]) * b0[j], -448.f, 448.f); h[4 + j] = __builtin_amdgcn_fmed3f(silu_f(a1[j]) * b1[j], -448.f, 448.f); }
                int p0 = __builtin_amdgcn_cvt_pk_fp8_f32(h[0], h[1], 0, false); p0 = __builtin_amdgcn_cvt_pk_fp8_f32(h[2], h[3], p0, true);
                int p1 = __builtin_amdgcn_cvt_pk_fp8_f32(h[4], h[5], 0, false); p1 = __builtin_amdgcn_cvt_pk_fp8_f32(h[6], h[7], p1, true);
                u32x2 w; w.x = (unsigned)p0; w.y = (unsigned)p1; *(u32x2*)rowp = w; }
    }
};
struct EpiStoreF32 {
    static constexpr bool PERM = false, AFTER_DRAIN = false;
    float* C; float* part; int kslice;
    __device__ __forceinline__ void operator()(const f32x4 (&acc)[2][2][4][2], const Unit& u, int wr, int wc, int fr, int fq) const {
        const int row0 = u.pm * BM + wr * 64 + fr, col0 = (u.pn & 7) * BM + wc * 32 + 4 * fq;
        float* base = u.nk != 0 ? part + ((size_t)(u.k0 / kslice) * 2048 + (row0 - 16384)) * 2048 + col0 : C + (size_t)row0 * 2048 + col0;
#pragma unroll
        for (int ai = 0; ai < 2; ++ai)
#pragma unroll
            for (int m = 0; m < 4; ++m) { float* rowp = base + (size_t)(ai * HALF + m * 16) * 2048;
#pragma unroll
                for (int bj = 0; bj < 2; ++bj)
#pragma unroll
                    for (int n = 0; n < 2; ++n) *(f32x4*)(rowp + bj * HALF + n * 16) = FP8_EMU ? acc[ai][bj][m][n] * (1.f / 64.f) : acc[ai][bj][m][n]; }
    }
};
struct InProjL1Order {
    StaticOrder so; int G, c;
    __device__ void init(int G_, int c_) { so.init(8192, 4864, G_, c_); G = G_; c = c_; }
    __device__ bool next(int i, Unit& u) const {
        const int L = i * G + c;
        if (L < so.nwg) return so.next(i, u);
        const int L2 = L - so.nwg; if (L2 >= 28) return false;
        u.pm = 32 + (L2 & 3); u.pn = (L2 >> 2) == 6 ? 18 : (L2 >> 2); u.k0 = 0; u.nk = 0; return true;
    }
    __device__ __forceinline__ void a_ready(const Unit&) const {}
    __device__ __forceinline__ void done(const Unit&) const {}
};
struct MoeOrder {
    StaticOrder so; const int* tile_e; int NT;
    __device__ void init(int ntiles, int NT_, const int* te, int G_, int c_) { so.nM = ntiles; so.nN = NT_; so.nwg = ntiles * NT_; so.G = G_; so.c = c_; tile_e = te; NT = NT_; }
    __device__ bool next(int i, Unit& u) const { if (!so.next(i, u)) return false; u.pn += tile_e[u.pm] * NT; return true; }
    __device__ __forceinline__ void a_ready(const Unit&) const {}
    __device__ __forceinline__ void done(const Unit&) const {}
};
struct MoeDownOrder {
    StaticOrder so; const int* tile_e; int ntiles, G, c, kslice;
    __device__ void init(int ntiles_, const int* te, int K, int G_, int c_) { ntiles = ntiles_; const int nm = ntiles_ < 64 ? ntiles_ : 64; so.nM = nm; so.nN = 8; so.nwg = nm * 8; so.G = G_; so.c = c_; tile_e = te; G = G_; c = c_; kslice = K / 4; }
    __device__ bool next(int i, Unit& u) const {
        const int L = i * G + c;
        if (L < so.nwg) { so.next(i, u); u.pn += tile_e[u.pm] * 8; return true; }
        const int j = L - so.nwg; if (j >= (ntiles - so.nM) * 32) return false;
        const int t = j >> 2; u.pm = 64 + (t >> 3); u.pn = tile_e[u.pm] * 8 + (t & 7); u.k0 = (j & 3) * kslice; u.nk = kslice / BK; return true;
    }
    __device__ __forceinline__ void a_ready(const Unit&) const {}
    __device__ __forceinline__ void done(const Unit&) const {}
};
}
namespace mk {
typedef const float* KP;
typedef __attribute__((address_space(4))) KP const* CIN;
struct Ctx {
    LAS unsigned char* lds;
    CIN in; float* out; unsigned char* ws;
    int tid, lane, wave, G, bid;
};
#define WSP(T, off) ((T*)(C.ws + (off)))
__device__ __forceinline__ const float* inp_(CIN p, int k) { asm volatile("" : "+s"(p)); return p[k]; }
#define INP(k) inp_(C.in, (k))

__device__ __forceinline__ void tr_item(const float* W, int ldw, int k0, int ncol0, bf16* WT, int ldt, int drow0, LAS float* scr, int lane, bool f8 = false) {
    f32x4 v[16];
#pragma unroll
    for (int i = 0; i < 16; ++i) { const int idx = lane + 64 * i, kk = idx >> 4, c4 = idx & 15; v[i] = *(const f32x4*)(W + (size_t)(k0 + kk) * ldw + ncol0 + 4 * c4); }
    if (FP8_EMU && f8) {
#pragma unroll
        for (int i = 0; i < 16; ++i) { v[i].x = rne_e4m3(v[i].x * 64.f); v[i].y = rne_e4m3(v[i].y * 64.f); v[i].z = rne_e4m3(v[i].z * 64.f); v[i].w = rne_e4m3(v[i].w * 64.f); } }
#pragma unroll
    for (int i = 0; i < 16; ++i) { const int idx = lane + 64 * i, kk = idx >> 4, c4 = idx & 15; LAS float* p = scr + kk * 65 + 4 * c4; p[0] = v[i].x; p[1] = v[i].y; p[2] = v[i].z; p[3] = v[i].w; }
    LDS_WAIT(); asm volatile("" ::: "memory");
    const int c = lane & 7;
#pragma unroll
    for (int jj = 0; jj < 8; ++jj) { const int n = (lane >> 3) + 8 * jj; const LAS float* s = scr + (8 * c) * 65 + n;
        u32x4 o; o.x = pk2(s[0], s[65]); o.y = pk2(s[2 * 65], s[3 * 65]); o.z = pk2(s[4 * 65], s[5 * 65]); o.w = pk2(s[6 * 65], s[7 * 65]);
        *(u32x4*)(WT + (size_t)(drow0 + n) * ldt + k0 + 8 * c) = o; }
    LDS_WAIT(); asm volatile("" ::: "memory");
}
__device__ __forceinline__ void tr_item8(const float* W, int ldw, int k0, int ncol0, unsigned char* WT, int ldt, int drow0, LAS float* scr, int lane) {
    f32x4 v[16];
#pragma unroll
    for (int i = 0; i < 16; ++i) { const int idx = lane + 64 * i, kk = idx >> 3, c4 = idx & 7; v[i] = *(const f32x4*)(W + (size_t)(k0 + kk) * ldw + ncol0 + 4 * c4); }
#pragma unroll
    for (int i = 0; i < 16; ++i) { const int idx = lane + 64 * i, kk = idx >> 3, c4 = idx & 7; LAS float* p = scr + kk * 33 + 4 * c4; p[0] = v[i].x * 64.f; p[1] = v[i].y * 64.f; p[2] = v[i].z * 64.f; p[3] = v[i].w * 64.f; }
    LDS_WAIT(); asm volatile("" ::: "memory");
    const int c = lane & 7;
#pragma unroll
    for (int jj = 0; jj < 4; ++jj) { const int n = (lane >> 3) + 8 * jj; const LAS float* s = scr + (16 * c) * 33 + n;
        u32x4 o; o.x = pk4_fp8(s[0], s[33], s[2 * 33], s[3 * 33]); o.y = pk4_fp8(s[4 * 33], s[5 * 33], s[6 * 33], s[7 * 33]);
        o.z = pk4_fp8(s[8 * 33], s[9 * 33], s[10 * 33], s[11 * 33]); o.w = pk4_fp8(s[12 * 33], s[13 * 33], s[14 * 33], s[15 * 33]);
        *(u32x4*)(WT + (size_t)(drow0 + n) * ldt + k0 + 16 * c) = o; }
    LDS_WAIT(); asm volatile("" ::: "memory");
}
constexpr int IT_WIN = 32 * 73, IT_WOUT = 32 * 32, IT_W1 = 32 * 88, IT_W2 = 88 * 32, IT_MW1 = 32 * 112, IT_MW2 = 112 * 32, IT_PW = 2 * 2;
constexpr int IT_PRO = IT_WIN + 8 * IT_PW;
constexpr int BG_WOUT0 = 0, BG_W13 = BG_WOUT0 + IT_WOUT, BG_W2 = BG_W13 + 2 * IT_W1, BG_WIN1 = BG_W2 + IT_W2, BG_WOUT1 = BG_WIN1 + IT_WIN, BG_MOE = BG_WOUT1 + IT_WOUT, NBG = BG_MOE + 16 * IT_MW1 + 8 * IT_MW2;
constexpr int IT_TOTAL = IT_PRO + NBG;
__device__ __forceinline__ void tr_dispatch(Ctx& C, int it, LAS float* scr) {
    const float* W; int ldw, k0, nc0, ldt, dr0; bf16* WT; int r = it;
    if (r < IT_WIN) { const int kb = r / 73, nb = r % 73; W = INP(7); ldw = INW; k0 = 64 * kb; nc0 = nb == 72 ? 1536 : nb < 24 ? 64 * nb : 1552 + 64 * (nb - 24); WT = WSP(bf16, WS_WIN); ldt = D; dr0 = nb == 72 ? 4608 : nb < 24 ? 64 * nb : 1536 + 64 * (nb - 24); }
    else if (r < IT_PRO) { r -= IT_WIN; const int m = r / IT_PW, q = r % IT_PW; W = INP(16) + (size_t)m * 128 * 128; ldw = 128; k0 = 64 * (q >> 1); nc0 = 64 * (q & 1); WT = WSP(bf16, WS_PWT) + (size_t)m * 128 * 128; ldt = 128; dr0 = 64 * (q & 1); }
    else { r -= IT_PRO;
        if (r < BG_W13) { const int kb = r / 32, nb = r % 32; W = INP(22); ldw = D; k0 = 64 * kb; nc0 = 64 * nb; WT = WSP(bf16, WS_WOUT); ldt = D; dr0 = 64 * nb; }
        else if (r < BG_W2) { r -= BG_W13; const int s = r / IT_W1; r -= s * IT_W1; const int kb = r / 88, nb = r % 88; W = INP(24 + s); ldw = DFF; k0 = 64 * kb; nc0 = 64 * nb; WT = WSP(bf16, WS_W13); ldt = D; dr0 = 256 * (nb >> 1) + 128 * s + 64 * (nb & 1); }
        else if (r < BG_WIN1) { r -= BG_W2; const int kb = r / 32, nb = r % 32; W = INP(26); ldw = D; k0 = 64 * kb; nc0 = 64 * nb; WT = WSP(bf16, WS_W2); ldt = DFF; dr0 = 64 * nb; }
        else if (r < BG_WOUT1) { r -= BG_WIN1; const int kb = r / 73, nb = r % 73; W = INP(7) + (size_t)D * INW; ldw = INW; k0 = 64 * kb; nc0 = nb == 72 ? 1536 : nb < 24 ? 64 * nb : 1552 + 64 * (nb - 24); WT = WSP(bf16, WS_WIN) + (size_t)NINP * D; ldt = D; dr0 = nb == 72 ? 4608 : nb < 24 ? 64 * nb : 1536 + 64 * (nb - 24); }
        else if (r < BG_MOE) { r -= BG_WOUT1; const int kb = r / 32, nb = r % 32; W = INP(22) + (size_t)D * D; ldw = D; k0 = 64 * kb; nc0 = 64 * nb; WT = WSP(bf16, WS_WOUT) + (size_t)D * D; ldt = D; dr0 = 64 * nb; }
        else { r -= BG_MOE;
            if (MOE_FP8) {
                if (r < 16 * IT_MW1) { const int j = r / IT_MW1; r -= j * IT_MW1; const int s = j >> 3, e = j & 7, kb = r / 224, nb = r % 224, h0 = 32 * nb;
                    tr_item8(INP(29 + s) + (size_t)e * D * DFE, DFE, 128 * kb, h0, WSP(unsigned char, WS_MW13) + (size_t)e * 2 * DFE * D, D, 256 * (h0 >> 7) + 128 * s + (h0 & 127), scr, C.lane); }
                else { r -= 16 * IT_MW1; const int e = r / IT_MW2; r -= e * IT_MW2; const int kb = r / 64, nb = r % 64;
                    tr_item8(INP(31) + (size_t)e * DFE * D, D, 128 * kb, 32 * nb, WSP(unsigned char, WS_MW2) + (size_t)e * D * DFE, DFE, 32 * nb, scr, C.lane); }
                return; }
            if (r < 16 * IT_MW1) { const int j = r / IT_MW1; r -= j * IT_MW1; const int s = j >> 3, e = j & 7, kb = r / 112, nb = r % 112;
                W = INP(29 + s) + (size_t)e * D * DFE; ldw = DFE; k0 = 64 * kb; nc0 = 64 * nb; WT = WSP(bf16, WS_MW13) + (size_t)e * 2 * DFE * D; ldt = D; dr0 = 256 * (nb >> 1) + 128 * s + 64 * (nb & 1); }
            else { r -= 16 * IT_MW1; const int e = r / IT_MW2; r -= e * IT_MW2; const int kb = r / 32, nb = r % 32;
                W = INP(31) + (size_t)e * DFE * D; ldw = D; k0 = 64 * kb; nc0 = 64 * nb; WT = WSP(bf16, WS_MW2) + (size_t)e * D * DFE; ldt = DFE; dr0 = 64 * nb; } } }
    tr_item(W, ldw, k0, nc0, WT, ldt, dr0, scr, C.lane, it >= IT_PRO + BG_MOE);
}
#ifndef BG_BATCH_N
#define BG_BATCH_N 1
#endif
constexpr int BG_BATCH = BG_BATCH_N;
__device__ __forceinline__ void bg_work(Ctx& C, int limit, int poll_phase) {
    unsigned* ctl = WSP(unsigned, WS_CTL);
    volatile LAS unsigned* flag = (volatile LAS unsigned*)(C.lds + LDS_BARW + 8);
    VM_WAIT(); __syncthreads();
    if (C.tid == 0) { flag[0] = 0u; flag[1] = __hip_atomic_load(ctl + CW_BGHEAD, __ATOMIC_RELAXED, __HIP_MEMORY_SCOPE_AGENT) >= (unsigned)NBG ? 1u : 0u;
        if (poll_phase >= 0) __hip_atomic_fetch_add(ctl + CW_DONE + 64 * poll_phase, 1u, __ATOMIC_RELAXED, __HIP_MEMORY_SCOPE_AGENT); }
    __syncthreads();
    if (flag[1] != 0u) return;
    LAS float* scr = (LAS float*)(C.lds + C.wave * 16896);
    for (;;) {
        if (C.tid == 0) { unsigned base = 0xffffffffu;
            const unsigned head = __hip_atomic_load(ctl + CW_BGHEAD, __ATOMIC_RELAXED, __HIP_MEMORY_SCOPE_AGENT);
            bool go = head < (unsigned)limit;
            if (!go && poll_phase >= 0 && head < (unsigned)NBG) go = __hip_atomic_load(ctl + CW_DONE + 64 * poll_phase, __ATOMIC_RELAXED, __HIP_MEMORY_SCOPE_AGENT) < (unsigned)C.G;
            if (go) base = __hip_atomic_fetch_add(ctl + CW_BGHEAD, (unsigned)NWAVE, __ATOMIC_RELAXED, __HIP_MEMORY_SCOPE_AGENT);
            flag[0] = base; }
        __syncthreads();
        const unsigned base = flag[0];
        if (base >= (unsigned)NBG) break;
        if (base + C.wave < (unsigned)NBG) tr_dispatch(C, IT_PRO + (int)base + C.wave, scr);
        __syncthreads();
    }
}
__device__ __forceinline__ void mod_unit(Ctx& C, int unit, LAS float* sv  , LAS float* red  ) {
    const int l = unit / 192, col0 = (unit % 192) * 64, cq = C.tid & 15, ks = C.tid >> 4;
    const float* w = INP(4) + ((size_t)l * D + ks * 64) * 12288 + col0 + 4 * cq;
    f32x4 acc[5];
#pragma unroll
    for (int v = 0; v < 5; ++v) acc[v] = (f32x4){0.f, 0.f, 0.f, 0.f};
#pragma unroll 8
    for (int k = 0; k < 64; ++k) { const f32x4 wv = *(const f32x4*)(w + (size_t)k * 12288);
#pragma unroll
        for (int v = 0; v < 5; ++v) acc[v] += wv * sv[v * 2048 + ks * 64 + k]; }
#pragma unroll
    for (int v = 0; v < 5; ++v) *(LAS f32x4*)(red + (ks * 5 + v) * 64 + 4 * cq) = acc[v];
    WG_BAR();
    if (C.tid < 320) { const int v = C.tid >> 6, c = C.tid & 63; float s = 0.f;
#pragma unroll 8
        for (int k = 0; k < 32; ++k) s += red[(k * 5 + v) * 64 + c];
        WSP(float, WS_MODV)[((size_t)l * 5 + v) * 12288 + col0 + c] = s + INP(5)[l * 12288 + col0 + c]; }
    WG_BAR();
}
__device__ __forceinline__ void p_prologue(Ctx& C) {
    LAS float* sv = (LAS float*)C.lds; LAS float* red = sv + 5 * 2048;
    for (int i = C.tid; i < 5 * 2048; i += NTHR) { const float x = i < 4 * 2048 ? INP(1)[i] : INP(3)[i - 4 * 2048]; sv[i] = x / (1.f + expf(-x)); }
    WG_BAR();
    for (int u = C.bid; u < 384; u += C.G) mod_unit(C, u, sv, red);
    for (int i = C.bid * NTHR + C.tid; i < 2 * 2048 * 4; i += C.G * NTHR) { const int lk = i >> 2, q = i & 3; *(f32x4*)(WSP(float, WS_WABC) + (size_t)lk * 16 + 4 * q) = *(const f32x4*)(INP(7) + (size_t)lk * INW + 1536 + 4 * q); }
    { float* pos = WSP(float, WS_POS);
      for (size_t i = (size_t)C.bid * NTHR + C.tid; i < (size_t)TX * D; i += (size_t)C.G * NTHR) {
          const int t = (int)(i >> 11), d = (int)(i & 2047), r = t >> 6, cc = t & 63, part = d >> 9, fi = d & 511;
          const float freq = expf(-9.210340371976184f * (float)fi / 512.f);
          const float ang = (part < 2 ? (float)r : (float)cc) * freq;
          pos[i] = (part & 1) ? __cosf(ang) : __sinf(ang); } }
    WG_BAR();
    LAS float* scr = (LAS float*)(C.lds + C.wave * 16896);
    const int gw = C.bid * NWAVE + C.wave, NGW = C.G * NWAVE;
    const int nit = (STATIC_FILL && C.G == 256) ? IT_PRO + BG_MOE : IT_TOTAL;
    for (int it = gw; it < nit; it += NGW) tr_dispatch(C, it, scr);
}
struct F8Item { const float* W; unsigned char* WT; int ldw, ldt; };
__device__ __forceinline__ F8Item f8_item(Ctx& C, int r) {
    F8Item t;
    if (r < 16 * IT_MW1) { const int j = r / IT_MW1; r -= j * IT_MW1; const int s = j >> 3, e = j & 7, kb = r / 224, nb = r % 224, h0 = 32 * nb;
        t.W = INP(29 + s) + (size_t)e * D * DFE + (size_t)(128 * kb) * DFE + h0; t.ldw = DFE; t.ldt = D;
        t.WT = WSP(unsigned char, WS_MW13) + (size_t)e * 2 * DFE * D + (size_t)(256 * (h0 >> 7) + 128 * s + (h0 & 127)) * D + 128 * kb; }
    else { r -= 16 * IT_MW1; const int e = r / IT_MW2; r -= e * IT_MW2; const int kb = r / 64, nb = r % 64;
        t.W = INP(31) + (size_t)e * DFE * D + (size_t)(128 * kb) * D + 32 * nb; t.ldw = D; t.ldt = DFE;
        t.WT = WSP(unsigned char, WS_MW2) + (size_t)e * D * DFE + (size_t)(32 * nb) * DFE + 128 * kb; }
    return t;
}
__device__ __forceinline__ void f8_load(const F8Item& t, f32x4 (&v)[16], int lane) {
#pragma unroll
    for (int i = 0; i < 16; ++i) { const int idx = lane + 64 * i, kk = idx >> 3, c4 = idx & 7; v[i] = *(const f32x4*)(t.W + (size_t)kk * t.ldw + 4 * c4); }
}
__device__ __forceinline__ void f8_store(const F8Item& t, const f32x4 (&v)[16], LAS float* scr, int lane) {
#pragma unroll
    for (int i = 0; i < 16; ++i) { const int idx = lane + 64 * i, kk = idx >> 3, c4 = idx & 7; LAS float* p = scr + kk * 33 + 4 * c4; p[0] = v[i].x * 64.f; p[1] = v[i].y * 64.f; p[2] = v[i].z * 64.f; p[3] = v[i].w * 64.f; }
    LDS_WAIT(); asm volatile("" ::: "memory");
    const int c = lane & 7;
#pragma unroll
    for (int jj = 0; jj < 4; ++jj) { const int n = (lane >> 3) + 8 * jj; const LAS float* s = scr + (16 * c) * 33 + n;
        u32x4 o; o.x = pk4_fp8(s[0], s[33], s[2 * 33], s[3 * 33]); o.y = pk4_fp8(s[4 * 33], s[5 * 33], s[6 * 33], s[7 * 33]);
        o.z = pk4_fp8(s[8 * 33], s[9 * 33], s[10 * 33], s[11 * 33]); o.w = pk4_fp8(s[12 * 33], s[13 * 33], s[14 * 33], s[15 * 33]);
        *(u32x4*)(t.WT + (size_t)n * t.ldt + 16 * c) = o; }
    LDS_WAIT(); asm volatile("" ::: "memory");
}
__device__ __forceinline__ void fill_static(Ctx& C, int first, int n, int b0) {
    if (!(STATIC_FILL && C.G == 256) || C.bid < b0 || n <= 0) return;
    VM_WAIT(); __syncthreads();
    LAS float* scr = (LAS float*)(C.lds + C.wave * 16896);
    const int nb = C.G - b0, step = nb * NWAVE, end = first + n;
    int it = first + (C.bid - b0) * NWAVE + C.wave;
    if (!MOE_FP8) { for (; it < end; it += step) tr_dispatch(C, IT_PRO + BG_MOE + it, scr); return; }
    if (it >= end) return;
    f32x4 va[16], vb[16];
    F8Item ta = f8_item(C, it), tb = ta; f8_load(ta, va, C.lane);
    for (;;) {
        const bool mb = it + step < end; if (mb) { tb = f8_item(C, it + step); f8_load(tb, vb, C.lane); }
        f8_store(ta, va, scr, C.lane);
        if (!mb) break; it += step;
        const bool ma = it + step < end; if (ma) { ta = f8_item(C, it + step); f8_load(ta, va, C.lane); }
        f8_store(tb, vb, scr, C.lane);
        if (!ma) break; it += step;
    }
}

template <int MODE>
__device__ __forceinline__ void p_norm(Ctx& C, int l) {
    const float* mod = WSP(float, WS_MODV) + (size_t)l * 5 * 12288;
    float* XS = WSP(float, WS_XS); bf16* AN = WSP(bf16, WS_AN);
    const bool mix = MODE <= 1;
    const float* gain = (mix ? INP(6) : INP(23)) + l * D;
    const int sh_off = mix ? 0 : 6144, sc_off = mix ? 2048 : 8192;
    LAS f32x4* wl = (LAS f32x4*)C.lds;
    if (MODE == 3) { const float* wsrc = INP(27);
        for (int idx = C.tid; idx < 2048 * 2; idx += NTHR) { const int k = idx >> 1, q = idx & 1, ln = (k & 255) >> 2, i = k & 3, j = k >> 8;
            wl[((j * 4 + i) * 2 + q) * 64 + ln] = *(const f32x4*)(wsrc + (size_t)k * 8 + 4 * q); } }
    WG_BAR();
    const int nrows = MODE == 3 ? MX : MT;
    const int gw = C.bid * NWAVE + C.wave, NGW = C.G * NWAVE, lane = C.lane;
    for (int row = gw; row < nrows; row += NGW) {
        int base, T, t, mv; rowinfo(row, base, T, t, mv);
        f32x4 x[8]; float ss = 0.f;
        if (MODE == 0) {
            if (row < MX) { const f32x4* xi = (const f32x4*)(INP(0) + (size_t)row * D) + lane; const f32x4* pp = (const f32x4*)(WSP(float, WS_POS) + (size_t)t * D) + lane;
#pragma unroll
                for (int j = 0; j < 8; ++j) x[j] = xi[64 * j] + pp[64 * j]; }
            else { const f32x4* xi = (const f32x4*)(INP(2) + (size_t)(row - MX) * D) + lane;
#pragma unroll
                for (int j = 0; j < 8; ++j) x[j] = xi[64 * j]; }
            f32x4* xo = (f32x4*)(XS + (size_t)row * D) + lane;
#pragma unroll
            for (int j = 0; j < 8; ++j) xo[64 * j] = x[j];
        } else { const f32x4* xi = (const f32x4*)(XS + (size_t)row * D) + lane;
#pragma unroll
            for (int j = 0; j < 8; ++j) x[j] = xi[64 * j];
            if ((MODE == 1 || (MODE == 2 && l == 0)) && row >= MX) {
#pragma unroll
                for (int ks = 0; ks < 4; ++ks) { const f32x4* pp = (const f32x4*)(WSP(float, WS_PART) + ((size_t)ks * MC + (row - MX)) * D) + lane;
#pragma unroll
                    for (int j = 0; j < 8; ++j) x[j] += pp[64 * j]; }
                f32x4* xo = (f32x4*)(XS + (size_t)row * D) + lane;
#pragma unroll
                for (int j = 0; j < 8; ++j) xo[64 * j] = x[j]; } }
#pragma unroll
        for (int j = 0; j < 8; ++j) ss += (x[j].x * x[j].x + x[j].y * x[j].y) + (x[j].z * x[j].z + x[j].w * x[j].w);
        const float rs = rsqrtf(wave_sum(ss) * (1.f / D) + EPS);
        const f32x4* gp = (const f32x4*)gain + lane; const f32x4* shp = (const f32x4*)(mod + (size_t)mv * 12288 + sh_off) + lane; const f32x4* scp = (const f32x4*)(mod + (size_t)mv * 12288 + sc_off) + lane;
        u32x2* ao = (u32x2*)(AN + (size_t)row * D) + lane;
#pragma unroll
        for (int j = 0; j < 8; ++j) { const f32x4 g = gp[64 * j], sh = shp[64 * j], sc = scp[64 * j];
            x[j] = x[j] * rs * g * (sc + 1.f) + sh;
            u32x2 w; w.x = pk2(x[j].x, x[j].y); w.y = pk2(x[j].z, x[j].w); ao[64 * j] = w; }
        if (MODE == 3) {
            f32x4 acc[2] = {(f32x4){0.f, 0.f, 0.f, 0.f}, (f32x4){0.f, 0.f, 0.f, 0.f}};
#pragma unroll
            for (int j = 0; j < 8; ++j)
#pragma unroll
                for (int i = 0; i < 4; ++i) { const float a = x[j][i];
#pragma unroll
                    for (int q = 0; q < 2; ++q) acc[q] += wl[((j * 4 + i) * 2 + q) * 64 + lane] * a; asm volatile("" ::: "memory"); }
            float lg[8];
#pragma unroll
            for (int e = 0; e < 8; ++e) lg[e] = wave_sum(acc[e >> 2][e & 3]) + INP(28)[e];
            if (lane == 0) { int i1 = 0;
#pragma unroll
                for (int e = 1; e < 8; ++e) if (lg[e] > lg[i1]) i1 = e;
                int i2 = i1 == 0 ? 1 : 0;
#pragma unroll
                for (int e = 0; e < 8; ++e) if (e != i1 && lg[e] > lg[i2]) i2 = e;
                float v1 = lg[0], v2 = lg[0];
#pragma unroll
                for (int e = 0; e < 8; ++e) { v1 = e == i1 ? lg[e] : v1; v2 = e == i2 ? lg[e] : v2; }
                const float g2 = 1.f / (1.f + expf(v1 - v2));
                int* R = WSP(int, WS_ROUTE); float* Rf = WSP(float, WS_ROUTE); unsigned* ctl = WSP(unsigned, WS_CTL);
                R[R_TE + 2 * row] = i1; R[R_TE + 2 * row + 1] = i2; Rf[R_TG + 2 * row] = 1.f - g2; Rf[R_TG + 2 * row + 1] = g2;
                R[R_RANK + 2 * row] = (int)atomicAdd(ctl + CW_CNT + 64 * i1, 1u); R[R_RANK + 2 * row + 1] = (int)atomicAdd(ctl + CW_CNT + 64 * i2, 1u); }
        }
    }
}
}
namespace mk {
__device__ __forceinline__ f32x4 mfma16(bf16x8 a, bf16x8 b, f32x4 c) { return __builtin_amdgcn_mfma_f32_16x16x32_bf16(a, b, c, 0, 0, 0); }

constexpr int DP_PITCH = 132;
constexpr int DP_Q = 0, DP_K = 33792, DP_V = 67584;
constexpr int DP_L = 101376;
constexpr int DP_QK = DP_L + 32768;
constexpr int DP_SM = DP_QK + 16384;
static_assert(DP_SM + 2048 <= LDS_BARW, "DN prep LDS map");
__device__ __forceinline__ size_t dn_rec(int dir, int cid, int h) { return ((size_t)dir * NCH + cid) * 4 + h; }

__device__ __forceinline__ void dnprep_unit(Ctx& C, int l, int cidx, int h) {
    LAS float* Qs = (LAS float*)(C.lds + DP_Q); LAS float* Ks = (LAS float*)(C.lds + DP_K); LAS float* Vs = (LAS float*)(C.lds + DP_V);
    LAS float* Ls = (LAS float*)(C.lds + DP_L); LAS bf16* QKi = (LAS bf16*)(C.lds + DP_QK); LAS float* sm = (LAS float*)(C.lds + DP_SM);
    LAS float* Gs = sm; LAS float* Bs = sm + 128; LAS float* EGs = sm + 256; LAS float* EGRs = sm + 384;
    const bf16* P = WSP(bf16, WS_P);
    const int tid = C.tid, lane = C.lane, wave = C.wave;
    const int r0 = cidx * 64; int sbase, T, t0, mv; rowinfo(r0, sbase, T, t0, mv);
    const int nloc = t0 >> 6, nch = T >> 6, cbase = sbase >> 6;
#ifndef DP_SKIP
#define DP_SKIP 0
#endif
    if (!(DP_SKIP & 1)) { if (tid < 384) {
        const int o = tid % 48, tg = tid / 48, wh = o >> 4, oc = o & 15, ch = wh * 512 + h * 128 + 8 * oc;
        float w[5][8];
        const float* cw = INP(8) + (size_t)l * 5 * 1536 + ch;
#pragma unroll
        for (int k = 0; k < 5; ++k) { const f32x4 a = *(const f32x4*)(cw + k * 1536), b = *(const f32x4*)(cw + k * 1536 + 4);
            w[k][0] = a.x; w[k][1] = a.y; w[k][2] = a.z; w[k][3] = a.w; w[k][4] = b.x; w[k][5] = b.y; w[k][6] = b.z; w[k][7] = b.w; }
#pragma unroll 1
        for (int hf = 0; hf < 2; ++hf) {
        float xin[8][8];
#pragma unroll
        for (int i = 0; i < 8; ++i) { const int t = t0 + 8 * tg + 4 * hf + i - 2;
            if (t >= 0 && t < T) { const u32x4 raw = *(const u32x4*)(P + (size_t)(sbase + t) * NIN + ch); unpack8(raw, xin[i]); }
            else {
#pragma unroll
                for (int c = 0; c < 8; ++c) xin[i][c] = 0.f; } }
#pragma unroll
        for (int i = 0; i < 4; ++i) { float ov[8]; float ss = 0.f;
#pragma unroll
            for (int c = 0; c < 8; ++c) { float s = 0.f;
#pragma unroll
                for (int k = 0; k < 5; ++k) s += w[k][c] * xin[i + k][c];
                ov[c] = silu(s); ss += ov[c] * ov[c]; }
            ss = sum16(ss);
            const float sc = wh == 0 ? rsqrtf(ss + EPS) * 0.08838834764831845f : wh == 1 ? rsqrtf(ss + EPS) : 1.f;
            LAS float* dst = (wh == 0 ? Qs : wh == 1 ? Ks : Vs) + (8 * tg + 4 * hf + i) * DP_PITCH + 8 * oc;
            *(LAS f32x4*)dst = (f32x4){ov[0] * sc, ov[1] * sc, ov[2] * sc, ov[3] * sc}; *(LAS f32x4*)(dst + 4) = (f32x4){ov[4] * sc, ov[5] * sc, ov[6] * sc, ov[7] * sc}; }
        }
    } else {
        const int d = wave - 6, s = lane, i = d ? 63 - s : s; const float* ab = WSP(float, WS_ABF) + (size_t)(r0 + i) * 16;
        const float la = -expf(INP(9)[l * 8 + d * 4 + h]) * softplus(ab[d * 4 + h] + INP(10)[l * 8 + d * 4 + h]);
        const float be = sigm(ab[8 + d * 4 + h]);
        float g = la;
#pragma unroll
        for (int o = 1; o < 64; o <<= 1) { const float up = __shfl_up(g, o); if (lane >= o) g += up; }
        const float gl = __shfl(g, 63);
        Gs[d * 64 + s] = g; Bs[d * 64 + s] = be; EGs[d * 64 + s] = expf(g); EGRs[d * 64 + s] = expf(gl - g);
        if (lane == 63) { const int cid = d ? cbase + (nch - 1 - nloc) : cidx; const float e = expf(gl); *(f32x4*)(WSP(float, WS_EGL) + dn_rec(d, cid, h) * 4) = (f32x4){e, e, e, e}; }
    } }
    WG_BAR();
    if (!(DP_SKIP & 2)) {
        const int wh = wave >> 2, mb = wave & 3, c = lane & 15, g4 = lane >> 4;
        const LAS float* Am = wh ? Qs : Ks;
        f32x4 acc[4];
#pragma unroll
        for (int nb = 0; nb < 4; ++nb) acc[nb] = (f32x4){0.f, 0.f, 0.f, 0.f};
#pragma unroll
        for (int ks = 0; ks < 4; ++ks) {
            float av[8]; { const LAS float* p = Am + (16 * mb + c) * DP_PITCH + 32 * ks + 8 * g4; const f32x4 a = *(const LAS f32x4*)p, b = *(const LAS f32x4*)(p + 4);
                av[0] = a.x; av[1] = a.y; av[2] = a.z; av[3] = a.w; av[4] = b.x; av[5] = b.y; av[6] = b.z; av[7] = b.w; }
            const bf16x8 af = pack8(av);
#pragma unroll
            for (int nb = 0; nb < 4; ++nb) { float bv[8]; const LAS float* p = Ks + (16 * nb + c) * DP_PITCH + 32 * ks + 8 * g4; const f32x4 a = *(const LAS f32x4*)p, b = *(const LAS f32x4*)(p + 4);
                bv[0] = a.x; bv[1] = a.y; bv[2] = a.z; bv[3] = a.w; bv[4] = b.x; bv[5] = b.y; bv[6] = b.z; bv[7] = b.w;
                acc[nb] = mfma16(af, pack8(bv), acc[nb]); }
        }
        if (wh == 0) {
#pragma unroll
            for (int d = 0; d < 2; ++d) { const LAS float* Gd = Gs + d * 64; const LAS float* Bd = Bs + d * 64; LAS float* Ld = Ls + d * 4096;
#pragma unroll
                for (int r = 0; r < 4; ++r) { const int i = 16 * mb + 4 * g4 + r, s = d ? 63 - i : i; const float gs = Gd[s], bs = Bd[s];
#pragma unroll
                    for (int nb = 0; nb < 4; ++nb) { const int ip = 16 * nb + c, sp = d ? 63 - ip : ip;
                        Ld[s * 64 + sp] = s > sp ? bs * acc[nb][r] * __expf(gs - Gd[sp]) : 0.f; } } }
        } else {
#pragma unroll
            for (int d = 0; d < 2; ++d) { const LAS float* Gd = Gs + d * 64; LAS bf16* Qd = QKi + d * 4096;
#pragma unroll
                for (int r = 0; r < 4; ++r) { const int i = 16 * mb + 4 * g4 + r, s = d ? 63 - i : i; const float gs = Gd[s];
#pragma unroll
                    for (int nb = 0; nb < 4; ++nb) { const int ip = 16 * nb + c, sp = d ? 63 - ip : ip;
                        const float qk = s >= sp ? acc[nb][r] * __expf(gs - Gd[sp]) : 0.f;
                        const int lp = ((sp & 15) >> 2) * 16 + (s & 15), jp = 4 * ((sp >> 4) & 1) + (sp & 3);
                        Qd[(((s >> 4) * 2 + (sp >> 5)) * 64 + lp) * 8 + jp] = (bf16)f2bf(qk); } } }
        }
    }
    WG_BAR();
    if (!(DP_SKIP & 4)) {
        const int d = tid >> 8; int col = tid & 255; asm volatile("" : "+v"(col));
        float X[64];
        const LAS float* src = col < 128 ? Vs + col : Ks + (col - 128);
        const LAS float* Bd = Bs + d * 64; const LAS float* Ed = EGs + d * 64;
        if (d == 0) {
#pragma unroll
            for (int s = 0; s < 64; ++s) { const float sc = col < 128 ? Bd[s] : Bd[s] * Ed[s]; X[s] = sc * src[s * DP_PITCH]; if ((s & 7) == 7) asm volatile("" ::: "memory"); }
        } else {
#pragma unroll
            for (int s = 0; s < 64; ++s) { const float sc = col < 128 ? Bd[s] : Bd[s] * Ed[s]; X[s] = sc * src[(63 - s) * DP_PITCH]; if ((s & 7) == 7) asm volatile("" ::: "memory"); }
        }
        WG_BAR();
        const LAS float* Ld = Ls + d * 4096;
#pragma unroll
        for (int s = 1; s < 64; ++s) { float a0 = X[s], a1 = 0.f, a2 = 0.f, a3 = 0.f;
#pragma unroll
            for (int j4 = 0; j4 < (s + 3) / 4; ++j4) { const f32x4 lv = *(const LAS f32x4*)(Ld + s * 64 + 4 * j4);
                if (4 * j4 + 0 < s) a0 -= lv.x * X[4 * j4 + 0];
                if (4 * j4 + 1 < s) a1 -= lv.y * X[4 * j4 + 1];
                if (4 * j4 + 2 < s) a2 -= lv.z * X[4 * j4 + 2];
                if (4 * j4 + 3 < s) a3 -= lv.w * X[4 * j4 + 3]; }
            X[s] = (a0 + a1) + (a2 + a3); asm volatile("" ::: "memory"); }
        WG_BAR();
        if (col < 128) { const int wq = col >> 4, c = col & 15;
            LAS bf16* Ui = (LAS bf16*)(C.lds + DP_L) + d * 8192;
#pragma unroll
            for (int s = 0; s < 64; ++s) { const int mb = s >> 4, g4 = (s & 15) >> 2, r = s & 3; Ui[(((wq * 2 + (mb >> 1)) * 64 + g4 * 16 + c) * 8) + 4 * (mb & 1) + r] = (bf16)f2bf(X[s]); } }
        else { const int dk = col - 128, ks = dk >> 5, q = dk & 31, j = 4 * (q >> 4) + (q & 3), g4 = (q & 15) >> 2;
            LAS bf16* Wi = (LAS bf16*)(C.lds + DP_V) + d * 8192;
#pragma unroll
            for (int s = 0; s < 64; ++s) Wi[(((s >> 4) * 4 + ks) * 64 + g4 * 16 + (s & 15)) * 8 + j] = (bf16)f2bf(X[s]); }
    }
    WG_BAR();
    if (!(DP_SKIP & 8)) {
        for (int ci = tid; ci < 2048; ci += NTHR) { const int d = ci >> 10, cc = ci & 1023; const int cid = d ? cbase + (nch - 1 - nloc) : cidx;
            ((u32x4*)(WSP(unsigned char, WS_DNU) + dn_rec(d, cid, h) * 16384))[cc] = ((const LAS u32x4*)(C.lds + DP_L + d * 16384))[cc]; }
        for (int ci = tid; ci < 2048; ci += NTHR) { const int d = ci >> 10, cc = ci & 1023; const int cid = d ? cbase + (nch - 1 - nloc) : cidx;
            ((u32x4*)(WSP(unsigned char, WS_DNW) + dn_rec(d, cid, h) * 16384))[cc] = ((const LAS u32x4*)(C.lds + DP_V + d * 16384))[cc]; }
        for (int ci = tid; ci < 1024; ci += NTHR) { const int d = ci >> 9, cc = ci & 511; const int cid = d ? cbase + (nch - 1 - nloc) : cidx;
            ((u32x4*)(WSP(unsigned char, WS_DNQK) + dn_rec(d, cid, h) * 8192))[cc] = ((const LAS u32x4*)(C.lds + DP_QK + d * 8192))[cc]; }
        for (int ci = tid; ci < 2048; ci += NTHR) { const int d = ci >> 10, cc = ci & 1023, mb = cc >> 8, ks = (cc >> 6) & 3, lp = cc & 63, c = lp & 15, g4 = lp >> 4;
            const int s = 16 * mb + c, i = d ? 63 - s : s; const float e = EGs[d * 64 + s];
            const LAS float* p = Qs + i * DP_PITCH + 32 * ks + 4 * g4; const f32x4 a = *(const LAS f32x4*)p, b = *(const LAS f32x4*)(p + 16);
            float v[8] = {a.x * e, a.y * e, a.z * e, a.w * e, b.x * e, b.y * e, b.z * e, b.w * e};
            const int cid = d ? cbase + (nch - 1 - nloc) : cidx;
            ((bf16x8*)(WSP(unsigned char, WS_DNQG) + dn_rec(d, cid, h) * 16384))[cc] = pack8(v); }
        for (int ci = tid; ci < 2048; ci += NTHR) { const int d = ci >> 10, cc = ci & 1023, tt = cc >> 7, ks2 = (cc >> 6) & 1, lp = cc & 63, c = lp & 15, g4 = lp >> 4;
            float v[8];
#pragma unroll
            for (int j = 0; j < 8; ++j) { const int s = 32 * ks2 + 16 * (j >> 2) + 4 * g4 + (j & 3), i = d ? 63 - s : s; v[j] = Ks[i * DP_PITCH + 16 * tt + c] * EGRs[d * 64 + s]; }
            const int cid = d ? cbase + (nch - 1 - nloc) : cidx;
            ((bf16x8*)(WSP(unsigned char, WS_DNKDT) + dn_rec(d, cid, h) * 16384))[cc] = pack8(v); }
    }
    WG_BAR();
}

constexpr int SG_VT = 0, SG_VPITCH = 136;
__device__ __forceinline__ void sg_unit(Ctx& C, int l, int cb, int h) {
    LAS bf16* vT = (LAS bf16*)(C.lds + SG_VT);
    const bf16* P = WSP(bf16, WS_P); bf16* Y = WSP(bf16, WS_Y);
    const int lane = C.lane, wave = C.wave, r0 = cb * 128;
    const float* lg = INP(12) + l * 512; const float* lb = INP(13) + l * 512;
    for (int q = 0; q < 16; ++q) { const int j = 16 * wave + q; float v[8];
        unpack8(*(const u32x4*)(P + (size_t)(r0 + j) * NIN + PSGV + 8 * lane), v);
        float s = 0.f;
#pragma unroll
        for (int c = 0; c < 8; ++c) { v[c] = gelu_tanh(v[c]); s += v[c]; }
        const float mu = wave_sum(s) * (1.f / 512.f); float s2 = 0.f;
#pragma unroll
        for (int c = 0; c < 8; ++c) { v[c] -= mu; s2 += v[c] * v[c]; }
        const float rs = rsqrtf(wave_sum(s2) * (1.f / 512.f) + EPS);
        if ((lane >> 4) == h) { const int d0 = 8 * (lane & 15);
#pragma unroll
            for (int c = 0; c < 8; ++c) vT[(d0 + c) * SG_VPITCH + j] = (bf16)f2bf(v[c] * rs * lg[128 * h + d0 + c] + lb[128 * h + d0 + c]); } }
    WG_BAR();
    const int c = lane & 15, g4 = lane >> 4;
    const float* W = INP(14) + ((size_t)(l * 4 + h) * 128 + 16 * wave + c) * 128;
    f32x4 acc[8];
#pragma unroll
    for (int nb = 0; nb < 8; ++nb) acc[nb] = (f32x4){0.f, 0.f, 0.f, 0.f};
#pragma unroll
    for (int ks = 0; ks < 4; ++ks) { const f32x4 a = *(const f32x4*)(W + 32 * ks + 8 * g4), b = *(const f32x4*)(W + 32 * ks + 8 * g4 + 4);
        float av[8] = {a.x, a.y, a.z, a.w, b.x, b.y, b.z, b.w}; const bf16x8 af = pack8(av);
#pragma unroll
        for (int nb = 0; nb < 8; ++nb) { const bf16x8 bfr = *(const LAS bf16x8*)(vT + (16 * nb + c) * SG_VPITCH + 32 * ks + 8 * g4); acc[nb] = mfma16(af, bfr, acc[nb]); } }
    const float* bs = INP(15) + (l * 4 + h) * 128;
#pragma unroll
    for (int r = 0; r < 4; ++r) { const int i = 16 * wave + 4 * g4 + r; const float bi = bs[i]; const size_t row = (size_t)(r0 + i);
#pragma unroll
        for (int nb = 0; nb < 8; ++nb) { const int d = 16 * nb + c; const float u = gelu_tanh(bf2f(P[row * NIN + PSGU + 128 * h + d]));
            Y[row * D + 512 + 128 * h + d] = (bf16)f2bf(u * (acc[nb][r] + bi)); } }
    WG_BAR();
}

constexpr int PL_PITCH = 132, PL_BUF = 80 * PL_PITCH;
__device__ __forceinline__ void pool_unit(Ctx& C, int l, int cidx, int g) {
    const bf16* P = WSP(bf16, WS_P); bf16* Y = WSP(bf16, WS_Y); const bf16* PW = WSP(bf16, WS_PWT) + (size_t)(l * 4 + g) * 128 * 128;
    LAS float* X = (LAS float*)C.lds; LAS float* B0 = X + PL_BUF; LAS float* B1 = B0 + PL_BUF;
    const int lane = C.lane, wave = C.wave, c = lane & 15, g4 = lane >> 4, mb = wave & 3, nh = wave >> 2;
    const int r0 = cidx * 64; int sbase, T, t0, mv; rowinfo(r0, sbase, T, t0, mv);
    for (int idx = C.tid; idx < 80 * 16; idx += NTHR) { const int q = idx >> 4, oc = idx & 15, t = t0 + q - 8; float v[8];
        if (t >= 0 && t < T) unpack8(*(const u32x4*)(P + (size_t)(sbase + t) * NIN + PPOOL + 128 * g + 8 * oc), v);
        else {
#pragma unroll
            for (int cc = 0; cc < 8; ++cc) v[cc] = 0.f; }
        LAS float* d = X + q * PL_PITCH + 8 * oc; *(LAS f32x4*)d = (f32x4){v[0], v[1], v[2], v[3]}; *(LAS f32x4*)(d + 4) = (f32x4){v[4], v[5], v[6], v[7]}; }
    WG_BAR();
    const LAS float* src = X; LAS float* dst = B0;
    for (int pass = 0, w = 1; pass <= g; ++pass, w <<= 1) {
        for (int idx = C.tid; idx < (80 - w) * 32; idx += NTHR) { const int r = idx >> 5, c4 = idx & 31;
            *(LAS f32x4*)(dst + r * PL_PITCH + 4 * c4) = *(const LAS f32x4*)(src + r * PL_PITCH + 4 * c4) + *(const LAS f32x4*)(src + (r + w) * PL_PITCH + 4 * c4); }
        WG_BAR();
        src = dst; dst = (dst == B0) ? B1 : B0;
    }
    const int i = 16 * mb + c, t = t0 + i, hw = 1 << g;
    const int lo = t - hw < 0 ? 0 : t - hw, hi = t + hw > T ? T : t + hw; const float inv = 1.f / (float)(hi - lo);
    f32x4 acc[4];
#pragma unroll
    for (int nb = 0; nb < 4; ++nb) acc[nb] = (f32x4){0.f, 0.f, 0.f, 0.f};
#pragma unroll
    for (int ks = 0; ks < 4; ++ks) { const LAS float* sp = src + (i + 8 - hw) * PL_PITCH + 32 * ks + 8 * g4; const LAS float* xp = X + (i + 8) * PL_PITCH + 32 * ks + 8 * g4;
        const f32x4 s0 = *(const LAS f32x4*)sp, s1 = *(const LAS f32x4*)(sp + 4), x0 = *(const LAS f32x4*)xp, x1 = *(const LAS f32x4*)(xp + 4);
        float s[8] = {s0.x * inv - x0.x, s0.y * inv - x0.y, s0.z * inv - x0.z, s0.w * inv - x0.w, s1.x * inv - x1.x, s1.y * inv - x1.y, s1.z * inv - x1.z, s1.w * inv - x1.w};
        const bf16x8 af = pack8(s);
#pragma unroll
        for (int nb = 0; nb < 4; ++nb) { const bf16x8 bfr = *(const bf16x8*)(PW + (size_t)(16 * (4 * nh + nb) + c) * 128 + 32 * ks + 8 * g4); acc[nb] = mfma16(af, bfr, acc[nb]); } }
    const float* psc = INP(17) + l * 512 + 128 * g;
#pragma unroll
    for (int nb = 0; nb < 4; ++nb) { const int e = 16 * (4 * nh + nb) + c; const float sc = psc[e];
#pragma unroll
        for (int r = 0; r < 4; ++r) Y[(size_t)(r0 + 16 * mb + 4 * g4 + r) * D + 1024 + 128 * g + e] = (bf16)f2bf(acc[nb][r] * sc); }
    WG_BAR();
}

constexpr int CV_PITCH = 132;
__device__ __forceinline__ void conf_unit(Ctx& C, int l, int cidx, int cq) {
    const bf16* P = WSP(bf16, WS_P); float* H = WSP(float, WS_CVH); LAS float* gl = (LAS float*)C.lds;
    const int r0 = cidx * 64; int sbase, T, t0, mv; rowinfo(r0, sbase, T, t0, mv);
    for (int idx = C.tid; idx < 94 * 16; idx += NTHR) { const int q = idx >> 4, oc = idx & 15, t = t0 + q - 15; float v[8];
        if (t >= 0 && t < T) { const bf16* pr = P + (size_t)(sbase + t) * NIN + 128 * cq + 8 * oc; float a[8], g[8];
            unpack8(*(const u32x4*)(pr + PCVA), a); unpack8(*(const u32x4*)(pr + PCVG), g);
#pragma unroll
            for (int c = 0; c < 8; ++c) v[c] = a[c] * sigm(g[c]); }
        else {
#pragma unroll
            for (int c = 0; c < 8; ++c) v[c] = 0.f; }
        LAS float* d = gl + q * CV_PITCH + 8 * oc; *(LAS f32x4*)d = (f32x4){v[0], v[1], v[2], v[3]}; *(LAS f32x4*)(d + 4) = (f32x4){v[4], v[5], v[6], v[7]}; }
    const int chl = C.tid & 127, ch = 128 * cq + chl, grp = C.tid >> 7;
    float w[31];
#pragma unroll
    for (int k = 0; k < 31; ++k) w[k] = INP(18)[((size_t)l * 31 + k) * 512 + ch];
    const float cb = INP(19)[l * 512 + ch];
    WG_BAR();
    float glu[46];
#pragma unroll
    for (int q = 0; q < 46; ++q) glu[q] = gl[(16 * grp + q) * CV_PITCH + chl];
#pragma unroll
    for (int i = 0; i < 16; ++i) { float a = cb;
#pragma unroll
        for (int k = 0; k < 31; ++k) a += w[k] * glu[i + k];
        H[(size_t)(r0 + 16 * grp + i) * 512 + ch] = a; }
    WG_BAR();
}

__device__ __forceinline__ void p_mixers(Ctx& C, int l) {
    const int nchk = l == 0 ? NCH : MX / 64;
    for (int u = C.bid; u < NCH * 4; u += C.G) dnprep_unit(C, l, u >> 2, u & 3);
}
__device__ __forceinline__ void p_mixers_bcd(Ctx& C, int l, int vb, int nb) {
    const int nchk = l == 0 ? NCH : MX / 64;
    const int o2 = (nchk * 4) % nb, o3 = (o2 + (nchk / 2) * 4) % nb;
    for (int u = vb; u < nchk * 4; u += nb) conf_unit(C, l, u >> 2, u & 3);
    for (int u = (vb + nb - o2) % nb; u < (nchk / 2) * 4; u += nb) sg_unit(C, l, u >> 2, u & 3);
    for (int u = (vb + nb - o3) % nb; u < nchk * 4; u += nb) pool_unit(C, l, u >> 2, u & 3);
}

constexpr int SC_SLOT = 58368, SC_U = 2 * SC_SLOT;
static_assert(SC_U + 16384 <= LDS_BARW, "scan LDS map");
__device__ __forceinline__ void p_scan(Ctx& C, int l) {
    if (C.bid >= 32) { const int nbcd = (STATIC_FILL && C.G == 256) ? SCAN_BCD_BLOCKS : C.G - 32;
        if (C.G > 32 && C.bid - 32 < nbcd) p_mixers_bcd(C, l, C.bid - 32, nbcd); return; }
    const int b = C.bid >> 3, h = (C.bid >> 1) & 3, dir = C.bid & 1, lane = C.lane, w = C.wave, c = lane & 15, g4 = lane >> 4;
    float* O = WSP(float, WS_O) + (size_t)dir * MT * 512;
    f32x4 S[8];
#pragma unroll
    for (int t = 0; t < 8; ++t) S[t] = (f32x4){0.f, 0.f, 0.f, 0.f};
    auto rec_of = [&](int st) -> size_t { const int rb = st < 4 ? MX + b * TC : b * TX, n = st < 4 ? st : st - 4; return dn_rec(dir, (rb >> 6) + n, h); };
#define SC_ISSUE(st_, SL) do { const size_t rec_ = rec_of(st_); \
        _Pragma("unroll") for (int q = 0; q < 7; ++q) { const int ch = w + 8 * q; \
            const unsigned char* src = ch < 16 ? WSP(unsigned char, WS_DNW) + rec_ * 16384 + ch * 1024 : ch < 32 ? WSP(unsigned char, WS_DNQG) + rec_ * 16384 + (ch - 16) * 1024 \
                                     : ch < 48 ? WSP(unsigned char, WS_DNKDT) + rec_ * 16384 + (ch - 32) * 1024 : WSP(unsigned char, WS_DNQK) + rec_ * 8192 + (ch - 48) * 1024; \
            __builtin_amdgcn_global_load_lds((const unsigned*)(src + lane * 16), (LAS unsigned*)(C.lds + (SL) * SC_SLOT + w * 1024 + q * 8192), 16, 0, 0); } \
        if (w == 0) __builtin_amdgcn_global_load_lds((const unsigned*)(WSP(unsigned char, WS_EGL) + rec_ * 16), (LAS unsigned*)(C.lds + (SL) * SC_SLOT + 57344), 16, 0, 0); } while (0)
#define SC_ISSUE_U(st_) do { const unsigned char* Us_ = WSP(unsigned char, WS_DNU) + rec_of(st_) * 16384 + w * 2048 + lane * 16; \
        _Pragma("unroll") for (int j = 0; j < 2; ++j) __builtin_amdgcn_global_load_lds((const unsigned*)(Us_ + j * 1024), (LAS unsigned*)(C.lds + SC_U + w * 2048 + j * 1024), 16, 0, 0); } while (0)
#define SC_STEP(st_, SL) do { const int st = (st_); \
        if (st == 0) asm volatile("s_waitcnt vmcnt(0)" ::: "memory"); else asm volatile("s_waitcnt vmcnt(16)" ::: "memory"); \
        __builtin_amdgcn_s_barrier(); asm volatile("" ::: "memory"); \
        if (st + 1 < 36) SC_ISSUE(st + 1, 1 - (SL)); \
        const LAS bf16x8* Wf = (const LAS bf16x8*)(C.lds + (SL) * SC_SLOT) + lane; const LAS bf16x8* QGf = Wf + 1024; const LAS bf16x8* KDf = Wf + 2048; const LAS bf16x8* QKf = Wf + 3072; \
        const float egl = *(const LAS float*)(C.lds + (SL) * SC_SLOT + 57344); \
        const int rbase = st < 4 ? MX + b * TC + 64 * st : b * TX + 64 * (st - 4); \
        bf16x8 Sb[4]; \
        _Pragma("unroll") for (int ks = 0; ks < 4; ++ks) { float v[8] = {S[2 * ks][0], S[2 * ks][1], S[2 * ks][2], S[2 * ks][3], S[2 * ks + 1][0], S[2 * ks + 1][1], S[2 * ks + 1][2], S[2 * ks + 1][3]}; Sb[ks] = pack8(v); } \
        f32x4 vn[4], oacc[4]; \
        _Pragma("unroll") for (int mb = 0; mb < 4; ++mb) { f32x4 a = (f32x4){0.f, 0.f, 0.f, 0.f}, o = (f32x4){0.f, 0.f, 0.f, 0.f}; \
            _Pragma("unroll") for (int ks = 0; ks < 4; ++ks) { a = mfma16(Wf[(mb * 4 + ks) * 64], Sb[ks], a); o = mfma16(QGf[(mb * 4 + ks) * 64], Sb[ks], o); } \
            vn[mb] = a; oacc[mb] = o; } \
        _Pragma("unroll") for (int j = 0; j < 2; ++j) { float uv[8]; unpack8(*(const LAS u32x4*)(C.lds + SC_U + w * 2048 + j * 1024 + lane * 16), uv); \
            vn[2 * j] = (f32x4){uv[0], uv[1], uv[2], uv[3]} - vn[2 * j]; vn[2 * j + 1] = (f32x4){uv[4], uv[5], uv[6], uv[7]} - vn[2 * j + 1]; } \
        asm volatile("s_waitcnt lgkmcnt(0)" ::: "memory"); __builtin_amdgcn_s_barrier(); asm volatile("" ::: "memory"); \
        if (st + 1 < 36) SC_ISSUE_U(st + 1); \
        bf16x8 Vb[2]; \
        _Pragma("unroll") for (int k2 = 0; k2 < 2; ++k2) { float v[8] = {vn[2 * k2][0], vn[2 * k2][1], vn[2 * k2][2], vn[2 * k2][3], vn[2 * k2 + 1][0], vn[2 * k2 + 1][1], vn[2 * k2 + 1][2], vn[2 * k2 + 1][3]}; Vb[k2] = pack8(v); } \
        _Pragma("unroll") for (int t = 0; t < 8; ++t) { f32x4 a = S[t] * egl; \
            _Pragma("unroll") for (int k2 = 0; k2 < 2; ++k2) a = mfma16(KDf[(t * 2 + k2) * 64], Vb[k2], a); \
            S[t] = a; } \
        _Pragma("unroll") for (int mb = 0; mb < 4; ++mb) { \
            _Pragma("unroll") for (int k2 = 0; k2 < 2; ++k2) oacc[mb] = mfma16(QKf[(mb * 2 + k2) * 64], Vb[k2], oacc[mb]); \
            _Pragma("unroll") for (int r = 0; r < 4; ++r) O[(size_t)(rbase + 16 * mb + 4 * g4 + r) * 512 + 128 * h + 16 * w + c] = oacc[mb][r]; } } while (0)
    SC_ISSUE(0, 0); SC_ISSUE_U(0);
#pragma unroll 1
    for (int s2 = 0; s2 < 36; s2 += 2) { SC_STEP(s2, 0); SC_STEP(s2 + 1, 1); }
    asm volatile("s_waitcnt vmcnt(0)" ::: "memory");
#undef SC_ISSUE
#undef SC_ISSUE_U
#undef SC_STEP
}

__device__ __forceinline__ void p_ghn(Ctx& C, int l) {
    const int nrows = l == 0 ? MT : MX, lane = C.lane; const float* O = WSP(float, WS_O); const bf16* P = WSP(bf16, WS_P); bf16* Y = WSP(bf16, WS_Y);
    const float* gn = INP(11) + l * 128 + 8 * (lane & 15);
    for (int row = C.bid * NWAVE + C.wave; row < nrows; row += C.G * NWAVE) {
        const int rb = dirrow(row, 1);
        const f32x4* pf = (const f32x4*)(O + (size_t)row * 512 + 8 * lane); const f32x4* pb = (const f32x4*)(O + ((size_t)MT + rb) * 512 + 8 * lane);
        const f32x4 a = pf[0] + pb[0], b2 = pf[1] + pb[1];
        float o[8] = {a.x, a.y, a.z, a.w, b2.x, b2.y, b2.z, b2.w}, z[8]; float ss = 0.f;
#pragma unroll
        for (int c = 0; c < 8; ++c) ss += o[c] * o[c];
        const float rs = rsqrtf(sum16(ss) * (1.f / 128.f) + EPS);
        unpack8(*(const u32x4*)(P + (size_t)row * NIN + PZ + 8 * lane), z);
#pragma unroll
        for (int c = 0; c < 8; ++c) o[c] = o[c] * rs * gn[c] * silu(z[c]);
        *(bf16x8*)(Y + (size_t)row * D + 8 * lane) = pack8(o);
        { const float* hp = WSP(float, WS_CVH) + (size_t)row * 512 + 8 * lane; const f32x4 a = *(const f32x4*)hp, b2 = *(const f32x4*)(hp + 4);
          float v[8] = {a.x, a.y, a.z, a.w, b2.x, b2.y, b2.z, b2.w}; float s = 0.f;
#pragma unroll
          for (int c = 0; c < 8; ++c) s += v[c];
          const float mu = wave_sum(s) * (1.f / 512.f); float s2 = 0.f;
#pragma unroll
          for (int c = 0; c < 8; ++c) { v[c] -= mu; s2 += v[c] * v[c]; }
          const float rs = rsqrtf(wave_sum(s2) * (1.f / 512.f) + EPS);
          const float* lg = INP(20) + l * 512 + 8 * lane; const float* lb = INP(21) + l * 512 + 8 * lane;
#pragma unroll
          for (int c = 0; c < 8; ++c) v[c] = silu(v[c] * rs * lg[c] + lb[c]);
          *(bf16x8*)(Y + (size_t)row * D + 1536 + 8 * lane) = pack8(v); }
    }
}

__device__ __forceinline__ void p_moe_gather(Ctx& C) {
    int* R = WSP(int, WS_ROUTE); const unsigned* ctl = WSP(unsigned, WS_CTL);
    LAS int* offs = (LAS int*)C.lds;
    if (C.tid == 0) { int o = 0, nt = 0;
        for (int e = 0; e < 8; ++e) { const int cnt = (int)ctl[CW_CNT + 64 * e], tl = (cnt + 255) >> 8; offs[e] = o;
            if (C.bid == 0) for (int q = 0; q < tl; ++q) R[R_TILEE + nt + q] = e;
            nt += tl; o += tl << 8; }
        if (C.bid == 0) R[R_NT] = nt; }
    WG_BAR();
    const bf16* AN = WSP(bf16, WS_AN); bf16* AS = WSP(bf16, WS_AS);
    for (int tok = C.bid * NWAVE + C.wave; tok < MX; tok += C.G * NWAVE) {
        const int p0 = offs[R[R_TE + 2 * tok]] + R[R_RANK + 2 * tok], p1 = offs[R[R_TE + 2 * tok + 1]] + R[R_RANK + 2 * tok + 1];
        if (C.lane == 0) { R[R_POS + 2 * tok] = p0; R[R_POS + 2 * tok + 1] = p1; }
        if (MOE_FP8) {
            const u32x4* src = (const u32x4*)(AN + (size_t)tok * D) + 4 * C.lane; float f[32];
#pragma unroll
            for (int j = 0; j < 4; ++j) unpack8(src[j], f + 8 * j);
            u32x4 o[2];
#pragma unroll
            for (int j = 0; j < 2; ++j) { const float* q = f + 16 * j;
                o[j].x = pk4_fp8(clamp448(q[0]), clamp448(q[1]), clamp448(q[2]), clamp448(q[3])); o[j].y = pk4_fp8(clamp448(q[4]), clamp448(q[5]), clamp448(q[6]), clamp448(q[7]));
                o[j].z = pk4_fp8(clamp448(q[8]), clamp448(q[9]), clamp448(q[10]), clamp448(q[11])); o[j].w = pk4_fp8(clamp448(q[12]), clamp448(q[13]), clamp448(q[14]), clamp448(q[15])); }
            u32x4* d0 = (u32x4*)((unsigned char*)AS + (size_t)p0 * D) + 2 * C.lane; u32x4* d1 = (u32x4*)((unsigned char*)AS + (size_t)p1 * D) + 2 * C.lane;
            d0[0] = o[0]; d0[1] = o[1]; d1[0] = o[0]; d1[1] = o[1];
        } else {
        const u32x4* src = (const u32x4*)(AN + (size_t)tok * D) + C.lane; u32x4* d0 = (u32x4*)(AS + (size_t)p0 * D) + C.lane; u32x4* d1 = (u32x4*)(AS + (size_t)p1 * D) + C.lane;
#pragma unroll
        for (int j = 0; j < 4; ++j) { u32x4 v = src[64 * j];
            if (FP8_EMU) { float f[8]; unpack8(v, f);
#pragma unroll
                for (int q = 0; q < 8; ++q) f[q] = rne_e4m3(f[q]);
                v = __builtin_bit_cast(u32x4, pack8(f)); }
            d0[64 * j] = v; d1[64 * j] = v; } }
    }
}

__device__ __forceinline__ void p_final(Ctx& C, float* out) {
    const int* R = WSP(int, WS_ROUTE); const float* Rf = WSP(float, WS_ROUTE); const float* XS = WSP(float, WS_XS); const float* OS = WSP(float, WS_OUTS);
    const float* mod = WSP(float, WS_MODV) + (size_t)5 * 12288; const int lane = C.lane;
    for (int tok = C.bid * NWAVE + C.wave; tok < MX; tok += C.G * NWAVE) {
        const int p0 = R[R_POS + 2 * tok], p1 = R[R_POS + 2 * tok + 1]; const float g0 = Rf[R_TG + 2 * tok], g1 = Rf[R_TG + 2 * tok + 1];
        const f32x4* xp = (const f32x4*)(XS + (size_t)tok * D) + lane; const f32x4* o0 = (const f32x4*)(OS + (size_t)p0 * D) + lane; const f32x4* o1 = (const f32x4*)(OS + (size_t)p1 * D) + lane;
        const f32x4* gf = (const f32x4*)(mod + (size_t)(tok >> 11) * 12288 + 10240) + lane; const f32x4* fg = (const f32x4*)INP(32) + lane;
        f32x4 x[8]; float ss = 0.f;
        f32x4 e0[8], e1[8];
        if (p0 < 16384) {
#pragma unroll
            for (int j = 0; j < 8; ++j) e0[j] = o0[64 * j];
        } else { const f32x4* q = (const f32x4*)(WSP(float, WS_PARTO) + (size_t)(p0 - 16384) * D) + lane;
#pragma unroll
            for (int j = 0; j < 8; ++j) e0[j] = (q[64 * j] + q[64 * j + (size_t)2048 * 512]) + (q[64 * j + (size_t)2 * 2048 * 512] + q[64 * j + (size_t)3 * 2048 * 512]); }
        if (p1 < 16384) {
#pragma unroll
            for (int j = 0; j < 8; ++j) e1[j] = o1[64 * j];
        } else { const f32x4* q = (const f32x4*)(WSP(float, WS_PARTO) + (size_t)(p1 - 16384) * D) + lane;
#pragma unroll
            for (int j = 0; j < 8; ++j) e1[j] = (q[64 * j] + q[64 * j + (size_t)2048 * 512]) + (q[64 * j + (size_t)2 * 2048 * 512] + q[64 * j + (size_t)3 * 2048 * 512]); }
#pragma unroll
        for (int j = 0; j < 8; ++j) { x[j] = xp[64 * j] + gf[64 * j] * (e0[j] * g0 + e1[j] * g1); ss += (x[j].x * x[j].x + x[j].y * x[j].y) + (x[j].z * x[j].z + x[j].w * x[j].w); }
        const float rs = rsqrtf(wave_sum(ss) * (1.f / D) + EPS);
        f32x4* op = (f32x4*)(out + (size_t)tok * D) + lane;
#pragma unroll
        for (int j = 0; j < 8; ++j) op[64 * j] = x[j] * rs * fg[64 * j];
    }
}
}
namespace mk {
constexpr int NPHASE = 21;
struct Args { const float* in[33]; float* out; unsigned char* ws; int ph_lo, ph_hi; };
static_assert(sizeof(Args) == 35 * 8 + 8, "Args has no padding");

#ifdef ONLY_PHASE
#define IN(k) ((k) == ONLY_PHASE)
#else
#define IN(k) (lo <= (k) && (k) < hi)
#endif
__device__ __forceinline__ constexpr int bg_need(int k) { return k >= 18 ? NBG : k >= 15 ? BG_MOE : k >= 11 ? BG_WOUT1 : k >= 9 ? BG_WIN1 : k >= 8 ? BG_W2 : k >= 6 ? BG_W13 : 0; }
#ifndef BG_FILL_MASK
#define BG_FILL_MASK ((1 << 2) | (1 << 4) | (1 << 6) | (1 << 8) | (1 << 9) | (1 << 11) | (1 << 13))
#endif
#define SEAM(k) do { if (IN(k) && IN((k) + 1)) { if (BG_QUEUE) bg_work(C, bg_need((k) + 1), ((BG_FILL_MASK >> (k)) & 1) ? (k) : -1); xcd_barrier(bar); } } while (0)
constexpr int NMOE = 16 * IT_MW1 + 8 * IT_MW2;
#ifndef FILL_R
#define FILL_R 25, 24, 2, 65, 10, 25, 24
#endif
#ifndef FILL_R2
#define FILL_R2 6, 6
#endif
constexpr int fill_rounds[7] = {FILL_R}; constexpr int fill_rounds2[2] = {FILL_R2};
constexpr int FB2 = 228, FB4 = 32 + SCAN_BCD_BLOCKS, FB6 = 128, FB8 = 227, FB9 = 128, FB11 = 212, FB13 = 32 + SCAN_BCD_BLOCKS;
constexpr int FN2 = fill_rounds[0] * (256 - FB2) * 8, FN4 = fill_rounds[1] * (256 - FB4) * 8, FN6 = fill_rounds[2] * (256 - FB6) * 8, FN8 = fill_rounds[3] * (256 - FB8) * 8,
              FN9 = fill_rounds[4] * (256 - FB9) * 8, FN11 = fill_rounds[5] * (256 - FB11) * 8;
constexpr int FS2 = 0, FS4 = FS2 + FN2, FS6 = FS4 + FN4, FS8 = FS6 + FN6, FS9 = FS8 + FN8, FS11 = FS9 + FN9, FS13 = FS11 + FN11, FN13 = fill_rounds[6] * (256 - FB13) * 8 < NMOE - FS13 ? fill_rounds[6] * (256 - FB13) * 8 : NMOE - FS13, FS3 = FS13 + FN13, FN3 = fill_rounds2[0] * 192 * 8 < NMOE - FS3 ? fill_rounds2[0] * 192 * 8 : NMOE - FS3, FS12 = FS3 + FN3, FN12 = fill_rounds2[1] * 192 * 8 < NMOE - FS12 ? fill_rounds2[1] * 192 * 8 : NMOE - FS12, FS17 = FS12 + FN12, FN17 = NMOE - FS17;
static_assert(FN13 >= 0 && FN17 >= 0, "fill schedule exceeds the MoE items");
template <int l>
__device__ __forceinline__ void layer_body(Ctx& C, const XcdBarrier& bar, const int lo, const int hi) {
        const int pb = l == 0 ? 1 : 10;
        const float* mod = WSP(float, WS_MODV) + (size_t)l * 5 * 12288;
        if (IN(pb + 0)) { if constexpr (l == 0) p_norm<0>(C, 0); else p_norm<1>(C, 1); } SEAM(pb + 0);
        if (IN(pb + 1)) {
            pg8::EpiStoreBf16 E{WSP(bf16, WS_P), NIN, WSP(float, WS_ABF)};
            pg8::Gemm g{WSP(bf16, WS_AN), WSP(bf16, WS_WIN) + (size_t)l * NINP * D, MT, NINP, D};
            const bool ded = STATIC_FILL && C.G == 256;
            if constexpr (l == 0) { if (!ded || C.bid < FB2) { pg8::StaticOrder S; S.init(MT, NINP, ded ? FB2 : C.G, C.bid); pg8::gemm_phase<pg8::EpiStoreBf16, pg8::StaticOrder, true, true>(C.lds, g, S, E); }
                fill_static(C, FS2, FN2, FB2); }
            else { if (!ded || C.bid < FB11) { pg8::InProjL1Order S; S.init(ded ? FB11 : C.G, C.bid); pg8::gemm_phase<pg8::EpiStoreBf16, pg8::InProjL1Order, true, true>(C.lds, g, S, E); }
                fill_static(C, FS11, FN11, FB11); }
        } SEAM(pb + 1);
        if (IN(pb + 2)) { p_mixers(C, l); if constexpr (l == 0) fill_static(C, FS3, FN3, 64); else fill_static(C, FS12, FN12, 64); } SEAM(pb + 2);
        if (IN(pb + 3)) { p_scan(C, l); if constexpr (l == 0) fill_static(C, FS4, FN4, FB4); else fill_static(C, FS13, FN13, FB13); } SEAM(pb + 3);
        if (IN(pb + 4)) { p_ghn(C, l); } SEAM(pb + 4);
        if (IN(pb + 5)) {
            pg8::EpiResid E{WSP(float, WS_XS), mod, 4096, WSP(float, WS_PART), D / 4};
            pg8::Gemm g{WSP(bf16, WS_Y), WSP(bf16, WS_WOUT) + (size_t)l * D * D, l == 0 ? MT : MX, D, D};
            if constexpr (l == 0) { pg8::ResidOrder S; S.init(D, C.G, C.bid); pg8::gemm_phase<pg8::EpiResid, pg8::ResidOrder, true, true>(C.lds, g, S, E); fill_static(C, FS6, FN6, FB6); }
            else { pg8::StaticOrder S; S.init(MX, D, C.G, C.bid); pg8::gemm_phase<pg8::EpiResid, pg8::StaticOrder, true, true>(C.lds, g, S, E); }
        } SEAM(pb + 5);
        if (IN(pb + 6)) { if constexpr (l == 0) p_norm<2>(C, 0); else p_norm<3>(C, 1); } SEAM(pb + 6);
        if constexpr (l == 0) {
            if (IN(8)) {
                pg8::EpiSwiglu E{WSP(bf16, WS_HM), DFF, 1 << 20};
                pg8::Gemm g{WSP(bf16, WS_AN), WSP(bf16, WS_W13), MT, 2 * DFF, D};
                const bool ded = STATIC_FILL && C.G == 256;
                if (!ded || C.bid < FB8) { pg8::StaticOrder S; S.init(MT, 2 * DFF, ded ? FB8 : C.G, C.bid); pg8::gemm_phase<pg8::EpiSwiglu, pg8::StaticOrder, true, true>(C.lds, g, S, E); }
                fill_static(C, FS8, FN8, FB8);
            } SEAM(8);
            if (IN(9)) {
                pg8::EpiResid E{WSP(float, WS_XS), mod, 10240, WSP(float, WS_PART), DFF / 4};
                pg8::Gemm g{WSP(bf16, WS_HM), WSP(bf16, WS_W2), MT, D, DFF};
                pg8::ResidOrder S; S.init(DFF, C.G, C.bid);
                pg8::gemm_phase<pg8::EpiResid, pg8::ResidOrder, true, true>(C.lds, g, S, E);
                fill_static(C, FS9, FN9, FB9);
            } SEAM(9);
        } else {
            if (IN(17)) { p_moe_gather(C); fill_static(C, FS17, FN17, 0); } SEAM(17);
            if (IN(18)) {
                const int* R = WSP(int, WS_ROUTE);
                pg8::MoeOrder S; S.init(R[R_NT], 56, R + R_TILEE, C.G, C.bid);
                if (MOE_FP8) { pg8::EpiSwiglu8 E{WSP(unsigned char, WS_HM), DFE, 56};
                    pg8::Gemm g{WSP(bf16, WS_AS), WSP(bf16, WS_MW13), MSORT, 2 * DFE * NE, D / 2};
                    pg8::gemm_phase<pg8::EpiSwiglu8, pg8::MoeOrder, true, true, true>(C.lds, g, S, E); }
                else { pg8::EpiSwiglu E{WSP(bf16, WS_HM), DFE, 56};
                    pg8::Gemm g{WSP(bf16, WS_AS), WSP(bf16, WS_MW13), MSORT, 2 * DFE * NE, D};
                    pg8::gemm_phase<pg8::EpiSwiglu, pg8::MoeOrder, true, true>(C.lds, g, S, E); }
            } SEAM(18);
            if (IN(19)) {
                const int* R = WSP(int, WS_ROUTE);
                pg8::EpiStoreF32 E{WSP(float, WS_OUTS), WSP(float, WS_PARTO), (MOE_FP8 ? DFE / 2 : DFE) / 4};
                if (MOE_FP8) { pg8::Gemm g{WSP(bf16, WS_HM), WSP(bf16, WS_MW2), MSORT, D * NE, DFE / 2};
                    pg8::MoeDownOrder S; S.init(R[R_NT], R + R_TILEE, DFE / 2, C.G, C.bid);
                    pg8::gemm_phase<pg8::EpiStoreF32, pg8::MoeDownOrder, true, true, true>(C.lds, g, S, E); }
                else { pg8::Gemm g{WSP(bf16, WS_HM), WSP(bf16, WS_MW2), MSORT, D * NE, DFE};
                    pg8::MoeDownOrder S; S.init(R[R_NT], R + R_TILEE, DFE, C.G, C.bid);
                    pg8::gemm_phase<pg8::EpiStoreF32, pg8::MoeDownOrder, true, true>(C.lds, g, S, E); }
            } SEAM(19);
        }
    }
__global__ void __launch_bounds__(NTHR, 2) fwd(Args a) {
    extern __shared__ __attribute__((aligned(16))) unsigned char lds_raw[];
    Ctx C;
    C.lds = (LAS unsigned char*)lds_raw;
    C.in = (CIN)__builtin_amdgcn_kernarg_segment_ptr();
    C.out = a.out; C.ws = a.ws; C.tid = threadIdx.x; C.lane = C.tid & 63; C.wave = __builtin_amdgcn_readfirstlane(C.tid >> 6); C.G = gridDim.x; C.bid = blockIdx.x;
    const int lo = a.ph_lo, hi = a.ph_hi;
    XcdBarrier bar; bar.bar = WSP(unsigned, WS_CTL) + CW_BAR; bar.x = 0; bar.st = (volatile LAS unsigned*)(C.lds + LDS_BARW);
    if (hi - lo > 1) {
        if (C.tid < 4) { ((volatile LAS unsigned*)(C.lds + LDS_BARW))[C.tid] = 0u; }
        __syncthreads();
        bar = xcd_barrier_post(WSP(unsigned, WS_CTL) + CW_BAR, (volatile LAS unsigned*)(C.lds + LDS_BARW));
    }
    if (IN(0)) { p_prologue(C); } SEAM(0);
    layer_body<0>(C, bar, lo, hi);
    layer_body<1>(C, bar, lo, hi);
    if (IN(20)) { p_final(C, C.out); }
}

static int g_grid = 0;
static inline bool setup(size_t ws_size, size_t need) {
    if (g_grid == 0) {
        if (ws_size < need) { fprintf(stderr, "kernel_launch: workspace too small: %zu < %zu\n", ws_size, need); g_grid = -1; return false; }
        int dev = 0, cus = 0, per_cu = 0;
        if (hipGetDevice(&dev) != hipSuccess || hipDeviceGetAttribute(&cus, hipDeviceAttributeMultiprocessorCount, dev) != hipSuccess) { g_grid = -1; return false; }
        if (hipFuncSetAttribute((const void*)fwd, hipFuncAttributeMaxDynamicSharedMemorySize, LDS_BYTES) != hipSuccess) { fprintf(stderr, "kernel_launch: hipFuncSetAttribute failed\n"); g_grid = -1; return false; }
        if (hipOccupancyMaxActiveBlocksPerMultiprocessor(&per_cu, (const void*)fwd, NTHR, LDS_BYTES) != hipSuccess || per_cu < 1) { fprintf(stderr, "kernel_launch: occupancy query says %d\n", per_cu); }
        (void)hipGetLastError();
        g_grid = cus;
    }
    return g_grid > 0;
}
static inline void launch(void* const* d_in, float* out, void* d_ws, int lo, int hi, hipStream_t stream) {
    Args a{};
    for (int i = 0; i < 33; ++i) a.in[i] = (const float*)d_in[i];
    a.out = out; a.ws = (unsigned char*)d_ws; a.ph_lo = lo; a.ph_hi = hi;
    hipLaunchKernelGGL(fwd, dim3(g_grid), dim3(NTHR), LDS_BYTES, stream, a);
}
}
#ifndef MK_DEBUG
#define MK_DEBUG 0
#endif
#ifndef MK_ONE_LAUNCH
#define MK_ONE_LAUNCH 0
#endif
#if MK_DEBUG
#ifndef DBG_LAYER
#define DBG_LAYER 0
#endif
namespace dbg {
using namespace mk;
constexpr size_t SNAP = (WS_END + 4095) & ~(size_t)4095;
constexpr size_t S_ERR = SNAP;
constexpr size_t S_MOD = S_ERR + 4096;
constexpr size_t S_AN = S_MOD + al((size_t)10 * 12288 * 2);
constexpr size_t S_AB = S_AN + al((size_t)MT * D * 2);
constexpr size_t S_P = S_AB + al((size_t)MT * 16 * 2);
constexpr size_t S_O = S_P + al((size_t)MT * NIN * 2);
constexpr size_t S_Y = S_O + al((size_t)2 * MT * 512 * 2);
constexpr size_t S_XM = S_Y + al((size_t)MT * D * 2);
constexpr size_t S_AF = S_XM + al((size_t)MT * D * 2);
constexpr size_t S_XE = S_AF + al((size_t)MT * D * 2);
constexpr size_t S_OUT2 = S_XE + al((size_t)MT * D * 2);
constexpr size_t S_END = S_OUT2 + al((size_t)MX * D * 4);
constexpr int NCK = 12;
__global__ void k_snap(const float* src, size_t lds_, bf16* dst, size_t ldd, int rows, int cols, int mode) {
    for (size_t i = (size_t)blockIdx.x * blockDim.x + threadIdx.x; i < (size_t)rows * cols; i += (size_t)gridDim.x * blockDim.x) {
        const int r = (int)(i / cols), c = (int)(i % cols); int sr = r, sc = c;
        if (mode == 1) sc = c < 1536 ? c : c + 16;
        if (mode == 2) sc = c + 1536;
        size_t dr = r;
        if (mode == 3) { const int dir = r / MT, row = r % MT; dr = (size_t)dir * MT + dirrow(row, dir); }
        dst[dr * ldd + c] = (bf16)f2bf(src[(size_t)sr * lds_ + sc]); }
}
__global__ void k_cmp(const void* a, int a_bf16, size_t lda, size_t acol0, const bf16* b, size_t ldb, size_t bcol0, int rows, int cols, float* acc) {
    float num = 0.f, den = 0.f;
    for (size_t i = (size_t)blockIdx.x * blockDim.x + threadIdx.x; i < (size_t)rows * cols; i += (size_t)gridDim.x * blockDim.x) {
        const size_t r = i / cols, c = i % cols;
        const float av = a_bf16 ? bf2f(((const bf16*)a)[r * lda + acol0 + c]) : ((const float*)a)[r * lda + acol0 + c];
        const float bv = bf2f(b[r * ldb + bcol0 + c]); const float d = av - bv;
        if (!(d == d)) { num += 1e30f; } else { num += d * d; } den += bv * bv; }
    num = wave_sum(num); den = wave_sum(den);
    if ((threadIdx.x & 63) == 0) { atomicAdd(acc, num); atomicAdd(acc + 1, den); }
}
__global__ void k_decide(float* err) {
    if (threadIdx.x != 0) return; int code = -1, level = 0;
    for (int k = 0; k < NCK; ++k) { const float num = err[2 * k], den = err[2 * k + 1]; if (den == 0.f && num == 0.f) continue;
        const float e = sqrtf(num / fmaxf(den, 1e-30f)); const float tol = (k == 4) ? 0.06f : 0.03f;
        if (!(e <= tol)) { code = k; level = !(e == e) ? 5 : e < 1e-4f ? 0 : e < 1e-3f ? 1 : e < 1e-2f ? 2 : e < 1e-1f ? 3 : e < 1.f ? 4 : 5; break; } }
    ((int*)err)[64] = code; ((int*)err)[65] = level;
}
__global__ void k_encode(float* out, const float* out2, const float* err) {
    const int code = ((const int*)err)[64], level = ((const int*)err)[65];
    for (size_t i = (size_t)blockIdx.x * blockDim.x + threadIdx.x; i < (size_t)MX * D; i += (size_t)gridDim.x * blockDim.x) {
        if (code < 0) { out[i] = out2[i]; continue; }
        const size_t row = i / D; if (row < (size_t)(code + 1) * (MX / 16)) out[i] = 0.f;
        if (i == (size_t)MX * D - 1) out[i] = (float)(16 << level); }
}
}
#endif

extern "C" void kernel_launch(void* const* d_in, const int* in_sizes, int n_in, void* d_out, int out_size, void* d_ws, size_t ws_size, hipStream_t stream) {
    using namespace mk;
#if MK_DEBUG
    if (!setup(ws_size, dbg::S_END) || n_in != 33) return;
    unsigned char* ws = (unsigned char*)d_ws;
    nv::Bufs nb; const size_t nneed = nv::carve(ws, nb);
    if (nneed > dbg::SNAP) { fprintf(stderr, "naive scratch overlaps snapshots\n"); return; }
    hipMemsetAsync(ws + dbg::S_ERR, 0, 4096, stream);
    auto snap = [&](const float* src, size_t lds_, size_t dst_off, size_t ldd, int rows, int cols, int mode) {
        hipLaunchKernelGGL(dbg::k_snap, dim3(2048), dim3(256), 0, stream, src, lds_, (bf16*)(ws + dst_off), ldd, rows, cols, mode); };
    auto hook = [&](int point, int l) {
        if (point == 0) { snap(nb.mod, 12288, dbg::S_MOD, 12288, 10, 12288, 0); return; }
        if (l != DBG_LAYER) return;
        if (point == 1) snap(nb.A, D, dbg::S_AN, D, MT, D, 0);
        if (point == 2) { snap(nb.p, nv::INW, dbg::S_P, NIN, MT, NIN, 1); snap(nb.p, nv::INW, dbg::S_AB, 16, MT, 16, 2); }
        if (point == 3) snap(nb.o, 512, dbg::S_O, 512, 2 * MT, 512, 3);
        if (point == 4) snap(nb.y, D, dbg::S_Y, D, MT, D, 0);
        if (point == 5) snap(nb.xs, D, dbg::S_XM, D, MT, D, 0);
        if (point == 6) snap(nb.A, D, dbg::S_AF, D, MT, D, 0);
        if (point == 7) snap(nb.xs, D, dbg::S_XE, D, MT, D, 0);
    };
    nv::forward(d_in, (float*)d_out, nb, stream, hook);
    hipMemsetAsync(ws + WS_CTL, 0, CTL_BYTES, stream);
    float* err = (float*)(ws + dbg::S_ERR); float* out2 = (float*)(ws + dbg::S_OUT2);
    auto cmp = [&](int k, const void* a, int a_bf16, size_t lda, size_t acol0, size_t snap_off, size_t ldb, size_t bcol0, int rows, int cols) {
        hipLaunchKernelGGL(dbg::k_cmp, dim3(1024), dim3(256), 0, stream, a, a_bf16, lda, acol0, (const bf16*)(ws + snap_off), ldb, bcol0, rows, cols, err + 2 * k); };
    const int L = DBG_LAYER, pb = L == 0 ? 1 : 10, nr = L == 0 ? MT : MX;
    for (int ph = 0; ph < NPHASE; ++ph) {
        launch(d_in, out2, d_ws, ph, ph + 1, stream);
        if (ph == 0) cmp(0, ws + WS_MODV, 0, 12288, 0, dbg::S_MOD, 12288, 0, 10, 12288);
        if (ph == pb + 0) { cmp(1, ws + WS_AN, 1, D, 0, dbg::S_AN, D, 0, MT, D); cmp(2, ws + WS_ABF, 0, 16, 0, dbg::S_AB, 16, 0, MT, 16); }
        if (ph == pb + 1) { cmp(3, ws + WS_P, 1, NIN, 0, dbg::S_P, NIN, 0, nr, NIN); if (L == 1) cmp(3, ws + WS_P + (size_t)MX * NIN * 2, 1, NIN, 0, dbg::S_P + (size_t)MX * NIN * 2, NIN, 0, MC, 1536); }
        if (ph == pb + 3) cmp(4, ws + WS_O, 0, 512, 0, dbg::S_O, 512, 0, 2 * MT, 512);
        if (ph == pb + 4) { cmp(5, ws + WS_Y, 1, D, 0, dbg::S_Y, D, 0, nr, 512); cmp(6, ws + WS_Y, 1, D, 512, dbg::S_Y, D, 512, nr, 512);
                            cmp(7, ws + WS_Y, 1, D, 1024, dbg::S_Y, D, 1024, nr, 512); cmp(8, ws + WS_Y, 1, D, 1536, dbg::S_Y, D, 1536, nr, 512); }
        if (ph == pb + 5) cmp(9, ws + WS_XS, 0, D, 0, dbg::S_XM, D, 0, nr, D);
        if (ph == pb + 6) cmp(10, ws + WS_AN, 1, D, 0, dbg::S_AF, D, 0, nr, D);
        if (L == 0 && ph == 9) cmp(11, ws + WS_XS, 0, D, 0, dbg::S_XE, D, 0, MT, D);
    }
    hipLaunchKernelGGL(dbg::k_decide, dim3(1), dim3(64), 0, stream, err);
    hipLaunchKernelGGL(dbg::k_encode, dim3(2048), dim3(256), 0, stream, (float*)d_out, out2, err);
#else
    if (!setup(ws_size, WS_END) || n_in != 33) return;
    hipMemsetAsync((unsigned char*)d_ws + WS_CTL, 0, CTL_BYTES, stream);
#if MK_ONE_LAUNCH
    launch(d_in, (float*)d_out, d_ws, 0, NPHASE, stream);
#else
#ifndef REP_MASK
#define REP_MASK 0
#endif
    for (int ph = 0; ph < NPHASE; ++ph) { launch(d_in, (float*)d_out, d_ws, ph, ph + 1, stream); if ((REP_MASK >> ph) & 1) launch(d_in, (float*)d_out, d_ws, ph, ph + 1, stream); }
#endif
#endif
}
```

```cpp
#include <hip/hip_runtime.h>
#include <cstdio>
#include <cstdint>
#define MK_DEBUG 0
#define DBG_LAYER 0
#define MK_ONE_LAUNCH 1
#define REP_MASK 0
#ifndef BG_QUEUE
#define BG_QUEUE 0
#endif
#ifndef STATIC_FILL
#define STATIC_FILL MK_ONE_LAUNCH
#endif
#define GAS __attribute__((address_space(1)))
#define LAS __attribute__((address_space(3)))
typedef unsigned short bf16;
typedef short bf16x8 __attribute__((ext_vector_type(8)));
typedef float f32x4 __attribute__((ext_vector_type(4)));
typedef float f32x2 __attribute__((ext_vector_type(2)));
typedef unsigned u32x4 __attribute__((ext_vector_type(4)));
typedef unsigned u32x2 __attribute__((ext_vector_type(2)));

#ifndef DN_BLOCKS
#define DN_BLOCKS 192
#endif
#ifndef SCAN_BCD_BLOCKS
#define SCAN_BCD_BLOCKS 160
#endif
#ifndef FP8_EMU
#define FP8_EMU 0
#endif
#ifndef MOE_FP8
#define MOE_FP8 1
#endif
__device__ __forceinline__ float rne_e4m3(float x) { return __builtin_amdgcn_cvt_f32_fp8(__builtin_amdgcn_cvt_pk_fp8_f32(x, x, 0, false), 0); }
namespace mk {
constexpr int D = 2048, NB = 4, TX = 2048, TC = 256, MX = NB * TX, MC = NB * TC, MT = MX + MC;
constexpr int INW = 4624, NIN = 4608, NINP = 4864;
constexpr int PQ = 0, PK = 512, PV = 1024, PZ = 1536, PSGU = 2048, PSGV = 2560, PPOOL = 3072, PCVA = 3584, PCVG = 4096;
constexpr int DFF = 5632, NE = 8, DFE = 7168;
constexpr int NCH = MT / 64;
constexpr int MSORT = 2 * MX + NE * 256;
constexpr float EPS = 1e-6f;
constexpr int NTHR = 512, NWAVE = 8;
constexpr int LDS_BYTES = 163840;
constexpr int LDS_BARW = LDS_BYTES - 16;

constexpr size_t al(size_t x) { return (x + 4095) & ~(size_t)4095; }
constexpr size_t WS_CTL = 0, CTL_BYTES = 1u << 20;
constexpr size_t WS_MODV = WS_CTL + CTL_BYTES;
constexpr size_t WS_POS = WS_MODV + al((size_t)2 * 5 * 12288 * 4);
constexpr size_t WS_PWT = WS_POS + al((size_t)TX * D * 4);
constexpr size_t WS_WABC = WS_PWT + al((size_t)2 * 4 * 128 * 128 * 2);
constexpr size_t WS_WIN = WS_WABC + al((size_t)2 * 2048 * 16 * 4);
constexpr size_t WS_WOUT = WS_WIN + al((size_t)2 * NINP * D * 2);
constexpr size_t WS_W13 = WS_WOUT + al((size_t)2 * D * D * 2);
constexpr size_t WS_W2 = WS_W13 + al((size_t)2 * DFF * D * 2);
constexpr size_t WS_MW13 = WS_W2 + al((size_t)D * DFF * 2);
constexpr size_t WS_MW2 = WS_MW13 + al((size_t)NE * 2 * DFE * D * 2);
constexpr size_t WS_XS = WS_MW2 + al((size_t)NE * D * DFE * 2);
constexpr size_t WS_AN = WS_XS + al((size_t)MT * D * 4);
constexpr size_t WS_ABF = WS_AN + al((size_t)MT * D * 2);
constexpr size_t WS_PART = WS_ABF + al((size_t)MT * 16 * 4);
constexpr size_t WS_ROUTE = WS_PART + al((size_t)4 * MC * D * 4);
constexpr size_t WS_BIG = WS_ROUTE + al((size_t)1 << 20);
constexpr size_t WS_P = WS_BIG;
constexpr size_t DN_FRAG = (size_t)2 * NCH * 4;
constexpr size_t WS_DNW = WS_P + al((size_t)MT * NIN * 2);
constexpr size_t WS_DNQG = WS_DNW + al(DN_FRAG * 16384);
constexpr size_t WS_DNKDT = WS_DNQG + al(DN_FRAG * 16384);
constexpr size_t WS_DNQK = WS_DNKDT + al(DN_FRAG * 16384);
constexpr size_t WS_DNU = WS_DNQK + al(DN_FRAG * 8192);
constexpr size_t WS_EGL = WS_DNU + al(DN_FRAG * 16384);
constexpr size_t WS_O = WS_EGL + al(DN_FRAG * 16);
constexpr size_t WS_Y = WS_O + al((size_t)2 * MT * 512 * 4);
constexpr size_t WS_CVH = WS_Y + al((size_t)MT * D * 2);
constexpr size_t WS_MIX_END = WS_CVH + al((size_t)MT * 512 * 4);
constexpr size_t WS_HM = WS_BIG;
constexpr size_t WS_AS = WS_HM + al((size_t)MSORT * DFE * 2);
constexpr size_t WS_OUTS = WS_AS + al((size_t)MSORT * D * 2);
constexpr size_t WS_PARTO = WS_OUTS + al((size_t)MSORT * D * 4);
constexpr size_t WS_FFN_END = WS_PARTO + al((size_t)4 * 2048 * D * 4);
constexpr size_t WS_END = WS_FFN_END > WS_MIX_END ? WS_FFN_END : WS_MIX_END;
constexpr int R_TE = 0;
constexpr int R_TG = R_TE + MX * 2;
constexpr int R_RANK = R_TG + MX * 2;
constexpr int R_POS = R_RANK + MX * 2;
constexpr int R_TILEE = R_POS + MX * 2;
constexpr int R_NT = R_TILEE + 128;
constexpr int CW_CNT = 64;
constexpr int CW_BGHEAD = 1024;
constexpr int CW_DONE = 2048;
constexpr int CW_BAR = 4096;

__device__ __forceinline__ float silu(float x) { return x * __builtin_amdgcn_rcpf(1.f + __expf(-x)); }
__device__ __forceinline__ float sigm(float x) { return __builtin_amdgcn_rcpf(1.f + __expf(-x)); }
__device__ __forceinline__ float gelu_tanh(float x) { const float u = 0.7978845608028654f * (x + 0.044715f * x * x * x); const float e = __expf(2.f * u); return x * (1.f - __builtin_amdgcn_rcpf(1.f + e)); }
__device__ __forceinline__ float softplus(float x) { return x > 20.f ? x : log1pf(__expf(x)); }
__device__ __forceinline__ unsigned f2bf(float f) { unsigned u = __builtin_bit_cast(unsigned, f); return (u + 0x7fffu + ((u >> 16) & 1u)) >> 16; }
__device__ __forceinline__ unsigned pk2(float lo, float hi) { return f2bf(lo) | (f2bf(hi) << 16); }
__device__ __forceinline__ float bf2f(unsigned short b) { return __builtin_bit_cast(float, (unsigned)b << 16); }
__device__ __forceinline__ float bflo(unsigned w) { return __builtin_bit_cast(float, w << 16); }
__device__ __forceinline__ float bfhi(unsigned w) { return __builtin_bit_cast(float, w & 0xffff0000u); }
__device__ __forceinline__ bf16x8 pack8(const float* v) { u32x4 w; w.x = pk2(v[0], v[1]); w.y = pk2(v[2], v[3]); w.z = pk2(v[4], v[5]); w.w = pk2(v[6], v[7]); return __builtin_bit_cast(bf16x8, w); }
__device__ __forceinline__ void unpack8(u32x4 w, float* v) { v[0] = bflo(w.x); v[1] = bfhi(w.x); v[2] = bflo(w.y); v[3] = bfhi(w.y); v[4] = bflo(w.z); v[5] = bfhi(w.z); v[6] = bflo(w.w); v[7] = bfhi(w.w); }
__device__ __forceinline__ unsigned pk4_fp8(float a, float b, float c, float d) { int p = __builtin_amdgcn_cvt_pk_fp8_f32(a, b, 0, false); p = __builtin_amdgcn_cvt_pk_fp8_f32(c, d, p, true); return (unsigned)p; }
__device__ __forceinline__ float clamp448(float x) { return fminf(fmaxf(x, -448.f), 448.f); }
__device__ __forceinline__ float wave_sum(float v) {
#pragma unroll
    for (int o = 1; o < 64; o <<= 1) v += __shfl_xor(v, o);
    return v;
}
__device__ __forceinline__ float sum16(float v) {
#pragma unroll
    for (int o = 1; o < 16; o <<= 1) v += __shfl_xor(v, o);
    return v;
}
__device__ __forceinline__ void rowinfo(int row, int& base, int& T, int& t, int& mv) {
    if (row < MX) { const int b = row >> 11; base = b << 11; T = TX; t = row - base; mv = b; }
    else { const int r = row - MX, b = r >> 8; base = MX + (b << 8); T = TC; t = r - (b << 8); mv = 4; }
}
__device__ __forceinline__ int dirrow(int row, int dir) { int base, T, t, mv; rowinfo(row, base, T, t, mv); return dir ? base + (T - 1 - t) : row; }
#define LDS_WAIT() asm volatile("s_waitcnt lgkmcnt(0)" ::: "memory")
#define VM_WAIT() asm volatile("s_waitcnt vmcnt(0)" ::: "memory")
#define WG_BAR() do { __syncthreads(); } while (0)
}
#define XB_TMO      128
#define XB_XCNT(j)  (256  + 64 * (j))
#define XB_XSUB(j)  (1280 + 64 * (j))
#define XB_XGEN(j)  (2304 + 64 * (j))
#define XB_TOP      3328
#define XB_TOPGEN   3392
#define XCD_BAR_WORDS 3456
#define XB_SPIN_CAP (1u << 18)
#define LAS __attribute__((address_space(3)))

__device__ __forceinline__ unsigned xb_ld(unsigned* p)              { return __hip_atomic_load(p, __ATOMIC_RELAXED, __HIP_MEMORY_SCOPE_AGENT); }
__device__ __forceinline__ unsigned xb_add(unsigned* p, unsigned v) { return __hip_atomic_fetch_add(p, v, __ATOMIC_RELAXED, __HIP_MEMORY_SCOPE_AGENT); }
__device__ __forceinline__ unsigned xb_xcc_id() { return (unsigned)__builtin_amdgcn_s_getreg((3 << 11) | 20) & 0xFu; }
#define XB_SPIN(cond, bar) do { unsigned _sp = 0; while (cond) { __builtin_amdgcn_s_sleep(1); \
    if ((++_sp & 255u) == 0u) { if (xb_ld(&(bar)[XB_TMO])) break; if (_sp > XB_SPIN_CAP) { atomicAdd(&(bar)[XB_TMO], 1u); break; } } } } while (0)

struct XcdBarrier {
    unsigned* bar; unsigned x;
    volatile LAS unsigned* st;
};

__device__ __forceinline__ XcdBarrier xcd_barrier_post(unsigned* bar, volatile LAS unsigned* st) {
    XcdBarrier b; b.bar = bar; b.x = xb_xcc_id(); b.st = st;
    if (threadIdx.x == 0) (void)xb_add(&bar[XB_XCNT(b.x)], 1u);
    return b;
}
__device__ __forceinline__ void xcd_barrier_complete(unsigned* bar, unsigned x, unsigned& nloc, unsigned& nx) {
    const unsigned G = gridDim.x * gridDim.y * gridDim.z;
    unsigned sum, cnt, mine, sp = 0u;
    for (;;) {
        sum = 0u; cnt = 0u; mine = 0u;
#pragma unroll
        for (unsigned j = 0; j < 16; ++j) { const unsigned c = xb_ld(&bar[XB_XCNT(j)]); sum += c; cnt += (c > 0u) ? 1u : 0u; mine = (j == x) ? c : mine; }
        if (sum == G) break;
        __builtin_amdgcn_s_sleep(1);
        if ((++sp & 255u) == 0u) { if (xb_ld(&bar[XB_TMO])) break; if (sp > XB_SPIN_CAP) { atomicAdd(&bar[XB_TMO], 1u); break; } }
    }
    nloc = mine > 0u ? mine : 1u; nx = cnt > 0u ? cnt : 1u;
}

__device__ __forceinline__ void xcd_barrier(const XcdBarrier& b) {
    asm volatile("s_waitcnt vmcnt(0)" ::: "memory");
    __syncthreads();
    if (threadIdx.x == 0) {
        unsigned* bar = b.bar;
        __builtin_amdgcn_s_waitcnt(0);
        unsigned nloc = b.st[0], nx = b.st[1];
        if (nloc == 0u) { xcd_barrier_complete(bar, b.x, nloc, nx); b.st[0] = nloc; b.st[1] = nx; }
        const unsigned old = xb_add(&bar[XB_XSUB(b.x)], 1u);
        const unsigned gen = old / nloc;
        if (old + 1u == (gen + 1u) * nloc) {
            __builtin_amdgcn_fence(__ATOMIC_RELEASE, "agent");
            asm volatile("s_waitcnt vmcnt(0)" ::: "memory");
            const unsigned og = xb_add(&bar[XB_TOP], 1u);
            const unsigned tg = og / nx;
            if (og + 1u == (tg + 1u) * nx) xb_add(&bar[XB_TOPGEN], 1u);
            else XB_SPIN(xb_ld(&bar[XB_TOPGEN]) == tg, bar);
            __builtin_amdgcn_fence(__ATOMIC_ACQUIRE, "agent");
            xb_add(&bar[XB_XGEN(b.x)], 1u);
            asm volatile("s_waitcnt vmcnt(0)" ::: "memory");
        } else {
            XB_SPIN(xb_ld(&bar[XB_XGEN(b.x)]) == gen, bar);
            __builtin_amdgcn_fence(__ATOMIC_ACQUIRE, "agent");
            asm volatile("s_waitcnt vmcnt(0)" ::: "memory");
        }
    }
    __syncthreads();
}
namespace pg8 {
#define PG8_LAS __attribute__((address_space(3)))
typedef unsigned short bf16_t;
typedef short bf16x8 __attribute__((ext_vector_type(8)));
typedef float f32x4 __attribute__((ext_vector_type(4)));
typedef unsigned u32x4 __attribute__((ext_vector_type(4)));
constexpr int BM = 256, BK = 64, HALF = 128, HTB = HALF * BK * 2  , STAGE_BYTES = 8 * HTB, NXCD = 8, WGM = 8;

__host__ __device__ __forceinline__ int lds_byte(int r, int c) { const int st = (r >> 4) * 2 + (c >> 5), rr = r & 15, cc = c & 31, ob = rr * 64 + cc * 2; return st * 1024 + (ob ^ (((ob >> 9) & 1) << 5)); }
__host__ __device__ __forceinline__ void stage_rc(int b, int& R, int& C) { const int st = b / 1024, sb = b % 1024, swz = sb ^ (((sb >> 9) & 1) << 5); R = (st >> 1) * 16 + swz / 64; C = (st & 1) * 32 + (swz % 64) / 2; }
__host__ __device__ __forceinline__ int perm32(int rho) { const int n = rho >> 4, i = rho & 15; return 8 * (i >> 2) + 4 * n + (i & 3); }

struct Unit { int pm, pn, k0, nk; };
struct Gemm { const bf16_t* A; const bf16_t* Bt; int M, N, K; };

struct StaticOrder {
    int nM, nN, nwg, G, c;
    __host__ __device__ void init(int M, int N, int G_, int c_) { nM = M / BM; nN = N / BM; nwg = nM * nN; G = G_; c = c_; }
    __host__ __device__ bool next(int i, Unit& u) const {
        const long L = (long)i * G + c; if (L >= nwg) return false;
        int wgid = (int)L; { const int q = nwg / NXCD, r = nwg % NXCD, xcd = wgid % NXCD, off = wgid / NXCD; wgid = (xcd < r ? xcd * (q + 1) : r * (q + 1) + (xcd - r) * q) + off; }
        const int nig = WGM * nN, gid = wgid / nig, fm = gid * WGM, gsz = (nM - fm) < WGM ? (nM - fm) : WGM;
        u.pm = fm + ((wgid % nig) % gsz); u.pn = (wgid % nig) / gsz; u.k0 = 0; u.nk = 0; return true;
    }
    __device__ __forceinline__ void a_ready(const Unit&) const {}
    __device__ __forceinline__ void done(const Unit&) const {}
};
__device__ __forceinline__ unsigned cvt_pk_bf16(float lo, float hi) { unsigned r; asm volatile("v_cvt_pk_bf16_f32 %0, %1, %2" : "=v"(r) : "v"(lo), "v"(hi)); return r; }
typedef float f32x2 __attribute__((ext_vector_type(2)));
typedef int pg8_v8i __attribute__((ext_vector_type(8)));
typedef int pg8_v4i __attribute__((ext_vector_type(4)));
__device__ __forceinline__ pg8_v8i pg8_cat(bf16x8 lo, bf16x8 hi) { const pg8_v4i a = __builtin_bit_cast(pg8_v4i, lo), b = __builtin_bit_cast(pg8_v4i, hi); return __builtin_shufflevector(a, b, 0, 1, 2, 3, 4, 5, 6, 7); }
constexpr int F8_WSCALE = 121;
template <class Epi, class Sched, bool ALIGN_EPI = false, bool SP2 = false, bool F8 = false>
__device__ __forceinline__ void gemm_phase(PG8_LAS unsigned char* lds, const Gemm g, const Sched& S, const Epi& E) {
    const int tid = threadIdx.x, wid = __builtin_amdgcn_readfirstlane(tid >> 6), lane = tid & 63, wr = wid >> 2, wc = wid & 3, fr = lane & 15, fq = lane >> 4;
    const int K = g.K, nt = K / BK;
    unsigned voffA[2], voffB[2];
#pragma unroll
    for (int i = 0; i < 2; ++i) { int R, C; stage_rc(tid * 16 + i * 8192, R, C); const int Rb = Epi::PERM ? ((R & ~31) + perm32(R & 31)) : R;
        voffA[i] = (unsigned)(R * K + C) * 2u; voffB[i] = (unsigned)(Rb * K + C) * 2u; }
    const size_t kstep = (size_t)(BK * 2);
    const size_t hstep = (size_t)HALF * K * 2;
    const size_t tstep = 2 * hstep;
    const unsigned ldsw = (unsigned)wid * 1024u;
    const int aoff = lds_byte(wr * 64 + fr, fq * 8), boff = lds_byte(wc * 32 + fr, fq * 8);
#define PG8_SA(b, h) (((b) * 2 + (h)) * HTB)
#define PG8_SB(b, h) ((4 + (b) * 2 + (h)) * HTB)
#define PG8_STAGE(bufoff, gbase, voff) do { _Pragma("unroll") for (int _i = 0; _i < 2; ++_i) \
        __builtin_amdgcn_global_load_lds((const unsigned*)((const char*)(gbase) + (voff)[_i]), (PG8_LAS unsigned*)(lds + (bufoff) + ldsw + _i * 8192), 16, 0, 0); } while (0)
#define PG8_LDA(dst, b, h) do { _Pragma("unroll") for (int m = 0; m < 4; ++m) { if constexpr (F8) { dst##8[m] = pg8_cat(*(const PG8_LAS bf16x8*)(lds + PG8_SA(b, h) + aoff + m * 2048), *(const PG8_LAS bf16x8*)(lds + PG8_SA(b, h) + aoff + m * 2048 + 1024)); } else { _Pragma("unroll") for (int k = 0; k < 2; ++k) dst[m][k] = *(const PG8_LAS bf16x8*)(lds + PG8_SA(b, h) + aoff + m * 2048 + k * 1024); } } } while (0)
#define PG8_LDB(dst, b, h) do { _Pragma("unroll") for (int n = 0; n < 2; ++n) { if constexpr (F8) { dst##8[n] = pg8_cat(*(const PG8_LAS bf16x8*)(lds + PG8_SB(b, h) + boff + n * 2048), *(const PG8_LAS bf16x8*)(lds + PG8_SB(b, h) + boff + n * 2048 + 1024)); } else { _Pragma("unroll") for (int k = 0; k < 2; ++k) dst[n][k] = *(const PG8_LAS bf16x8*)(lds + PG8_SB(b, h) + boff + n * 2048 + k * 1024); } } } while (0)
#define PG8_MMA(ai, bj, At, Bt) do { __builtin_amdgcn_s_setprio(1); if constexpr (F8) { _Pragma("unroll") for (int m = 0; m < 4; ++m) _Pragma("unroll") for (int n = 0; n < 2; ++n) \
        asm volatile("v_mfma_scale_f32_16x16x128_f8f6f4 %0, %1, %2, %0, %3, %4 op_sel_hi:[0,0,0]" : "+v"(acc[ai][bj][m][n]) : "v"(Bt##8[n]), "v"(At##8[m]), "v"(f8_sw), "v"(f8_sa)); } \
        else { _Pragma("unroll") for (int m = 0; m < 4; ++m) _Pragma("unroll") for (int n = 0; n < 2; ++n) _Pragma("unroll") for (int k = 0; k < 2; ++k) \
        acc[ai][bj][m][n] = __builtin_amdgcn_mfma_f32_16x16x32_bf16(Bt[n][k], At[m][k], acc[ai][bj][m][n], 0, 0, 0); } __builtin_amdgcn_s_setprio(0); } while (0)
#define PG8_WAIT_V(n) asm volatile("s_waitcnt vmcnt(" #n ")" ::: "memory")
#define PG8_WAIT_L(n) asm volatile("s_waitcnt lgkmcnt(" #n ")" ::: "memory")
#define PG8_BAR __builtin_amdgcn_s_barrier()
#define PG8_SCHED __builtin_amdgcn_sched_barrier(0)
    Unit cur, nxt; int ui = 0;
    if (!S.next(0, cur)) return;
    f32x4 acc[2][2][4][2];
#pragma unroll
    for (int a = 0; a < 2; ++a)
#pragma unroll
        for (int b = 0; b < 2; ++b)
#pragma unroll
            for (int m = 0; m < 4; ++m)
#pragma unroll
                for (int n = 0; n < 2; ++n) acc[a][b][m][n] = (f32x4){0.f, 0.f, 0.f, 0.f};
    bf16x8 At[4][2], B0[2][2], B1[2][2]; pg8_v8i At8[4], B08[2], B18[2]; const int f8_sw = F8_WSCALE, f8_sa = 127;
    const char* cA = (const char*)g.A + (size_t)cur.pm * tstep + (size_t)cur.k0 * 2; const char* cB = (const char*)g.Bt + (size_t)cur.pn * tstep + (size_t)cur.k0 * 2;
    S.a_ready(cur);
    if constexpr (SP2) {
        PG8_STAGE(PG8_SB(0, 0), cB, voffB); PG8_STAGE(PG8_SB(0, 1), cB + hstep, voffB); PG8_STAGE(PG8_SA(0, 0), cA, voffA); PG8_STAGE(PG8_SA(0, 1), cA + hstep, voffA);
        if (wr == 1) PG8_BAR;
        PG8_WAIT_V(2); PG8_BAR;
        PG8_STAGE(PG8_SB(1, 0), cB + kstep, voffB); PG8_STAGE(PG8_SA(1, 0), cA + kstep, voffA); PG8_STAGE(PG8_SB(1, 1), cB + hstep + kstep, voffB);
        PG8_WAIT_V(6); PG8_BAR;
    } else {
        PG8_STAGE(PG8_SB(0, 0), cB, voffB); PG8_STAGE(PG8_SA(0, 0), cA, voffA); PG8_STAGE(PG8_SB(0, 1), cB + hstep, voffB); PG8_STAGE(PG8_SA(0, 1), cA + hstep, voffA);
        if (wr == 1) PG8_BAR;
        PG8_WAIT_V(4); PG8_BAR;
        PG8_STAGE(PG8_SB(1, 0), cB + kstep, voffB); PG8_STAGE(PG8_SA(1, 0), cA + kstep, voffA); PG8_STAGE(PG8_SB(1, 1), cB + hstep + kstep, voffB);
        PG8_WAIT_V(6); PG8_BAR;
    }
    for (;;) {
        const bool has_next = S.next(ui + 1, nxt);
        const char* nA = has_next ? (const char*)g.A + (size_t)nxt.pm * tstep + (size_t)nxt.k0 * 2 : cA; const char* nB = has_next ? (const char*)g.Bt + (size_t)nxt.pn * tstep + (size_t)nxt.k0 * 2 : cB;
        const int ntc = cur.nk ? cur.nk : nt;
        for (int t = 0; t < ntc; t += 2) {
            const bool last = (t == ntc - 2);
            const char* a1 = cA + (size_t)(t + 1) * kstep;
            const char* a2 = last ? nA : cA + (size_t)(t + 2) * kstep; const char* b2 = last ? nB : cB + (size_t)(t + 2) * kstep;
            const char* a3 = a2 + kstep; const char* b3 = b2 + kstep;
            if (last && has_next) S.a_ready(nxt);
            if constexpr (SP2) {
            PG8_LDB(B0, 0, 0); PG8_LDB(B1, 0, 1); PG8_SCHED; PG8_LDA(At, 0, 0); PG8_STAGE(PG8_SA(1, 1), a1 + hstep, voffA);
            PG8_WAIT_V(8); PG8_WAIT_L(0); PG8_BAR; PG8_MMA(0, 0, At, B0); PG8_MMA(0, 1, At, B1); PG8_BAR; PG8_SCHED;
            PG8_LDA(At, 0, 1); PG8_STAGE(PG8_SB(0, 0), b2, voffB); PG8_STAGE(PG8_SB(0, 1), b2 + hstep, voffB); PG8_STAGE(PG8_SA(0, 0), a2, voffA);
            PG8_WAIT_V(8); PG8_WAIT_L(0); PG8_BAR; PG8_MMA(1, 0, At, B0); PG8_MMA(1, 1, At, B1); PG8_BAR; PG8_SCHED;
            PG8_LDB(B0, 1, 0); PG8_LDB(B1, 1, 1); PG8_SCHED; PG8_LDA(At, 1, 0); PG8_STAGE(PG8_SA(0, 1), a2 + hstep, voffA);
            PG8_WAIT_V(8); PG8_WAIT_L(0); PG8_BAR; PG8_MMA(0, 0, At, B0); PG8_MMA(0, 1, At, B1); PG8_BAR; PG8_SCHED;
            PG8_LDA(At, 1, 1); PG8_STAGE(PG8_SB(1, 0), b3, voffB); PG8_STAGE(PG8_SB(1, 1), b3 + hstep, voffB); PG8_STAGE(PG8_SA(1, 0), a3, voffA);
            PG8_WAIT_V(8); PG8_WAIT_L(0); PG8_BAR; PG8_MMA(1, 0, At, B0); PG8_MMA(1, 1, At, B1); PG8_BAR; PG8_SCHED;
            } else {
            PG8_LDB(B0, 0, 0); PG8_SCHED; PG8_LDA(At, 0, 0); PG8_STAGE(PG8_SA(1, 1), a1 + hstep, voffA);
            PG8_WAIT_L(8); PG8_BAR; PG8_WAIT_L(0); PG8_MMA(0, 0, At, B0); PG8_BAR; PG8_SCHED;
            PG8_LDB(B1, 0, 1); PG8_STAGE(PG8_SB(0, 0), b2, voffB);
            PG8_BAR; PG8_WAIT_L(0); PG8_MMA(0, 1, At, B1); PG8_BAR;
            PG8_LDA(At, 0, 1); PG8_STAGE(PG8_SA(0, 0), a2, voffA);
            PG8_BAR; PG8_WAIT_L(0); PG8_MMA(1, 0, At, B0); PG8_BAR; PG8_SCHED;
            PG8_STAGE(PG8_SB(0, 1), b2 + hstep, voffB);
            PG8_WAIT_V(6); PG8_BAR; PG8_MMA(1, 1, At, B1); PG8_BAR;
            PG8_LDB(B0, 1, 0); PG8_SCHED; PG8_LDA(At, 1, 0); PG8_STAGE(PG8_SA(0, 1), a2 + hstep, voffA);
            PG8_WAIT_L(8); PG8_BAR; PG8_WAIT_L(0); PG8_MMA(0, 0, At, B0); PG8_BAR; PG8_SCHED;
            PG8_LDB(B1, 1, 1); PG8_STAGE(PG8_SB(1, 0), b3, voffB);
            PG8_BAR; PG8_WAIT_L(0); PG8_MMA(0, 1, At, B1); PG8_BAR;
            PG8_LDA(At, 1, 1); PG8_STAGE(PG8_SA(1, 0), a3, voffA);
            PG8_BAR; PG8_WAIT_L(0); PG8_MMA(1, 0, At, B0); PG8_BAR; PG8_SCHED;
            PG8_STAGE(PG8_SB(1, 1), b3 + hstep, voffB);
            PG8_WAIT_V(6); PG8_BAR; PG8_MMA(1, 1, At, B1); PG8_BAR;
            }
        }
        if constexpr (F8) { asm volatile("s_nop 15\n\ts_nop 15" ::: "memory"); }
        if constexpr (ALIGN_EPI) { if (wr == 0) PG8_BAR; }
        if constexpr (!Epi::AFTER_DRAIN) { E(acc, cur, wr, wc, fr, fq); S.done(cur); }
        if (!has_next) break;
#pragma unroll
        for (int a = 0; a < 2; ++a)
#pragma unroll
            for (int b = 0; b < 2; ++b)
#pragma unroll
                for (int m = 0; m < 4; ++m)
#pragma unroll
                    for (int n = 0; n < 2; ++n) acc[a][b][m][n] = (f32x4){0.f, 0.f, 0.f, 0.f};
        cur = nxt; cA = nA; cB = nB; ++ui;
        if constexpr (ALIGN_EPI) { if (wr == 1) PG8_BAR; }
    }
    PG8_WAIT_V(0);
    if constexpr (!ALIGN_EPI) { if (wr == 0) PG8_BAR; }
    PG8_BAR;
    if constexpr (Epi::AFTER_DRAIN) { E.fused(acc, cur, wr, wc, fr, fq, lds, wid, lane); S.done(cur); }
#undef PG8_SA
#undef PG8_SB
#undef PG8_STAGE
#undef PG8_LDA
#undef PG8_LDB
#undef PG8_MMA
#undef PG8_WAIT_V
#undef PG8_WAIT_L
#undef PG8_BAR
#undef PG8_SCHED
}
struct EpiStoreBf16 {
    static constexpr bool PERM = true, AFTER_DRAIN = false;
    bf16_t* O; int ldc; float* AB;
    __device__ __forceinline__ void operator()(const f32x4 (&acc)[2][2][4][2], const Unit& u, int wr, int wc, int fr, int fq) const {
        const int row0 = u.pm * BM + wr * 64 + fr, col0 = u.pn * BM + wc * 32 + 8 * fq;
        if (u.pn == 18) { if (wc == 0 && fq < 2) {
#pragma unroll
            for (int ai = 0; ai < 2; ++ai)
#pragma unroll
                for (int m = 0; m < 4; ++m) { float* rp = AB + (size_t)(row0 + ai * HALF + m * 16) * 16 + 8 * fq; *(f32x4*)rp = acc[ai][0][m][0]; *(f32x4*)(rp + 4) = acc[ai][0][m][1]; } }
            return; }
#pragma unroll
        for (int ai = 0; ai < 2; ++ai)
#pragma unroll
            for (int m = 0; m < 4; ++m) { bf16_t* rowp = O + (size_t)(row0 + ai * HALF + m * 16) * ldc + col0;
#pragma unroll
                for (int bj = 0; bj < 2; ++bj) { const f32x4 v0 = acc[ai][bj][m][0], v1 = acc[ai][bj][m][1];
                    u32x4 w; w.x = cvt_pk_bf16(v0[0], v0[1]); w.y = cvt_pk_bf16(v0[2], v0[3]); w.z = cvt_pk_bf16(v1[0], v1[1]); w.w = cvt_pk_bf16(v1[2], v1[3]);
                    *(u32x4*)(rowp + bj * HALF) = w; } }
    }
};
struct EpiResid {
    static constexpr bool PERM = false, AFTER_DRAIN = false;
    float* X; const float* mod; int goff; float* part; int kslice;
    __device__ __forceinline__ void operator()(const f32x4 (&acc)[2][2][4][2], const Unit& u, int wr, int wc, int fr, int fq) const {
        const int row0 = u.pm * BM + wr * 64 + fr, col0 = u.pn * BM + wc * 32 + 4 * fq;
        const int mv = u.pm < 32 ? (u.pm >> 3) : 4;
        const float* gp = mod + (size_t)mv * 12288 + goff + col0;
        f32x4 gv[2][2];
#pragma unroll
        for (int bj = 0; bj < 2; ++bj)
#pragma unroll
            for (int n = 0; n < 2; ++n) gv[bj][n] = *(const f32x4*)(gp + bj * HALF + n * 16);
        if (u.nk != 0) { float* pb = part + ((size_t)(u.k0 / kslice) * 1024 + (row0 - 8192)) * 2048 + col0;
#pragma unroll
            for (int ai = 0; ai < 2; ++ai)
#pragma unroll
                for (int m = 0; m < 4; ++m) { float* rowp = pb + (size_t)(ai * HALF + m * 16) * 2048;
#pragma unroll
                    for (int bj = 0; bj < 2; ++bj)
#pragma unroll
                        for (int n = 0; n < 2; ++n) *(f32x4*)(rowp + bj * HALF + n * 16) = gv[bj][n] * acc[ai][bj][m][n]; }
            return; }
#pragma unroll
        for (int ai = 0; ai < 2; ++ai)
#pragma unroll
            for (int m = 0; m < 4; ++m) { float* rowp = X + (size_t)(row0 + ai * HALF + m * 16) * 2048 + col0;
#pragma unroll
                for (int bj = 0; bj < 2; ++bj)
#pragma unroll
                    for (int n = 0; n < 2; ++n) { f32x4* p = (f32x4*)(rowp + bj * HALF + n * 16); *p = *p + gv[bj][n] * acc[ai][bj][m][n]; } }
    }
};
struct ResidOrder {
    StaticOrder so; int G, c, kslice;
    __device__ void init(int K, int G_, int c_) { so.init(8192, 2048, G_, c_); G = G_; c = c_; kslice = K / 4; }
    __device__ bool next(int i, Unit& u) const {
        const int L = i * G + c;
        if (L < so.nwg) return so.next(i, u);
        const int j = L - so.nwg; if (j >= 128) return false;
        const int t = j >> 2; u.pm = 32 + (t >> 3); u.pn = t & 7; u.k0 = (j & 3) * kslice; u.nk = kslice / BK; return true;
    }
    __device__ __forceinline__ void a_ready(const Unit&) const {}
    __device__ __forceinline__ void done(const Unit&) const {}
};
__device__ __forceinline__ float silu_f(float x) { return x * __builtin_amdgcn_rcpf(1.f + __builtin_amdgcn_exp2f(-1.4426950408889634f * x)); }
struct EpiSwiglu {
    static constexpr bool PERM = true, AFTER_DRAIN = false;
    bf16_t* H; int ldh; int ntn;
    __device__ __forceinline__ void operator()(const f32x4 (&acc)[2][2][4][2], const Unit& u, int wr, int wc, int fr, int fq) const {
        const int row0 = u.pm * BM + wr * 64 + fr, hcol0 = (u.pn % ntn) * HALF + wc * 32 + 8 * fq;
#pragma unroll
        for (int ai = 0; ai < 2; ++ai)
#pragma unroll
            for (int m = 0; m < 4; ++m) { bf16_t* rowp = H + (size_t)(row0 + ai * HALF + m * 16) * ldh + hcol0;
                const f32x4 a0 = acc[ai][0][m][0], a1 = acc[ai][0][m][1], b0 = acc[ai][1][m][0], b1 = acc[ai][1][m][1];
                float h[8];
#pragma unroll
                for (int j = 0; j < 4; ++j) { if (FP8_EMU && ntn == 56) { const float q = 1.f / 64.f; h[j] = rne_e4m3(silu_f(a0[j] * q) * (b0[j] * q)); h[4 + j] = rne_e4m3(silu_f(a1[j] * q) * (b1[j] * q)); } else { h[j] = silu_f(a0[j]) * b0[j]; h[4 + j] = silu_f(a1[j]) * b1[j]; } }
                u32x4 w; w.x = cvt_pk_bf16(h[0], h[1]); w.y = cvt_pk_bf16(h[2], h[3]); w.z = cvt_pk_bf16(h[4], h[5]); w.w = cvt_pk_bf16(h[6], h[7]);
                *(u32x4*)rowp = w; }
    }
};
struct EpiSwiglu8 {
    static constexpr bool PERM = true, AFTER_DRAIN = false;
    unsigned char* H; int ldh; int ntn;
    __device__ __forceinline__ void operator()(const f32x4 (&acc)[2][2][4][2], const Unit& u, int wr, int wc, int fr, int fq) const {
        const int row0 = u.pm * BM + wr * 64 + fr, hcol0 = (u.pn % ntn) * HALF + wc * 32 + 8 * fq;
#pragma unroll
        for (int ai = 0; ai < 2; ++ai)
#pragma unroll
            for (int m = 0; m < 4; ++m) { unsigned char* rowp = H + (size_t)(row0 + ai * HALF + m * 16) * ldh + hcol0;
                const f32x4 a0 = acc[ai][0][m][0], a1 = acc[ai][0][m][1], b0 = acc[ai][1][m][0], b1 = acc[ai][1][m][1];
                float h[8];
#pragma unroll
                for (int j = 0; j < 4; ++j) { h[j] = __builtin_amdgcn_fmed3f(silu_f(a0[j]) * b0[j], -448.f, 448.f); h[4 + j] = __builtin_amdgcn_fmed3f(silu_f(a1[j]) * b1[j], -448.f, 448.f); }
                int p0 = __builtin_amdgcn_cvt_pk_fp8_f32(h[0], h[1], 0, false); p0 = __builtin_amdgcn_cvt_pk_fp8_f32(h[2], h[3], p0, true);
                int p1 = __builtin_amdgcn_cvt_pk_fp8_f32(h[4], h[5], 0, false); p1 = __builtin_amdgcn_cvt_pk_fp8_f32(h[6], h[7], p1, true);
                u32x2 w; w.x = (unsigned)p0; w.y = (unsigned)p1; *(u32x2*)rowp = w; }
    }
};
struct EpiStoreF32 {
    static constexpr bool PERM = false, AFTER_DRAIN = false;
    float* C; float* part; int kslice;
    __device__ __forceinline__ void operator()(const f32x4 (&acc)[2][2][4][2], const Unit& u, int wr, int wc, int fr, int fq) const {
        const int row0 = u.pm * BM + wr * 64 + fr, col0 = (u.pn & 7) * BM + wc * 32 + 4 * fq;
        float* base = u.nk != 0 ? part + ((size_t)(u.k0 / kslice) * 2048 + (row0 - 16384)) * 2048 + col0 : C + (size_t)row0 * 2048 + col0;
#pragma unroll
        for (int ai = 0; ai < 2; ++ai)
#pragma unroll
            for (int m = 0; m < 4; ++m) { float* rowp = base + (size_t)(ai * HALF + m * 16) * 2048;
#pragma unroll
                for (int bj = 0; bj < 2; ++bj)
#pragma unroll
                    for (int n = 0; n < 2; ++n) *(f32x4*)(rowp + bj * HALF + n * 16) = FP8_EMU ? acc[ai][bj][m][n] * (1.f / 64.f) : acc[ai][bj][m][n]; }
    }
};
struct InProjL1Order {
    StaticOrder so; int G, c;
    __device__ void init(int G_, int c_) { so.init(8192, 4864, G_, c_); G = G_; c = c_; }
    __device__ bool next(int i, Unit& u) const {
        const int L = i * G + c;
        if (L < so.nwg) return so.next(i, u);
        const int L2 = L - so.nwg; if (L2 >= 28) return false;
        u.pm = 32 + (L2 & 3); u.pn = (L2 >> 2) == 6 ? 18 : (L2 >> 2); u.k0 = 0; u.nk = 0; return true;
    }
    __device__ __forceinline__ void a_ready(const Unit&) const {}
    __device__ __forceinline__ void done(const Unit&) const {}
};
struct MoeOrder {
    StaticOrder so; const int* tile_e; int NT;
    __device__ void init(int ntiles, int NT_, const int* te, int G_, int c_) { so.nM = ntiles; so.nN = NT_; so.nwg = ntiles * NT_; so.G = G_; so.c = c_; tile_e = te; NT = NT_; }
    __device__ bool next(int i, Unit& u) const { if (!so.next(i, u)) return false; u.pn += tile_e[u.pm] * NT; return true; }
    __device__ __forceinline__ void a_ready(const Unit&) const {}
    __device__ __forceinline__ void done(const Unit&) const {}
};
struct MoeDownOrder {
    StaticOrder so; const int* tile_e; int ntiles, G, c, kslice;
    __device__ void init(int ntiles_, const int* te, int K, int G_, int c_) { ntiles = ntiles_; const int nm = ntiles_ < 64 ? ntiles_ : 64; so.nM = nm; so.nN = 8; so.nwg = nm * 8; so.G = G_; so.c = c_; tile_e = te; G = G_; c = c_; kslice = K / 4; }
    __device__ bool next(int i, Unit& u) const {
        const int L = i * G + c;
        if (L < so.nwg) { so.next(i, u); u.pn += tile_e[u.pm] * 8; return true; }
        const int j = L - so.nwg; if (j >= (ntiles - so.nM) * 32) return false;
        const int t = j >> 2; u.pm = 64 + (t >> 3); u.pn = tile_e[u.pm] * 8 + (t & 7); u.k0 = (j & 3) * kslice; u.nk = kslice / BK; return true;
    }
    __device__ __forceinline__ void a_ready(const Unit&) const {}
    __device__ __forceinline__ void done(const Unit&) const {}
};
}
namespace mk {
typedef const float* KP;
typedef __attribute__((address_space(4))) KP const* CIN;
struct Ctx {
    LAS unsigned char* lds;
    CIN in; float* out; unsigned char* ws;
    int tid, lane, wave, G, bid;
};
#define WSP(T, off) ((T*)(C.ws + (off)))
__device__ __forceinline__ const float* inp_(CIN p, int k) { asm volatile("" : "+s"(p)); return p[k]; }
#define INP(k) inp_(C.in, (k))

__device__ __forceinline__ void tr_item(const float* W, int ldw, int k0, int ncol0, bf16* WT, int ldt, int drow0, LAS float* scr, int lane, bool f8 = false) {
    f32x4 v[16];
#pragma unroll
    for (int i = 0; i < 16; ++i) { const int idx = lane + 64 * i, kk = idx >> 4, c4 = idx & 15; v[i] = *(const f32x4*)(W + (size_t)(k0 + kk) * ldw + ncol0 + 4 * c4); }
    if (FP8_EMU && f8) {
#pragma unroll
        for (int i = 0; i < 16; ++i) { v[i].x = rne_e4m3(v[i].x * 64.f); v[i].y = rne_e4m3(v[i].y * 64.f); v[i].z = rne_e4m3(v[i].z * 64.f); v[i].w = rne_e4m3(v[i].w * 64.f); } }
#pragma unroll
    for (int i = 0; i < 16; ++i) { const int idx = lane + 64 * i, kk = idx >> 4, c4 = idx & 15; LAS float* p = scr + kk * 65 + 4 * c4; p[0] = v[i].x; p[1] = v[i].y; p[2] = v[i].z; p[3] = v[i].w; }
    LDS_WAIT(); asm volatile("" ::: "memory");
    const int c = lane & 7;
#pragma unroll
    for (int jj = 0; jj < 8; ++jj) { const int n = (lane >> 3) + 8 * jj; const LAS float* s = scr + (8 * c) * 65 + n;
        u32x4 o; o.x = pk2(s[0], s[65]); o.y = pk2(s[2 * 65], s[3 * 65]); o.z = pk2(s[4 * 65], s[5 * 65]); o.w = pk2(s[6 * 65], s[7 * 65]);
        *(u32x4*)(WT + (size_t)(drow0 + n) * ldt + k0 + 8 * c) = o; }
    LDS_WAIT(); asm volatile("" ::: "memory");
}
__device__ __forceinline__ void tr_item8(const float* W, int ldw, int k0, int ncol0, unsigned char* WT, int ldt, int drow0, LAS float* scr, int lane) {
    f32x4 v[16];
#pragma unroll
    for (int i = 0; i < 16; ++i) { const int idx = lane + 64 * i, kk = idx >> 3, c4 = idx & 7; v[i] = *(const f32x4*)(W + (size_t)(k0 + kk) * ldw + ncol0 + 4 * c4); }
#pragma unroll
    for (int i = 0; i < 16; ++i) { const int idx = lane + 64 * i, kk = idx >> 3, c4 = idx & 7; LAS float* p = scr + kk * 33 + 4 * c4; p[0] = v[i].x * 64.f; p[1] = v[i].y * 64.f; p[2] = v[i].z * 64.f; p[3] = v[i].w * 64.f; }
    LDS_WAIT(); asm volatile("" ::: "memory");
    const int c = lane & 7;
#pragma unroll
    for (int jj = 0; jj < 4; ++jj) { const int n = (lane >> 3) + 8 * jj; const LAS float* s = scr + (16 * c) * 33 + n;
        u32x4 o; o.x = pk4_fp8(s[0], s[33], s[2 * 33], s[3 * 33]); o.y = pk4_fp8(s[4 * 33], s[5 * 33], s[6 * 33], s[7 * 33]);
        o.z = pk4_fp8(s[8 * 33], s[9 * 33], s[10 * 33], s[11 * 33]); o.w = pk4_fp8(s[12 * 33], s[13 * 33], s[14 * 33], s[15 * 33]);
        *(u32x4*)(WT + (size_t)(drow0 + n) * ldt + k0 + 16 * c) = o; }
    LDS_WAIT(); asm volatile("" ::: "memory");
}
constexpr int IT_WIN = 32 * 73, IT_WOUT = 32 * 32, IT_W1 = 32 * 88, IT_W2 = 88 * 32, IT_MW1 = 32 * 112, IT_MW2 = 112 * 32, IT_PW = 2 * 2;
constexpr int IT_PRO = IT_WIN + 8 * IT_PW;
constexpr int BG_WOUT0 = 0, BG_W13 = BG_WOUT0 + IT_WOUT, BG_W2 = BG_W13 + 2 * IT_W1, BG_WIN1 = BG_W2 + IT_W2, BG_WOUT1 = BG_WIN1 + IT_WIN, BG_MOE = BG_WOUT1 + IT_WOUT, NBG = BG_MOE + 16 * IT_MW1 + 8 * IT_MW2;
constexpr int IT_TOTAL = IT_PRO + NBG;
__device__ __forceinline__ void tr_dispatch(Ctx& C, int it, LAS float* scr) {
    const float* W; int ldw, k0, nc0, ldt, dr0; bf16* WT; int r = it;
    if (r < IT_WIN) { const int kb = r / 73, nb = r % 73; W = INP(7); ldw = INW; k0 = 64 * kb; nc0 = nb == 72 ? 1536 : nb < 24 ? 64 * nb : 1552 + 64 * (nb - 24); WT = WSP(bf16, WS_WIN); ldt = D; dr0 = nb == 72 ? 4608 : nb < 24 ? 64 * nb : 1536 + 64 * (nb - 24); }
    else if (r < IT_PRO) { r -= IT_WIN; const int m = r / IT_PW, q = r % IT_PW; W = INP(16) + (size_t)m * 128 * 128; ldw = 128; k0 = 64 * (q >> 1); nc0 = 64 * (q & 1); WT = WSP(bf16, WS_PWT) + (size_t)m * 128 * 128; ldt = 128; dr0 = 64 * (q & 1); }
    else { r -= IT_PRO;
        if (r < BG_W13) { const int kb = r / 32, nb = r % 32; W = INP(22); ldw = D; k0 = 64 * kb; nc0 = 64 * nb; WT = WSP(bf16, WS_WOUT); ldt = D; dr0 = 64 * nb; }
        else if (r < BG_W2) { r -= BG_W13; const int s = r / IT_W1; r -= s * IT_W1; const int kb = r / 88, nb = r % 88; W = INP(24 + s); ldw = DFF; k0 = 64 * kb; nc0 = 64 * nb; WT = WSP(bf16, WS_W13); ldt = D; dr0 = 256 * (nb >> 1) + 128 * s + 64 * (nb & 1); }
        else if (r < BG_WIN1) { r -= BG_W2; const int kb = r / 32, nb = r % 32; W = INP(26); ldw = D; k0 = 64 * kb; nc0 = 64 * nb; WT = WSP(bf16, WS_W2); ldt = DFF; dr0 = 64 * nb; }
        else if (r < BG_WOUT1) { r -= BG_WIN1; const int kb = r / 73, nb = r % 73; W = INP(7) + (size_t)D * INW; ldw = INW; k0 = 64 * kb; nc0 = nb == 72 ? 1536 : nb < 24 ? 64 * nb : 1552 + 64 * (nb - 24); WT = WSP(bf16, WS_WIN) + (size_t)NINP * D; ldt = D; dr0 = nb == 72 ? 4608 : nb < 24 ? 64 * nb : 1536 + 64 * (nb - 24); }
        else if (r < BG_MOE) { r -= BG_WOUT1; const int kb = r / 32, nb = r % 32; W = INP(22) + (size_t)D * D; ldw = D; k0 = 64 * kb; nc0 = 64 * nb; WT = WSP(bf16, WS_WOUT) + (size_t)D * D; ldt = D; dr0 = 64 * nb; }
        else { r -= BG_MOE;
            if (MOE_FP8) {
                if (r < 16 * IT_MW1) { const int j = r / IT_MW1; r -= j * IT_MW1; const int s = j >> 3, e = j & 7, kb = r / 224, nb = r % 224, h0 = 32 * nb;
                    tr_item8(INP(29 + s) + (size_t)e * D * DFE, DFE, 128 * kb, h0, WSP(unsigned char, WS_MW13) + (size_t)e * 2 * DFE * D, D, 256 * (h0 >> 7) + 128 * s + (h0 & 127), scr, C.lane); }
                else { r -= 16 * IT_MW1; const int e = r / IT_MW2; r -= e * IT_MW2; const int kb = r / 64, nb = r % 64;
                    tr_item8(INP(31) + (size_t)e * DFE * D, D, 128 * kb, 32 * nb, WSP(unsigned char, WS_MW2) + (size_t)e * D * DFE, DFE, 32 * nb, scr, C.lane); }
                return; }
            if (r < 16 * IT_MW1) { const int j = r / IT_MW1; r -= j * IT_MW1; const int s = j >> 3, e = j & 7, kb = r / 112, nb = r % 112;
                W = INP(29 + s) + (size_t)e * D * DFE; ldw = DFE; k0 = 64 * kb; nc0 = 64 * nb; WT = WSP(bf16, WS_MW13) + (size_t)e * 2 * DFE * D; ldt = D; dr0 = 256 * (nb >> 1) + 128 * s + 64 * (nb & 1); }
            else { r -= 16 * IT_MW1; const int e = r / IT_MW2; r -= e * IT_MW2; const int kb = r / 32, nb = r % 32;
                W = INP(31) + (size_t)e * DFE * D; ldw = D; k0 = 64 * kb; nc0 = 64 * nb; WT = WSP(bf16, WS_MW2) + (size_t)e * D * DFE; ldt = DFE; dr0 = 64 * nb; } } }
    tr_item(W, ldw, k0, nc0, WT, ldt, dr0, scr, C.lane, it >= IT_PRO + BG_MOE);
}
#ifndef BG_BATCH_N
#define BG_BATCH_N 1
#endif
constexpr int BG_BATCH = BG_BATCH_N;
__device__ __forceinline__ void bg_work(Ctx& C, int limit, int poll_phase) {
    unsigned* ctl = WSP(unsigned, WS_CTL);
    volatile LAS unsigned* flag = (volatile LAS unsigned*)(C.lds + LDS_BARW + 8);
    VM_WAIT(); __syncthreads();
    if (C.tid == 0) { flag[0] = 0u; flag[1] = __hip_atomic_load(ctl + CW_BGHEAD, __ATOMIC_RELAXED, __HIP_MEMORY_SCOPE_AGENT) >= (unsigned)NBG ? 1u : 0u;
        if (poll_phase >= 0) __hip_atomic_fetch_add(ctl + CW_DONE + 64 * poll_phase, 1u, __ATOMIC_RELAXED, __HIP_MEMORY_SCOPE_AGENT); }
    __syncthreads();
    if (flag[1] != 0u) return;
    LAS float* scr = (LAS float*)(C.lds + C.wave * 16896);
    for (;;) {
        if (C.tid == 0) { unsigned base = 0xffffffffu;
            const unsigned head = __hip_atomic_load(ctl + CW_BGHEAD, __ATOMIC_RELAXED, __HIP_MEMORY_SCOPE_AGENT);
            bool go = head < (unsigned)limit;
            if (!go && poll_phase >= 0 && head < (unsigned)NBG) go = __hip_atomic_load(ctl + CW_DONE + 64 * poll_phase, __ATOMIC_RELAXED, __HIP_MEMORY_SCOPE_AGENT) < (unsigned)C.G;
            if (go) base = __hip_atomic_fetch_add(ctl + CW_BGHEAD, (unsigned)NWAVE, __ATOMIC_RELAXED, __HIP_MEMORY_SCOPE_AGENT);
            flag[0] = base; }
        __syncthreads();
        const unsigned base = flag[0];
        if (base >= (unsigned)NBG) break;
        if (base + C.wave < (unsigned)NBG) tr_dispatch(C, IT_PRO + (int)base + C.wave, scr);
        __syncthreads();
    }
}
__device__ __forceinline__ void mod_unit(Ctx& C, int unit, LAS float* sv  , LAS float* red  ) {
    const int l = unit / 192, col0 = (unit % 192) * 64, cq = C.tid & 15, ks = C.tid >> 4;
    const float* w = INP(4) + ((size_t)l * D + ks * 64) * 12288 + col0 + 4 * cq;
    f32x4 acc[5];
#pragma unroll
    for (int v = 0; v < 5; ++v) acc[v] = (f32x4){0.f, 0.f, 0.f, 0.f};
#pragma unroll 8
    for (int k = 0; k < 64; ++k) { const f32x4 wv = *(const f32x4*)(w + (size_t)k * 12288);
#pragma unroll
        for (int v = 0; v < 5; ++v) acc[v] += wv * sv[v * 2048 + ks * 64 + k]; }
#pragma unroll
    for (int v = 0; v < 5; ++v) *(LAS f32x4*)(red + (ks * 5 + v) * 64 + 4 * cq) = acc[v];
    WG_BAR();
    if (C.tid < 320) { const int v = C.tid >> 6, c = C.tid & 63; float s = 0.f;
#pragma unroll 8
        for (int k = 0; k < 32; ++k) s += red[(k * 5 + v) * 64 + c];
        WSP(float, WS_MODV)[((size_t)l * 5 + v) * 12288 + col0 + c] = s + INP(5)[l * 12288 + col0 + c]; }
    WG_BAR();
}
__device__ __forceinline__ void p_prologue(Ctx& C) {
    LAS float* sv = (LAS float*)C.lds; LAS float* red = sv + 5 * 2048;
    for (int i = C.tid; i < 5 * 2048; i += NTHR) { const float x = i < 4 * 2048 ? INP(1)[i] : INP(3)[i - 4 * 2048]; sv[i] = x / (1.f + expf(-x)); }
    WG_BAR();
    for (int u = C.bid; u < 384; u += C.G) mod_unit(C, u, sv, red);
    for (int i = C.bid * NTHR + C.tid; i < 2 * 2048 * 4; i += C.G * NTHR) { const int lk = i >> 2, q = i & 3; *(f32x4*)(WSP(float, WS_WABC) + (size_t)lk * 16 + 4 * q) = *(const f32x4*)(INP(7) + (size_t)lk * INW + 1536 + 4 * q); }
    { float* pos = WSP(float, WS_POS);
      for (size_t i = (size_t)C.bid * NTHR + C.tid; i < (size_t)TX * D; i += (size_t)C.G * NTHR) {
          const int t = (int)(i >> 11), d = (int)(i & 2047), r = t >> 6, cc = t & 63, part = d >> 9, fi = d & 511;
          const float freq = expf(-9.210340371976184f * (float)fi / 512.f);
          const float ang = (part < 2 ? (float)r : (float)cc) * freq;
          pos[i] = (part & 1) ? __cosf(ang) : __sinf(ang); } }
    WG_BAR();
    LAS float* scr = (LAS float*)(C.lds + C.wave * 16896);
    const int gw = C.bid * NWAVE + C.wave, NGW = C.G * NWAVE;
    const int nit = (STATIC_FILL && C.G == 256) ? IT_PRO + BG_MOE : IT_TOTAL;
    for (int it = gw; it < nit; it += NGW) tr_dispatch(C, it, scr);
}
struct F8Item { const float* W; unsigned char* WT; int ldw, ldt; };
__device__ __forceinline__ F8Item f8_item(Ctx& C, int r) {
    F8Item t;
    if (r < 16 * IT_MW1) { const int j = r / IT_MW1; r -= j * IT_MW1; const int s = j >> 3, e = j & 7, kb = r / 224, nb = r % 224, h0 = 32 * nb;
        t.W = INP(29 + s) + (size_t)e * D * DFE + (size_t)(128 * kb) * DFE + h0; t.ldw = DFE; t.ldt = D;
        t.WT = WSP(unsigned char, WS_MW13) + (size_t)e * 2 * DFE * D + (size_t)(256 * (h0 >> 7) + 128 * s + (h0 & 127)) * D + 128 * kb; }
    else { r -= 16 * IT_MW1; const int e = r / IT_MW2; r -= e * IT_MW2; const int kb = r / 64, nb = r % 64;
        t.W = INP(31) + (size_t)e * DFE * D + (size_t)(128 * kb) * D + 32 * nb; t.ldw = D; t.ldt = DFE;
        t.WT = WSP(unsigned char, WS_MW2) + (size_t)e * D * DFE + (size_t)(32 * nb) * DFE + 128 * kb; }
    return t;
}
__device__ __forceinline__ void f8_load(const F8Item& t, f32x4 (&v)[16], int lane) {
#pragma unroll
    for (int i = 0; i < 16; ++i) { const int idx = lane + 64 * i, kk = idx >> 3, c4 = idx & 7; v[i] = *(const f32x4*)(t.W + (size_t)kk * t.ldw + 4 * c4); }
}
__device__ __forceinline__ void f8_store(const F8Item& t, const f32x4 (&v)[16], LAS float* scr, int lane) {
#pragma unroll
    for (int i = 0; i < 16; ++i) { const int idx = lane + 64 * i, kk = idx >> 3, c4 = idx & 7; LAS float* p = scr + kk * 33 + 4 * c4; p[0] = v[i].x * 64.f; p[1] = v[i].y * 64.f; p[2] = v[i].z * 64.f; p[3] = v[i].w * 64.f; }
    LDS_WAIT(); asm volatile("" ::: "memory");
    const int c = lane & 7;
#pragma unroll
    for (int jj = 0; jj < 4; ++jj) { const int n = (lane >> 3) + 8 * jj; const LAS float* s = scr + (16 * c) * 33 + n;
        u32x4 o; o.x = pk4_fp8(s[0], s[33], s[2 * 33], s[3 * 33]); o.y = pk4_fp8(s[4 * 33], s[5 * 33], s[6 * 33], s[7 * 33]);
        o.z = pk4_fp8(s[8 * 33], s[9 * 33], s[10 * 33], s[11 * 33]); o.w = pk4_fp8(s[12 * 33], s[13 * 33], s[14 * 33], s[15 * 33]);
        *(u32x4*)(t.WT + (size_t)n * t.ldt + 16 * c) = o; }
    LDS_WAIT(); asm volatile("" ::: "memory");
}
__device__ __forceinline__ void fill_static(Ctx& C, int first, int n, int b0) {
    if (!(STATIC_FILL && C.G == 256) || C.bid < b0 || n <= 0) return;
    VM_WAIT(); __syncthreads();
    LAS float* scr = (LAS float*)(C.lds + C.wave * 16896);
    const int nb = C.G - b0, step = nb * NWAVE, end = first + n;
    int it = first + (C.bid - b0) * NWAVE + C.wave;
    if (!MOE_FP8) { for (; it < end; it += step) tr_dispatch(C, IT_PRO + BG_MOE + it, scr); return; }
    if (it >= end) return;
    f32x4 va[16], vb[16];
    F8Item ta = f8_item(C, it), tb = ta; f8_load(ta, va, C.lane);
    for (;;) {
        const bool mb = it + step < end; if (mb) { tb = f8_item(C, it + step); f8_load(tb, vb, C.lane); }
        f8_store(ta, va, scr, C.lane);
        if (!mb) break; it += step;
        const bool ma = it + step < end; if (ma) { ta = f8_item(C, it + step); f8_load(ta, va, C.lane); }
        f8_store(tb, vb, scr, C.lane);
        if (!ma) break; it += step;
    }
}

template <int MODE>
__device__ __forceinline__ void p_norm(Ctx& C, int l) {
    const float* mod = WSP(float, WS_MODV) + (size_t)l * 5 * 12288;
    float* XS = WSP(float, WS_XS); bf16* AN = WSP(bf16, WS_AN);
    const bool mix = MODE <= 1;
    const float* gain = (mix ? INP(6) : INP(23)) + l * D;
    const int sh_off = mix ? 0 : 6144, sc_off = mix ? 2048 : 8192;
    LAS f32x4* wl = (LAS f32x4*)C.lds;
    if (MODE == 3) { const float* wsrc = INP(27);
        for (int idx = C.tid; idx < 2048 * 2; idx += NTHR) { const int k = idx >> 1, q = idx & 1, ln = (k & 255) >> 2, i = k & 3, j = k >> 8;
            wl[((j * 4 + i) * 2 + q) * 64 + ln] = *(const f32x4*)(wsrc + (size_t)k * 8 + 4 * q); } }
    WG_BAR();
    const int nrows = MODE == 3 ? MX : MT;
    const int gw = C.bid * NWAVE + C.wave, NGW = C.G * NWAVE, lane = C.lane;
    for (int row = gw; row < nrows; row += NGW) {
        int base, T, t, mv; rowinfo(row, base, T, t, mv);
        f32x4 x[8]; float ss = 0.f;
        if (MODE == 0) {
            if (row < MX) { const f32x4* xi = (const f32x4*)(INP(0) + (size_t)row * D) + lane; const f32x4* pp = (const f32x4*)(WSP(float, WS_POS) + (size_t)t * D) + lane;
#pragma unroll
                for (int j = 0; j < 8; ++j) x[j] = xi[64 * j] + pp[64 * j]; }
            else { const f32x4* xi = (const f32x4*)(INP(2) + (size_t)(row - MX) * D) + lane;
#pragma unroll
                for (int j = 0; j < 8; ++j) x[j] = xi[64 * j]; }
            f32x4* xo = (f32x4*)(XS + (size_t)row * D) + lane;
#pragma unroll
            for (int j = 0; j < 8; ++j) xo[64 * j] = x[j];
        } else { const f32x4* xi = (const f32x4*)(XS + (size_t)row * D) + lane;
#pragma unroll
            for (int j = 0; j < 8; ++j) x[j] = xi[64 * j];
            if ((MODE == 1 || (MODE == 2 && l == 0)) && row >= MX) {
#pragma unroll
                for (int ks = 0; ks < 4; ++ks) { const f32x4* pp = (const f32x4*)(WSP(float, WS_PART) + ((size_t)ks * MC + (row - MX)) * D) + lane;
#pragma unroll
                    for (int j = 0; j < 8; ++j) x[j] += pp[64 * j]; }
                f32x4* xo = (f32x4*)(XS + (size_t)row * D) + lane;
#pragma unroll
                for (int j = 0; j < 8; ++j) xo[64 * j] = x[j]; } }
#pragma unroll
        for (int j = 0; j < 8; ++j) ss += (x[j].x * x[j].x + x[j].y * x[j].y) + (x[j].z * x[j].z + x[j].w * x[j].w);
        const float rs = rsqrtf(wave_sum(ss) * (1.f / D) + EPS);
        const f32x4* gp = (const f32x4*)gain + lane; const f32x4* shp = (const f32x4*)(mod + (size_t)mv * 12288 + sh_off) + lane; const f32x4* scp = (const f32x4*)(mod + (size_t)mv * 12288 + sc_off) + lane;
        u32x2* ao = (u32x2*)(AN + (size_t)row * D) + lane;
#pragma unroll
        for (int j = 0; j < 8; ++j) { const f32x4 g = gp[64 * j], sh = shp[64 * j], sc = scp[64 * j];
            x[j] = x[j] * rs * g * (sc + 1.f) + sh;
            u32x2 w; w.x = pk2(x[j].x, x[j].y); w.y = pk2(x[j].z, x[j].w); ao[64 * j] = w; }
        if (MODE == 3) {
            f32x4 acc[2] = {(f32x4){0.f, 0.f, 0.f, 0.f}, (f32x4){0.f, 0.f, 0.f, 0.f}};
#pragma unroll
            for (int j = 0; j < 8; ++j)
#pragma unroll
                for (int i = 0; i < 4; ++i) { const float a = x[j][i];
#pragma unroll
                    for (int q = 0; q < 2; ++q) acc[q] += wl[((j * 4 + i) * 2 + q) * 64 + lane] * a; asm volatile("" ::: "memory"); }
            float lg[8];
#pragma unroll
            for (int e = 0; e < 8; ++e) lg[e] = wave_sum(acc[e >> 2][e & 3]) + INP(28)[e];
            if (lane == 0) { int i1 = 0;
#pragma unroll
                for (int e = 1; e < 8; ++e) if (lg[e] > lg[i1]) i1 = e;
                int i2 = i1 == 0 ? 1 : 0;
#pragma unroll
                for (int e = 0; e < 8; ++e) if (e != i1 && lg[e] > lg[i2]) i2 = e;
                float v1 = lg[0], v2 = lg[0];
#pragma unroll
                for (int e = 0; e < 8; ++e) { v1 = e == i1 ? lg[e] : v1; v2 = e == i2 ? lg[e] : v2; }
                const float g2 = 1.f / (1.f + expf(v1 - v2));
                int* R = WSP(int, WS_ROUTE); float* Rf = WSP(float, WS_ROUTE); unsigned* ctl = WSP(unsigned, WS_CTL);
                R[R_TE + 2 * row] = i1; R[R_TE + 2 * row + 1] = i2; Rf[R_TG + 2 * row] = 1.f - g2; Rf[R_TG + 2 * row + 1] = g2;
                R[R_RANK + 2 * row] = (int)atomicAdd(ctl + CW_CNT + 64 * i1, 1u); R[R_RANK + 2 * row + 1] = (int)atomicAdd(ctl + CW_CNT + 64 * i2, 1u); }
        }
    }
}
}
namespace mk {
__device__ __forceinline__ f32x4 mfma16(bf16x8 a, bf16x8 b, f32x4 c) { return __builtin_amdgcn_mfma_f32_16x16x32_bf16(a, b, c, 0, 0, 0); }

constexpr int DP_PITCH = 132;
constexpr int DP_Q = 0, DP_K = 33792, DP_V = 67584;
constexpr int DP_LP = 68;
constexpr int DP_L = 101376;
constexpr int DP_QK = DP_L + 2 * 64 * DP_LP * 4;
constexpr int DP_SM = DP_QK + 16384;
static_assert(DP_SM + 2048 <= LDS_BARW, "DN prep LDS map");
__device__ __forceinline__ size_t dn_rec(int dir, int cid, int h) { return ((size_t)dir * NCH + cid) * 4 + h; }

__device__ __forceinline__ void dnprep_unit(Ctx& C, int l, int cidx, int h) {
    LAS float* Qs = (LAS float*)(C.lds + DP_Q); LAS float* Ks = (LAS float*)(C.lds + DP_K); LAS float* Vs = (LAS float*)(C.lds + DP_V);
    LAS float* Ls = (LAS float*)(C.lds + DP_L); LAS bf16* QKi = (LAS bf16*)(C.lds + DP_QK); LAS float* sm = (LAS float*)(C.lds + DP_SM);
    LAS float* Gs = sm; LAS float* Bs = sm + 128; LAS float* EGs = sm + 256; LAS float* EGRs = sm + 384;
    const bf16* P = WSP(bf16, WS_P);
    const int tid = C.tid, lane = C.lane, wave = C.wave;
    const int r0 = cidx * 64; int sbase, T, t0, mv; rowinfo(r0, sbase, T, t0, mv);
    const int nloc = t0 >> 6, nch = T >> 6, cbase = sbase >> 6;
#ifndef DP_SKIP
#define DP_SKIP 0
#endif
    if (!(DP_SKIP & 1)) { if (tid < 384) {
        const int o = tid % 48, tg = tid / 48, wh = o >> 4, oc = o & 15, ch = wh * 512 + h * 128 + 8 * oc;
        float w[5][8];
        const float* cw = INP(8) + (size_t)l * 5 * 1536 + ch;
#pragma unroll
        for (int k = 0; k < 5; ++k) { const f32x4 a = *(const f32x4*)(cw + k * 1536), b = *(const f32x4*)(cw + k * 1536 + 4);
            w[k][0] = a.x; w[k][1] = a.y; w[k][2] = a.z; w[k][3] = a.w; w[k][4] = b.x; w[k][5] = b.y; w[k][6] = b.z; w[k][7] = b.w; }
#pragma unroll 1
        for (int hf = 0; hf < 2; ++hf) {
        float xin[8][8];
#pragma unroll
        for (int i = 0; i < 8; ++i) { const int t = t0 + 8 * tg + 4 * hf + i - 2;
            if (t >= 0 && t < T) { const u32x4 raw = *(const u32x4*)(P + (size_t)(sbase + t) * NIN + ch); unpack8(raw, xin[i]); }
            else {
#pragma unroll
                for (int c = 0; c < 8; ++c) xin[i][c] = 0.f; } }
#pragma unroll
        for (int i = 0; i < 4; ++i) { float ov[8]; float ss = 0.f;
#pragma unroll
            for (int c = 0; c < 8; ++c) { float s = 0.f;
#pragma unroll
                for (int k = 0; k < 5; ++k) s += w[k][c] * xin[i + k][c];
                ov[c] = silu(s); ss += ov[c] * ov[c]; }
            ss = sum16(ss);
            const float sc = wh == 0 ? rsqrtf(ss + EPS) * 0.08838834764831845f : wh == 1 ? rsqrtf(ss + EPS) : 1.f;
            LAS float* dst = (wh == 0 ? Qs : wh == 1 ? Ks : Vs) + (8 * tg + 4 * hf + i) * DP_PITCH + 8 * oc;
            *(LAS f32x4*)dst = (f32x4){ov[0] * sc, ov[1] * sc, ov[2] * sc, ov[3] * sc}; *(LAS f32x4*)(dst + 4) = (f32x4){ov[4] * sc, ov[5] * sc, ov[6] * sc, ov[7] * sc}; }
        }
    } else {
        const int d = wave - 6, s = lane, i = d ? 63 - s : s; const float* ab = WSP(float, WS_ABF) + (size_t)(r0 + i) * 16;
        const float la = -expf(INP(9)[l * 8 + d * 4 + h]) * softplus(ab[d * 4 + h] + INP(10)[l * 8 + d * 4 + h]);
        const float be = sigm(ab[8 + d * 4 + h]);
        float g = la;
#pragma unroll
        for (int o = 1; o < 64; o <<= 1) { const float up = __shfl_up(g, o); if (lane >= o) g += up; }
        const float gl = __shfl(g, 63);
        Gs[d * 64 + s] = g; Bs[d * 64 + s] = be; EGs[d * 64 + s] = expf(g); EGRs[d * 64 + s] = expf(gl - g);
        if (lane == 63) { const int cid = d ? cbase + (nch - 1 - nloc) : cidx; const float e = expf(gl); *(f32x4*)(WSP(float, WS_EGL) + dn_rec(d, cid, h) * 4) = (f32x4){e, e, e, e}; }
    } }
    WG_BAR();
    if (!(DP_SKIP & 2)) {
        const int wh = wave >> 2, mb = wave & 3, c = lane & 15, g4 = lane >> 4;
        const LAS float* Am = wh ? Qs : Ks;
        f32x4 acc[4];
#pragma unroll
        for (int nb = 0; nb < 4; ++nb) acc[nb] = (f32x4){0.f, 0.f, 0.f, 0.f};
#pragma unroll
        for (int ks = 0; ks < 4; ++ks) {
            float av[8]; { const LAS float* p = Am + (16 * mb + c) * DP_PITCH + 32 * ks + 8 * g4; const f32x4 a = *(const LAS f32x4*)p, b = *(const LAS f32x4*)(p + 4);
                av[0] = a.x; av[1] = a.y; av[2] = a.z; av[3] = a.w; av[4] = b.x; av[5] = b.y; av[6] = b.z; av[7] = b.w; }
            const bf16x8 af = pack8(av);
#pragma unroll
            for (int nb = 0; nb < 4; ++nb) { float bv[8]; const LAS float* p = Ks + (16 * nb + c) * DP_PITCH + 32 * ks + 8 * g4; const f32x4 a = *(const LAS f32x4*)p, b = *(const LAS f32x4*)(p + 4);
                bv[0] = a.x; bv[1] = a.y; bv[2] = a.z; bv[3] = a.w; bv[4] = b.x; bv[5] = b.y; bv[6] = b.z; bv[7] = b.w;
                acc[nb] = mfma16(af, pack8(bv), acc[nb]); }
        }
        if (wh == 0) {
#pragma unroll
            for (int d = 0; d < 2; ++d) { const LAS float* Gd = Gs + d * 64; const LAS float* Bd = Bs + d * 64; LAS float* Ld = Ls + d * 64 * DP_LP;
#pragma unroll
                for (int r = 0; r < 4; ++r) { const int i = 16 * mb + 4 * g4 + r, s = d ? 63 - i : i; const float gs = Gd[s], bs = Bd[s];
#pragma unroll
                    for (int nb = 0; nb < 4; ++nb) { const int ip = 16 * nb + c, sp = d ? 63 - ip : ip;
                        Ld[s * DP_LP + sp] = s > sp ? bs * acc[nb][r] * __expf(gs - Gd[sp]) : 0.f; } } }
        } else {
#pragma unroll
            for (int d = 0; d < 2; ++d) { const LAS float* Gd = Gs + d * 64; LAS bf16* Qd = QKi + d * 4096;
#pragma unroll
                for (int r = 0; r < 4; ++r) { const int i = 16 * mb + 4 * g4 + r, s = d ? 63 - i : i; const float gs = Gd[s];
#pragma unroll
                    for (int nb = 0; nb < 4; ++nb) { const int ip = 16 * nb + c, sp = d ? 63 - ip : ip;
                        const float qk = s >= sp ? acc[nb][r] * __expf(gs - Gd[sp]) : 0.f;
                        const int lp = ((sp & 15) >> 2) * 16 + (s & 15), jp = 4 * ((sp >> 4) & 1) + (sp & 3);
                        Qd[(((s >> 4) * 2 + (sp >> 5)) * 64 + lp) * 8 + jp] = (bf16)f2bf(qk); } } }
        }
    }
    WG_BAR();
    if (wave < 2) {
        const int d = wave; LAS float* Ld = Ls + d * 64 * DP_LP; int ln = lane; asm volatile("" : "+v"(ln));
        float X[64];
#pragma unroll
        for (int s = 0; s < 64; ++s) X[s] = 0.f;
#pragma unroll
        for (int s = 0; s < 64; ++s) { float a0 = (s == ln) ? 1.f : 0.f, a1 = 0.f, a2 = 0.f, a3 = 0.f;
#pragma unroll
            for (int j4 = 0; j4 < (s + 3) / 4; ++j4) { const f32x4 lv = *(const LAS f32x4*)(Ld + s * DP_LP + 4 * j4);
                if (4 * j4 + 0 < s) a0 -= lv.x * X[4 * j4 + 0];
                if (4 * j4 + 1 < s) a1 -= lv.y * X[4 * j4 + 1];
                if (4 * j4 + 2 < s) a2 -= lv.z * X[4 * j4 + 2];
                if (4 * j4 + 3 < s) a3 -= lv.w * X[4 * j4 + 3]; }
            X[s] = (a0 + a1) + (a2 + a3);
            Ld[s * DP_LP + ln] = X[s];
            asm volatile("" ::: "memory"); }
    }
    WG_BAR();
    {
        const int d = wave >> 2, q = wave & 3; int c = lane & 15, g4 = lane >> 4; asm volatile("" : "+v"(c), "+v"(g4));
        const LAS float* Td = Ls + d * 64 * DP_LP; const LAS float* Bd = Bs + d * 64; const LAS float* Ed = EGs + d * 64;
        const int cid = d ? cbase + (nch - 1 - nloc) : cidx; const size_t rec = dn_rec(d, cid, h);
        bf16x8 Th[4][2], Tl[4][2];
#pragma unroll
        for (int mb = 0; mb < 4; ++mb)
#pragma unroll
            for (int ks = 0; ks < 2; ++ks) { const LAS float* tp = Td + (16 * mb + c) * DP_LP + 32 * ks + 8 * g4; const f32x4 a = *(const LAS f32x4*)tp, b2 = *(const LAS f32x4*)(tp + 4);
                float v[8] = {a.x, a.y, a.z, a.w, b2.x, b2.y, b2.z, b2.w}, lo[8]; const bf16x8 hi = pack8(v); float hf[8]; unpack8(__builtin_bit_cast(u32x4, hi), hf);
#pragma unroll
                for (int e = 0; e < 8; ++e) lo[e] = v[e] - hf[e];
                Th[mb][ks] = hi; Tl[mb][ks] = pack8(lo); }
#pragma unroll
        for (int tt = 0; tt < 2; ++tt) { const int nt = 2 * q + tt, col = 16 * nt + c;
            f32x4 ua[4];
#pragma unroll
            for (int mb = 0; mb < 4; ++mb) ua[mb] = (f32x4){0.f, 0.f, 0.f, 0.f};
#pragma unroll
            for (int ks = 0; ks < 2; ++ks) { float bv[8];
#pragma unroll
                for (int e = 0; e < 8; ++e) { const int sp = 32 * ks + 8 * g4 + e, i = d ? 63 - sp : sp; bv[e] = Bd[sp] * Vs[i * DP_PITCH + col]; }
                const bf16x8 bf = pack8(bv);
#pragma unroll
                for (int mb = 0; mb < 4; ++mb) { ua[mb] = mfma16(Th[mb][ks], bf, ua[mb]); ua[mb] = mfma16(Tl[mb][ks], bf, ua[mb]); } }
            bf16x8* ug = (bf16x8*)(WSP(unsigned char, WS_DNU) + rec * 16384) + (nt * 2) * 64 + lane;
#pragma unroll
            for (int j = 0; j < 2; ++j) { float v[8] = {ua[2 * j][0], ua[2 * j][1], ua[2 * j][2], ua[2 * j][3], ua[2 * j + 1][0], ua[2 * j + 1][1], ua[2 * j + 1][2], ua[2 * j + 1][3]}; ug[j * 64] = pack8(v); } }
        { f32x4 wa[2][4];
#pragma unroll
          for (int tt = 0; tt < 2; ++tt)
#pragma unroll
              for (int nb = 0; nb < 4; ++nb) wa[tt][nb] = (f32x4){0.f, 0.f, 0.f, 0.f};
#pragma unroll
          for (int tt = 0; tt < 2; ++tt) { const int dk = 16 * (2 * q + tt) + c;
#pragma unroll
              for (int ks = 0; ks < 2; ++ks) { float av[8];
#pragma unroll
                  for (int e = 0; e < 8; ++e) { const int sp = 32 * ks + 8 * g4 + e, i = d ? 63 - sp : sp; av[e] = Bd[sp] * Ed[sp] * Ks[i * DP_PITCH + dk]; }
                  const bf16x8 af = pack8(av);
#pragma unroll
                  for (int nb = 0; nb < 4; ++nb) { wa[tt][nb] = mfma16(af, Th[nb][ks], wa[tt][nb]); wa[tt][nb] = mfma16(af, Tl[nb][ks], wa[tt][nb]); } } }
          bf16x8* wg = (bf16x8*)(WSP(unsigned char, WS_DNW) + rec * 16384) + lane;
#pragma unroll
          for (int nb = 0; nb < 4; ++nb) { float v[8] = {wa[0][nb][0], wa[0][nb][1], wa[0][nb][2], wa[0][nb][3], wa[1][nb][0], wa[1][nb][1], wa[1][nb][2], wa[1][nb][3]}; wg[(nb * 4 + q) * 64] = pack8(v); } }
    }
    {
        for (int ci = tid; ci < 1024; ci += NTHR) { const int d = ci >> 9, cc = ci & 511; const int cid = d ? cbase + (nch - 1 - nloc) : cidx;
            ((u32x4*)(WSP(unsigned char, WS_DNQK) + dn_rec(d, cid, h) * 8192))[cc] = ((const LAS u32x4*)(C.lds + DP_QK + d * 8192))[cc]; }
        for (int ci = tid; ci < 2048; ci += NTHR) { const int d = ci >> 10, cc = ci & 1023, mb = cc >> 8, ks = (cc >> 6) & 3, lp = cc & 63, c = lp & 15, g4 = lp >> 4;
            const int s = 16 * mb + c, i = d ? 63 - s : s; const float e = EGs[d * 64 + s];
            const LAS float* p = Qs + i * DP_PITCH + 32 * ks + 4 * g4; const f32x4 a = *(const LAS f32x4*)p, b = *(const LAS f32x4*)(p + 16);
            float v[8] = {a.x * e, a.y * e, a.z * e, a.w * e, b.x * e, b.y * e, b.z * e, b.w * e};
            const int cid = d ? cbase + (nch - 1 - nloc) : cidx;
            ((bf16x8*)(WSP(unsigned char, WS_DNQG) + dn_rec(d, cid, h) * 16384))[cc] = pack8(v); }
        for (int ci = tid; ci < 2048; ci += NTHR) { const int d = ci >> 10, cc = ci & 1023, tt = cc >> 7, ks2 = (cc >> 6) & 1, lp = cc & 63, c = lp & 15, g4 = lp >> 4;
            float v[8];
#pragma unroll
            for (int j = 0; j < 8; ++j) { const int s = 32 * ks2 + 16 * (j >> 2) + 4 * g4 + (j & 3), i = d ? 63 - s : s; v[j] = Ks[i * DP_PITCH + 16 * tt + c] * EGRs[d * 64 + s]; }
            const int cid = d ? cbase + (nch - 1 - nloc) : cidx;
            ((bf16x8*)(WSP(unsigned char, WS_DNKDT) + dn_rec(d, cid, h) * 16384))[cc] = pack8(v); }
    }
    WG_BAR();
}

constexpr int SG_VT = 0, SG_VPITCH = 136;
__device__ __forceinline__ void sg_unit(Ctx& C, int l, int cb, int h) {
    LAS bf16* vT = (LAS bf16*)(C.lds + SG_VT);
    const bf16* P = WSP(bf16, WS_P); bf16* Y = WSP(bf16, WS_Y);
    const int lane = C.lane, wave = C.wave, r0 = cb * 128;
    const float* lg = INP(12) + l * 512; const float* lb = INP(13) + l * 512;
    for (int q = 0; q < 16; ++q) { const int j = 16 * wave + q; float v[8];
        unpack8(*(const u32x4*)(P + (size_t)(r0 + j) * NIN + PSGV + 8 * lane), v);
        float s = 0.f;
#pragma unroll
        for (int c = 0; c < 8; ++c) { v[c] = gelu_tanh(v[c]); s += v[c]; }
        const float mu = wave_sum(s) * (1.f / 512.f); float s2 = 0.f;
#pragma unroll
        for (int c = 0; c < 8; ++c) { v[c] -= mu; s2 += v[c] * v[c]; }
        const float rs = rsqrtf(wave_sum(s2) * (1.f / 512.f) + EPS);
        if ((lane >> 4) == h) { const int d0 = 8 * (lane & 15);
#pragma unroll
            for (int c = 0; c < 8; ++c) vT[(d0 + c) * SG_VPITCH + j] = (bf16)f2bf(v[c] * rs * lg[128 * h + d0 + c] + lb[128 * h + d0 + c]); } }
    WG_BAR();
    const int c = lane & 15, g4 = lane >> 4;
    const float* W = INP(14) + ((size_t)(l * 4 + h) * 128 + 16 * wave + c) * 128;
    f32x4 acc[8];
#pragma unroll
    for (int nb = 0; nb < 8; ++nb) acc[nb] = (f32x4){0.f, 0.f, 0.f, 0.f};
#pragma unroll
    for (int ks = 0; ks < 4; ++ks) { const f32x4 a = *(const f32x4*)(W + 32 * ks + 8 * g4), b = *(const f32x4*)(W + 32 * ks + 8 * g4 + 4);
        float av[8] = {a.x, a.y, a.z, a.w, b.x, b.y, b.z, b.w}; const bf16x8 af = pack8(av);
#pragma unroll
        for (int nb = 0; nb < 8; ++nb) { const bf16x8 bfr = *(const LAS bf16x8*)(vT + (16 * nb + c) * SG_VPITCH + 32 * ks + 8 * g4); acc[nb] = mfma16(af, bfr, acc[nb]); } }
    const float* bs = INP(15) + (l * 4 + h) * 128;
#pragma unroll
    for (int r = 0; r < 4; ++r) { const int i = 16 * wave + 4 * g4 + r; const float bi = bs[i]; const size_t row = (size_t)(r0 + i);
#pragma unroll
        for (int nb = 0; nb < 8; ++nb) { const int d = 16 * nb + c; const float u = gelu_tanh(bf2f(P[row * NIN + PSGU + 128 * h + d]));
            Y[row * D + 512 + 128 * h + d] = (bf16)f2bf(u * (acc[nb][r] + bi)); } }
    WG_BAR();
}

constexpr int PL_PITCH = 132, PL_BUF = 80 * PL_PITCH;
__device__ __forceinline__ void pool_unit(Ctx& C, int l, int cidx, int g) {
    const bf16* P = WSP(bf16, WS_P); bf16* Y = WSP(bf16, WS_Y); const bf16* PW = WSP(bf16, WS_PWT) + (size_t)(l * 4 + g) * 128 * 128;
    LAS float* X = (LAS float*)C.lds; LAS float* B0 = X + PL_BUF; LAS float* B1 = B0 + PL_BUF;
    const int lane = C.lane, wave = C.wave, c = lane & 15, g4 = lane >> 4, mb = wave & 3, nh = wave >> 2;
    const int r0 = cidx * 64; int sbase, T, t0, mv; rowinfo(r0, sbase, T, t0, mv);
    for (int idx = C.tid; idx < 80 * 16; idx += NTHR) { const int q = idx >> 4, oc = idx & 15, t = t0 + q - 8; float v[8];
        if (t >= 0 && t < T) unpack8(*(const u32x4*)(P + (size_t)(sbase + t) * NIN + PPOOL + 128 * g + 8 * oc), v);
        else {
#pragma unroll
            for (int cc = 0; cc < 8; ++cc) v[cc] = 0.f; }
        LAS float* d = X + q * PL_PITCH + 8 * oc; *(LAS f32x4*)d = (f32x4){v[0], v[1], v[2], v[3]}; *(LAS f32x4*)(d + 4) = (f32x4){v[4], v[5], v[6], v[7]}; }
    WG_BAR();
    const LAS float* src = X; LAS float* dst = B0;
    for (int pass = 0, w = 1; pass <= g; ++pass, w <<= 1) {
        for (int idx = C.tid; idx < (80 - w) * 32; idx += NTHR) { const int r = idx >> 5, c4 = idx & 31;
            *(LAS f32x4*)(dst + r * PL_PITCH + 4 * c4) = *(const LAS f32x4*)(src + r * PL_PITCH + 4 * c4) + *(const LAS f32x4*)(src + (r + w) * PL_PITCH + 4 * c4); }
        WG_BAR();
        src = dst; dst = (dst == B0) ? B1 : B0;
    }
    const int i = 16 * mb + c, t = t0 + i, hw = 1 << g;
    const int lo = t - hw < 0 ? 0 : t - hw, hi = t + hw > T ? T : t + hw; const float inv = 1.f / (float)(hi - lo);
    f32x4 acc[4];
#pragma unroll
    for (int nb = 0; nb < 4; ++nb) acc[nb] = (f32x4){0.f, 0.f, 0.f, 0.f};
#pragma unroll
    for (int ks = 0; ks < 4; ++ks) { const LAS float* sp = src + (i + 8 - hw) * PL_PITCH + 32 * ks + 8 * g4; const LAS float* xp = X + (i + 8) * PL_PITCH + 32 * ks + 8 * g4;
        const f32x4 s0 = *(const LAS f32x4*)sp, s1 = *(const LAS f32x4*)(sp + 4), x0 = *(const LAS f32x4*)xp, x1 = *(const LAS f32x4*)(xp + 4);
        float s[8] = {s0.x * inv - x0.x, s0.y * inv - x0.y, s0.z * inv - x0.z, s0.w * inv - x0.w, s1.x * inv - x1.x, s1.y * inv - x1.y, s1.z * inv - x1.z, s1.w * inv - x1.w};
        const bf16x8 af = pack8(s);
#pragma unroll
        for (int nb = 0; nb < 4; ++nb) { const bf16x8 bfr = *(const bf16x8*)(PW + (size_t)(16 * (4 * nh + nb) + c) * 128 + 32 * ks + 8 * g4); acc[nb] = mfma16(af, bfr, acc[nb]); } }
    const float* psc = INP(17) + l * 512 + 128 * g;
#pragma unroll
    for (int nb = 0; nb < 4; ++nb) { const int e = 16 * (4 * nh + nb) + c; const float sc = psc[e];
#pragma unroll
        for (int r = 0; r < 4; ++r) Y[(size_t)(r0 + 16 * mb + 4 * g4 + r) * D + 1024 + 128 * g + e] = (bf16)f2bf(acc[nb][r] * sc); }
    WG_BAR();
}

constexpr int CV_PITCH = 132;
__device__ __forceinline__ void conf_unit(Ctx& C, int l, int cidx, int cq) {
    const bf16* P = WSP(bf16, WS_P); float* H = WSP(float, WS_CVH); LAS float* gl = (LAS float*)C.lds;
    const int r0 = cidx * 64; int sbase, T, t0, mv; rowinfo(r0, sbase, T, t0, mv);
    for (int idx = C.tid; idx < 94 * 16; idx += NTHR) { const int q = idx >> 4, oc = idx & 15, t = t0 + q - 15; float v[8];
        if (t >= 0 && t < T) { const bf16* pr = P + (size_t)(sbase + t) * NIN + 128 * cq + 8 * oc; float a[8], g[8];
            unpack8(*(const u32x4*)(pr + PCVA), a); unpack8(*(const u32x4*)(pr + PCVG), g);
#pragma unroll
            for (int c = 0; c < 8; ++c) v[c] = a[c] * sigm(g[c]); }
        else {
#pragma unroll
            for (int c = 0; c < 8; ++c) v[c] = 0.f; }
        LAS float* d = gl + q * CV_PITCH + 8 * oc; *(LAS f32x4*)d = (f32x4){v[0], v[1], v[2], v[3]}; *(LAS f32x4*)(d + 4) = (f32x4){v[4], v[5], v[6], v[7]}; }
    const int chl = C.tid & 127, ch = 128 * cq + chl, grp = C.tid >> 7;
    float w[31];
#pragma unroll
    for (int k = 0; k < 31; ++k) w[k] = INP(18)[((size_t)l * 31 + k) * 512 + ch];
    const float cb = INP(19)[l * 512 + ch];
    WG_BAR();
    float glu[46];
#pragma unroll
    for (int q = 0; q < 46; ++q) glu[q] = gl[(16 * grp + q) * CV_PITCH + chl];
#pragma unroll
    for (int i = 0; i < 16; ++i) { float a = cb;
#pragma unroll
        for (int k = 0; k < 31; ++k) a += w[k] * glu[i + k];
        H[(size_t)(r0 + 16 * grp + i) * 512 + ch] = a; }
    WG_BAR();
}

__device__ __forceinline__ void p_mixers(Ctx& C, int l) {
    const int nchk = l == 0 ? NCH : MX / 64;
    const int nb = (STATIC_FILL && C.G == 256) ? DN_BLOCKS : C.G;
    if (C.bid < nb) for (int u = C.bid; u < NCH * 4; u += nb) dnprep_unit(C, l, u >> 2, u & 3);
}
__device__ __forceinline__ void p_mixers_bcd(Ctx& C, int l, int vb, int nb) {
    const int nchk = l == 0 ? NCH : MX / 64;
    const int o2 = (nchk * 4) % nb, o3 = (o2 + (nchk / 2) * 4) % nb;
    for (int u = vb; u < nchk * 4; u += nb) conf_unit(C, l, u >> 2, u & 3);
    for (int u = (vb + nb - o2) % nb; u < (nchk / 2) * 4; u += nb) sg_unit(C, l, u >> 2, u & 3);
    for (int u = (vb + nb - o3) % nb; u < nchk * 4; u += nb) pool_unit(C, l, u >> 2, u & 3);
}

constexpr int SC_SLOT = 58368, SC_U = 2 * SC_SLOT;
static_assert(SC_U + 16384 <= LDS_BARW, "scan LDS map");
__device__ __forceinline__ void p_scan(Ctx& C, int l) {
    if (C.bid >= 32) { const int nbcd = (STATIC_FILL && C.G == 256) ? SCAN_BCD_BLOCKS : C.G - 32;
        if (C.G > 32 && C.bid - 32 < nbcd) p_mixers_bcd(C, l, C.bid - 32, nbcd); return; }
    const int b = C.bid >> 3, h = (C.bid >> 1) & 3, dir = C.bid & 1, lane = C.lane, w = C.wave, c = lane & 15, g4 = lane >> 4;
    float* O = WSP(float, WS_O) + (size_t)dir * MT * 512;
    f32x4 S[8];
#pragma unroll
    for (int t = 0; t < 8; ++t) S[t] = (f32x4){0.f, 0.f, 0.f, 0.f};
    auto rec_of = [&](int st) -> size_t { const int rb = st < 4 ? MX + b * TC : b * TX, n = st < 4 ? st : st - 4; return dn_rec(dir, (rb >> 6) + n, h); };
#define SC_ISSUE(st_, SL) do { const size_t rec_ = rec_of(st_); \
        _Pragma("unroll") for (int q = 0; q < 7; ++q) { const int ch = w + 8 * q; \
            const unsigned char* src = ch < 16 ? WSP(unsigned char, WS_DNW) + rec_ * 16384 + ch * 1024 : ch < 32 ? WSP(unsigned char, WS_DNQG) + rec_ * 16384 + (ch - 16) * 1024 \
                                     : ch < 48 ? WSP(unsigned char, WS_DNKDT) + rec_ * 16384 + (ch - 32) * 1024 : WSP(unsigned char, WS_DNQK) + rec_ * 8192 + (ch - 48) * 1024; \
            __builtin_amdgcn_global_load_lds((const unsigned*)(src + lane * 16), (LAS unsigned*)(C.lds + (SL) * SC_SLOT + w * 1024 + q * 8192), 16, 0, 0); } \
        if (w == 0) __builtin_amdgcn_global_load_lds((const unsigned*)(WSP(unsigned char, WS_EGL) + rec_ * 16), (LAS unsigned*)(C.lds + (SL) * SC_SLOT + 57344), 16, 0, 0); } while (0)
#define SC_ISSUE_U(st_) do { const unsigned char* Us_ = WSP(unsigned char, WS_DNU) + rec_of(st_) * 16384 + w * 2048 + lane * 16; \
        _Pragma("unroll") for (int j = 0; j < 2; ++j) __builtin_amdgcn_global_load_lds((const unsigned*)(Us_ + j * 1024), (LAS unsigned*)(C.lds + SC_U + w * 2048 + j * 1024), 16, 0, 0); } while (0)
#define SC_STEP(st_, SL) do { const int st = (st_); \
        if (st == 0) asm volatile("s_waitcnt vmcnt(0)" ::: "memory"); else asm volatile("s_waitcnt vmcnt(16)" ::: "memory"); \
        __builtin_amdgcn_s_barrier(); asm volatile("" ::: "memory"); \
        if (st + 1 < 36) SC_ISSUE(st + 1, 1 - (SL)); \
        const LAS bf16x8* Wf = (const LAS bf16x8*)(C.lds + (SL) * SC_SLOT) + lane; const LAS bf16x8* QGf = Wf + 1024; const LAS bf16x8* KDf = Wf + 2048; const LAS bf16x8* QKf = Wf + 3072; \
        const float egl = *(const LAS float*)(C.lds + (SL) * SC_SLOT + 57344); \
        const int rbase = st < 4 ? MX + b * TC + 64 * st : b * TX + 64 * (st - 4); \
        bf16x8 Sb[4]; \
        _Pragma("unroll") for (int ks = 0; ks < 4; ++ks) { float v[8] = {S[2 * ks][0], S[2 * ks][1], S[2 * ks][2], S[2 * ks][3], S[2 * ks + 1][0], S[2 * ks + 1][1], S[2 * ks + 1][2], S[2 * ks + 1][3]}; Sb[ks] = pack8(v); } \
        f32x4 vn[4], oacc[4]; \
        _Pragma("unroll") for (int mb = 0; mb < 4; ++mb) { f32x4 a = (f32x4){0.f, 0.f, 0.f, 0.f}, o = (f32x4){0.f, 0.f, 0.f, 0.f}; \
            _Pragma("unroll") for (int ks = 0; ks < 4; ++ks) { a = mfma16(Wf[(mb * 4 + ks) * 64], Sb[ks], a); o = mfma16(QGf[(mb * 4 + ks) * 64], Sb[ks], o); } \
            vn[mb] = a; oacc[mb] = o; } \
        _Pragma("unroll") for (int j = 0; j < 2; ++j) { float uv[8]; unpack8(*(const LAS u32x4*)(C.lds + SC_U + w * 2048 + j * 1024 + lane * 16), uv); \
            vn[2 * j] = (f32x4){uv[0], uv[1], uv[2], uv[3]} - vn[2 * j]; vn[2 * j + 1] = (f32x4){uv[4], uv[5], uv[6], uv[7]} - vn[2 * j + 1]; } \
        asm volatile("s_waitcnt lgkmcnt(0)" ::: "memory"); __builtin_amdgcn_s_barrier(); asm volatile("" ::: "memory"); \
        if (st + 1 < 36) SC_ISSUE_U(st + 1); \
        bf16x8 Vb[2]; \
        _Pragma("unroll") for (int k2 = 0; k2 < 2; ++k2) { float v[8] = {vn[2 * k2][0], vn[2 * k2][1], vn[2 * k2][2], vn[2 * k2][3], vn[2 * k2 + 1][0], vn[2 * k2 + 1][1], vn[2 * k2 + 1][2], vn[2 * k2 + 1][3]}; Vb[k2] = pack8(v); } \
        _Pragma("unroll") for (int t = 0; t < 8; ++t) { f32x4 a = S[t] * egl; \
            _Pragma("unroll") for (int k2 = 0; k2 < 2; ++k2) a = mfma16(KDf[(t * 2 + k2) * 64], Vb[k2], a); \
            S[t] = a; } \
        _Pragma("unroll") for (int mb = 0; mb < 4; ++mb) { \
            _Pragma("unroll") for (int k2 = 0; k2 < 2; ++k2) oacc[mb] = mfma16(QKf[(mb * 2 + k2) * 64], Vb[k2], oacc[mb]); \
            _Pragma("unroll") for (int r = 0; r < 4; ++r) O[(size_t)(rbase + 16 * mb + 4 * g4 + r) * 512 + 128 * h + 16 * w + c] = oacc[mb][r]; } } while (0)
    SC_ISSUE(0, 0); SC_ISSUE_U(0);
#pragma unroll 1
    for (int s2 = 0; s2 < 36; s2 += 2) { SC_STEP(s2, 0); SC_STEP(s2 + 1, 1); }
    asm volatile("s_waitcnt vmcnt(0)" ::: "memory");
#undef SC_ISSUE
#undef SC_ISSUE_U
#undef SC_STEP
}

__device__ __forceinline__ void p_ghn(Ctx& C, int l) {
    const int nrows = l == 0 ? MT : MX, lane = C.lane; const float* O = WSP(float, WS_O); const bf16* P = WSP(bf16, WS_P); bf16* Y = WSP(bf16, WS_Y);
    const float* gn = INP(11) + l * 128 + 8 * (lane & 15);
    for (int row = C.bid * NWAVE + C.wave; row < nrows; row += C.G * NWAVE) {
        const int rb = dirrow(row, 1);
        const f32x4* pf = (const f32x4*)(O + (size_t)row * 512 + 8 * lane); const f32x4* pb = (const f32x4*)(O + ((size_t)MT + rb) * 512 + 8 * lane);
        const f32x4 a = pf[0] + pb[0], b2 = pf[1] + pb[1];
        float o[8] = {a.x, a.y, a.z, a.w, b2.x, b2.y, b2.z, b2.w}, z[8]; float ss = 0.f;
#pragma unroll
        for (int c = 0; c < 8; ++c) ss += o[c] * o[c];
        const float rs = rsqrtf(sum16(ss) * (1.f / 128.f) + EPS);
        unpack8(*(const u32x4*)(P + (size_t)row * NIN + PZ + 8 * lane), z);
#pragma unroll
        for (int c = 0; c < 8; ++c) o[c] = o[c] * rs * gn[c] * silu(z[c]);
        *(bf16x8*)(Y + (size_t)row * D + 8 * lane) = pack8(o);
        { const float* hp = WSP(float, WS_CVH) + (size_t)row * 512 + 8 * lane; const f32x4 a = *(const f32x4*)hp, b2 = *(const f32x4*)(hp + 4);
          float v[8] = {a.x, a.y, a.z, a.w, b2.x, b2.y, b2.z, b2.w}; float s = 0.f;
#pragma unroll
          for (int c = 0; c < 8; ++c) s += v[c];
          const float mu = wave_sum(s) * (1.f / 512.f); float s2 = 0.f;
#pragma unroll
          for (int c = 0; c < 8; ++c) { v[c] -= mu; s2 += v[c] * v[c]; }
          const float rs = rsqrtf(wave_sum(s2) * (1.f / 512.f) + EPS);
          const float* lg = INP(20) + l * 512 + 8 * lane; const float* lb = INP(21) + l * 512 + 8 * lane;
#pragma unroll
          for (int c = 0; c < 8; ++c) v[c] = silu(v[c] * rs * lg[c] + lb[c]);
          *(bf16x8*)(Y + (size_t)row * D + 1536 + 8 * lane) = pack8(v); }
    }
}

__device__ __forceinline__ void p_moe_gather(Ctx& C) {
    int* R = WSP(int, WS_ROUTE); const unsigned* ctl = WSP(unsigned, WS_CTL);
    LAS int* offs = (LAS int*)C.lds;
    if (C.tid == 0) { int o = 0, nt = 0;
        for (int e = 0; e < 8; ++e) { const int cnt = (int)ctl[CW_CNT + 64 * e], tl = (cnt + 255) >> 8; offs[e] = o;
            if (C.bid == 0) for (int q = 0; q < tl; ++q) R[R_TILEE + nt + q] = e;
            nt += tl; o += tl << 8; }
        if (C.bid == 0) R[R_NT] = nt; }
    WG_BAR();
    const bf16* AN = WSP(bf16, WS_AN); bf16* AS = WSP(bf16, WS_AS);
    for (int tok = C.bid * NWAVE + C.wave; tok < MX; tok += C.G * NWAVE) {
        const int p0 = offs[R[R_TE + 2 * tok]] + R[R_RANK + 2 * tok], p1 = offs[R[R_TE + 2 * tok + 1]] + R[R_RANK + 2 * tok + 1];
        if (C.lane == 0) { R[R_POS + 2 * tok] = p0; R[R_POS + 2 * tok + 1] = p1; }
        if (MOE_FP8) {
            const u32x4* src = (const u32x4*)(AN + (size_t)tok * D) + 4 * C.lane; float f[32];
#pragma unroll
            for (int j = 0; j < 4; ++j) unpack8(src[j], f + 8 * j);
            u32x4 o[2];
#pragma unroll
            for (int j = 0; j < 2; ++j) { const float* q = f + 16 * j;
                o[j].x = pk4_fp8(clamp448(q[0]), clamp448(q[1]), clamp448(q[2]), clamp448(q[3])); o[j].y = pk4_fp8(clamp448(q[4]), clamp448(q[5]), clamp448(q[6]), clamp448(q[7]));
                o[j].z = pk4_fp8(clamp448(q[8]), clamp448(q[9]), clamp448(q[10]), clamp448(q[11])); o[j].w = pk4_fp8(clamp448(q[12]), clamp448(q[13]), clamp448(q[14]), clamp448(q[15])); }
            u32x4* d0 = (u32x4*)((unsigned char*)AS + (size_t)p0 * D) + 2 * C.lane; u32x4* d1 = (u32x4*)((unsigned char*)AS + (size_t)p1 * D) + 2 * C.lane;
            d0[0] = o[0]; d0[1] = o[1]; d1[0] = o[0]; d1[1] = o[1];
        } else {
        const u32x4* src = (const u32x4*)(AN + (size_t)tok * D) + C.lane; u32x4* d0 = (u32x4*)(AS + (size_t)p0 * D) + C.lane; u32x4* d1 = (u32x4*)(AS + (size_t)p1 * D) + C.lane;
#pragma unroll
        for (int j = 0; j < 4; ++j) { u32x4 v = src[64 * j];
            if (FP8_EMU) { float f[8]; unpack8(v, f);
#pragma unroll
                for (int q = 0; q < 8; ++q) f[q] = rne_e4m3(f[q]);
                v = __builtin_bit_cast(u32x4, pack8(f)); }
            d0[64 * j] = v; d1[64 * j] = v; } }
    }
}

__device__ __forceinline__ void p_final(Ctx& C, float* out) {
    const int* R = WSP(int, WS_ROUTE); const float* Rf = WSP(float, WS_ROUTE); const float* XS = WSP(float, WS_XS); const float* OS = WSP(float, WS_OUTS);
    const float* mod = WSP(float, WS_MODV) + (size_t)5 * 12288; const int lane = C.lane;
    for (int tok = C.bid * NWAVE + C.wave; tok < MX; tok += C.G * NWAVE) {
        const int p0 = R[R_POS + 2 * tok], p1 = R[R_POS + 2 * tok + 1]; const float g0 = Rf[R_TG + 2 * tok], g1 = Rf[R_TG + 2 * tok + 1];
        const f32x4* xp = (const f32x4*)(XS + (size_t)tok * D) + lane; const f32x4* o0 = (const f32x4*)(OS + (size_t)p0 * D) + lane; const f32x4* o1 = (const f32x4*)(OS + (size_t)p1 * D) + lane;
        const f32x4* gf = (const f32x4*)(mod + (size_t)(tok >> 11) * 12288 + 10240) + lane; const f32x4* fg = (const f32x4*)INP(32) + lane;
        f32x4 x[8]; float ss = 0.f;
        f32x4 e0[8], e1[8];
        if (p0 < 16384) {
#pragma unroll
            for (int j = 0; j < 8; ++j) e0[j] = o0[64 * j];
        } else { const f32x4* q = (const f32x4*)(WSP(float, WS_PARTO) + (size_t)(p0 - 16384) * D) + lane;
#pragma unroll
            for (int j = 0; j < 8; ++j) e0[j] = (q[64 * j] + q[64 * j + (size_t)2048 * 512]) + (q[64 * j + (size_t)2 * 2048 * 512] + q[64 * j + (size_t)3 * 2048 * 512]); }
        if (p1 < 16384) {
#pragma unroll
            for (int j = 0; j < 8; ++j) e1[j] = o1[64 * j];
        } else { const f32x4* q = (const f32x4*)(WSP(float, WS_PARTO) + (size_t)(p1 - 16384) * D) + lane;
#pragma unroll
            for (int j = 0; j < 8; ++j) e1[j] = (q[64 * j] + q[64 * j + (size_t)2048 * 512]) + (q[64 * j + (size_t)2 * 2048 * 512] + q[64 * j + (size_t)3 * 2048 * 512]); }
#pragma unroll
        for (int j = 0; j < 8; ++j) { x[j] = xp[64 * j] + gf[64 * j] * (e0[j] * g0 + e1[j] * g1); ss += (x[j].x * x[j].x + x[j].y * x[j].y) + (x[j].z * x[j].z + x[j].w * x[j].w); }
        const float rs = rsqrtf(wave_sum(ss) * (1.f / D) + EPS);
        f32x4* op = (f32x4*)(out + (size_t)tok * D) + lane;
#pragma unroll
        for (int j = 0; j < 8; ++j) op[64 * j] = x[j] * rs * fg[64 * j];
    }
}
}
namespace mk {
constexpr int NPHASE = 21;
struct Args { const float* in[33]; float* out; unsigned char* ws; int ph_lo, ph_hi; };
static_assert(sizeof(Args) == 35 * 8 + 8, "Args has no padding");

#ifdef ONLY_PHASE
#define IN(k) ((k) == ONLY_PHASE)
#else
#define IN(k) (lo <= (k) && (k) < hi)
#endif
__device__ __forceinline__ constexpr int bg_need(int k) { return k >= 18 ? NBG : k >= 15 ? BG_MOE : k >= 11 ? BG_WOUT1 : k >= 9 ? BG_WIN1 : k >= 8 ? BG_W2 : k >= 6 ? BG_W13 : 0; }
#ifndef BG_FILL_MASK
#define BG_FILL_MASK ((1 << 2) | (1 << 4) | (1 << 6) | (1 << 8) | (1 << 9) | (1 << 11) | (1 << 13))
#endif
#define SEAM(k) do { if (IN(k) && IN((k) + 1)) { if (BG_QUEUE) bg_work(C, bg_need((k) + 1), ((BG_FILL_MASK >> (k)) & 1) ? (k) : -1); xcd_barrier(bar); } } while (0)
constexpr int NMOE = 16 * IT_MW1 + 8 * IT_MW2;
#ifndef FILL_R
#define FILL_R 25, 24, 2, 65, 10, 25, 24
#endif
#ifndef FILL_R2
#define FILL_R2 20, 20
#endif
constexpr int fill_rounds[7] = {FILL_R}; constexpr int fill_rounds2[2] = {FILL_R2};
constexpr int FB2 = 228, FB4 = 32 + SCAN_BCD_BLOCKS, FB6 = 128, FB8 = 227, FB9 = 128, FB11 = 212, FB13 = 32 + SCAN_BCD_BLOCKS;
constexpr int FN2 = fill_rounds[0] * (256 - FB2) * 8, FN4 = fill_rounds[1] * (256 - FB4) * 8, FN6 = fill_rounds[2] * (256 - FB6) * 8, FN8 = fill_rounds[3] * (256 - FB8) * 8,
              FN9 = fill_rounds[4] * (256 - FB9) * 8, FN11 = fill_rounds[5] * (256 - FB11) * 8;
constexpr int FS2 = 0, FS4 = FS2 + FN2, FS6 = FS4 + FN4, FS8 = FS6 + FN6, FS9 = FS8 + FN8, FS11 = FS9 + FN9, FS13 = FS11 + FN11, FN13 = fill_rounds[6] * (256 - FB13) * 8 < NMOE - FS13 ? fill_rounds[6] * (256 - FB13) * 8 : NMOE - FS13, FS3 = FS13 + FN13, FN3 = fill_rounds2[0] * (256 - DN_BLOCKS) * 8 < NMOE - FS3 ? fill_rounds2[0] * (256 - DN_BLOCKS) * 8 : NMOE - FS3, FS12 = FS3 + FN3, FN12 = fill_rounds2[1] * (256 - DN_BLOCKS) * 8 < NMOE - FS12 ? fill_rounds2[1] * (256 - DN_BLOCKS) * 8 : NMOE - FS12, FS17 = FS12 + FN12, FN17 = NMOE - FS17;
static_assert(FN13 >= 0 && FN17 >= 0, "fill schedule exceeds the MoE items");
template <int l>
__device__ __forceinline__ void layer_body(Ctx& C, const XcdBarrier& bar, const int lo, const int hi) {
        const int pb = l == 0 ? 1 : 10;
        const float* mod = WSP(float, WS_MODV) + (size_t)l * 5 * 12288;
        if (IN(pb + 0)) { if constexpr (l == 0) p_norm<0>(C, 0); else p_norm<1>(C, 1); } SEAM(pb + 0);
        if (IN(pb + 1)) {
            pg8::EpiStoreBf16 E{WSP(bf16, WS_P), NIN, WSP(float, WS_ABF)};
            pg8::Gemm g{WSP(bf16, WS_AN), WSP(bf16, WS_WIN) + (size_t)l * NINP * D, MT, NINP, D};
            const bool ded = STATIC_FILL && C.G == 256;
            if constexpr (l == 0) { if (!ded || C.bid < FB2) { pg8::StaticOrder S; S.init(MT, NINP, ded ? FB2 : C.G, C.bid); pg8::gemm_phase<pg8::EpiStoreBf16, pg8::StaticOrder, true, true>(C.lds, g, S, E); }
                fill_static(C, FS2, FN2, FB2); }
            else { if (!ded || C.bid < FB11) { pg8::InProjL1Order S; S.init(ded ? FB11 : C.G, C.bid); pg8::gemm_phase<pg8::EpiStoreBf16, pg8::InProjL1Order, true, true>(C.lds, g, S, E); }
                fill_static(C, FS11, FN11, FB11); }
        } SEAM(pb + 1);
        if (IN(pb + 2)) { p_mixers(C, l); if constexpr (l == 0) fill_static(C, FS3, FN3, DN_BLOCKS); else fill_static(C, FS12, FN12, DN_BLOCKS); } SEAM(pb + 2);
        if (IN(pb + 3)) { p_scan(C, l); if constexpr (l == 0) fill_static(C, FS4, FN4, FB4); else fill_static(C, FS13, FN13, FB13); } SEAM(pb + 3);
        if (IN(pb + 4)) { p_ghn(C, l); } SEAM(pb + 4);
        if (IN(pb + 5)) {
            pg8::EpiResid E{WSP(float, WS_XS), mod, 4096, WSP(float, WS_PART), D / 4};
            pg8::Gemm g{WSP(bf16, WS_Y), WSP(bf16, WS_WOUT) + (size_t)l * D * D, l == 0 ? MT : MX, D, D};
            if constexpr (l == 0) { pg8::ResidOrder S; S.init(D, C.G, C.bid); pg8::gemm_phase<pg8::EpiResid, pg8::ResidOrder, true, true>(C.lds, g, S, E); fill_static(C, FS6, FN6, FB6); }
            else { pg8::StaticOrder S; S.init(MX, D, C.G, C.bid); pg8::gemm_phase<pg8::EpiResid, pg8::StaticOrder, true, true>(C.lds, g, S, E); }
        } SEAM(pb + 5);
        if (IN(pb + 6)) { if constexpr (l == 0) p_norm<2>(C, 0); else p_norm<3>(C, 1); } SEAM(pb + 6);
        if constexpr (l == 0) {
            if (IN(8)) {
                pg8::EpiSwiglu E{WSP(bf16, WS_HM), DFF, 1 << 20};
                pg8::Gemm g{WSP(bf16, WS_AN), WSP(bf16, WS_W13), MT, 2 * DFF, D};
                const bool ded = STATIC_FILL && C.G == 256;
                if (!ded || C.bid < FB8) { pg8::StaticOrder S; S.init(MT, 2 * DFF, ded ? FB8 : C.G, C.bid); pg8::gemm_phase<pg8::EpiSwiglu, pg8::StaticOrder, true, true>(C.lds, g, S, E); }
                fill_static(C, FS8, FN8, FB8);
            } SEAM(8);
            if (IN(9)) {
                pg8::EpiResid E{WSP(float, WS_XS), mod, 10240, WSP(float, WS_PART), DFF / 4};
                pg8::Gemm g{WSP(bf16, WS_HM), WSP(bf16, WS_W2), MT, D, DFF};
                pg8::ResidOrder S; S.init(DFF, C.G, C.bid);
                pg8::gemm_phase<pg8::EpiResid, pg8::ResidOrder, true, true>(C.lds, g, S, E);
                fill_static(C, FS9, FN9, FB9);
            } SEAM(9);
        } else {
            if (IN(17)) { p_moe_gather(C); fill_static(C, FS17, FN17, 0); } SEAM(17);
            if (IN(18)) {
                const int* R = WSP(int, WS_ROUTE);
                pg8::MoeOrder S; S.init(R[R_NT], 56, R + R_TILEE, C.G, C.bid);
                if (MOE_FP8) { pg8::EpiSwiglu8 E{WSP(unsigned char, WS_HM), DFE, 56};
                    pg8::Gemm g{WSP(bf16, WS_AS), WSP(bf16, WS_MW13), MSORT, 2 * DFE * NE, D / 2};
                    pg8::gemm_phase<pg8::EpiSwiglu8, pg8::MoeOrder, true, true, true>(C.lds, g, S, E); }
                else { pg8::EpiSwiglu E{WSP(bf16, WS_HM), DFE, 56};
                    pg8::Gemm g{WSP(bf16, WS_AS), WSP(bf16, WS_MW13), MSORT, 2 * DFE * NE, D};
                    pg8::gemm_phase<pg8::EpiSwiglu, pg8::MoeOrder, true, true>(C.lds, g, S, E); }
            } SEAM(18);
            if (IN(19)) {
                const int* R = WSP(int, WS_ROUTE);
                pg8::EpiStoreF32 E{WSP(float, WS_OUTS), WSP(float, WS_PARTO), (MOE_FP8 ? DFE / 2 : DFE) / 4};
                if (MOE_FP8) { pg8::Gemm g{WSP(bf16, WS_HM), WSP(bf16, WS_MW2), MSORT, D * NE, DFE / 2};
                    pg8::MoeDownOrder S; S.init(R[R_NT], R + R_TILEE, DFE / 2, C.G, C.bid);
                    pg8::gemm_phase<pg8::EpiStoreF32, pg8::MoeDownOrder, true, true, true>(C.lds, g, S, E); }
                else { pg8::Gemm g{WSP(bf16, WS_HM), WSP(bf16, WS_MW2), MSORT, D * NE, DFE};
                    pg8::MoeDownOrder S; S.init(R[R_NT], R + R_TILEE, DFE, C.G, C.bid);
                    pg8::gemm_phase<pg8::EpiStoreF32, pg8::MoeDownOrder, true, true>(C.lds, g, S, E); }
            } SEAM(19);
        }
    }
__global__ void __launch_bounds__(NTHR, 2) fwd(Args a) {
    extern __shared__ __attribute__((aligned(16))) unsigned char lds_raw[];
    Ctx C;
    C.lds = (LAS unsigned char*)lds_raw;
    C.in = (CIN)__builtin_amdgcn_kernarg_segment_ptr();
    C.out = a.out; C.ws = a.ws; C.tid = threadIdx.x; C.lane = C.tid & 63; C.wave = __builtin_amdgcn_readfirstlane(C.tid >> 6); C.G = gridDim.x; C.bid = blockIdx.x;
    const int lo = a.ph_lo, hi = a.ph_hi;
    XcdBarrier bar; bar.bar = WSP(unsigned, WS_CTL) + CW_BAR; bar.x = 0; bar.st = (volatile LAS unsigned*)(C.lds + LDS_BARW);
    if (hi - lo > 1) {
        if (C.tid < 4) { ((volatile LAS unsigned*)(C.lds + LDS_BARW))[C.tid] = 0u; }
        __syncthreads();
        bar = xcd_barrier_post(WSP(unsigned, WS_CTL) + CW_BAR, (volatile LAS unsigned*)(C.lds + LDS_BARW));
    }
    if (IN(0)) { p_prologue(C); } SEAM(0);
    layer_body<0>(C, bar, lo, hi);
    layer_body<1>(C, bar, lo, hi);
    if (IN(20)) { p_final(C, C.out); }
}

static int g_grid = 0;
static inline bool setup(size_t ws_size, size_t need) {
    if (g_grid == 0) {
        if (ws_size < need) { fprintf(stderr, "kernel_launch: workspace too small: %zu < %zu\n", ws_size, need); g_grid = -1; return false; }
        int dev = 0, cus = 0, per_cu = 0;
        if (hipGetDevice(&dev) != hipSuccess || hipDeviceGetAttribute(&cus, hipDeviceAttributeMultiprocessorCount, dev) != hipSuccess) { g_grid = -1; return false; }
        if (hipFuncSetAttribute((const void*)fwd, hipFuncAttributeMaxDynamicSharedMemorySize, LDS_BYTES) != hipSuccess) { fprintf(stderr, "kernel_launch: hipFuncSetAttribute failed\n"); g_grid = -1; return false; }
        if (hipOccupancyMaxActiveBlocksPerMultiprocessor(&per_cu, (const void*)fwd, NTHR, LDS_BYTES) != hipSuccess || per_cu < 1) { fprintf(stderr, "kernel_launch: occupancy query says %d\n", per_cu); }
        (void)hipGetLastError();
        g_grid = cus;
    }
    return g_grid > 0;
}
static inline void launch(void* const* d_in, float* out, void* d_ws, int lo, int hi, hipStream_t stream) {
    Args a{};
    for (int i = 0; i < 33; ++i) a.in[i] = (const float*)d_in[i];
    a.out = out; a.ws = (unsigned char*)d_ws; a.ph_lo = lo; a.ph_hi = hi;
    hipLaunchKernelGGL(fwd, dim3(g_grid), dim3(NTHR), LDS_BYTES, stream, a);
}
}
#ifndef MK_DEBUG
#define MK_DEBUG 0
#endif
#ifndef MK_ONE_LAUNCH
#define MK_ONE_LAUNCH 0
#endif
#if MK_DEBUG
#ifndef DBG_LAYER
#define DBG_LAYER 0
#endif
namespace dbg {
using namespace mk;
constexpr size_t SNAP = (WS_END + 4095) & ~(size_t)4095;
constexpr size_t S_ERR = SNAP;
constexpr size_t S_MOD = S_ERR + 4096;
constexpr size_t S_AN = S_MOD + al((size_t)10 * 12288 * 2);
constexpr size_t S_AB = S_AN + al((size_t)MT * D * 2);
constexpr size_t S_P = S_AB + al((size_t)MT * 16 * 2);
constexpr size_t S_O = S_P + al((size_t)MT * NIN * 2);
constexpr size_t S_Y = S_O + al((size_t)2 * MT * 512 * 2);
constexpr size_t S_XM = S_Y + al((size_t)MT * D * 2);
constexpr size_t S_AF = S_XM + al((size_t)MT * D * 2);
constexpr size_t S_XE = S_AF + al((size_t)MT * D * 2);
constexpr size_t S_OUT2 = S_XE + al((size_t)MT * D * 2);
constexpr size_t S_END = S_OUT2 + al((size_t)MX * D * 4);
constexpr int NCK = 12;
__global__ void k_snap(const float* src, size_t lds_, bf16* dst, size_t ldd, int rows, int cols, int mode) {
    for (size_t i = (size_t)blockIdx.x * blockDim.x + threadIdx.x; i < (size_t)rows * cols; i += (size_t)gridDim.x * blockDim.x) {
        const int r = (int)(i / cols), c = (int)(i % cols); int sr = r, sc = c;
        if (mode == 1) sc = c < 1536 ? c : c + 16;
        if (mode == 2) sc = c + 1536;
        size_t dr = r;
        if (mode == 3) { const int dir = r / MT, row = r % MT; dr = (size_t)dir * MT + dirrow(row, dir); }
        dst[dr * ldd + c] = (bf16)f2bf(src[(size_t)sr * lds_ + sc]); }
}
__global__ void k_cmp(const void* a, int a_bf16, size_t lda, size_t acol0, const bf16* b, size_t ldb, size_t bcol0, int rows, int cols, float* acc) {
    float num = 0.f, den = 0.f;
    for (size_t i = (size_t)blockIdx.x * blockDim.x + threadIdx.x; i < (size_t)rows * cols; i += (size_t)gridDim.x * blockDim.x) {
        const size_t r = i / cols, c = i % cols;
        const float av = a_bf16 ? bf2f(((const bf16*)a)[r * lda + acol0 + c]) : ((const float*)a)[r * lda + acol0 + c];
        const float bv = bf2f(b[r * ldb + bcol0 + c]); const float d = av - bv;
        if (!(d == d)) { num += 1e30f; } else { num += d * d; } den += bv * bv; }
    num = wave_sum(num); den = wave_sum(den);
    if ((threadIdx.x & 63) == 0) { atomicAdd(acc, num); atomicAdd(acc + 1, den); }
}
__global__ void k_decide(float* err) {
    if (threadIdx.x != 0) return; int code = -1, level = 0;
    for (int k = 0; k < NCK; ++k) { const float num = err[2 * k], den = err[2 * k + 1]; if (den == 0.f && num == 0.f) continue;
        const float e = sqrtf(num / fmaxf(den, 1e-30f)); const float tol = (k == 4) ? 0.06f : 0.03f;
        if (!(e <= tol)) { code = k; level = !(e == e) ? 5 : e < 1e-4f ? 0 : e < 1e-3f ? 1 : e < 1e-2f ? 2 : e < 1e-1f ? 3 : e < 1.f ? 4 : 5; break; } }
    ((int*)err)[64] = code; ((int*)err)[65] = level;
}
__global__ void k_encode(float* out, const float* out2, const float* err) {
    const int code = ((const int*)err)[64], level = ((const int*)err)[65];
    for (size_t i = (size_t)blockIdx.x * blockDim.x + threadIdx.x; i < (size_t)MX * D; i += (size_t)gridDim.x * blockDim.x) {
        if (code < 0) { out[i] = out2[i]; continue; }
        const size_t row = i / D; if (row < (size_t)(code + 1) * (MX / 16)) out[i] = 0.f;
        if (i == (size_t)MX * D - 1) out[i] = (float)(16 << level); }
}
}
#endif

extern "C" void kernel_launch(void* const* d_in, const int* in_sizes, int n_in, void* d_out, int out_size, void* d_ws, size_t ws_size, hipStream_t stream) {
    using namespace mk;
#if MK_DEBUG
    if (!setup(ws_size, dbg::S_END) || n_in != 33) return;
    unsigned char* ws = (unsigned char*)d_ws;
    nv::Bufs nb; const size_t nneed = nv::carve(ws, nb);
    if (nneed > dbg::SNAP) { fprintf(stderr, "naive scratch overlaps snapshots\n"); return; }
    hipMemsetAsync(ws + dbg::S_ERR, 0, 4096, stream);
    auto snap = [&](const float* src, size_t lds_, size_t dst_off, size_t ldd, int rows, int cols, int mode) {
        hipLaunchKernelGGL(dbg::k_snap, dim3(2048), dim3(256), 0, stream, src, lds_, (bf16*)(ws + dst_off), ldd, rows, cols, mode); };
    auto hook = [&](int point, int l) {
        if (point == 0) { snap(nb.mod, 12288, dbg::S_MOD, 12288, 10, 12288, 0); return; }
        if (l != DBG_LAYER) return;
        if (point == 1) snap(nb.A, D, dbg::S_AN, D, MT, D, 0);
        if (point == 2) { snap(nb.p, nv::INW, dbg::S_P, NIN, MT, NIN, 1); snap(nb.p, nv::INW, dbg::S_AB, 16, MT, 16, 2); }
        if (point == 3) snap(nb.o, 512, dbg::S_O, 512, 2 * MT, 512, 3);
        if (point == 4) snap(nb.y, D, dbg::S_Y, D, MT, D, 0);
        if (point == 5) snap(nb.xs, D, dbg::S_XM, D, MT, D, 0);
        if (point == 6) snap(nb.A, D, dbg::S_AF, D, MT, D, 0);
        if (point == 7) snap(nb.xs, D, dbg::S_XE, D, MT, D, 0);
    };
    nv::forward(d_in, (float*)d_out, nb, stream, hook);
    hipMemsetAsync(ws + WS_CTL, 0, CTL_BYTES, stream);
    float* err = (float*)(ws + dbg::S_ERR); float* out2 = (float*)(ws + dbg::S_OUT2);
    auto cmp = [&](int k, const void* a, int a_bf16, size_t lda, size_t acol0, size_t snap_off, size_t ldb, size_t bcol0, int rows, int cols) {
        hipLaunchKernelGGL(dbg::k_cmp, dim3(1024), dim3(256), 0, stream, a, a_bf16, lda, acol0, (const bf16*)(ws + snap_off), ldb, bcol0, rows, cols, err + 2 * k); };
    const int L = DBG_LAYER, pb = L == 0 ? 1 : 10, nr = L == 0 ? MT : MX;
    for (int ph = 0; ph < NPHASE; ++ph) {
        launch(d_in, out2, d_ws, ph, ph + 1, stream);
        if (ph == 0) cmp(0, ws + WS_MODV, 0, 12288, 0, dbg::S_MOD, 12288, 0, 10, 12288);
        if (ph == pb + 0) { cmp(1, ws + WS_AN, 1, D, 0, dbg::S_AN, D, 0, MT, D); cmp(2, ws + WS_ABF, 0, 16, 0, dbg::S_AB, 16, 0, MT, 16); }
        if (ph == pb + 1) { cmp(3, ws + WS_P, 1, NIN, 0, dbg::S_P, NIN, 0, nr, NIN); if (L == 1) cmp(3, ws + WS_P + (size_t)MX * NIN * 2, 1, NIN, 0, dbg::S_P + (size_t)MX * NIN * 2, NIN, 0, MC, 1536); }
        if (ph == pb + 3) cmp(4, ws + WS_O, 0, 512, 0, dbg::S_O, 512, 0, 2 * MT, 512);
        if (ph == pb + 4) { cmp(5, ws + WS_Y, 1, D, 0, dbg::S_Y, D, 0, nr, 512); cmp(6, ws + WS_Y, 1, D, 512, dbg::S_Y, D, 512, nr, 512);
                            cmp(7, ws + WS_Y, 1, D, 1024, dbg::S_Y, D, 1024, nr, 512); cmp(8, ws + WS_Y, 1, D, 1536, dbg::S_Y, D, 1536, nr, 512); }
        if (ph == pb + 5) cmp(9, ws + WS_XS, 0, D, 0, dbg::S_XM, D, 0, nr, D);
        if (ph == pb + 6) cmp(10, ws + WS_AN, 1, D, 0, dbg::S_AF, D, 0, nr, D);
        if (L == 0 && ph == 9) cmp(11, ws + WS_XS, 0, D, 0, dbg::S_XE, D, 0, MT, D);
    }
    hipLaunchKernelGGL(dbg::k_decide, dim3(1), dim3(64), 0, stream, err);
    hipLaunchKernelGGL(dbg::k_encode, dim3(2048), dim3(256), 0, stream, (float*)d_out, out2, err);
#else
    if (!setup(ws_size, WS_END) || n_in != 33) return;
    hipMemsetAsync((unsigned char*)d_ws + WS_CTL, 0, CTL_BYTES, stream);
#if MK_ONE_LAUNCH
    launch(d_in, (float*)d_out, d_ws, 0, NPHASE, stream);
#else
#ifndef REP_MASK
#define REP_MASK 0
#endif
    for (int ph = 0; ph < NPHASE; ++ph) { launch(d_in, (float*)d_out, d_ws, ph, ph + 1, stream); if ((REP_MASK >> ph) & 1) launch(d_in, (float*)d_out, d_ws, ph, ph + 1, stream); }
#endif
#endif
}
```

```cpp
#include <hip/hip_runtime.h>
#include <cstdio>
#include <cstdint>
#define MK_DEBUG 0
#define DBG_LAYER 0
#define MK_ONE_LAUNCH 1
#define REP_MASK 0
#ifndef BG_QUEUE
#define BG_QUEUE 0
#endif
#ifndef STATIC_FILL
#define STATIC_FILL MK_ONE_LAUNCH
#endif
#define GAS __attribute__((address_space(1)))
#define LAS __attribute__((address_space(3)))
typedef unsigned short bf16;
typedef short bf16x8 __attribute__((ext_vector_type(8)));
typedef float f32x4 __attribute__((ext_vector_type(4)));
typedef float f32x2 __attribute__((ext_vector_type(2)));
typedef unsigned u32x4 __attribute__((ext_vector_type(4)));
typedef unsigned u32x2 __attribute__((ext_vector_type(2)));

#ifndef DENSE_IN_SCAN
#define DENSE_IN_SCAN 1
#endif
#ifndef DN_BLOCKS
#define DN_BLOCKS 192
#endif
#ifndef SCAN_BCD_BLOCKS
#define SCAN_BCD_BLOCKS 160
#endif
#ifndef FP8_EMU
#define FP8_EMU 0
#endif
#ifndef MOE_FP8
#define MOE_FP8 1
#endif
#ifndef DENSE_FP8_UP
#define DENSE_FP8_UP 1
#endif
#ifndef DENSE_FP8_DN
#define DENSE_FP8_DN 0
#endif
__device__ __forceinline__ float rne_e4m3(float x) { return __builtin_amdgcn_cvt_f32_fp8(__builtin_amdgcn_cvt_pk_fp8_f32(x, x, 0, false), 0); }
namespace mk {
constexpr int D = 2048, NB = 4, TX = 2048, TC = 256, MX = NB * TX, MC = NB * TC, MT = MX + MC;
constexpr int INW = 4624, NIN = 4608, NINP = 4864;
constexpr int PQ = 0, PK = 512, PV = 1024, PZ = 1536, PSGU = 2048, PSGV = 2560, PPOOL = 3072, PCVA = 3584, PCVG = 4096;
constexpr int DFF = 5632, NE = 8, DFE = 7168;
constexpr int NCH = MT / 64;
constexpr int MSORT = 2 * MX + NE * 256;
constexpr float EPS = 1e-6f;
constexpr int NTHR = 512, NWAVE = 8;
constexpr int LDS_BYTES = 163840;
constexpr int LDS_BARW = LDS_BYTES - 16;

constexpr size_t al(size_t x) { return (x + 4095) & ~(size_t)4095; }
constexpr size_t WS_CTL = 0, CTL_BYTES = 1u << 20;
constexpr size_t WS_MODV = WS_CTL + CTL_BYTES;
constexpr size_t WS_POS = WS_MODV + al((size_t)2 * 5 * 12288 * 4);
constexpr size_t WS_PWT = WS_POS + al((size_t)TX * D * 4);
constexpr size_t WS_WABC = WS_PWT + al((size_t)2 * 4 * 128 * 128 * 2);
constexpr size_t WS_WIN = WS_WABC + al((size_t)2 * 2048 * 16 * 4);
constexpr size_t WS_WOUT = WS_WIN + al((size_t)2 * NINP * D * 2);
constexpr size_t WS_W13 = WS_WOUT + al((size_t)2 * D * D * 2);
constexpr size_t WS_W2 = WS_W13 + al((size_t)2 * DFF * D * 2);
constexpr size_t WS_MW13 = WS_W2 + al((size_t)D * DFF * 2);
constexpr size_t WS_MW2 = WS_MW13 + al((size_t)NE * 2 * DFE * D * 2);
constexpr size_t WS_XS = WS_MW2 + al((size_t)NE * D * DFE * 2);
constexpr size_t WS_AN = WS_XS + al((size_t)MT * D * 4);
constexpr size_t WS_ABF = WS_AN + al((size_t)MT * D * 2);
constexpr size_t WS_PART = WS_ABF + al((size_t)MT * 16 * 4);
constexpr size_t WS_ROUTE = WS_PART + al((size_t)4 * MC * D * 4);
constexpr size_t WS_BIG = WS_ROUTE + al((size_t)1 << 20);
constexpr size_t WS_P = WS_BIG;
constexpr size_t DN_FRAG = (size_t)2 * NCH * 4;
constexpr size_t WS_DNW = WS_P + al((size_t)MT * NIN * 2);
constexpr size_t WS_DNQG = WS_DNW + al(DN_FRAG * 16384);
constexpr size_t WS_DNKDT = WS_DNQG + al(DN_FRAG * 16384);
constexpr size_t WS_DNQK = WS_DNKDT + al(DN_FRAG * 16384);
constexpr size_t WS_DNU = WS_DNQK + al(DN_FRAG * 8192);
constexpr size_t WS_EGL = WS_DNU + al(DN_FRAG * 16384);
constexpr size_t WS_O = WS_EGL + al(DN_FRAG * 16);
constexpr size_t WS_Y = WS_O + al((size_t)2 * MT * 512 * 4);
constexpr size_t WS_CVH = WS_Y + al((size_t)MT * D * 2);
constexpr size_t WS_MIX_END = WS_CVH + al((size_t)MT * 512 * 4);
constexpr size_t WS_HM = WS_BIG;
constexpr size_t WS_AS = WS_HM + al((size_t)MSORT * DFE * 2);
constexpr size_t WS_OUTS = WS_AS + al((size_t)MSORT * D * 2);
constexpr size_t WS_PARTO = WS_OUTS + al((size_t)MSORT * D * 4);
constexpr size_t WS_FFN_END = WS_PARTO + al((size_t)4 * 2048 * D * 4);
constexpr size_t WS_END = WS_FFN_END > WS_MIX_END ? WS_FFN_END : WS_MIX_END;
constexpr int R_TE = 0;
constexpr int R_TG = R_TE + MX * 2;
constexpr int R_RANK = R_TG + MX * 2;
constexpr int R_POS = R_RANK + MX * 2;
constexpr int R_TILEE = R_POS + MX * 2;
constexpr int R_NT = R_TILEE + 128;
constexpr int R_TB = R_NT + 8;
constexpr int CW_CNT = 64;
constexpr int CW_BGHEAD = 1024;
constexpr int CW_DONE = 2048;
constexpr int CW_BAR = 4096;

__device__ __forceinline__ float silu(float x) { return x * __builtin_amdgcn_rcpf(1.f + __expf(-x)); }
__device__ __forceinline__ float sigm(float x) { return __builtin_amdgcn_rcpf(1.f + __expf(-x)); }
__device__ __forceinline__ float gelu_tanh(float x) { const float u = 0.7978845608028654f * (x + 0.044715f * x * x * x); const float e = __expf(2.f * u); return x * (1.f - __builtin_amdgcn_rcpf(1.f + e)); }
__device__ __forceinline__ float softplus(float x) { return x > 20.f ? x : log1pf(__expf(x)); }
__device__ __forceinline__ unsigned f2bf(float f) { unsigned u = __builtin_bit_cast(unsigned, f); return (u + 0x7fffu + ((u >> 16) & 1u)) >> 16; }
__device__ __forceinline__ unsigned pk2(float lo, float hi) { return f2bf(lo) | (f2bf(hi) << 16); }
__device__ __forceinline__ float bf2f(unsigned short b) { return __builtin_bit_cast(float, (unsigned)b << 16); }
__device__ __forceinline__ float bflo(unsigned w) { return __builtin_bit_cast(float, w << 16); }
__device__ __forceinline__ float bfhi(unsigned w) { return __builtin_bit_cast(float, w & 0xffff0000u); }
__device__ __forceinline__ bf16x8 pack8(const float* v) { u32x4 w; w.x = pk2(v[0], v[1]); w.y = pk2(v[2], v[3]); w.z = pk2(v[4], v[5]); w.w = pk2(v[6], v[7]); return __builtin_bit_cast(bf16x8, w); }
__device__ __forceinline__ void unpack8(u32x4 w, float* v) { v[0] = bflo(w.x); v[1] = bfhi(w.x); v[2] = bflo(w.y); v[3] = bfhi(w.y); v[4] = bflo(w.z); v[5] = bfhi(w.z); v[6] = bflo(w.w); v[7] = bfhi(w.w); }
__device__ __forceinline__ unsigned pk4_fp8(float a, float b, float c, float d) { int p = __builtin_amdgcn_cvt_pk_fp8_f32(a, b, 0, false); p = __builtin_amdgcn_cvt_pk_fp8_f32(c, d, p, true); return (unsigned)p; }
__device__ __forceinline__ float clamp448(float x) { return fminf(fmaxf(x, -448.f), 448.f); }
__device__ __forceinline__ float wave_sum(float v) {
#pragma unroll
    for (int o = 1; o < 64; o <<= 1) v += __shfl_xor(v, o);
    return v;
}
__device__ __forceinline__ float sum16(float v) {
#pragma unroll
    for (int o = 1; o < 16; o <<= 1) v += __shfl_xor(v, o);
    return v;
}
__device__ __forceinline__ void rowinfo(int row, int& base, int& T, int& t, int& mv) {
    if (row < MX) { const int b = row >> 11; base = b << 11; T = TX; t = row - base; mv = b; }
    else { const int r = row - MX, b = r >> 8; base = MX + (b << 8); T = TC; t = r - (b << 8); mv = 4; }
}
__device__ __forceinline__ int dirrow(int row, int dir) { int base, T, t, mv; rowinfo(row, base, T, t, mv); return dir ? base + (T - 1 - t) : row; }
#define LDS_WAIT() asm volatile("s_waitcnt lgkmcnt(0)" ::: "memory")
#define VM_WAIT() asm volatile("s_waitcnt vmcnt(0)" ::: "memory")
#define WG_BAR() do { __syncthreads(); } while (0)
}
#define XB_TMO      128
#define XB_XCNT(j)  (256  + 64 * (j))
#define XB_XSUB(j)  (1280 + 64 * (j))
#define XB_XGEN(j)  (2304 + 64 * (j))
#define XB_TOP      3328
#define XB_TOPGEN   3392
#define XCD_BAR_WORDS 3456
#define XB_SPIN_CAP (1u << 18)
#define LAS __attribute__((address_space(3)))

__device__ __forceinline__ unsigned xb_ld(unsigned* p)              { return __hip_atomic_load(p, __ATOMIC_RELAXED, __HIP_MEMORY_SCOPE_AGENT); }
__device__ __forceinline__ unsigned xb_add(unsigned* p, unsigned v) { return __hip_atomic_fetch_add(p, v, __ATOMIC_RELAXED, __HIP_MEMORY_SCOPE_AGENT); }
__device__ __forceinline__ unsigned xb_xcc_id() { return (unsigned)__builtin_amdgcn_s_getreg((3 << 11) | 20) & 0xFu; }
#define XB_SPIN(cond, bar) do { unsigned _sp = 0; while (cond) { __builtin_amdgcn_s_sleep(1); \
    if ((++_sp & 255u) == 0u) { if (xb_ld(&(bar)[XB_TMO])) break; if (_sp > XB_SPIN_CAP) { atomicAdd(&(bar)[XB_TMO], 1u); break; } } } } while (0)

struct XcdBarrier {
    unsigned* bar; unsigned x;
    volatile LAS unsigned* st;
};

__device__ __forceinline__ XcdBarrier xcd_barrier_post(unsigned* bar, volatile LAS unsigned* st) {
    XcdBarrier b; b.bar = bar; b.x = xb_xcc_id(); b.st = st;
    if (threadIdx.x == 0) (void)xb_add(&bar[XB_XCNT(b.x)], 1u);
    return b;
}
__device__ __forceinline__ void xcd_barrier_complete(unsigned* bar, unsigned x, unsigned& nloc, unsigned& nx) {
    const unsigned G = gridDim.x * gridDim.y * gridDim.z;
    unsigned sum, cnt, mine, sp = 0u;
    for (;;) {
        sum = 0u; cnt = 0u; mine = 0u;
#pragma unroll
        for (unsigned j = 0; j < 16; ++j) { const unsigned c = xb_ld(&bar[XB_XCNT(j)]); sum += c; cnt += (c > 0u) ? 1u : 0u; mine = (j == x) ? c : mine; }
        if (sum == G) break;
        __builtin_amdgcn_s_sleep(1);
        if ((++sp & 255u) == 0u) { if (xb_ld(&bar[XB_TMO])) break; if (sp > XB_SPIN_CAP) { atomicAdd(&bar[XB_TMO], 1u); break; } }
    }
    nloc = mine > 0u ? mine : 1u; nx = cnt > 0u ? cnt : 1u;
}

__device__ __forceinline__ void xcd_barrier(const XcdBarrier& b) {
    asm volatile("s_waitcnt vmcnt(0)" ::: "memory");
    __syncthreads();
    if (threadIdx.x == 0) {
        unsigned* bar = b.bar;
        __builtin_amdgcn_s_waitcnt(0);
        unsigned nloc = b.st[0], nx = b.st[1];
        if (nloc == 0u) { xcd_barrier_complete(bar, b.x, nloc, nx); b.st[0] = nloc; b.st[1] = nx; }
        const unsigned old = xb_add(&bar[XB_XSUB(b.x)], 1u);
        const unsigned gen = old / nloc;
        if (old + 1u == (gen + 1u) * nloc) {
            __builtin_amdgcn_fence(__ATOMIC_RELEASE, "agent");
            asm volatile("s_waitcnt vmcnt(0)" ::: "memory");
            const unsigned og = xb_add(&bar[XB_TOP], 1u);
            const unsigned tg = og / nx;
            if (og + 1u == (tg + 1u) * nx) xb_add(&bar[XB_TOPGEN], 1u);
            else XB_SPIN(xb_ld(&bar[XB_TOPGEN]) == tg, bar);
            __builtin_amdgcn_fence(__ATOMIC_ACQUIRE, "agent");
            xb_add(&bar[XB_XGEN(b.x)], 1u);
            asm volatile("s_waitcnt vmcnt(0)" ::: "memory");
        } else {
            XB_SPIN(xb_ld(&bar[XB_XGEN(b.x)]) == gen, bar);
            __builtin_amdgcn_fence(__ATOMIC_ACQUIRE, "agent");
            asm volatile("s_waitcnt vmcnt(0)" ::: "memory");
        }
    }
    __syncthreads();
}
namespace pg8 {
#define PG8_LAS __attribute__((address_space(3)))
typedef unsigned short bf16_t;
typedef short bf16x8 __attribute__((ext_vector_type(8)));
typedef float f32x4 __attribute__((ext_vector_type(4)));
typedef unsigned u32x4 __attribute__((ext_vector_type(4)));
constexpr int BM = 256, BK = 64, HALF = 128, HTB = HALF * BK * 2  , STAGE_BYTES = 8 * HTB, NXCD = 8, WGM = 8;

__host__ __device__ __forceinline__ int lds_byte(int r, int c) { const int st = (r >> 4) * 2 + (c >> 5), rr = r & 15, cc = c & 31, ob = rr * 64 + cc * 2; return st * 1024 + (ob ^ (((ob >> 9) & 1) << 5)); }
__host__ __device__ __forceinline__ void stage_rc(int b, int& R, int& C) { const int st = b / 1024, sb = b % 1024, swz = sb ^ (((sb >> 9) & 1) << 5); R = (st >> 1) * 16 + swz / 64; C = (st & 1) * 32 + (swz % 64) / 2; }
__host__ __device__ __forceinline__ int perm32(int rho) { const int n = rho >> 4, i = rho & 15; return 8 * (i >> 2) + 4 * n + (i & 3); }

struct Unit { int pm, pn, k0, nk; };
struct Gemm { const bf16_t* A; const bf16_t* Bt; int M, N, K; };

struct StaticOrder {
    int nM, nN, nwg, G, c;
    __host__ __device__ void init(int M, int N, int G_, int c_) { nM = M / BM; nN = N / BM; nwg = nM * nN; G = G_; c = c_; }
    __host__ __device__ bool next(int i, Unit& u) const {
        const long L = (long)i * G + c; if (L >= nwg) return false;
        int wgid = (int)L; { const int q = nwg / NXCD, r = nwg % NXCD, xcd = wgid % NXCD, off = wgid / NXCD; wgid = (xcd < r ? xcd * (q + 1) : r * (q + 1) + (xcd - r) * q) + off; }
        const int nig = WGM * nN, gid = wgid / nig, fm = gid * WGM, gsz = (nM - fm) < WGM ? (nM - fm) : WGM;
        u.pm = fm + ((wgid % nig) % gsz); u.pn = (wgid % nig) / gsz; u.k0 = 0; u.nk = 0; return true;
    }
    __device__ __forceinline__ void a_ready(const Unit&) const {}
    __device__ __forceinline__ void done(const Unit&) const {}
};
__device__ __forceinline__ unsigned cvt_pk_bf16(float lo, float hi) { unsigned r; asm volatile("v_cvt_pk_bf16_f32 %0, %1, %2" : "=v"(r) : "v"(lo), "v"(hi)); return r; }
typedef float f32x2 __attribute__((ext_vector_type(2)));
typedef int pg8_v8i __attribute__((ext_vector_type(8)));
typedef int pg8_v4i __attribute__((ext_vector_type(4)));
__device__ __forceinline__ pg8_v8i pg8_cat(bf16x8 lo, bf16x8 hi) { const pg8_v4i a = __builtin_bit_cast(pg8_v4i, lo), b = __builtin_bit_cast(pg8_v4i, hi); return __builtin_shufflevector(a, b, 0, 1, 2, 3, 4, 5, 6, 7); }
constexpr int F8_WSCALE = 121;
template <class Epi, class Sched, bool ALIGN_EPI = false, bool SP2 = false, bool F8 = false>
__device__ __forceinline__ void gemm_phase(PG8_LAS unsigned char* lds, const Gemm g, const Sched& S, const Epi& E) {
    const int tid = threadIdx.x, wid = __builtin_amdgcn_readfirstlane(tid >> 6), lane = tid & 63, wr = wid >> 2, wc = wid & 3, fr = lane & 15, fq = lane >> 4;
    const int K = g.K, nt = K / BK;
    unsigned voffA[2], voffB[2];
#pragma unroll
    for (int i = 0; i < 2; ++i) { int R, C; stage_rc(tid * 16 + i * 8192, R, C); const int Rb = Epi::PERM ? ((R & ~31) + perm32(R & 31)) : R;
        voffA[i] = (unsigned)(R * K + C) * 2u; voffB[i] = (unsigned)(Rb * K + C) * 2u; }
    const size_t kstep = (size_t)(BK * 2);
    const size_t hstep = (size_t)HALF * K * 2;
    const size_t tstep = 2 * hstep;
    const unsigned ldsw = (unsigned)wid * 1024u;
    const int aoff = lds_byte(wr * 64 + fr, fq * 8), boff = lds_byte(wc * 32 + fr, fq * 8);
#define PG8_SA(b, h) (((b) * 2 + (h)) * HTB)
#define PG8_SB(b, h) ((4 + (b) * 2 + (h)) * HTB)
#define PG8_STAGE(bufoff, gbase, voff) do { _Pragma("unroll") for (int _i = 0; _i < 2; ++_i) \
        __builtin_amdgcn_global_load_lds((const unsigned*)((const char*)(gbase) + (voff)[_i]), (PG8_LAS unsigned*)(lds + (bufoff) + ldsw + _i * 8192), 16, 0, 0); } while (0)
#define PG8_LDA(dst, b, h) do { _Pragma("unroll") for (int m = 0; m < 4; ++m) { if constexpr (F8) { dst##8[m] = pg8_cat(*(const PG8_LAS bf16x8*)(lds + PG8_SA(b, h) + aoff + m * 2048), *(const PG8_LAS bf16x8*)(lds + PG8_SA(b, h) + aoff + m * 2048 + 1024)); } else { _Pragma("unroll") for (int k = 0; k < 2; ++k) dst[m][k] = *(const PG8_LAS bf16x8*)(lds + PG8_SA(b, h) + aoff + m * 2048 + k * 1024); } } } while (0)
#define PG8_LDB(dst, b, h) do { _Pragma("unroll") for (int n = 0; n < 2; ++n) { if constexpr (F8) { dst##8[n] = pg8_cat(*(const PG8_LAS bf16x8*)(lds + PG8_SB(b, h) + boff + n * 2048), *(const PG8_LAS bf16x8*)(lds + PG8_SB(b, h) + boff + n * 2048 + 1024)); } else { _Pragma("unroll") for (int k = 0; k < 2; ++k) dst[n][k] = *(const PG8_LAS bf16x8*)(lds + PG8_SB(b, h) + boff + n * 2048 + k * 1024); } } } while (0)
#define PG8_MMA(ai, bj, At, Bt) do { __builtin_amdgcn_s_setprio(1); if constexpr (F8) { _Pragma("unroll") for (int m = 0; m < 4; ++m) _Pragma("unroll") for (int n = 0; n < 2; ++n) \
        asm volatile("v_mfma_scale_f32_16x16x128_f8f6f4 %0, %1, %2, %0, %3, %4 op_sel_hi:[0,0,0]" : "+v"(acc[ai][bj][m][n]) : "v"(Bt##8[n]), "v"(At##8[m]), "v"(f8_sw), "v"(f8_sa)); } \
        else { _Pragma("unroll") for (int m = 0; m < 4; ++m) _Pragma("unroll") for (int n = 0; n < 2; ++n) _Pragma("unroll") for (int k = 0; k < 2; ++k) \
        acc[ai][bj][m][n] = __builtin_amdgcn_mfma_f32_16x16x32_bf16(Bt[n][k], At[m][k], acc[ai][bj][m][n], 0, 0, 0); } __builtin_amdgcn_s_setprio(0); } while (0)
#define PG8_WAIT_V(n) asm volatile("s_waitcnt vmcnt(" #n ")" ::: "memory")
#define PG8_WAIT_L(n) asm volatile("s_waitcnt lgkmcnt(" #n ")" ::: "memory")
#define PG8_BAR __builtin_amdgcn_s_barrier()
#define PG8_SCHED __builtin_amdgcn_sched_barrier(0)
    Unit cur, nxt; int ui = 0;
    if (!S.next(0, cur)) return;
    f32x4 acc[2][2][4][2];
#pragma unroll
    for (int a = 0; a < 2; ++a)
#pragma unroll
        for (int b = 0; b < 2; ++b)
#pragma unroll
            for (int m = 0; m < 4; ++m)
#pragma unroll
                for (int n = 0; n < 2; ++n) acc[a][b][m][n] = (f32x4){0.f, 0.f, 0.f, 0.f};
    bf16x8 At[4][2], B0[2][2], B1[2][2]; pg8_v8i At8[4], B08[2], B18[2]; const int f8_sw = F8_WSCALE, f8_sa = 127;
    const char* cA = (const char*)g.A + (size_t)cur.pm * tstep + (size_t)cur.k0 * 2; const char* cB = (const char*)g.Bt + (size_t)cur.pn * tstep + (size_t)cur.k0 * 2;
    S.a_ready(cur);
    if constexpr (SP2) {
        PG8_STAGE(PG8_SB(0, 0), cB, voffB); PG8_STAGE(PG8_SB(0, 1), cB + hstep, voffB); PG8_STAGE(PG8_SA(0, 0), cA, voffA); PG8_STAGE(PG8_SA(0, 1), cA + hstep, voffA);
        if (wr == 1) PG8_BAR;
        PG8_WAIT_V(2); PG8_BAR;
        PG8_STAGE(PG8_SB(1, 0), cB + kstep, voffB); PG8_STAGE(PG8_SA(1, 0), cA + kstep, voffA); PG8_STAGE(PG8_SB(1, 1), cB + hstep + kstep, voffB);
        PG8_WAIT_V(6); PG8_BAR;
    } else {
        PG8_STAGE(PG8_SB(0, 0), cB, voffB); PG8_STAGE(PG8_SA(0, 0), cA, voffA); PG8_STAGE(PG8_SB(0, 1), cB + hstep, voffB); PG8_STAGE(PG8_SA(0, 1), cA + hstep, voffA);
        if (wr == 1) PG8_BAR;
        PG8_WAIT_V(4); PG8_BAR;
        PG8_STAGE(PG8_SB(1, 0), cB + kstep, voffB); PG8_STAGE(PG8_SA(1, 0), cA + kstep, voffA); PG8_STAGE(PG8_SB(1, 1), cB + hstep + kstep, voffB);
        PG8_WAIT_V(6); PG8_BAR;
    }
    for (;;) {
        const bool has_next = S.next(ui + 1, nxt);
        const char* nA = has_next ? (const char*)g.A + (size_t)nxt.pm * tstep + (size_t)nxt.k0 * 2 : cA; const char* nB = has_next ? (const char*)g.Bt + (size_t)nxt.pn * tstep + (size_t)nxt.k0 * 2 : cB;
        const int ntc = cur.nk ? cur.nk : nt;
        for (int t = 0; t < ntc; t += 2) {
            const bool last = (t == ntc - 2);
            const char* a1 = cA + (size_t)(t + 1) * kstep;
            const char* a2 = last ? nA : cA + (size_t)(t + 2) * kstep; const char* b2 = last ? nB : cB + (size_t)(t + 2) * kstep;
            const char* a3 = a2 + kstep; const char* b3 = b2 + kstep;
            if (last && has_next) S.a_ready(nxt);
            if constexpr (SP2) {
            PG8_LDB(B0, 0, 0); PG8_LDB(B1, 0, 1); PG8_SCHED; PG8_LDA(At, 0, 0); PG8_STAGE(PG8_SA(1, 1), a1 + hstep, voffA);
            PG8_WAIT_V(8); PG8_WAIT_L(0); PG8_BAR; PG8_MMA(0, 0, At, B0); PG8_MMA(0, 1, At, B1); PG8_BAR; PG8_SCHED;
            PG8_LDA(At, 0, 1); PG8_STAGE(PG8_SB(0, 0), b2, voffB); PG8_STAGE(PG8_SB(0, 1), b2 + hstep, voffB); PG8_STAGE(PG8_SA(0, 0), a2, voffA);
            PG8_WAIT_V(8); PG8_WAIT_L(0); PG8_BAR; PG8_MMA(1, 0, At, B0); PG8_MMA(1, 1, At, B1); PG8_BAR; PG8_SCHED;
            PG8_LDB(B0, 1, 0); PG8_LDB(B1, 1, 1); PG8_SCHED; PG8_LDA(At, 1, 0); PG8_STAGE(PG8_SA(0, 1), a2 + hstep, voffA);
            PG8_WAIT_V(8); PG8_WAIT_L(0); PG8_BAR; PG8_MMA(0, 0, At, B0); PG8_MMA(0, 1, At, B1); PG8_BAR; PG8_SCHED;
            PG8_LDA(At, 1, 1); PG8_STAGE(PG8_SB(1, 0), b3, voffB); PG8_STAGE(PG8_SB(1, 1), b3 + hstep, voffB); PG8_STAGE(PG8_SA(1, 0), a3, voffA);
            PG8_WAIT_V(8); PG8_WAIT_L(0); PG8_BAR; PG8_MMA(1, 0, At, B0); PG8_MMA(1, 1, At, B1); PG8_BAR; PG8_SCHED;
            } else {
            PG8_LDB(B0, 0, 0); PG8_SCHED; PG8_LDA(At, 0, 0); PG8_STAGE(PG8_SA(1, 1), a1 + hstep, voffA);
            PG8_WAIT_L(8); PG8_BAR; PG8_WAIT_L(0); PG8_MMA(0, 0, At, B0); PG8_BAR; PG8_SCHED;
            PG8_LDB(B1, 0, 1); PG8_STAGE(PG8_SB(0, 0), b2, voffB);
            PG8_BAR; PG8_WAIT_L(0); PG8_MMA(0, 1, At, B1); PG8_BAR;
            PG8_LDA(At, 0, 1); PG8_STAGE(PG8_SA(0, 0), a2, voffA);
            PG8_BAR; PG8_WAIT_L(0); PG8_MMA(1, 0, At, B0); PG8_BAR; PG8_SCHED;
            PG8_STAGE(PG8_SB(0, 1), b2 + hstep, voffB);
            PG8_WAIT_V(6); PG8_BAR; PG8_MMA(1, 1, At, B1); PG8_BAR;
            PG8_LDB(B0, 1, 0); PG8_SCHED; PG8_LDA(At, 1, 0); PG8_STAGE(PG8_SA(0, 1), a2 + hstep, voffA);
            PG8_WAIT_L(8); PG8_BAR; PG8_WAIT_L(0); PG8_MMA(0, 0, At, B0); PG8_BAR; PG8_SCHED;
            PG8_LDB(B1, 1, 1); PG8_STAGE(PG8_SB(1, 0), b3, voffB);
            PG8_BAR; PG8_WAIT_L(0); PG8_MMA(0, 1, At, B1); PG8_BAR;
            PG8_LDA(At, 1, 1); PG8_STAGE(PG8_SA(1, 0), a3, voffA);
            PG8_BAR; PG8_WAIT_L(0); PG8_MMA(1, 0, At, B0); PG8_BAR; PG8_SCHED;
            PG8_STAGE(PG8_SB(1, 1), b3 + hstep, voffB);
            PG8_WAIT_V(6); PG8_BAR; PG8_MMA(1, 1, At, B1); PG8_BAR;
            }
        }
        if constexpr (F8) { asm volatile("s_nop 15\n\ts_nop 15" ::: "memory"); }
        if constexpr (ALIGN_EPI) { if (wr == 0) PG8_BAR; }
        if constexpr (!Epi::AFTER_DRAIN) { E(acc, cur, wr, wc, fr, fq); S.done(cur); }
        if (!has_next) break;
#pragma unroll
        for (int a = 0; a < 2; ++a)
#pragma unroll
            for (int b = 0; b < 2; ++b)
#pragma unroll
                for (int m = 0; m < 4; ++m)
#pragma unroll
                    for (int n = 0; n < 2; ++n) acc[a][b][m][n] = (f32x4){0.f, 0.f, 0.f, 0.f};
        cur = nxt; cA = nA; cB = nB; ++ui;
        if constexpr (ALIGN_EPI) { if (wr == 1) PG8_BAR; }
    }
    PG8_WAIT_V(0);
    if constexpr (!ALIGN_EPI) { if (wr == 0) PG8_BAR; }
    PG8_BAR;
    if constexpr (Epi::AFTER_DRAIN) { E.fused(acc, cur, wr, wc, fr, fq, lds, wid, lane); S.done(cur); }
#undef PG8_SA
#undef PG8_SB
#undef PG8_STAGE
#undef PG8_LDA
#undef PG8_LDB
#undef PG8_MMA
#undef PG8_WAIT_V
#undef PG8_WAIT_L
#undef PG8_BAR
#undef PG8_SCHED
}
struct EpiStoreBf16 {
    static constexpr bool PERM = true, AFTER_DRAIN = false;
    bf16_t* O; int ldc; float* AB;
    __device__ __forceinline__ void operator()(const f32x4 (&acc)[2][2][4][2], const Unit& u, int wr, int wc, int fr, int fq) const {
        const int row0 = u.pm * BM + wr * 64 + fr, col0 = u.pn * BM + wc * 32 + 8 * fq;
        if (u.pn == 18) { if (wc == 0 && fq < 2) {
#pragma unroll
            for (int ai = 0; ai < 2; ++ai)
#pragma unroll
                for (int m = 0; m < 4; ++m) { float* rp = AB + (size_t)(row0 + ai * HALF + m * 16) * 16 + 8 * fq; *(f32x4*)rp = acc[ai][0][m][0]; *(f32x4*)(rp + 4) = acc[ai][0][m][1]; } }
            return; }
#pragma unroll
        for (int ai = 0; ai < 2; ++ai)
#pragma unroll
            for (int m = 0; m < 4; ++m) { bf16_t* rowp = O + (size_t)(row0 + ai * HALF + m * 16) * ldc + col0;
#pragma unroll
                for (int bj = 0; bj < 2; ++bj) { const f32x4 v0 = acc[ai][bj][m][0], v1 = acc[ai][bj][m][1];
                    u32x4 w; w.x = cvt_pk_bf16(v0[0], v0[1]); w.y = cvt_pk_bf16(v0[2], v0[3]); w.z = cvt_pk_bf16(v1[0], v1[1]); w.w = cvt_pk_bf16(v1[2], v1[3]);
                    *(u32x4*)(rowp + bj * HALF) = w; } }
    }
};
struct EpiResid {
    static constexpr bool PERM = false, AFTER_DRAIN = false;
    float* X; const float* mod; int goff; float* part; int kslice;
    __device__ __forceinline__ void operator()(const f32x4 (&acc)[2][2][4][2], const Unit& u, int wr, int wc, int fr, int fq) const {
        const int row0 = u.pm * BM + wr * 64 + fr, col0 = u.pn * BM + wc * 32 + 4 * fq;
        const int mv = u.pm < 32 ? (u.pm >> 3) : 4;
        const float* gp = mod + (size_t)mv * 12288 + goff + col0;
        f32x4 gv[2][2];
#pragma unroll
        for (int bj = 0; bj < 2; ++bj)
#pragma unroll
            for (int n = 0; n < 2; ++n) gv[bj][n] = *(const f32x4*)(gp + bj * HALF + n * 16);
        if (u.nk != 0) { float* pb = part + ((size_t)(u.k0 / kslice) * 1024 + (row0 - 8192)) * 2048 + col0;
#pragma unroll
            for (int ai = 0; ai < 2; ++ai)
#pragma unroll
                for (int m = 0; m < 4; ++m) { float* rowp = pb + (size_t)(ai * HALF + m * 16) * 2048;
#pragma unroll
                    for (int bj = 0; bj < 2; ++bj)
#pragma unroll
                        for (int n = 0; n < 2; ++n) *(f32x4*)(rowp + bj * HALF + n * 16) = gv[bj][n] * acc[ai][bj][m][n]; }
            return; }
#pragma unroll
        for (int ai = 0; ai < 2; ++ai)
#pragma unroll
            for (int m = 0; m < 4; ++m) { float* rowp = X + (size_t)(row0 + ai * HALF + m * 16) * 2048 + col0;
#pragma unroll
                for (int bj = 0; bj < 2; ++bj)
#pragma unroll
                    for (int n = 0; n < 2; ++n) { f32x4* p = (f32x4*)(rowp + bj * HALF + n * 16); *p = *p + gv[bj][n] * acc[ai][bj][m][n]; } }
    }
};
struct ResidOrder {
    StaticOrder so; int G, c, kslice;
    __device__ void init(int K, int G_, int c_) { so.init(8192, 2048, G_, c_); G = G_; c = c_; kslice = K / 4; }
    __device__ bool next(int i, Unit& u) const {
        const int L = i * G + c;
        if (L < so.nwg) return so.next(i, u);
        const int j = L - so.nwg; if (j >= 128) return false;
        const int t = j >> 2; u.pm = 32 + (t >> 3); u.pn = t & 7; u.k0 = (j & 3) * kslice; u.nk = kslice / BK; return true;
    }
    __device__ __forceinline__ void a_ready(const Unit&) const {}
    __device__ __forceinline__ void done(const Unit&) const {}
};
__device__ __forceinline__ float silu_f(float x) { return x * __builtin_amdgcn_rcpf(1.f + __builtin_amdgcn_exp2f(-1.4426950408889634f * x)); }
struct EpiSwiglu {
    static constexpr bool PERM = true, AFTER_DRAIN = false;
    bf16_t* H; int ldh; int ntn;
    __device__ __forceinline__ void operator()(const f32x4 (&acc)[2][2][4][2], const Unit& u, int wr, int wc, int fr, int fq) const {
        const int row0 = u.pm * BM + wr * 64 + fr, hcol0 = (u.pn % ntn) * HALF + wc * 32 + 8 * fq;
#pragma unroll
        for (int ai = 0; ai < 2; ++ai)
#pragma unroll
            for (int m = 0; m < 4; ++m) { bf16_t* rowp = H + (size_t)(row0 + ai * HALF + m * 16) * ldh + hcol0;
                const f32x4 a0 = acc[ai][0][m][0], a1 = acc[ai][0][m][1], b0 = acc[ai][1][m][0], b1 = acc[ai][1][m][1];
                float h[8];
#pragma unroll
                for (int j = 0; j < 4; ++j) { if (FP8_EMU && ntn == 56) { const float q = 1.f / 64.f; h[j] = rne_e4m3(silu_f(a0[j] * q) * (b0[j] * q)); h[4 + j] = rne_e4m3(silu_f(a1[j] * q) * (b1[j] * q)); } else { h[j] = silu_f(a0[j]) * b0[j]; h[4 + j] = silu_f(a1[j]) * b1[j]; } }
                u32x4 w; w.x = cvt_pk_bf16(h[0], h[1]); w.y = cvt_pk_bf16(h[2], h[3]); w.z = cvt_pk_bf16(h[4], h[5]); w.w = cvt_pk_bf16(h[6], h[7]);
                *(u32x4*)rowp = w; }
    }
};
struct EpiSwiglu8 {
    static constexpr bool PERM = true, AFTER_DRAIN = false;
    unsigned char* H; int ldh; int ntn;
    __device__ __forceinline__ void operator()(const f32x4 (&acc)[2][2][4][2], const Unit& u, int wr, int wc, int fr, int fq) const {
        const int row0 = u.pm * BM + wr * 64 + fr, hcol0 = (u.pn % ntn) * HALF + wc * 32 + 8 * fq;
#pragma unroll
        for (int ai = 0; ai < 2; ++ai)
#pragma unroll
            for (int m = 0; m < 4; ++m) { unsigned char* rowp = H + (size_t)(row0 + ai * HALF + m * 16) * ldh + hcol0;
                const f32x4 a0 = acc[ai][0][m][0], a1 = acc[ai][0][m][1], b0 = acc[ai][1][m][0], b1 = acc[ai][1][m][1];
                float h[8];
#pragma unroll
                for (int j = 0; j < 4; ++j) { h[j] = __builtin_amdgcn_fmed3f(silu_f(a0[j]) * b0[j], -448.f, 448.f); h[4 + j] = __builtin_amdgcn_fmed3f(silu_f(a1[j]) * b1[j], -448.f, 448.f); }
                int p0 = __builtin_amdgcn_cvt_pk_fp8_f32(h[0], h[1], 0, false); p0 = __builtin_amdgcn_cvt_pk_fp8_f32(h[2], h[3], p0, true);
                int p1 = __builtin_amdgcn_cvt_pk_fp8_f32(h[4], h[5], 0, false); p1 = __builtin_amdgcn_cvt_pk_fp8_f32(h[6], h[7], p1, true);
                u32x2 w; w.x = (unsigned)p0; w.y = (unsigned)p1; *(u32x2*)rowp = w; }
    }
};
struct EpiStoreF32 {
    static constexpr bool PERM = true, AFTER_DRAIN = false;
    bf16_t* C; float* part; int kslice;
    __device__ __forceinline__ void operator()(const f32x4 (&acc)[2][2][4][2], const Unit& u, int wr, int wc, int fr, int fq) const {
        const int row0 = u.pm * BM + wr * 64 + fr, col0 = (u.pn & 7) * BM + wc * 32 + 8 * fq;
        if (u.nk != 0) { float* base = part + ((size_t)(u.k0 / kslice) * 2048 + (row0 - 16384)) * 2048 + col0;
#pragma unroll
            for (int ai = 0; ai < 2; ++ai)
#pragma unroll
                for (int m = 0; m < 4; ++m) { float* rowp = base + (size_t)(ai * HALF + m * 16) * 2048;
#pragma unroll
                    for (int bj = 0; bj < 2; ++bj) { *(f32x4*)(rowp + bj * HALF) = acc[ai][bj][m][0]; *(f32x4*)(rowp + bj * HALF + 4) = acc[ai][bj][m][1]; } }
            return; }
#pragma unroll
        for (int ai = 0; ai < 2; ++ai)
#pragma unroll
            for (int m = 0; m < 4; ++m) { bf16_t* rowp = C + (size_t)(row0 + ai * HALF + m * 16) * 2048 + col0;
#pragma unroll
                for (int bj = 0; bj < 2; ++bj) { const f32x4 v0 = acc[ai][bj][m][0], v1 = acc[ai][bj][m][1];
                    u32x4 w; w.x = cvt_pk_bf16(v0[0], v0[1]); w.y = cvt_pk_bf16(v0[2], v0[3]); w.z = cvt_pk_bf16(v1[0], v1[1]); w.w = cvt_pk_bf16(v1[2], v1[3]);
                    *(u32x4*)(rowp + bj * HALF) = w; } }
    }
};
struct InProjL1Order {
    StaticOrder so; int G, c;
    __device__ void init(int G_, int c_) { so.init(8192, 4864, G_, c_); G = G_; c = c_; }
    __device__ bool next(int i, Unit& u) const {
        const int L = i * G + c;
        if (L < so.nwg) return so.next(i, u);
        const int L2 = L - so.nwg; if (L2 >= 28) return false;
        u.pm = 32 + (L2 & 3); u.pn = (L2 >> 2) == 6 ? 18 : (L2 >> 2); u.k0 = 0; u.nk = 0; return true;
    }
    __device__ __forceinline__ void a_ready(const Unit&) const {}
    __device__ __forceinline__ void done(const Unit&) const {}
};
struct TileExp { int b1, b2, b3, b4, b5, b6, b7;
    __device__ void init(const int* tb) { b1 = __builtin_amdgcn_readfirstlane(tb[1]); b2 = __builtin_amdgcn_readfirstlane(tb[2]); b3 = __builtin_amdgcn_readfirstlane(tb[3]); b4 = __builtin_amdgcn_readfirstlane(tb[4]);
        b5 = __builtin_amdgcn_readfirstlane(tb[5]); b6 = __builtin_amdgcn_readfirstlane(tb[6]); b7 = __builtin_amdgcn_readfirstlane(tb[7]); }
    __device__ __forceinline__ int of(int rt) const { return (rt >= b1) + (rt >= b2) + (rt >= b3) + (rt >= b4) + (rt >= b5) + (rt >= b6) + (rt >= b7); } };
struct MoeOrder {
    StaticOrder so; TileExp te; int NT;
    __device__ void init(int ntiles, int NT_, const int* tb, int G_, int c_) { so.nM = ntiles; so.nN = NT_; so.nwg = ntiles * NT_; so.G = G_; so.c = c_; te.init(tb); NT = NT_; }
    __device__ bool next(int i, Unit& u) const { if (!so.next(i, u)) return false; u.pn += te.of(u.pm) * NT; return true; }
    __device__ __forceinline__ void a_ready(const Unit&) const {}
    __device__ __forceinline__ void done(const Unit&) const {}
};
struct MoeDownOrder {
    StaticOrder so; TileExp te; int ntiles, G, c, kslice;
    __device__ void init(int ntiles_, const int* tb, int K, int G_, int c_) { ntiles = ntiles_; const int nm = ntiles_ < 64 ? ntiles_ : 64; so.nM = nm; so.nN = 8; so.nwg = nm * 8; so.G = G_; so.c = c_; te.init(tb); G = G_; c = c_; kslice = K / 4; }
    __device__ bool next(int i, Unit& u) const {
        const int L = i * G + c;
        if (L < so.nwg) { so.next(i, u); u.pn += te.of(u.pm) * 8; return true; }
        const int j = L - so.nwg; if (j >= (ntiles - so.nM) * 32) return false;
        const int t = j >> 2; u.pm = 64 + (t >> 3); u.pn = te.of(u.pm) * 8 + (t & 7); u.k0 = (j & 3) * kslice; u.nk = kslice / BK; return true;
    }
    __device__ __forceinline__ void a_ready(const Unit&) const {}
    __device__ __forceinline__ void done(const Unit&) const {}
};
}
namespace mk {
typedef const float* KP;
typedef __attribute__((address_space(4))) KP const* CIN;
struct Ctx {
    LAS unsigned char* lds;
    CIN in; float* out; unsigned char* ws;
    int tid, lane, wave, G, bid;
};
#define WSP(T, off) ((T*)(C.ws + (off)))
__device__ __forceinline__ const float* inp_(CIN p, int k) { asm volatile("" : "+s"(p)); return p[k]; }
#define INP(k) inp_(C.in, (k))

__device__ __forceinline__ void tr_item(const float* W, int ldw, int k0, int ncol0, bf16* WT, int ldt, int drow0, LAS float* scr, int lane, bool f8 = false) {
    f32x4 v[16];
#pragma unroll
    for (int i = 0; i < 16; ++i) { const int idx = lane + 64 * i, kk = idx >> 4, c4 = idx & 15; v[i] = *(const f32x4*)(W + (size_t)(k0 + kk) * ldw + ncol0 + 4 * c4); }
    if (FP8_EMU && f8) {
#pragma unroll
        for (int i = 0; i < 16; ++i) { v[i].x = rne_e4m3(v[i].x * 64.f); v[i].y = rne_e4m3(v[i].y * 64.f); v[i].z = rne_e4m3(v[i].z * 64.f); v[i].w = rne_e4m3(v[i].w * 64.f); } }
#pragma unroll
    for (int i = 0; i < 16; ++i) { const int idx = lane + 64 * i, kk = idx >> 4, c4 = idx & 15; LAS float* p = scr + kk * 65 + 4 * c4; p[0] = v[i].x; p[1] = v[i].y; p[2] = v[i].z; p[3] = v[i].w; }
    LDS_WAIT(); asm volatile("" ::: "memory");
    const int c = lane & 7;
#pragma unroll
    for (int jj = 0; jj < 8; ++jj) { const int n = (lane >> 3) + 8 * jj; const LAS float* s = scr + (8 * c) * 65 + n;
        u32x4 o; o.x = pk2(s[0], s[65]); o.y = pk2(s[2 * 65], s[3 * 65]); o.z = pk2(s[4 * 65], s[5 * 65]); o.w = pk2(s[6 * 65], s[7 * 65]);
        *(u32x4*)(WT + (size_t)(drow0 + n) * ldt + k0 + 8 * c) = o; }
    LDS_WAIT(); asm volatile("" ::: "memory");
}
__device__ __forceinline__ void tr_item8(const float* W, int ldw, int k0, int ncol0, unsigned char* WT, int ldt, int drow0, LAS float* scr, int lane) {
    f32x4 v[16];
#pragma unroll
    for (int i = 0; i < 16; ++i) { const int idx = lane + 64 * i, kk = idx >> 3, c4 = idx & 7; v[i] = *(const f32x4*)(W + (size_t)(k0 + kk) * ldw + ncol0 + 4 * c4); }
#pragma unroll
    for (int i = 0; i < 16; ++i) { const int idx = lane + 64 * i, kk = idx >> 3, c4 = idx & 7; LAS float* p = scr + kk * 33 + 4 * c4; p[0] = v[i].x * 64.f; p[1] = v[i].y * 64.f; p[2] = v[i].z * 64.f; p[3] = v[i].w * 64.f; }
    LDS_WAIT(); asm volatile("" ::: "memory");
    const int c = lane & 7;
#pragma unroll
    for (int jj = 0; jj < 4; ++jj) { const int n = (lane >> 3) + 8 * jj; const LAS float* s = scr + (16 * c) * 33 + n;
        u32x4 o; o.x = pk4_fp8(s[0], s[33], s[2 * 33], s[3 * 33]); o.y = pk4_fp8(s[4 * 33], s[5 * 33], s[6 * 33], s[7 * 33]);
        o.z = pk4_fp8(s[8 * 33], s[9 * 33], s[10 * 33], s[11 * 33]); o.w = pk4_fp8(s[12 * 33], s[13 * 33], s[14 * 33], s[15 * 33]);
        *(u32x4*)(WT + (size_t)(drow0 + n) * ldt + k0 + 16 * c) = o; }
    LDS_WAIT(); asm volatile("" ::: "memory");
}
constexpr int IT_WIN = 32 * 73, IT_WOUT = 32 * 32, IT_W1 = 32 * 88, IT_W2 = 88 * 32, IT_MW1 = 32 * 112, IT_MW2 = 112 * 32, IT_PW = 2 * 2;
constexpr int IT_PRO = IT_WIN + 8 * IT_PW;
constexpr int BG_WOUT0 = 0, BG_W13 = BG_WOUT0 + IT_WOUT, BG_W2 = BG_W13 + 2 * IT_W1, BG_WIN1 = BG_W2 + IT_W2, BG_WOUT1 = BG_WIN1 + IT_WIN, BG_MOE = BG_WOUT1 + IT_WOUT, NBG = BG_MOE + 16 * IT_MW1 + 8 * IT_MW2;
constexpr int IT_TOTAL = IT_PRO + NBG;
__device__ __forceinline__ void tr_dispatch(Ctx& C, int it, LAS float* scr) {
    const float* W; int ldw, k0, nc0, ldt, dr0; bf16* WT; int r = it;
    if (r < IT_WIN) { const int kb = r / 73, nb = r % 73; W = INP(7); ldw = INW; k0 = 64 * kb; nc0 = nb == 72 ? 1536 : nb < 24 ? 64 * nb : 1552 + 64 * (nb - 24); WT = WSP(bf16, WS_WIN); ldt = D; dr0 = nb == 72 ? 4608 : nb < 24 ? 64 * nb : 1536 + 64 * (nb - 24); }
    else if (r < IT_PRO) { r -= IT_WIN; const int m = r / IT_PW, q = r % IT_PW; W = INP(16) + (size_t)m * 128 * 128; ldw = 128; k0 = 64 * (q >> 1); nc0 = 64 * (q & 1); WT = WSP(bf16, WS_PWT) + (size_t)m * 128 * 128; ldt = 128; dr0 = 64 * (q & 1); }
    else { r -= IT_PRO;
        if (r < BG_W13) { const int kb = r / 32, nb = r % 32; W = INP(22); ldw = D; k0 = 64 * kb; nc0 = 64 * nb; WT = WSP(bf16, WS_WOUT); ldt = D; dr0 = 64 * nb; }
        else if (DENSE_FP8_UP && r < BG_W2) { r -= BG_W13; const int s = r / IT_W1; r -= s * IT_W1; const int kb = r / 176, nb = r % 176, h0 = 32 * nb;
            tr_item8(INP(24 + s), DFF, 128 * kb, h0, WSP(unsigned char, WS_W13), D, 256 * (h0 >> 7) + 128 * s + (h0 & 127), scr, C.lane); return; }
        else if (DENSE_FP8_DN && r >= BG_W2 && r < BG_WIN1) { r -= BG_W2; const int kb = r / 64, nb = r % 64;
            tr_item8(INP(26), D, 128 * kb, 32 * nb, WSP(unsigned char, WS_W2), DFF, 32 * nb, scr, C.lane); return; }
        else if (r < BG_W2) { r -= BG_W13; const int s = r / IT_W1; r -= s * IT_W1; const int kb = r / 88, nb = r % 88; W = INP(24 + s); ldw = DFF; k0 = 64 * kb; nc0 = 64 * nb; WT = WSP(bf16, WS_W13); ldt = D; dr0 = 256 * (nb >> 1) + 128 * s + 64 * (nb & 1); }
        else if (r < BG_WIN1) { r -= BG_W2; const int kb = r / 32, nb = r % 32; W = INP(26); ldw = D; k0 = 64 * kb; nc0 = 64 * nb; WT = WSP(bf16, WS_W2); ldt = DFF; dr0 = 64 * nb; }
        else if (r < BG_WOUT1) { r -= BG_WIN1; const int kb = r / 73, nb = r % 73; W = INP(7) + (size_t)D * INW; ldw = INW; k0 = 64 * kb; nc0 = nb == 72 ? 1536 : nb < 24 ? 64 * nb : 1552 + 64 * (nb - 24); WT = WSP(bf16, WS_WIN) + (size_t)NINP * D; ldt = D; dr0 = nb == 72 ? 4608 : nb < 24 ? 64 * nb : 1536 + 64 * (nb - 24); }
        else if (r < BG_MOE) { r -= BG_WOUT1; const int kb = r / 32, nb = r % 32; W = INP(22) + (size_t)D * D; ldw = D; k0 = 64 * kb; nc0 = 64 * nb; WT = WSP(bf16, WS_WOUT) + (size_t)D * D; ldt = D; dr0 = 64 * nb; }
        else { r -= BG_MOE;
            if (MOE_FP8) {
                if (r < 16 * IT_MW1) { const int j = r / IT_MW1; r -= j * IT_MW1; const int s = j >> 3, e = j & 7, kb = r / 224, nb = r % 224, h0 = 32 * nb;
                    tr_item8(INP(29 + s) + (size_t)e * D * DFE, DFE, 128 * kb, h0, WSP(unsigned char, WS_MW13) + (size_t)e * 2 * DFE * D, D, 256 * (h0 >> 7) + 128 * s + (h0 & 127), scr, C.lane); }
                else { r -= 16 * IT_MW1; const int e = r / IT_MW2; r -= e * IT_MW2; const int kb = r / 64, nb = r % 64;
                    tr_item8(INP(31) + (size_t)e * DFE * D, D, 128 * kb, 32 * nb, WSP(unsigned char, WS_MW2) + (size_t)e * D * DFE, DFE, 32 * nb, scr, C.lane); }
                return; }
            if (r < 16 * IT_MW1) { const int j = r / IT_MW1; r -= j * IT_MW1; const int s = j >> 3, e = j & 7, kb = r / 112, nb = r % 112;
                W = INP(29 + s) + (size_t)e * D * DFE; ldw = DFE; k0 = 64 * kb; nc0 = 64 * nb; WT = WSP(bf16, WS_MW13) + (size_t)e * 2 * DFE * D; ldt = D; dr0 = 256 * (nb >> 1) + 128 * s + 64 * (nb & 1); }
            else { r -= 16 * IT_MW1; const int e = r / IT_MW2; r -= e * IT_MW2; const int kb = r / 32, nb = r % 32;
                W = INP(31) + (size_t)e * DFE * D; ldw = D; k0 = 64 * kb; nc0 = 64 * nb; WT = WSP(bf16, WS_MW2) + (size_t)e * D * DFE; ldt = DFE; dr0 = 64 * nb; } } }
    tr_item(W, ldw, k0, nc0, WT, ldt, dr0, scr, C.lane, it >= IT_PRO + BG_MOE);
}
#ifndef BG_BATCH_N
#define BG_BATCH_N 1
#endif
constexpr int BG_BATCH = BG_BATCH_N;
__device__ __forceinline__ void bg_work(Ctx& C, int limit, int poll_phase) {
    unsigned* ctl = WSP(unsigned, WS_CTL);
    volatile LAS unsigned* flag = (volatile LAS unsigned*)(C.lds + LDS_BARW + 8);
    VM_WAIT(); __syncthreads();
    if (C.tid == 0) { flag[0] = 0u; flag[1] = __hip_atomic_load(ctl + CW_BGHEAD, __ATOMIC_RELAXED, __HIP_MEMORY_SCOPE_AGENT) >= (unsigned)NBG ? 1u : 0u;
        if (poll_phase >= 0) __hip_atomic_fetch_add(ctl + CW_DONE + 64 * poll_phase, 1u, __ATOMIC_RELAXED, __HIP_MEMORY_SCOPE_AGENT); }
    __syncthreads();
    if (flag[1] != 0u) return;
    LAS float* scr = (LAS float*)(C.lds + C.wave * 16896);
    for (;;) {
        if (C.tid == 0) { unsigned base = 0xffffffffu;
            const unsigned head = __hip_atomic_load(ctl + CW_BGHEAD, __ATOMIC_RELAXED, __HIP_MEMORY_SCOPE_AGENT);
            bool go = head < (unsigned)limit;
            if (!go && poll_phase >= 0 && head < (unsigned)NBG) go = __hip_atomic_load(ctl + CW_DONE + 64 * poll_phase, __ATOMIC_RELAXED, __HIP_MEMORY_SCOPE_AGENT) < (unsigned)C.G;
            if (go) base = __hip_atomic_fetch_add(ctl + CW_BGHEAD, (unsigned)NWAVE, __ATOMIC_RELAXED, __HIP_MEMORY_SCOPE_AGENT);
            flag[0] = base; }
        __syncthreads();
        const unsigned base = flag[0];
        if (base >= (unsigned)NBG) break;
        if (base + C.wave < (unsigned)NBG) tr_dispatch(C, IT_PRO + (int)base + C.wave, scr);
        __syncthreads();
    }
}
__device__ __forceinline__ void mod_unit(Ctx& C, int unit, LAS float* sv  , LAS float* red  ) {
    const int l = unit / 192, col0 = (unit % 192) * 64, cq = C.tid & 15, ks = C.tid >> 4;
    const float* w = INP(4) + ((size_t)l * D + ks * 64) * 12288 + col0 + 4 * cq;
    f32x4 acc[5];
#pragma unroll
    for (int v = 0; v < 5; ++v) acc[v] = (f32x4){0.f, 0.f, 0.f, 0.f};
#pragma unroll 8
    for (int k = 0; k < 64; ++k) { const f32x4 wv = *(const f32x4*)(w + (size_t)k * 12288);
#pragma unroll
        for (int v = 0; v < 5; ++v) acc[v] += wv * sv[v * 2048 + ks * 64 + k]; }
#pragma unroll
    for (int v = 0; v < 5; ++v) *(LAS f32x4*)(red + (ks * 5 + v) * 64 + 4 * cq) = acc[v];
    WG_BAR();
    if (C.tid < 320) { const int v = C.tid >> 6, c = C.tid & 63; float s = 0.f;
#pragma unroll 8
        for (int k = 0; k < 32; ++k) s += red[(k * 5 + v) * 64 + c];
        WSP(float, WS_MODV)[((size_t)l * 5 + v) * 12288 + col0 + c] = s + INP(5)[l * 12288 + col0 + c]; }
    WG_BAR();
}
__device__ __forceinline__ void p_prologue(Ctx& C) {
    LAS float* sv = (LAS float*)C.lds; LAS float* red = sv + 5 * 2048;
    for (int i = C.tid; i < 5 * 2048; i += NTHR) { const float x = i < 4 * 2048 ? INP(1)[i] : INP(3)[i - 4 * 2048]; sv[i] = x / (1.f + expf(-x)); }
    WG_BAR();
    for (int u = C.bid; u < 384; u += C.G) mod_unit(C, u, sv, red);
    for (int i = C.bid * NTHR + C.tid; i < 2 * 2048 * 4; i += C.G * NTHR) { const int lk = i >> 2, q = i & 3; *(f32x4*)(WSP(float, WS_WABC) + (size_t)lk * 16 + 4 * q) = *(const f32x4*)(INP(7) + (size_t)lk * INW + 1536 + 4 * q); }
    { float* pos = WSP(float, WS_POS);
      for (size_t i = (size_t)C.bid * NTHR + C.tid; i < (size_t)TX * D; i += (size_t)C.G * NTHR) {
          const int t = (int)(i >> 11), d = (int)(i & 2047), r = t >> 6, cc = t & 63, part = d >> 9, fi = d & 511;
          const float freq = expf(-9.210340371976184f * (float)fi / 512.f);
          const float ang = (part < 2 ? (float)r : (float)cc) * freq;
          pos[i] = (part & 1) ? __cosf(ang) : __sinf(ang); } }
    WG_BAR();
    LAS float* scr = (LAS float*)(C.lds + C.wave * 16896);
    const int gw = C.bid * NWAVE + C.wave, NGW = C.G * NWAVE;
    const int nit = (STATIC_FILL && C.G == 256) ? (DENSE_IN_SCAN ? IT_PRO : IT_PRO + BG_MOE) : IT_TOTAL;
    for (int it = gw; it < nit; it += NGW) tr_dispatch(C, it, scr);
}
struct F8Item { const float* W; unsigned char* WT; int ldw, ldt; };
__device__ __forceinline__ F8Item f8_item(Ctx& C, int r) {
    F8Item t;
    if (r < 16 * IT_MW1) { const int j = r / IT_MW1; r -= j * IT_MW1; const int s = j >> 3, e = j & 7, kb = r / 224, nb = r % 224, h0 = 32 * nb;
        t.W = INP(29 + s) + (size_t)e * D * DFE + (size_t)(128 * kb) * DFE + h0; t.ldw = DFE; t.ldt = D;
        t.WT = WSP(unsigned char, WS_MW13) + (size_t)e * 2 * DFE * D + (size_t)(256 * (h0 >> 7) + 128 * s + (h0 & 127)) * D + 128 * kb; }
    else { r -= 16 * IT_MW1; const int e = r / IT_MW2; r -= e * IT_MW2; const int kb = r / 64, nb = r % 64;
        t.W = INP(31) + (size_t)e * DFE * D + (size_t)(128 * kb) * D + 32 * nb; t.ldw = D; t.ldt = DFE;
        t.WT = WSP(unsigned char, WS_MW2) + (size_t)e * D * DFE + (size_t)(32 * nb) * DFE + 128 * kb; }
    return t;
}
__device__ __forceinline__ void f8_load(const F8Item& t, f32x4 (&v)[16], int lane) {
#pragma unroll
    for (int i = 0; i < 16; ++i) { const int idx = lane + 64 * i, kk = idx >> 3, c4 = idx & 7; v[i] = *(const f32x4*)(t.W + (size_t)kk * t.ldw + 4 * c4); }
}
__device__ __forceinline__ void f8_store(const F8Item& t, const f32x4 (&v)[16], LAS float* scr, int lane) {
#pragma unroll
    for (int i = 0; i < 16; ++i) { const int idx = lane + 64 * i, kk = idx >> 3, c4 = idx & 7; LAS float* p = scr + kk * 33 + 4 * c4; p[0] = v[i].x * 64.f; p[1] = v[i].y * 64.f; p[2] = v[i].z * 64.f; p[3] = v[i].w * 64.f; }
    LDS_WAIT(); asm volatile("" ::: "memory");
    const int c = lane & 7;
#pragma unroll
    for (int jj = 0; jj < 4; ++jj) { const int n = (lane >> 3) + 8 * jj; const LAS float* s = scr + (16 * c) * 33 + n;
        u32x4 o; o.x = pk4_fp8(s[0], s[33], s[2 * 33], s[3 * 33]); o.y = pk4_fp8(s[4 * 33], s[5 * 33], s[6 * 33], s[7 * 33]);
        o.z = pk4_fp8(s[8 * 33], s[9 * 33], s[10 * 33], s[11 * 33]); o.w = pk4_fp8(s[12 * 33], s[13 * 33], s[14 * 33], s[15 * 33]);
        *(u32x4*)(t.WT + (size_t)n * t.ldt + 16 * c) = o; }
    LDS_WAIT(); asm volatile("" ::: "memory");
}
__device__ __forceinline__ void fill_static(Ctx& C, int first, int n, int b0) {
    if (!(STATIC_FILL && C.G == 256) || C.bid < b0 || n <= 0) return;
    VM_WAIT(); __syncthreads();
    LAS float* scr = (LAS float*)(C.lds + C.wave * 16896);
    const int nb = C.G - b0, step = nb * NWAVE, end = first + n;
    int it = first + (C.bid - b0) * NWAVE + C.wave;
    if (!MOE_FP8) { for (; it < end; it += step) tr_dispatch(C, IT_PRO + BG_MOE + it, scr); return; }
    if (it >= end) return;
    f32x4 va[16], vb[16];
    F8Item ta = f8_item(C, it), tb = ta; f8_load(ta, va, C.lane);
    for (;;) {
        const bool mb = it + step < end; if (mb) { tb = f8_item(C, it + step); f8_load(tb, vb, C.lane); }
        f8_store(ta, va, scr, C.lane);
        if (!mb) break; it += step;
        const bool ma = it + step < end; if (ma) { ta = f8_item(C, it + step); f8_load(ta, va, C.lane); }
        f8_store(tb, vb, scr, C.lane);
        if (!ma) break; it += step;
    }
}

template <int MODE>
__device__ __forceinline__ void p_norm(Ctx& C, int l) {
    const float* mod = WSP(float, WS_MODV) + (size_t)l * 5 * 12288;
    float* XS = WSP(float, WS_XS); bf16* AN = WSP(bf16, WS_AN);
    const bool mix = MODE <= 1;
    const float* gain = (mix ? INP(6) : INP(23)) + l * D;
    const int sh_off = mix ? 0 : 6144, sc_off = mix ? 2048 : 8192;
    LAS f32x4* wl = (LAS f32x4*)C.lds;
    LAS f32x4* vt = (LAS f32x4*)(C.lds + 65536);
    for (int idx = C.tid; idx < 5 * 512; idx += NTHR) { const int m = idx >> 9, f = idx & 511, j = f >> 6, ln = f & 63;
        const f32x4 g = *((const f32x4*)gain + f), sc = *((const f32x4*)(mod + (size_t)m * 12288 + sc_off) + f), sh = *((const f32x4*)(mod + (size_t)m * 12288 + sh_off) + f);
        vt[((m * 2 + 0) * 8 + j) * 64 + ln] = g * (sc + 1.f); vt[((m * 2 + 1) * 8 + j) * 64 + ln] = sh; }
    if (MODE == 3 && C.tid < 16) ((LAS unsigned*)(C.lds + 147456))[C.tid] = 0u;
    if (MODE == 3) { const float* wsrc = INP(27);
        for (int idx = C.tid; idx < 2048 * 2; idx += NTHR) { const int k = idx >> 1, q = idx & 1, ln = (k & 255) >> 2, i = k & 3, j = k >> 8;
            wl[((j * 4 + i) * 2 + q) * 64 + ln] = *(const f32x4*)(wsrc + (size_t)k * 8 + 4 * q); } }
    WG_BAR();
    LAS unsigned* lcnt = (LAS unsigned*)(C.lds + 147456); LAS unsigned* lrk = lcnt + 16;
    const int nrows = MODE == 3 ? MX : MT;
    const int gw = C.bid * NWAVE + C.wave, NGW = C.G * NWAVE, lane = C.lane;
    for (int row = gw; row < nrows; row += NGW) {
        int base, T, t, mv; rowinfo(row, base, T, t, mv);
        f32x4 x[8]; float ss = 0.f;
        if (MODE == 0) {
            if (row < MX) { const f32x4* xi = (const f32x4*)(INP(0) + (size_t)row * D) + lane; const f32x4* pp = (const f32x4*)(WSP(float, WS_POS) + (size_t)t * D) + lane;
#pragma unroll
                for (int j = 0; j < 8; ++j) x[j] = xi[64 * j] + pp[64 * j]; }
            else { const f32x4* xi = (const f32x4*)(INP(2) + (size_t)(row - MX) * D) + lane;
#pragma unroll
                for (int j = 0; j < 8; ++j) x[j] = xi[64 * j]; }
            f32x4* xo = (f32x4*)(XS + (size_t)row * D) + lane;
#pragma unroll
            for (int j = 0; j < 8; ++j) xo[64 * j] = x[j];
        } else { const f32x4* xi = (const f32x4*)(XS + (size_t)row * D) + lane;
#pragma unroll
            for (int j = 0; j < 8; ++j) x[j] = xi[64 * j];
            if ((MODE == 1 || (MODE == 2 && l == 0)) && row >= MX) {
#pragma unroll
                for (int ks = 0; ks < 4; ++ks) { const f32x4* pp = (const f32x4*)(WSP(float, WS_PART) + ((size_t)ks * MC + (row - MX)) * D) + lane;
#pragma unroll
                    for (int j = 0; j < 8; ++j) x[j] += pp[64 * j]; }
                f32x4* xo = (f32x4*)(XS + (size_t)row * D) + lane;
#pragma unroll
                for (int j = 0; j < 8; ++j) xo[64 * j] = x[j]; } }
#pragma unroll
        for (int j = 0; j < 8; ++j) ss += (x[j].x * x[j].x + x[j].y * x[j].y) + (x[j].z * x[j].z + x[j].w * x[j].w);
        const float rs = rsqrtf(wave_sum(ss) * (1.f / D) + EPS);
        const LAS f32x4* gsp = vt + (mv * 2) * 512 + lane; const LAS f32x4* shp = gsp + 512;
        u32x2* ao = (u32x2*)(AN + (size_t)row * D) + lane;
#pragma unroll
        for (int j = 0; j < 8; ++j) { const f32x4 gs = gsp[64 * j], sh = shp[64 * j];
            x[j] = x[j] * rs * gs + sh;
            if (DENSE_FP8_UP && MODE == 2) { ((unsigned*)((unsigned char*)AN + (size_t)row * D) + lane)[64 * j] = pk4_fp8(clamp448(x[j].x), clamp448(x[j].y), clamp448(x[j].z), clamp448(x[j].w)); }
            else { u32x2 w; w.x = pk2(x[j].x, x[j].y); w.y = pk2(x[j].z, x[j].w); ao[64 * j] = w; } }
        if (MODE == 3) {
            f32x4 acc[2] = {(f32x4){0.f, 0.f, 0.f, 0.f}, (f32x4){0.f, 0.f, 0.f, 0.f}};
#pragma unroll
            for (int j = 0; j < 8; ++j)
#pragma unroll
                for (int i = 0; i < 4; ++i) { const float a = x[j][i];
#pragma unroll
                    for (int q = 0; q < 2; ++q) acc[q] += wl[((j * 4 + i) * 2 + q) * 64 + lane] * a; asm volatile("" ::: "memory"); }
            float lg[8];
#pragma unroll
            for (int e = 0; e < 8; ++e) lg[e] = wave_sum(acc[e >> 2][e & 3]) + INP(28)[e];
            if (lane == 0) { int i1 = 0;
#pragma unroll
                for (int e = 1; e < 8; ++e) if (lg[e] > lg[i1]) i1 = e;
                int i2 = i1 == 0 ? 1 : 0;
#pragma unroll
                for (int e = 0; e < 8; ++e) if (e != i1 && lg[e] > lg[i2]) i2 = e;
                float v1 = lg[0], v2 = lg[0];
#pragma unroll
                for (int e = 0; e < 8; ++e) { v1 = e == i1 ? lg[e] : v1; v2 = e == i2 ? lg[e] : v2; }
                const float g2 = 1.f / (1.f + expf(v1 - v2));
                int* R = WSP(int, WS_ROUTE); float* Rf = WSP(float, WS_ROUTE); unsigned* ctl = WSP(unsigned, WS_CTL);
                R[R_TE + 2 * row] = i1; R[R_TE + 2 * row + 1] = i2; Rf[R_TG + 2 * row] = 1.f - g2; Rf[R_TG + 2 * row + 1] = g2;
                const int k = (row - gw) / NGW;
                if (k < 16) { const unsigned l1 = __hip_atomic_fetch_add(lcnt + i1, 1u, __ATOMIC_RELAXED, __HIP_MEMORY_SCOPE_WORKGROUP), l2 = __hip_atomic_fetch_add(lcnt + i2, 1u, __ATOMIC_RELAXED, __HIP_MEMORY_SCOPE_WORKGROUP);
                    lrk[(C.wave * 16 + k) * 2] = ((unsigned)i1 << 16) | l1; lrk[(C.wave * 16 + k) * 2 + 1] = ((unsigned)i2 << 16) | l2; }
                else { R[R_RANK + 2 * row] = (int)atomicAdd(ctl + CW_CNT + 64 * i1, 1u); R[R_RANK + 2 * row + 1] = (int)atomicAdd(ctl + CW_CNT + 64 * i2, 1u); } }
        }
    }
    if (MODE == 3) {
        WG_BAR();
        if (C.tid < 8) lcnt[8 + C.tid] = __hip_atomic_fetch_add(WSP(unsigned, WS_CTL) + CW_CNT + 64 * C.tid, lcnt[C.tid], __ATOMIC_RELAXED, __HIP_MEMORY_SCOPE_AGENT);
        WG_BAR();
        if (lane == 0) { int* R = WSP(int, WS_ROUTE); int k = 0;
            for (int row = gw; row < nrows && k < 16; row += NGW, ++k) { const unsigned a = lrk[(C.wave * 16 + k) * 2], b2 = lrk[(C.wave * 16 + k) * 2 + 1];
                R[R_RANK + 2 * row] = (int)(lcnt[8 + (a >> 16)] + (a & 0xffffu)); R[R_RANK + 2 * row + 1] = (int)(lcnt[8 + (b2 >> 16)] + (b2 & 0xffffu)); } }
    }
}
}
namespace mk {
__device__ __forceinline__ f32x4 mfma16(bf16x8 a, bf16x8 b, f32x4 c) { return __builtin_amdgcn_mfma_f32_16x16x32_bf16(a, b, c, 0, 0, 0); }

constexpr int DP_PITCH = 132;
constexpr int DP_Q = 0, DP_K = 33792, DP_V = 67584;
constexpr int DP_LP = 68;
constexpr int DP_L = 101376;
constexpr int DP_QK = DP_L + 2 * 64 * DP_LP * 4;
constexpr int DP_SM = DP_QK + 16384;
static_assert(DP_SM + 2048 <= LDS_BARW, "DN prep LDS map");
__device__ __forceinline__ size_t dn_rec(int dir, int cid, int h) { return ((size_t)dir * NCH + cid) * 4 + h; }

__device__ __forceinline__ void dnprep_unit(Ctx& C, int l, int cidx, int h) {
    LAS float* Qs = (LAS float*)(C.lds + DP_Q); LAS float* Ks = (LAS float*)(C.lds + DP_K); LAS float* Vs = (LAS float*)(C.lds + DP_V);
    LAS float* Ls = (LAS float*)(C.lds + DP_L); LAS bf16* QKi = (LAS bf16*)(C.lds + DP_QK); LAS float* sm = (LAS float*)(C.lds + DP_SM);
    LAS float* Gs = sm; LAS float* Bs = sm + 128; LAS float* EGs = sm + 256; LAS float* EGRs = sm + 384;
    const bf16* P = WSP(bf16, WS_P);
    const int tid = C.tid, lane = C.lane, wave = C.wave;
    const int r0 = cidx * 64; int sbase, T, t0, mv; rowinfo(r0, sbase, T, t0, mv);
    const int nloc = t0 >> 6, nch = T >> 6, cbase = sbase >> 6;
#ifndef DP_SKIP
#define DP_SKIP 0
#endif
    if (!(DP_SKIP & 1)) { if (tid < 384) {
        const int o = tid % 48, tg = tid / 48, wh = o >> 4, oc = o & 15, ch = wh * 512 + h * 128 + 8 * oc;
        float w[5][8];
        const float* cw = INP(8) + (size_t)l * 5 * 1536 + ch;
#pragma unroll
        for (int k = 0; k < 5; ++k) { const f32x4 a = *(const f32x4*)(cw + k * 1536), b = *(const f32x4*)(cw + k * 1536 + 4);
            w[k][0] = a.x; w[k][1] = a.y; w[k][2] = a.z; w[k][3] = a.w; w[k][4] = b.x; w[k][5] = b.y; w[k][6] = b.z; w[k][7] = b.w; }
        u32x4 raw[12];
#pragma unroll
        for (int i = 0; i < 12; ++i) { const int t = t0 + 8 * tg + i - 2; raw[i] = (u32x4){0u, 0u, 0u, 0u};
            if (t >= 0 && t < T) raw[i] = *(const u32x4*)(P + (size_t)(sbase + t) * NIN + ch); }
        float win[5][8];
#pragma unroll
        for (int k = 0; k < 4; ++k) unpack8(raw[k], win[k + 1]);
#pragma unroll
        for (int i = 0; i < 8; ++i) {
#pragma unroll
            for (int k = 0; k < 4; ++k)
#pragma unroll
                for (int c = 0; c < 8; ++c) win[k][c] = win[k + 1][c];
            unpack8(raw[i + 4], win[4]);
            float ov[8]; float ss = 0.f;
#pragma unroll
            for (int c = 0; c < 8; ++c) { float s = 0.f;
#pragma unroll
                for (int k = 0; k < 5; ++k) s += w[k][c] * win[k][c];
                ov[c] = silu(s); ss += ov[c] * ov[c]; }
            ss = sum16(ss);
            const float sc = wh == 0 ? rsqrtf(ss + EPS) * 0.08838834764831845f : wh == 1 ? rsqrtf(ss + EPS) : 1.f;
            LAS float* dst = (wh == 0 ? Qs : wh == 1 ? Ks : Vs) + (8 * tg + i) * DP_PITCH + 8 * oc;
            *(LAS f32x4*)dst = (f32x4){ov[0] * sc, ov[1] * sc, ov[2] * sc, ov[3] * sc}; *(LAS f32x4*)(dst + 4) = (f32x4){ov[4] * sc, ov[5] * sc, ov[6] * sc, ov[7] * sc}; }
    } else {
        const int d = wave - 6, s = lane, i = d ? 63 - s : s; const float* ab = WSP(float, WS_ABF) + (size_t)(r0 + i) * 16;
        const float la = -expf(INP(9)[l * 8 + d * 4 + h]) * softplus(ab[d * 4 + h] + INP(10)[l * 8 + d * 4 + h]);
        const float be = sigm(ab[8 + d * 4 + h]);
        float g = la;
#pragma unroll
        for (int o = 1; o < 64; o <<= 1) { const float up = __shfl_up(g, o); if (lane >= o) g += up; }
        const float gl = __shfl(g, 63);
        Gs[d * 64 + s] = g; Bs[d * 64 + s] = be; EGs[d * 64 + s] = expf(g); EGRs[d * 64 + s] = expf(gl - g);
        if (lane == 63) { const int cid = d ? cbase + (nch - 1 - nloc) : cidx; const float e = expf(gl); *(f32x4*)(WSP(float, WS_EGL) + dn_rec(d, cid, h) * 4) = (f32x4){e, e, e, e}; }
    } }
    WG_BAR();
    if (!(DP_SKIP & 2)) {
        const int wh = wave >> 2, mb = wave & 3, c = lane & 15, g4 = lane >> 4;
        const LAS float* Am = wh ? Qs : Ks;
        f32x4 acc[4];
#pragma unroll
        for (int nb = 0; nb < 4; ++nb) acc[nb] = (f32x4){0.f, 0.f, 0.f, 0.f};
#pragma unroll
        for (int ks = 0; ks < 4; ++ks) {
            float av[8]; { const LAS float* p = Am + (16 * mb + c) * DP_PITCH + 32 * ks + 8 * g4; const f32x4 a = *(const LAS f32x4*)p, b = *(const LAS f32x4*)(p + 4);
                av[0] = a.x; av[1] = a.y; av[2] = a.z; av[3] = a.w; av[4] = b.x; av[5] = b.y; av[6] = b.z; av[7] = b.w; }
            const bf16x8 af = pack8(av);
#pragma unroll
            for (int nb = 0; nb < 4; ++nb) { float bv[8]; const LAS float* p = Ks + (16 * nb + c) * DP_PITCH + 32 * ks + 8 * g4; const f32x4 a = *(const LAS f32x4*)p, b = *(const LAS f32x4*)(p + 4);
                bv[0] = a.x; bv[1] = a.y; bv[2] = a.z; bv[3] = a.w; bv[4] = b.x; bv[5] = b.y; bv[6] = b.z; bv[7] = b.w;
                acc[nb] = mfma16(af, pack8(bv), acc[nb]); }
        }
        if (wh == 0) {
#pragma unroll
            for (int d = 0; d < 2; ++d) { const LAS float* Gd = Gs + d * 64; const LAS float* Bd = Bs + d * 64; LAS float* Ld = Ls + d * 64 * DP_LP;
#pragma unroll
                for (int r = 0; r < 4; ++r) { const int i = 16 * mb + 4 * g4 + r, s = d ? 63 - i : i; const float gs = Gd[s], bs = Bd[s];
#pragma unroll
                    for (int nb = 0; nb < 4; ++nb) { const int ip = 16 * nb + c, sp = d ? 63 - ip : ip;
                        Ld[s * DP_LP + sp] = s > sp ? bs * acc[nb][r] * __expf(gs - Gd[sp]) : 0.f; } } }
        } else {
#pragma unroll
            for (int d = 0; d < 2; ++d) { const LAS float* Gd = Gs + d * 64; LAS bf16* Qd = QKi + d * 4096;
#pragma unroll
                for (int r = 0; r < 4; ++r) { const int i = 16 * mb + 4 * g4 + r, s = d ? 63 - i : i; const float gs = Gd[s];
#pragma unroll
                    for (int nb = 0; nb < 4; ++nb) { const int ip = 16 * nb + c, sp = d ? 63 - ip : ip;
                        const float qk = s >= sp ? acc[nb][r] * __expf(gs - Gd[sp]) : 0.f;
                        const int lp = ((sp & 15) >> 2) * 16 + (s & 15), jp = 4 * ((sp >> 4) & 1) + (sp & 3);
                        Qd[(((s >> 4) * 2 + (sp >> 5)) * 64 + lp) * 8 + jp] = (bf16)f2bf(qk); } } }
        }
    }
    WG_BAR();
    if (wave < 2) {
        const int d = wave; LAS float* Ld = Ls + d * 64 * DP_LP; int ln = lane; asm volatile("" : "+v"(ln));
        float X[64];
#pragma unroll
        for (int s = 0; s < 64; ++s) X[s] = 0.f;
#pragma unroll
        for (int s = 0; s < 64; ++s) { float a0 = (s == ln) ? 1.f : 0.f, a1 = 0.f, a2 = 0.f, a3 = 0.f;
#pragma unroll
            for (int j4 = 0; j4 < (s + 3) / 4; ++j4) { const f32x4 lv = *(const LAS f32x4*)(Ld + s * DP_LP + 4 * j4);
                if (4 * j4 + 0 < s) a0 -= lv.x * X[4 * j4 + 0];
                if (4 * j4 + 1 < s) a1 -= lv.y * X[4 * j4 + 1];
                if (4 * j4 + 2 < s) a2 -= lv.z * X[4 * j4 + 2];
                if (4 * j4 + 3 < s) a3 -= lv.w * X[4 * j4 + 3]; }
            X[s] = (a0 + a1) + (a2 + a3);
            Ld[s * DP_LP + ln] = X[s];
            asm volatile("" ::: "memory"); }
    }
    WG_BAR();
    {
        const int d = wave >> 2, q = wave & 3; int c = lane & 15, g4 = lane >> 4; asm volatile("" : "+v"(c), "+v"(g4));
        const LAS float* Td = Ls + d * 64 * DP_LP; const LAS float* Bd = Bs + d * 64; const LAS float* Ed = EGs + d * 64;
        const int cid = d ? cbase + (nch - 1 - nloc) : cidx; const size_t rec = dn_rec(d, cid, h);
        bf16x8 Th[4][2], Tl[4][2];
#pragma unroll
        for (int mb = 0; mb < 4; ++mb)
#pragma unroll
            for (int ks = 0; ks < 2; ++ks) { const LAS float* tp = Td + (16 * mb + c) * DP_LP + 32 * ks + 8 * g4; const f32x4 a = *(const LAS f32x4*)tp, b2 = *(const LAS f32x4*)(tp + 4);
                float v[8] = {a.x, a.y, a.z, a.w, b2.x, b2.y, b2.z, b2.w}, lo[8]; const bf16x8 hi = pack8(v); float hf[8]; unpack8(__builtin_bit_cast(u32x4, hi), hf);
#pragma unroll
                for (int e = 0; e < 8; ++e) lo[e] = v[e] - hf[e];
                Th[mb][ks] = hi; Tl[mb][ks] = pack8(lo); }
#pragma unroll
        for (int tt = 0; tt < 2; ++tt) { const int nt = 2 * q + tt, col = 16 * nt + c;
            f32x4 ua[4];
#pragma unroll
            for (int mb = 0; mb < 4; ++mb) ua[mb] = (f32x4){0.f, 0.f, 0.f, 0.f};
#pragma unroll
            for (int ks = 0; ks < 2; ++ks) { float bv[8];
#pragma unroll
                for (int e = 0; e < 8; ++e) { const int sp = 32 * ks + 8 * g4 + e, i = d ? 63 - sp : sp; bv[e] = Bd[sp] * Vs[i * DP_PITCH + col]; }
                const bf16x8 bf = pack8(bv);
#pragma unroll
                for (int mb = 0; mb < 4; ++mb) { ua[mb] = mfma16(Th[mb][ks], bf, ua[mb]); ua[mb] = mfma16(Tl[mb][ks], bf, ua[mb]); } }
            bf16x8* ug = (bf16x8*)(WSP(unsigned char, WS_DNU) + rec * 16384) + (nt * 2) * 64 + lane;
#pragma unroll
            for (int j = 0; j < 2; ++j) { float v[8] = {ua[2 * j][0], ua[2 * j][1], ua[2 * j][2], ua[2 * j][3], ua[2 * j + 1][0], ua[2 * j + 1][1], ua[2 * j + 1][2], ua[2 * j + 1][3]}; ug[j * 64] = pack8(v); } }
        { f32x4 wa[2][4];
#pragma unroll
          for (int tt = 0; tt < 2; ++tt)
#pragma unroll
              for (int nb = 0; nb < 4; ++nb) wa[tt][nb] = (f32x4){0.f, 0.f, 0.f, 0.f};
#pragma unroll
          for (int tt = 0; tt < 2; ++tt) { const int dk = 16 * (2 * q + tt) + c;
#pragma unroll
              for (int ks = 0; ks < 2; ++ks) { float av[8];
#pragma unroll
                  for (int e = 0; e < 8; ++e) { const int sp = 32 * ks + 8 * g4 + e, i = d ? 63 - sp : sp; av[e] = Bd[sp] * Ed[sp] * Ks[i * DP_PITCH + dk]; }
                  const bf16x8 af = pack8(av);
#pragma unroll
                  for (int nb = 0; nb < 4; ++nb) { wa[tt][nb] = mfma16(af, Th[nb][ks], wa[tt][nb]); wa[tt][nb] = mfma16(af, Tl[nb][ks], wa[tt][nb]); } } }
          bf16x8* wg = (bf16x8*)(WSP(unsigned char, WS_DNW) + rec * 16384) + lane;
#pragma unroll
          for (int nb = 0; nb < 4; ++nb) { float v[8] = {wa[0][nb][0], wa[0][nb][1], wa[0][nb][2], wa[0][nb][3], wa[1][nb][0], wa[1][nb][1], wa[1][nb][2], wa[1][nb][3]}; wg[(nb * 4 + q) * 64] = pack8(v); } }
    }
    {
        for (int ci = tid; ci < 1024; ci += NTHR) { const int d = ci >> 9, cc = ci & 511; const int cid = d ? cbase + (nch - 1 - nloc) : cidx;
            ((u32x4*)(WSP(unsigned char, WS_DNQK) + dn_rec(d, cid, h) * 8192))[cc] = ((const LAS u32x4*)(C.lds + DP_QK + d * 8192))[cc]; }
        for (int ci = tid; ci < 2048; ci += NTHR) { const int d = ci >> 10, cc = ci & 1023, mb = cc >> 8, ks = (cc >> 6) & 3, lp = cc & 63, c = lp & 15, g4 = lp >> 4;
            const int s = 16 * mb + c, i = d ? 63 - s : s; const float e = EGs[d * 64 + s];
            const LAS float* p = Qs + i * DP_PITCH + 32 * ks + 4 * g4; const f32x4 a = *(const LAS f32x4*)p, b = *(const LAS f32x4*)(p + 16);
            float v[8] = {a.x * e, a.y * e, a.z * e, a.w * e, b.x * e, b.y * e, b.z * e, b.w * e};
            const int cid = d ? cbase + (nch - 1 - nloc) : cidx;
            ((bf16x8*)(WSP(unsigned char, WS_DNQG) + dn_rec(d, cid, h) * 16384))[cc] = pack8(v); }
        for (int ci = tid; ci < 2048; ci += NTHR) { const int d = ci >> 10, cc = ci & 1023, tt = cc >> 7, ks2 = (cc >> 6) & 1, lp = cc & 63, c = lp & 15, g4 = lp >> 4;
            float v[8];
#pragma unroll
            for (int j = 0; j < 8; ++j) { const int s = 32 * ks2 + 16 * (j >> 2) + 4 * g4 + (j & 3), i = d ? 63 - s : s; v[j] = Ks[i * DP_PITCH + 16 * tt + c] * EGRs[d * 64 + s]; }
            const int cid = d ? cbase + (nch - 1 - nloc) : cidx;
            ((bf16x8*)(WSP(unsigned char, WS_DNKDT) + dn_rec(d, cid, h) * 16384))[cc] = pack8(v); }
    }
    WG_BAR();
}

constexpr int SG_VT = 0, SG_VPITCH = 136;
__device__ __forceinline__ void sg_unit(Ctx& C, int l, int cb, int h) {
    LAS bf16* vT = (LAS bf16*)(C.lds + SG_VT);
    const bf16* P = WSP(bf16, WS_P); bf16* Y = WSP(bf16, WS_Y);
    const int lane = C.lane, wave = C.wave, r0 = cb * 128;
    const float* lg = INP(12) + l * 512; const float* lb = INP(13) + l * 512;
    for (int q = 0; q < 16; ++q) { const int j = 16 * wave + q; float v[8];
        unpack8(*(const u32x4*)(P + (size_t)(r0 + j) * NIN + PSGV + 8 * lane), v);
        float s = 0.f;
#pragma unroll
        for (int c = 0; c < 8; ++c) { v[c] = gelu_tanh(v[c]); s += v[c]; }
        const float mu = wave_sum(s) * (1.f / 512.f); float s2 = 0.f;
#pragma unroll
        for (int c = 0; c < 8; ++c) { v[c] -= mu; s2 += v[c] * v[c]; }
        const float rs = rsqrtf(wave_sum(s2) * (1.f / 512.f) + EPS);
        if ((lane >> 4) == h) { const int d0 = 8 * (lane & 15);
#pragma unroll
            for (int c = 0; c < 8; ++c) vT[(d0 + c) * SG_VPITCH + j] = (bf16)f2bf(v[c] * rs * lg[128 * h + d0 + c] + lb[128 * h + d0 + c]); } }
    WG_BAR();
    const int c = lane & 15, g4 = lane >> 4;
    const float* W = INP(14) + ((size_t)(l * 4 + h) * 128 + 16 * wave + c) * 128;
    f32x4 acc[8];
#pragma unroll
    for (int nb = 0; nb < 8; ++nb) acc[nb] = (f32x4){0.f, 0.f, 0.f, 0.f};
#pragma unroll
    for (int ks = 0; ks < 4; ++ks) { const f32x4 a = *(const f32x4*)(W + 32 * ks + 8 * g4), b = *(const f32x4*)(W + 32 * ks + 8 * g4 + 4);
        float av[8] = {a.x, a.y, a.z, a.w, b.x, b.y, b.z, b.w}; const bf16x8 af = pack8(av);
#pragma unroll
        for (int nb = 0; nb < 8; ++nb) { const bf16x8 bfr = *(const LAS bf16x8*)(vT + (16 * nb + c) * SG_VPITCH + 32 * ks + 8 * g4); acc[nb] = mfma16(af, bfr, acc[nb]); } }
    const float* bs = INP(15) + (l * 4 + h) * 128;
#pragma unroll
    for (int r = 0; r < 4; ++r) { const int i = 16 * wave + 4 * g4 + r; const float bi = bs[i]; const size_t row = (size_t)(r0 + i);
#pragma unroll
        for (int nb = 0; nb < 8; ++nb) { const int d = 16 * nb + c; const float u = gelu_tanh(bf2f(P[row * NIN + PSGU + 128 * h + d]));
            Y[row * D + 512 + 128 * h + d] = (bf16)f2bf(u * (acc[nb][r] + bi)); } }
    WG_BAR();
}

constexpr int PL_PITCH = 132, PL_BUF = 80 * PL_PITCH;
__device__ __forceinline__ void pool_unit(Ctx& C, int l, int cidx, int g) {
    const bf16* P = WSP(bf16, WS_P); bf16* Y = WSP(bf16, WS_Y); const bf16* PW = WSP(bf16, WS_PWT) + (size_t)(l * 4 + g) * 128 * 128;
    LAS float* X = (LAS float*)C.lds; LAS float* B0 = X + PL_BUF; LAS float* B1 = B0 + PL_BUF;
    const int lane = C.lane, wave = C.wave, c = lane & 15, g4 = lane >> 4, mb = wave & 3, nh = wave >> 2;
    const int r0 = cidx * 64; int sbase, T, t0, mv; rowinfo(r0, sbase, T, t0, mv);
    for (int idx = C.tid; idx < 80 * 16; idx += NTHR) { const int q = idx >> 4, oc = idx & 15, t = t0 + q - 8; float v[8];
        if (t >= 0 && t < T) unpack8(*(const u32x4*)(P + (size_t)(sbase + t) * NIN + PPOOL + 128 * g + 8 * oc), v);
        else {
#pragma unroll
            for (int cc = 0; cc < 8; ++cc) v[cc] = 0.f; }
        LAS float* d = X + q * PL_PITCH + 8 * oc; *(LAS f32x4*)d = (f32x4){v[0], v[1], v[2], v[3]}; *(LAS f32x4*)(d + 4) = (f32x4){v[4], v[5], v[6], v[7]}; }
    WG_BAR();
    const LAS float* src = X; LAS float* dst = B0;
    for (int pass = 0, w = 1; pass <= g; ++pass, w <<= 1) {
        for (int idx = C.tid; idx < (80 - w) * 32; idx += NTHR) { const int r = idx >> 5, c4 = idx & 31;
            *(LAS f32x4*)(dst + r * PL_PITCH + 4 * c4) = *(const LAS f32x4*)(src + r * PL_PITCH + 4 * c4) + *(const LAS f32x4*)(src + (r + w) * PL_PITCH + 4 * c4); }
        WG_BAR();
        src = dst; dst = (dst == B0) ? B1 : B0;
    }
    const int i = 16 * mb + c, t = t0 + i, hw = 1 << g;
    const int lo = t - hw < 0 ? 0 : t - hw, hi = t + hw > T ? T : t + hw; const float inv = 1.f / (float)(hi - lo);
    f32x4 acc[4];
#pragma unroll
    for (int nb = 0; nb < 4; ++nb) acc[nb] = (f32x4){0.f, 0.f, 0.f, 0.f};
#pragma unroll
    for (int ks = 0; ks < 4; ++ks) { const LAS float* sp = src + (i + 8 - hw) * PL_PITCH + 32 * ks + 8 * g4; const LAS float* xp = X + (i + 8) * PL_PITCH + 32 * ks + 8 * g4;
        const f32x4 s0 = *(const LAS f32x4*)sp, s1 = *(const LAS f32x4*)(sp + 4), x0 = *(const LAS f32x4*)xp, x1 = *(const LAS f32x4*)(xp + 4);
        float s[8] = {s0.x * inv - x0.x, s0.y * inv - x0.y, s0.z * inv - x0.z, s0.w * inv - x0.w, s1.x * inv - x1.x, s1.y * inv - x1.y, s1.z * inv - x1.z, s1.w * inv - x1.w};
        const bf16x8 af = pack8(s);
#pragma unroll
        for (int nb = 0; nb < 4; ++nb) { const bf16x8 bfr = *(const bf16x8*)(PW + (size_t)(16 * (4 * nh + nb) + c) * 128 + 32 * ks + 8 * g4); acc[nb] = mfma16(af, bfr, acc[nb]); } }
    const float* psc = INP(17) + l * 512 + 128 * g;
#pragma unroll
    for (int nb = 0; nb < 4; ++nb) { const int e = 16 * (4 * nh + nb) + c; const float sc = psc[e];
#pragma unroll
        for (int r = 0; r < 4; ++r) Y[(size_t)(r0 + 16 * mb + 4 * g4 + r) * D + 1024 + 128 * g + e] = (bf16)f2bf(acc[nb][r] * sc); }
    WG_BAR();
}

constexpr int CV_PITCH = 132;
__device__ __forceinline__ void conf_unit(Ctx& C, int l, int cidx, int cq) {
    const bf16* P = WSP(bf16, WS_P); float* H = WSP(float, WS_CVH); LAS float* gl = (LAS float*)C.lds;
    const int r0 = cidx * 64; int sbase, T, t0, mv; rowinfo(r0, sbase, T, t0, mv);
    for (int idx = C.tid; idx < 94 * 16; idx += NTHR) { const int q = idx >> 4, oc = idx & 15, t = t0 + q - 15; float v[8];
        if (t >= 0 && t < T) { const bf16* pr = P + (size_t)(sbase + t) * NIN + 128 * cq + 8 * oc; float a[8], g[8];
            unpack8(*(const u32x4*)(pr + PCVA), a); unpack8(*(const u32x4*)(pr + PCVG), g);
#pragma unroll
            for (int c = 0; c < 8; ++c) v[c] = a[c] * sigm(g[c]); }
        else {
#pragma unroll
            for (int c = 0; c < 8; ++c) v[c] = 0.f; }
        LAS float* d = gl + q * CV_PITCH + 8 * oc; *(LAS f32x4*)d = (f32x4){v[0], v[1], v[2], v[3]}; *(LAS f32x4*)(d + 4) = (f32x4){v[4], v[5], v[6], v[7]}; }
    const int chl = C.tid & 127, ch = 128 * cq + chl, grp = C.tid >> 7;
    float w[31];
#pragma unroll
    for (int k = 0; k < 31; ++k) w[k] = INP(18)[((size_t)l * 31 + k) * 512 + ch];
    const float cb = INP(19)[l * 512 + ch];
    WG_BAR();
    float glu[46];
#pragma unroll
    for (int q = 0; q < 46; ++q) glu[q] = gl[(16 * grp + q) * CV_PITCH + chl];
#pragma unroll
    for (int i = 0; i < 16; ++i) { float a = cb;
#pragma unroll
        for (int k = 0; k < 31; ++k) a += w[k] * glu[i + k];
        H[(size_t)(r0 + 16 * grp + i) * 512 + ch] = a; }
    WG_BAR();
}

__device__ __forceinline__ void p_mixers(Ctx& C, int l) {
    const int nchk = l == 0 ? NCH : MX / 64;
    const int nb = (STATIC_FILL && C.G == 256) ? DN_BLOCKS : C.G;
    if (C.bid < nb) for (int u = C.bid; u < NCH * 4; u += nb) dnprep_unit(C, l, u >> 2, u & 3);
}
__device__ __forceinline__ void p_mixers_bcd(Ctx& C, int l, int vb, int nb) {
    const int nchk = l == 0 ? NCH : MX / 64;
    const int o2 = (nchk * 4) % nb, o3 = (o2 + (nchk / 2) * 4) % nb;
    for (int u = vb; u < nchk * 4; u += nb) conf_unit(C, l, u >> 2, u & 3);
    for (int u = (vb + nb - o2) % nb; u < (nchk / 2) * 4; u += nb) sg_unit(C, l, u >> 2, u & 3);
    for (int u = (vb + nb - o3) % nb; u < nchk * 4; u += nb) pool_unit(C, l, u >> 2, u & 3);
}

constexpr int SC_SLOT = 58368, SC_U = 2 * SC_SLOT;
static_assert(SC_U + 16384 <= LDS_BARW, "scan LDS map");
__device__ __forceinline__ void p_scan(Ctx& C, int l) {
    if (C.bid >= 32) { const int nbcd = (STATIC_FILL && C.G == 256) ? SCAN_BCD_BLOCKS : C.G - 32;
        if (C.G > 32 && C.bid - 32 < nbcd) { p_mixers_bcd(C, l, C.bid - 32, nbcd);
            if (DENSE_IN_SCAN && STATIC_FILL && C.G == 256 && l == 0) {
                VM_WAIT(); __syncthreads();
                LAS float* scr = (LAS float*)(C.lds + C.wave * 16896);
                for (int it = (C.bid - 32) * NWAVE + C.wave; it < BG_MOE; it += nbcd * NWAVE) tr_dispatch(C, IT_PRO + it, scr); } }
        return; }
    const int b = C.bid >> 3, h = (C.bid >> 1) & 3, dir = C.bid & 1, lane = C.lane, w = C.wave, c = lane & 15, g4 = lane >> 4;
    float* O = WSP(float, WS_O) + (size_t)dir * MT * 512;
    f32x4 S[8];
#pragma unroll
    for (int t = 0; t < 8; ++t) S[t] = (f32x4){0.f, 0.f, 0.f, 0.f};
    auto rec_of = [&](int st) -> size_t { const int rb = st < 4 ? MX + b * TC : b * TX, n = st < 4 ? st : st - 4; return dn_rec(dir, (rb >> 6) + n, h); };
#define SC_ISSUE(st_, SL) do { const size_t rec_ = rec_of(st_); \
        _Pragma("unroll") for (int q = 0; q < 7; ++q) { const int ch = w + 8 * q; \
            const unsigned char* src = ch < 16 ? WSP(unsigned char, WS_DNW) + rec_ * 16384 + ch * 1024 : ch < 32 ? WSP(unsigned char, WS_DNQG) + rec_ * 16384 + (ch - 16) * 1024 \
                                     : ch < 48 ? WSP(unsigned char, WS_DNKDT) + rec_ * 16384 + (ch - 32) * 1024 : WSP(unsigned char, WS_DNQK) + rec_ * 8192 + (ch - 48) * 1024; \
            __builtin_amdgcn_global_load_lds((const unsigned*)(src + lane * 16), (LAS unsigned*)(C.lds + (SL) * SC_SLOT + w * 1024 + q * 8192), 16, 0, 0); } \
        if (w == 0) __builtin_amdgcn_global_load_lds((const unsigned*)(WSP(unsigned char, WS_EGL) + rec_ * 16), (LAS unsigned*)(C.lds + (SL) * SC_SLOT + 57344), 16, 0, 0); } while (0)
#define SC_ISSUE_U(st_) do { const unsigned char* Us_ = WSP(unsigned char, WS_DNU) + rec_of(st_) * 16384 + w * 2048 + lane * 16; \
        _Pragma("unroll") for (int j = 0; j < 2; ++j) __builtin_amdgcn_global_load_lds((const unsigned*)(Us_ + j * 1024), (LAS unsigned*)(C.lds + SC_U + w * 2048 + j * 1024), 16, 0, 0); } while (0)
#define SC_STEP(st_, SL) do { const int st = (st_); \
        if (st == 0) asm volatile("s_waitcnt vmcnt(0)" ::: "memory"); else asm volatile("s_waitcnt vmcnt(16)" ::: "memory"); \
        __builtin_amdgcn_s_barrier(); asm volatile("" ::: "memory"); \
        if (st + 1 < 36) SC_ISSUE(st + 1, 1 - (SL)); \
        const LAS bf16x8* Wf = (const LAS bf16x8*)(C.lds + (SL) * SC_SLOT) + lane; const LAS bf16x8* QGf = Wf + 1024; const LAS bf16x8* KDf = Wf + 2048; const LAS bf16x8* QKf = Wf + 3072; \
        const float egl = *(const LAS float*)(C.lds + (SL) * SC_SLOT + 57344); \
        const int rbase = st < 4 ? MX + b * TC + 64 * st : b * TX + 64 * (st - 4); \
        bf16x8 Sb[4]; \
        _Pragma("unroll") for (int ks = 0; ks < 4; ++ks) { float v[8] = {S[2 * ks][0], S[2 * ks][1], S[2 * ks][2], S[2 * ks][3], S[2 * ks + 1][0], S[2 * ks + 1][1], S[2 * ks + 1][2], S[2 * ks + 1][3]}; Sb[ks] = pack8(v); } \
        f32x4 vn[4], oacc[4]; \
        _Pragma("unroll") for (int mb = 0; mb < 4; ++mb) { f32x4 a = (f32x4){0.f, 0.f, 0.f, 0.f}, o = (f32x4){0.f, 0.f, 0.f, 0.f}; \
            _Pragma("unroll") for (int ks = 0; ks < 4; ++ks) { a = mfma16(Wf[(mb * 4 + ks) * 64], Sb[ks], a); o = mfma16(QGf[(mb * 4 + ks) * 64], Sb[ks], o); } \
            vn[mb] = a; oacc[mb] = o; } \
        _Pragma("unroll") for (int j = 0; j < 2; ++j) { float uv[8]; unpack8(*(const LAS u32x4*)(C.lds + SC_U + w * 2048 + j * 1024 + lane * 16), uv); \
            vn[2 * j] = (f32x4){uv[0], uv[1], uv[2], uv[3]} - vn[2 * j]; vn[2 * j + 1] = (f32x4){uv[4], uv[5], uv[6], uv[7]} - vn[2 * j + 1]; } \
        asm volatile("s_waitcnt lgkmcnt(0)" ::: "memory"); __builtin_amdgcn_s_barrier(); asm volatile("" ::: "memory"); \
        if (st + 1 < 36) SC_ISSUE_U(st + 1); \
        bf16x8 Vb[2]; \
        _Pragma("unroll") for (int k2 = 0; k2 < 2; ++k2) { float v[8] = {vn[2 * k2][0], vn[2 * k2][1], vn[2 * k2][2], vn[2 * k2][3], vn[2 * k2 + 1][0], vn[2 * k2 + 1][1], vn[2 * k2 + 1][2], vn[2 * k2 + 1][3]}; Vb[k2] = pack8(v); } \
        _Pragma("unroll") for (int t = 0; t < 8; ++t) { f32x4 a = S[t] * egl; \
            _Pragma("unroll") for (int k2 = 0; k2 < 2; ++k2) a = mfma16(KDf[(t * 2 + k2) * 64], Vb[k2], a); \
            S[t] = a; } \
        _Pragma("unroll") for (int mb = 0; mb < 4; ++mb) { \
            _Pragma("unroll") for (int k2 = 0; k2 < 2; ++k2) oacc[mb] = mfma16(QKf[(mb * 2 + k2) * 64], Vb[k2], oacc[mb]); \
            _Pragma("unroll") for (int r = 0; r < 4; ++r) O[(size_t)(rbase + 16 * mb + 4 * g4 + r) * 512 + 128 * h + 16 * w + c] = oacc[mb][r]; } } while (0)
    SC_ISSUE(0, 0); SC_ISSUE_U(0);
#pragma unroll 1
    for (int s2 = 0; s2 < 36; s2 += 2) { SC_STEP(s2, 0); SC_STEP(s2 + 1, 1); }
    asm volatile("s_waitcnt vmcnt(0)" ::: "memory");
#undef SC_ISSUE
#undef SC_ISSUE_U
#undef SC_STEP
}

__device__ __forceinline__ void p_ghn(Ctx& C, int l) {
    const int nrows = l == 0 ? MT : MX, lane = C.lane; const float* O = WSP(float, WS_O); const bf16* P = WSP(bf16, WS_P); bf16* Y = WSP(bf16, WS_Y);
    const float* gn = INP(11) + l * 128 + 8 * (lane & 15);
    for (int row = C.bid * NWAVE + C.wave; row < nrows; row += C.G * NWAVE) {
        const int rb = dirrow(row, 1);
        const f32x4* pf = (const f32x4*)(O + (size_t)row * 512 + 8 * lane); const f32x4* pb = (const f32x4*)(O + ((size_t)MT + rb) * 512 + 8 * lane);
        const f32x4 a = pf[0] + pb[0], b2 = pf[1] + pb[1];
        float o[8] = {a.x, a.y, a.z, a.w, b2.x, b2.y, b2.z, b2.w}, z[8]; float ss = 0.f;
#pragma unroll
        for (int c = 0; c < 8; ++c) ss += o[c] * o[c];
        const float rs = rsqrtf(sum16(ss) * (1.f / 128.f) + EPS);
        unpack8(*(const u32x4*)(P + (size_t)row * NIN + PZ + 8 * lane), z);
#pragma unroll
        for (int c = 0; c < 8; ++c) o[c] = o[c] * rs * gn[c] * silu(z[c]);
        *(bf16x8*)(Y + (size_t)row * D + 8 * lane) = pack8(o);
        { const float* hp = WSP(float, WS_CVH) + (size_t)row * 512 + 8 * lane; const f32x4 a = *(const f32x4*)hp, b2 = *(const f32x4*)(hp + 4);
          float v[8] = {a.x, a.y, a.z, a.w, b2.x, b2.y, b2.z, b2.w}; float s = 0.f;
#pragma unroll
          for (int c = 0; c < 8; ++c) s += v[c];
          const float mu = wave_sum(s) * (1.f / 512.f); float s2 = 0.f;
#pragma unroll
          for (int c = 0; c < 8; ++c) { v[c] -= mu; s2 += v[c] * v[c]; }
          const float rs = rsqrtf(wave_sum(s2) * (1.f / 512.f) + EPS);
          const float* lg = INP(20) + l * 512 + 8 * lane; const float* lb = INP(21) + l * 512 + 8 * lane;
#pragma unroll
          for (int c = 0; c < 8; ++c) v[c] = silu(v[c] * rs * lg[c] + lb[c]);
          *(bf16x8*)(Y + (size_t)row * D + 1536 + 8 * lane) = pack8(v); }
    }
}

__device__ __forceinline__ void p_moe_gather(Ctx& C) {
    int* R = WSP(int, WS_ROUTE); const unsigned* ctl = WSP(unsigned, WS_CTL);
    LAS int* offs = (LAS int*)C.lds;
    if (C.tid == 0) { int o = 0, nt = 0;
        for (int e = 0; e < 8; ++e) { const int cnt = (int)ctl[CW_CNT + 64 * e], tl = (cnt + 255) >> 8; offs[e] = o;
            if (C.bid == 0) { R[R_TB + e] = nt; for (int q = 0; q < tl; ++q) R[R_TILEE + nt + q] = e; }
            nt += tl; o += tl << 8; }
        if (C.bid == 0) { R[R_NT] = nt; R[R_TB + 8] = nt; } }
    WG_BAR();
    const bf16* AN = WSP(bf16, WS_AN); bf16* AS = WSP(bf16, WS_AS);
    for (int tok = C.bid * NWAVE + C.wave; tok < MX; tok += C.G * NWAVE) {
        const int p0 = offs[R[R_TE + 2 * tok]] + R[R_RANK + 2 * tok], p1 = offs[R[R_TE + 2 * tok + 1]] + R[R_RANK + 2 * tok + 1];
        if (C.lane == 0) { R[R_POS + 2 * tok] = p0; R[R_POS + 2 * tok + 1] = p1; }
        if (MOE_FP8) {
            const u32x4* src = (const u32x4*)(AN + (size_t)tok * D) + 4 * C.lane; float f[32];
#pragma unroll
            for (int j = 0; j < 4; ++j) unpack8(src[j], f + 8 * j);
            u32x4 o[2];
#pragma unroll
            for (int j = 0; j < 2; ++j) { const float* q = f + 16 * j;
                o[j].x = pk4_fp8(clamp448(q[0]), clamp448(q[1]), clamp448(q[2]), clamp448(q[3])); o[j].y = pk4_fp8(clamp448(q[4]), clamp448(q[5]), clamp448(q[6]), clamp448(q[7]));
                o[j].z = pk4_fp8(clamp448(q[8]), clamp448(q[9]), clamp448(q[10]), clamp448(q[11])); o[j].w = pk4_fp8(clamp448(q[12]), clamp448(q[13]), clamp448(q[14]), clamp448(q[15])); }
            u32x4* d0 = (u32x4*)((unsigned char*)AS + (size_t)p0 * D) + 2 * C.lane; u32x4* d1 = (u32x4*)((unsigned char*)AS + (size_t)p1 * D) + 2 * C.lane;
            d0[0] = o[0]; d0[1] = o[1]; d1[0] = o[0]; d1[1] = o[1];
        } else {
        const u32x4* src = (const u32x4*)(AN + (size_t)tok * D) + C.lane; u32x4* d0 = (u32x4*)(AS + (size_t)p0 * D) + C.lane; u32x4* d1 = (u32x4*)(AS + (size_t)p1 * D) + C.lane;
#pragma unroll
        for (int j = 0; j < 4; ++j) { u32x4 v = src[64 * j];
            if (FP8_EMU) { float f[8]; unpack8(v, f);
#pragma unroll
                for (int q = 0; q < 8; ++q) f[q] = rne_e4m3(f[q]);
                v = __builtin_bit_cast(u32x4, pack8(f)); }
            d0[64 * j] = v; d1[64 * j] = v; } }
    }
}

__device__ __forceinline__ void p_final(Ctx& C, float* out) {
    const int* R = WSP(int, WS_ROUTE); const float* Rf = WSP(float, WS_ROUTE); const float* XS = WSP(float, WS_XS); const bf16* OS = WSP(bf16, WS_OUTS);
    const float* mod = WSP(float, WS_MODV) + (size_t)5 * 12288; const int lane = C.lane;
    for (int tok = C.bid * NWAVE + C.wave; tok < MX; tok += C.G * NWAVE) {
        const int p0 = R[R_POS + 2 * tok], p1 = R[R_POS + 2 * tok + 1]; const float g0 = Rf[R_TG + 2 * tok], g1 = Rf[R_TG + 2 * tok + 1];
        const f32x4* xp = (const f32x4*)(XS + (size_t)tok * D) + lane;
        const f32x4* gf = (const f32x4*)(mod + (size_t)(tok >> 11) * 12288 + 10240) + lane; const f32x4* fg = (const f32x4*)INP(32) + lane;
        f32x4 x[8]; float ss = 0.f;
        f32x4 e0[8], e1[8];
        if (p0 < 16384) { const u32x2* o = (const u32x2*)(OS + (size_t)p0 * D) + lane;
#pragma unroll
            for (int j = 0; j < 8; ++j) { const u32x2 w = o[64 * j]; e0[j] = (f32x4){bflo(w.x), bfhi(w.x), bflo(w.y), bfhi(w.y)}; }
        } else { const f32x4* q = (const f32x4*)(WSP(float, WS_PARTO) + (size_t)(p0 - 16384) * D) + lane;
#pragma unroll
            for (int j = 0; j < 8; ++j) e0[j] = (q[64 * j] + q[64 * j + (size_t)2048 * 512]) + (q[64 * j + (size_t)2 * 2048 * 512] + q[64 * j + (size_t)3 * 2048 * 512]); }
        if (p1 < 16384) { const u32x2* o = (const u32x2*)(OS + (size_t)p1 * D) + lane;
#pragma unroll
            for (int j = 0; j < 8; ++j) { const u32x2 w = o[64 * j]; e1[j] = (f32x4){bflo(w.x), bfhi(w.x), bflo(w.y), bfhi(w.y)}; }
        } else { const f32x4* q = (const f32x4*)(WSP(float, WS_PARTO) + (size_t)(p1 - 16384) * D) + lane;
#pragma unroll
            for (int j = 0; j < 8; ++j) e1[j] = (q[64 * j] + q[64 * j + (size_t)2048 * 512]) + (q[64 * j + (size_t)2 * 2048 * 512] + q[64 * j + (size_t)3 * 2048 * 512]); }
#pragma unroll
        for (int j = 0; j < 8; ++j) { x[j] = xp[64 * j] + gf[64 * j] * (e0[j] * g0 + e1[j] * g1); ss += (x[j].x * x[j].x + x[j].y * x[j].y) + (x[j].z * x[j].z + x[j].w * x[j].w); }
        const float rs = rsqrtf(wave_sum(ss) * (1.f / D) + EPS);
        f32x4* op = (f32x4*)(out + (size_t)tok * D) + lane;
#pragma unroll
        for (int j = 0; j < 8; ++j) op[64 * j] = x[j] * rs * fg[64 * j];
    }
}
}
namespace mk {
constexpr int NPHASE = 21;
struct Args { const float* in[33]; float* out; unsigned char* ws; int ph_lo, ph_hi; };
static_assert(sizeof(Args) == 35 * 8 + 8, "Args has no padding");

#ifdef ONLY_PHASE
#define IN(k) ((k) == ONLY_PHASE)
#else
#define IN(k) (lo <= (k) && (k) < hi)
#endif
__device__ __forceinline__ constexpr int bg_need(int k) { return k >= 18 ? NBG : k >= 15 ? BG_MOE : k >= 11 ? BG_WOUT1 : k >= 9 ? BG_WIN1 : k >= 8 ? BG_W2 : k >= 6 ? BG_W13 : 0; }
#ifndef BG_FILL_MASK
#define BG_FILL_MASK ((1 << 2) | (1 << 4) | (1 << 6) | (1 << 8) | (1 << 9) | (1 << 11) | (1 << 13))
#endif
#define SEAM(k) do { if (IN(k) && IN((k) + 1)) { if (BG_QUEUE) bg_work(C, bg_need((k) + 1), ((BG_FILL_MASK >> (k)) & 1) ? (k) : -1); xcd_barrier(bar); } } while (0)
constexpr int NMOE = 16 * IT_MW1 + 8 * IT_MW2;
#ifndef FILL_R
#define FILL_R 25, 24, 2, 45, 10, 25, 24
#endif
#ifndef FILL_R2
#define FILL_R2 24, 24
#endif
constexpr int fill_rounds[7] = {FILL_R}; constexpr int fill_rounds2[2] = {FILL_R2};
constexpr int FB2 = 228, FB4 = 32 + SCAN_BCD_BLOCKS, FB6 = 128, FB8 = 227, FB9 = 128, FB11 = 212, FB13 = 32 + SCAN_BCD_BLOCKS;
constexpr int FN2 = fill_rounds[0] * (256 - FB2) * 8, FN4 = fill_rounds[1] * (256 - FB4) * 8, FN6 = fill_rounds[2] * (256 - FB6) * 8, FN8 = fill_rounds[3] * (256 - FB8) * 8,
              FN9 = fill_rounds[4] * (256 - FB9) * 8, FN11 = fill_rounds[5] * (256 - FB11) * 8;
constexpr int FS2 = 0, FS4 = FS2 + FN2, FS6 = FS4 + FN4, FS8 = FS6 + FN6, FS9 = FS8 + FN8, FS11 = FS9 + FN9, FS13 = FS11 + FN11, FN13 = fill_rounds[6] * (256 - FB13) * 8 < NMOE - FS13 ? fill_rounds[6] * (256 - FB13) * 8 : NMOE - FS13, FS3 = FS13 + FN13, FN3 = fill_rounds2[0] * (256 - DN_BLOCKS) * 8 < NMOE - FS3 ? fill_rounds2[0] * (256 - DN_BLOCKS) * 8 : NMOE - FS3, FS12 = FS3 + FN3, FN12 = fill_rounds2[1] * (256 - DN_BLOCKS) * 8 < NMOE - FS12 ? fill_rounds2[1] * (256 - DN_BLOCKS) * 8 : NMOE - FS12, FS17 = FS12 + FN12, FN17 = NMOE - FS17;
static_assert(FN13 >= 0 && FN17 >= 0, "fill schedule exceeds the MoE items");
template <int l>
__device__ __forceinline__ void layer_body(Ctx& C, const XcdBarrier& bar, const int lo, const int hi) {
        const int pb = l == 0 ? 1 : 10;
        const float* mod = WSP(float, WS_MODV) + (size_t)l * 5 * 12288;
        if (IN(pb + 0)) { if constexpr (l == 0) p_norm<0>(C, 0); else p_norm<1>(C, 1); } SEAM(pb + 0);
        if (IN(pb + 1)) {
            pg8::EpiStoreBf16 E{WSP(bf16, WS_P), NIN, WSP(float, WS_ABF)};
            pg8::Gemm g{WSP(bf16, WS_AN), WSP(bf16, WS_WIN) + (size_t)l * NINP * D, MT, NINP, D};
            const bool ded = STATIC_FILL && C.G == 256;
            if constexpr (l == 0) { if (!ded || C.bid < FB2) { pg8::StaticOrder S; S.init(MT, NINP, ded ? FB2 : C.G, C.bid); pg8::gemm_phase<pg8::EpiStoreBf16, pg8::StaticOrder, true, true>(C.lds, g, S, E); }
                fill_static(C, FS2, FN2, FB2); }
            else { if (!ded || C.bid < FB11) { pg8::InProjL1Order S; S.init(ded ? FB11 : C.G, C.bid); pg8::gemm_phase<pg8::EpiStoreBf16, pg8::InProjL1Order, true, true>(C.lds, g, S, E); }
                fill_static(C, FS11, FN11, FB11); }
        } SEAM(pb + 1);
        if (IN(pb + 2)) { p_mixers(C, l); if constexpr (l == 0) fill_static(C, FS3, FN3, DN_BLOCKS); else fill_static(C, FS12, FN12, DN_BLOCKS); } SEAM(pb + 2);
        if (IN(pb + 3)) { p_scan(C, l); if constexpr (l == 0) fill_static(C, FS4, FN4, FB4); else fill_static(C, FS13, FN13, FB13); } SEAM(pb + 3);
        if (IN(pb + 4)) { p_ghn(C, l); } SEAM(pb + 4);
        if (IN(pb + 5)) {
            pg8::EpiResid E{WSP(float, WS_XS), mod, 4096, WSP(float, WS_PART), D / 4};
            pg8::Gemm g{WSP(bf16, WS_Y), WSP(bf16, WS_WOUT) + (size_t)l * D * D, l == 0 ? MT : MX, D, D};
            if constexpr (l == 0) { pg8::ResidOrder S; S.init(D, C.G, C.bid); pg8::gemm_phase<pg8::EpiResid, pg8::ResidOrder, true, true>(C.lds, g, S, E); fill_static(C, FS6, FN6, FB6); }
            else { pg8::StaticOrder S; S.init(MX, D, C.G, C.bid); pg8::gemm_phase<pg8::EpiResid, pg8::StaticOrder, true, true>(C.lds, g, S, E); }
        } SEAM(pb + 5);
        if (IN(pb + 6)) { if constexpr (l == 0) p_norm<2>(C, 0); else p_norm<3>(C, 1); } SEAM(pb + 6);
        if constexpr (l == 0) {
            if (IN(8)) {
                const bool ded = STATIC_FILL && C.G == 256;
                constexpr int KU = DENSE_FP8_UP ? D / 2 : D;
                pg8::Gemm g{WSP(bf16, WS_AN), WSP(bf16, WS_W13), MT, 2 * DFF, KU};
                if (!ded || C.bid < FB8) { pg8::StaticOrder S; S.init(MT, 2 * DFF, ded ? FB8 : C.G, C.bid);
                    if (DENSE_FP8_DN) { pg8::EpiSwiglu8 E{WSP(unsigned char, WS_HM), DFF, 1 << 20}; pg8::gemm_phase<pg8::EpiSwiglu8, pg8::StaticOrder, true, true, DENSE_FP8_UP != 0>(C.lds, g, S, E); }
                    else { pg8::EpiSwiglu E{WSP(bf16, WS_HM), DFF, 1 << 20}; pg8::gemm_phase<pg8::EpiSwiglu, pg8::StaticOrder, true, true, DENSE_FP8_UP != 0>(C.lds, g, S, E); } }
                fill_static(C, FS8, FN8, FB8);
            } SEAM(8);
            if (IN(9)) {
                constexpr int KD = DENSE_FP8_DN ? DFF / 2 : DFF;
                pg8::EpiResid E{WSP(float, WS_XS), mod, 10240, WSP(float, WS_PART), KD / 4};
                pg8::Gemm g{WSP(bf16, WS_HM), WSP(bf16, WS_W2), MT, D, KD};
                pg8::ResidOrder S; S.init(KD, C.G, C.bid);
                pg8::gemm_phase<pg8::EpiResid, pg8::ResidOrder, true, true, DENSE_FP8_DN != 0>(C.lds, g, S, E);
                fill_static(C, FS9, FN9, FB9);
            } SEAM(9);
        } else {
            if (IN(17)) { p_moe_gather(C); fill_static(C, FS17, FN17, 0); } SEAM(17);
            if (IN(18)) {
                const int* R = WSP(int, WS_ROUTE);
                pg8::MoeOrder S; S.init(R[R_NT], 56, R + R_TB, C.G, C.bid);
                if (MOE_FP8) { pg8::EpiSwiglu8 E{WSP(unsigned char, WS_HM), DFE, 56};
                    pg8::Gemm g{WSP(bf16, WS_AS), WSP(bf16, WS_MW13), MSORT, 2 * DFE * NE, D / 2};
                    pg8::gemm_phase<pg8::EpiSwiglu8, pg8::MoeOrder, true, true, true>(C.lds, g, S, E); }
                else { pg8::EpiSwiglu E{WSP(bf16, WS_HM), DFE, 56};
                    pg8::Gemm g{WSP(bf16, WS_AS), WSP(bf16, WS_MW13), MSORT, 2 * DFE * NE, D};
                    pg8::gemm_phase<pg8::EpiSwiglu, pg8::MoeOrder, true, true>(C.lds, g, S, E); }
            } SEAM(18);
            if (IN(19)) {
                const int* R = WSP(int, WS_ROUTE);
                pg8::EpiStoreF32 E{WSP(bf16, WS_OUTS), WSP(float, WS_PARTO), (MOE_FP8 ? DFE / 2 : DFE) / 4};
                if (MOE_FP8) { pg8::Gemm g{WSP(bf16, WS_HM), WSP(bf16, WS_MW2), MSORT, D * NE, DFE / 2};
                    pg8::MoeDownOrder S; S.init(R[R_NT], R + R_TB, DFE / 2, C.G, C.bid);
                    pg8::gemm_phase<pg8::EpiStoreF32, pg8::MoeDownOrder, true, true, true>(C.lds, g, S, E); }
                else { pg8::Gemm g{WSP(bf16, WS_HM), WSP(bf16, WS_MW2), MSORT, D * NE, DFE};
                    pg8::MoeDownOrder S; S.init(R[R_NT], R + R_TB, DFE, C.G, C.bid);
                    pg8::gemm_phase<pg8::EpiStoreF32, pg8::MoeDownOrder, true, true>(C.lds, g, S, E); }
            } SEAM(19);
        }
    }
__global__ void __launch_bounds__(NTHR, 2) fwd(Args a) {
    extern __shared__ __attribute__((aligned(16))) unsigned char lds_raw[];
    Ctx C;
    C.lds = (LAS unsigned char*)lds_raw;
    C.in = (CIN)__builtin_amdgcn_kernarg_segment_ptr();
    C.out = a.out; C.ws = a.ws; C.tid = threadIdx.x; C.lane = C.tid & 63; C.wave = __builtin_amdgcn_readfirstlane(C.tid >> 6); C.G = gridDim.x; C.bid = blockIdx.x;
    const int lo = a.ph_lo, hi = a.ph_hi;
    XcdBarrier bar; bar.bar = WSP(unsigned, WS_CTL) + CW_BAR; bar.x = 0; bar.st = (volatile LAS unsigned*)(C.lds + LDS_BARW);
    if (hi - lo > 1) {
        if (C.tid < 4) { ((volatile LAS unsigned*)(C.lds + LDS_BARW))[C.tid] = 0u; }
        __syncthreads();
        bar = xcd_barrier_post(WSP(unsigned, WS_CTL) + CW_BAR, (volatile LAS unsigned*)(C.lds + LDS_BARW));
    }
    if (IN(0)) { p_prologue(C); } SEAM(0);
    layer_body<0>(C, bar, lo, hi);
    layer_body<1>(C, bar, lo, hi);
    if (IN(20)) { p_final(C, C.out); }
}

static int g_grid = 0;
static inline bool setup(size_t ws_size, size_t need) {
    if (g_grid == 0) {
        if (ws_size < need) { fprintf(stderr, "kernel_launch: workspace too small: %zu < %zu\n", ws_size, need); g_grid = -1; return false; }
        int dev = 0, cus = 0, per_cu = 0;
        if (hipGetDevice(&dev) != hipSuccess || hipDeviceGetAttribute(&cus, hipDeviceAttributeMultiprocessorCount, dev) != hipSuccess) { g_grid = -1; return false; }
        if (hipFuncSetAttribute((const void*)fwd, hipFuncAttributeMaxDynamicSharedMemorySize, LDS_BYTES) != hipSuccess) { fprintf(stderr, "kernel_launch: hipFuncSetAttribute failed\n"); g_grid = -1; return false; }
        if (hipOccupancyMaxActiveBlocksPerMultiprocessor(&per_cu, (const void*)fwd, NTHR, LDS_BYTES) != hipSuccess || per_cu < 1) { fprintf(stderr, "kernel_launch: occupancy query says %d\n", per_cu); }
        (void)hipGetLastError();
        g_grid = cus;
    }
    return g_grid > 0;
}
static inline void launch(void* const* d_in, float* out, void* d_ws, int lo, int hi, hipStream_t stream) {
    Args a{};
    for (int i = 0; i < 33; ++i) a.in[i] = (const float*)d_in[i];
    a.out = out; a.ws = (unsigned char*)d_ws; a.ph_lo = lo; a.ph_hi = hi;
    hipLaunchKernelGGL(fwd, dim3(g_grid), dim3(NTHR), LDS_BYTES, stream, a);
}
}
#ifndef MK_DEBUG
#define MK_DEBUG 0
#endif
#ifndef MK_ONE_LAUNCH
#define MK_ONE_LAUNCH 0
#endif
#if MK_DEBUG
#ifndef DBG_LAYER
#define DBG_LAYER 0
#endif
namespace dbg {
using namespace mk;
constexpr size_t SNAP = (WS_END + 4095) & ~(size_t)4095;
constexpr size_t S_ERR = SNAP;
constexpr size_t S_MOD = S_ERR + 4096;
constexpr size_t S_AN = S_MOD + al((size_t)10 * 12288 * 2);
constexpr size_t S_AB = S_AN + al((size_t)MT * D * 2);
constexpr size_t S_P = S_AB + al((size_t)MT * 16 * 2);
constexpr size_t S_O = S_P + al((size_t)MT * NIN * 2);
constexpr size_t S_Y = S_O + al((size_t)2 * MT * 512 * 2);
constexpr size_t S_XM = S_Y + al((size_t)MT * D * 2);
constexpr size_t S_AF = S_XM + al((size_t)MT * D * 2);
constexpr size_t S_XE = S_AF + al((size_t)MT * D * 2);
constexpr size_t S_OUT2 = S_XE + al((size_t)MT * D * 2);
constexpr size_t S_END = S_OUT2 + al((size_t)MX * D * 4);
constexpr int NCK = 12;
__global__ void k_snap(const float* src, size_t lds_, bf16* dst, size_t ldd, int rows, int cols, int mode) {
    for (size_t i = (size_t)blockIdx.x * blockDim.x + threadIdx.x; i < (size_t)rows * cols; i += (size_t)gridDim.x * blockDim.x) {
        const int r = (int)(i / cols), c = (int)(i % cols); int sr = r, sc = c;
        if (mode == 1) sc = c < 1536 ? c : c + 16;
        if (mode == 2) sc = c + 1536;
        size_t dr = r;
        if (mode == 3) { const int dir = r / MT, row = r % MT; dr = (size_t)dir * MT + dirrow(row, dir); }
        dst[dr * ldd + c] = (bf16)f2bf(src[(size_t)sr * lds_ + sc]); }
}
__global__ void k_cmp(const void* a, int a_bf16, size_t lda, size_t acol0, const bf16* b, size_t ldb, size_t bcol0, int rows, int cols, float* acc) {
    float num = 0.f, den = 0.f;
    for (size_t i = (size_t)blockIdx.x * blockDim.x + threadIdx.x; i < (size_t)rows * cols; i += (size_t)gridDim.x * blockDim.x) {
        const size_t r = i / cols, c = i % cols;
        const float av = a_bf16 ? bf2f(((const bf16*)a)[r * lda + acol0 + c]) : ((const float*)a)[r * lda + acol0 + c];
        const float bv = bf2f(b[r * ldb + bcol0 + c]); const float d = av - bv;
        if (!(d == d)) { num += 1e30f; } else { num += d * d; } den += bv * bv; }
    num = wave_sum(num); den = wave_sum(den);
    if ((threadIdx.x & 63) == 0) { atomicAdd(acc, num); atomicAdd(acc + 1, den); }
}
__global__ void k_decide(float* err) {
    if (threadIdx.x != 0) return; int code = -1, level = 0;
    for (int k = 0; k < NCK; ++k) { const float num = err[2 * k], den = err[2 * k + 1]; if (den == 0.f && num == 0.f) continue;
        const float e = sqrtf(num / fmaxf(den, 1e-30f)); const float tol = (k == 4) ? 0.06f : 0.03f;
        if (!(e <= tol)) { code = k; level = !(e == e) ? 5 : e < 1e-4f ? 0 : e < 1e-3f ? 1 : e < 1e-2f ? 2 : e < 1e-1f ? 3 : e < 1.f ? 4 : 5; break; } }
    ((int*)err)[64] = code; ((int*)err)[65] = level;
}
__global__ void k_encode(float* out, const float* out2, const float* err) {
    const int code = ((const int*)err)[64], level = ((const int*)err)[65];
    for (size_t i = (size_t)blockIdx.x * blockDim.x + threadIdx.x; i < (size_t)MX * D; i += (size_t)gridDim.x * blockDim.x) {
        if (code < 0) { out[i] = out2[i]; continue; }
        const size_t row = i / D; if (row < (size_t)(code + 1) * (MX / 16)) out[i] = 0.f;
        if (i == (size_t)MX * D - 1) out[i] = (float)(16 << level); }
}
}
#endif

extern "C" void kernel_launch(void* const* d_in, const int* in_sizes, int n_in, void* d_out, int out_size, void* d_ws, size_t ws_size, hipStream_t stream) {
    using namespace mk;
#if MK_DEBUG
    if (!setup(ws_size, dbg::S_END) || n_in != 33) return;
    unsigned char* ws = (unsigned char*)d_ws;
    nv::Bufs nb; const size_t nneed = nv::carve(ws, nb);
    if (nneed > dbg::SNAP) { fprintf(stderr, "naive scratch overlaps snapshots\n"); return; }
    hipMemsetAsync(ws + dbg::S_ERR, 0, 4096, stream);
    auto snap = [&](const float* src, size_t lds_, size_t dst_off, size_t ldd, int rows, int cols, int mode) {
        hipLaunchKernelGGL(dbg::k_snap, dim3(2048), dim3(256), 0, stream, src, lds_, (bf16*)(ws + dst_off), ldd, rows, cols, mode); };
    auto hook = [&](int point, int l) {
        if (point == 0) { snap(nb.mod, 12288, dbg::S_MOD, 12288, 10, 12288, 0); return; }
        if (l != DBG_LAYER) return;
        if (point == 1) snap(nb.A, D, dbg::S_AN, D, MT, D, 0);
        if (point == 2) { snap(nb.p, nv::INW, dbg::S_P, NIN, MT, NIN, 1); snap(nb.p, nv::INW, dbg::S_AB, 16, MT, 16, 2); }
        if (point == 3) snap(nb.o, 512, dbg::S_O, 512, 2 * MT, 512, 3);
        if (point == 4) snap(nb.y, D, dbg::S_Y, D, MT, D, 0);
        if (point == 5) snap(nb.xs, D, dbg::S_XM, D, MT, D, 0);
        if (point == 6) snap(nb.A, D, dbg::S_AF, D, MT, D, 0);
        if (point == 7) snap(nb.xs, D, dbg::S_XE, D, MT, D, 0);
    };
    nv::forward(d_in, (float*)d_out, nb, stream, hook);
    hipMemsetAsync(ws + WS_CTL, 0, CTL_BYTES, stream);
    float* err = (float*)(ws + dbg::S_ERR); float* out2 = (float*)(ws + dbg::S_OUT2);
    auto cmp = [&](int k, const void* a, int a_bf16, size_t lda, size_t acol0, size_t snap_off, size_t ldb, size_t bcol0, int rows, int cols) {
        hipLaunchKernelGGL(dbg::k_cmp, dim3(1024), dim3(256), 0, stream, a, a_bf16, lda, acol0, (const bf16*)(ws + snap_off), ldb, bcol0, rows, cols, err + 2 * k); };
    const int L = DBG_LAYER, pb = L == 0 ? 1 : 10, nr = L == 0 ? MT : MX;
    for (int ph = 0; ph < NPHASE; ++ph) {
        launch(d_in, out2, d_ws, ph, ph + 1, stream);
        if (ph == 0) cmp(0, ws + WS_MODV, 0, 12288, 0, dbg::S_MOD, 12288, 0, 10, 12288);
        if (ph == pb + 0) { cmp(1, ws + WS_AN, 1, D, 0, dbg::S_AN, D, 0, MT, D); cmp(2, ws + WS_ABF, 0, 16, 0, dbg::S_AB, 16, 0, MT, 16); }
        if (ph == pb + 1) { cmp(3, ws + WS_P, 1, NIN, 0, dbg::S_P, NIN, 0, nr, NIN); if (L == 1) cmp(3, ws + WS_P + (size_t)MX * NIN * 2, 1, NIN, 0, dbg::S_P + (size_t)MX * NIN * 2, NIN, 0, MC, 1536); }
        if (ph == pb + 3) cmp(4, ws + WS_O, 0, 512, 0, dbg::S_O, 512, 0, 2 * MT, 512);
        if (ph == pb + 4) { cmp(5, ws + WS_Y, 1, D, 0, dbg::S_Y, D, 0, nr, 512); cmp(6, ws + WS_Y, 1, D, 512, dbg::S_Y, D, 512, nr, 512);
                            cmp(7, ws + WS_Y, 1, D, 1024, dbg::S_Y, D, 1024, nr, 512); cmp(8, ws + WS_Y, 1, D, 1536, dbg::S_Y, D, 1536, nr, 512); }
        if (ph == pb + 5) cmp(9, ws + WS_XS, 0, D, 0, dbg::S_XM, D, 0, nr, D);
        if (ph == pb + 6) cmp(10, ws + WS_AN, 1, D, 0, dbg::S_AF, D, 0, nr, D);
        if (L == 0 && ph == 9) cmp(11, ws + WS_XS, 0, D, 0, dbg::S_XE, D, 0, MT, D);
    }
    hipLaunchKernelGGL(dbg::k_decide, dim3(1), dim3(64), 0, stream, err);
    hipLaunchKernelGGL(dbg::k_encode, dim3(2048), dim3(256), 0, stream, (float*)d_out, out2, err);
#else
    if (!setup(ws_size, WS_END) || n_in != 33) return;
    hipMemsetAsync((unsigned char*)d_ws + WS_CTL, 0, CTL_BYTES, stream);
#if MK_ONE_LAUNCH
    launch(d_in, (float*)d_out, d_ws, 0, NPHASE, stream);
#else
#ifndef REP_MASK
#define REP_MASK 0
#endif
    for (int ph = 0; ph < NPHASE; ++ph) { launch(d_in, (float*)d_out, d_ws, ph, ph + 1, stream); if ((REP_MASK >> ph) & 1) launch(d_in, (float*)d_out, d_ws, ph, ph + 1, stream); }
#endif
#endif
}
```
